# Optimizing an MI355X kernel written in HIP

```python
import math
import jax
import jax.numpy as jnp
from jax import lax
import numpy as np

D_MODEL = 2048
BATCH = 32
SEQ = 256
DEPTH = 4
DEC_BATCH = 8
DEC_SEQ = 2048
PAST_LEN = 512

GRID_W = 64
N_MIXERS = 3
N_HEADS = 16
KV_HEADS = 4
HEAD_DIM = 128
GROUP = N_HEADS // KV_HEADS
NQ = N_HEADS * HEAD_DIM
NKV = KV_HEADS * HEAD_DIM
WINDOW = 128
Q_BLOCK = 128
BAND = Q_BLOCK + 2 * WINDOW
DIFF_HEADS = 8
DIFF_KV_HEADS = 2
DIFF_GROUP = DIFF_HEADS // DIFF_KV_HEADS
DIFF_DIM = 128
NQD = DIFF_HEADS * 2 * DIFF_DIM
NKD = DIFF_KV_HEADS * 2 * DIFF_DIM
D_FF = -(-8 * D_MODEL // (3 * 256)) * 256
ROPE_THETA = 10000.0
EPS = 1e-6
NEG_INF = -1e30
N_FULL = (DEPTH - 0 + N_MIXERS - 1) // N_MIXERS
N_WIN = (DEPTH - 1 + N_MIXERS - 1) // N_MIXERS
N_DIFF = (DEPTH - 2 + N_MIXERS - 1) // N_MIXERS

kernel_name = 'hybrid_diffusion_prefix_trunk_step'


def rms_norm(x, g):
    xf = x.astype(jnp.float32)
    y = xf * lax.rsqrt(jnp.mean(xf * xf, axis=-1, keepdims=True) + EPS)
    return (y * g.astype(jnp.float32)).astype(x.dtype)


def grid_positions(n_tokens):
    n_rows = n_tokens // GRID_W
    rows = jnp.repeat(jnp.arange(n_rows, dtype=jnp.int32), GRID_W)
    cols = jnp.tile(jnp.arange(GRID_W, dtype=jnp.int32), n_rows)
    return rows, cols


def rope_2d(x, rows, cols):
    hd = x.shape[-1]
    half = hd // 2
    nf = half // 2
    inv = 1.0 / (ROPE_THETA ** (jnp.arange(nf, dtype=jnp.float32) / nf))
    bshape = (1, x.shape[1]) + (1,) * (x.ndim - 3) + (nf,)
    xf = x.astype(jnp.float32)

    def rot(xh, pos):
        ang = (pos.astype(jnp.float32)[:, None] * inv).reshape(bshape)
        cos, sin = jnp.cos(ang), jnp.sin(ang)
        x1, x2 = xh[..., :nf], xh[..., nf:]
        return jnp.concatenate([x1 * cos - x2 * sin, x1 * sin + x2 * cos], axis=-1)

    out = jnp.concatenate([rot(xf[..., :half], rows), rot(xf[..., half:], cols)], axis=-1)
    return out.astype(x.dtype)


def sweep_query_blocks(fn, q):
    b, s = q.shape[:2]
    nb = s // Q_BLOCK
    qb = jnp.moveaxis(q.reshape((b, nb, Q_BLOCK) + q.shape[2:]), 1, 0)
    out = lax.map(lambda a: fn(a[0], a[1]), (jnp.arange(nb), qb))
    return jnp.moveaxis(out, 0, 1).reshape((b, s) + out.shape[3:])


def gqa_softmax(qb, keys, vals, mask=None, sink=None):
    s = jnp.einsum('bqhgd,bkhd->bhgqk', qb, keys).astype(jnp.float32) * (qb.shape[-1] ** -0.5)
    if mask is not None:
        s = jnp.where(mask, s, NEG_INF)
    if sink is not None:
        sk = jnp.broadcast_to(sink.astype(jnp.float32).reshape(1, s.shape[1], s.shape[2], 1, 1), s.shape[:-1] + (1,))
        p = jax.nn.softmax(jnp.concatenate([s, sk], axis=-1), axis=-1)[..., :-1]
    else:
        p = jax.nn.softmax(s, axis=-1)
    return jnp.einsum('bhgqk,bkhd->bqhgd', p.astype(vals.dtype), vals)


def full_mixer(h, ctx_kv, pos, w_qkv, w_o, g_q, g_k):
    b, s, _ = h.shape
    q, k, v = jnp.split(h @ w_qkv, [NQ, NQ + NKV], axis=-1)
    q = rms_norm(q.reshape(b, s, N_HEADS, HEAD_DIM), g_q)
    k = rms_norm(k.reshape(b, s, KV_HEADS, HEAD_DIM), g_k)
    v = v.reshape(b, s, KV_HEADS, HEAD_DIM)
    if pos is None:
        keys, vals = k, v
    else:
        q = rope_2d(q, *pos)
        k = rope_2d(k, *pos)
        keys = jnp.concatenate([k, ctx_kv[0]], axis=1)
        vals = jnp.concatenate([v, ctx_kv[1]], axis=1)
    q5 = q.reshape(b, s, KV_HEADS, GROUP, HEAD_DIM)
    o = sweep_query_blocks(lambda i, qb: gqa_softmax(qb, keys, vals), q5)
    return o.reshape(b, s, NQ) @ w_o, k, v


def window_mixer(h, ctx_kv, pos, w_qkv, w_o, sink):
    b, s, _ = h.shape
    q, k, v = jnp.split(h @ w_qkv, [NQ, NQ + NKV], axis=-1)
    q = q.reshape(b, s, N_HEADS, HEAD_DIM)
    k = k.reshape(b, s, KV_HEADS, HEAD_DIM)
    v = v.reshape(b, s, KV_HEADS, HEAD_DIM)
    if pos is None:
        q5 = q.reshape(b, s, KV_HEADS, GROUP, HEAD_DIM)
        o = sweep_query_blocks(lambda i, qb: gqa_softmax(qb, k, v, sink=sink), q5)
    else:
        q = rope_2d(q, *pos)
        k = rope_2d(k, *pos)
        q5 = q.reshape(b, s, KV_HEADS, GROUP, HEAD_DIM)
        kc, vc = ctx_kv
        n_ctx = kc.shape[1]
        padw = ((0, 0), (WINDOW, WINDOW), (0, 0), (0, 0))
        kp, vp = jnp.pad(k, padw), jnp.pad(v, padw)

        def blk(i, qb):
            start = i * Q_BLOCK
            kb = lax.dynamic_slice_in_dim(kp, start, BAND, axis=1)
            vb = lax.dynamic_slice_in_dim(vp, start, BAND, axis=1)
            qpos = start + jnp.arange(Q_BLOCK)
            kpos = start - WINDOW + jnp.arange(BAND)
            band = (jnp.abs(qpos[:, None] - kpos[None, :]) <= WINDOW) & (kpos >= 0)[None, :] & (kpos < s)[None, :]
            mask = jnp.concatenate([band, jnp.ones((Q_BLOCK, n_ctx), dtype=bool)], axis=1)
            return gqa_softmax(qb, jnp.concatenate([kb, kc], axis=1), jnp.concatenate([vb, vc], axis=1), mask, sink)

        o = sweep_query_blocks(blk, q5)
    return o.reshape(b, s, NQ) @ w_o, k, v


def diff_lambda_init(layer):
    return 0.8 - 0.6 * math.exp(-0.3 * layer)


def diff_mixer(h, ctx_kv, pos, w_qkv, w_o, lam_q1, lam_k1, lam_q2, lam_k2, g_subln, lam_init):
    b, s, _ = h.shape
    q, k, v = jnp.split(h @ w_qkv, [NQD, NQD + NKD], axis=-1)
    q = q.reshape(b, s, DIFF_HEADS, 2, DIFF_DIM)
    k = k.reshape(b, s, DIFF_KV_HEADS, 2, DIFF_DIM)
    v = v.reshape(b, s, DIFF_KV_HEADS, 2 * DIFF_DIM)
    if pos is None:
        keys, vals = k, v
    else:
        q = rope_2d(q, *pos)
        k = rope_2d(k, *pos)
        keys = jnp.concatenate([k, ctx_kv[0]], axis=1)
        vals = jnp.concatenate([v, ctx_kv[1]], axis=1)
    lam = (jnp.exp(jnp.sum(lam_q1.astype(jnp.float32) * lam_k1.astype(jnp.float32)))
           - jnp.exp(jnp.sum(lam_q2.astype(jnp.float32) * lam_k2.astype(jnp.float32))) + lam_init)
    q6 = q.reshape(b, s, DIFF_KV_HEADS, DIFF_GROUP, 2, DIFF_DIM)

    def blk(i, qb):
        sc = jnp.einsum('bqhgmd,bkhmd->bhgmqk', qb, keys).astype(jnp.float32) * (DIFF_DIM ** -0.5)
        p = jax.nn.softmax(sc, axis=-1)
        w = p[:, :, :, 0] - lam * p[:, :, :, 1]
        return jnp.einsum('bhgqk,bkhe->bqhge', w.astype(vals.dtype), vals)

    o = sweep_query_blocks(blk, q6)
    o = rms_norm(o, g_subln) * (1.0 - lam_init)
    return o.reshape(b, s, NQD) @ w_o, k, v


def swiglu(h, w_gate, w_up, w_down):
    return (jax.nn.silu(h @ w_gate) * (h @ w_up)) @ w_down


def run_trunk(x, cond, caches, pos, p):
    ctx_mode = caches is None
    kept = ([], [], [], [], [], [])
    for layer in range(DEPTH):
        kind, slot = layer % N_MIXERS, layer // N_MIXERS
        mod = jax.nn.silu(cond) @ p['w_ada'][layer] + p['b_ada'][layer]
        sh1, sc1, gt1, sh2, sc2, gt2 = [m[:, None, :] for m in jnp.split(mod, 6, axis=-1)]
        g = p['g_norm'][layer]
        h = rms_norm(x, g[0]) * (1.0 + sc1) + sh1
        ctx_kv = None if ctx_mode else (caches[2 * kind][:, slot], caches[2 * kind + 1][:, slot])
        if kind == 0:
            m, k, v = full_mixer(h, ctx_kv, pos, p['w_qkv_full'][slot], p['w_o_full'][slot],
                                 p['g_q_full'][slot], p['g_k_full'][slot])
        elif kind == 1:
            m, k, v = window_mixer(h, ctx_kv, pos, p['w_qkv_win'][slot], p['w_o_win'][slot], p['sink_win'][slot])
        else:
            m, k, v = diff_mixer(h, ctx_kv, pos, p['w_qkv_diff'][slot], p['w_o_diff'][slot],
                                 p['lam_q1'][slot], p['lam_k1'][slot], p['lam_q2'][slot], p['lam_k2'][slot],
                                 p['g_subln_diff'][slot], diff_lambda_init(layer))
        if ctx_mode:
            kept[2 * kind].append(k)
            kept[2 * kind + 1].append(v)
        x = x + gt1 * rms_norm(m, g[1])
        h = rms_norm(x, g[2]) * (1.0 + sc2) + sh2
        x = x + gt2 * rms_norm(swiglu(h, p['w_gate'][layer], p['w_up'][layer], p['w_down'][layer]), g[3])
    new_state = [jnp.stack(a, axis=1) for a in kept] if ctx_mode else None
    return x, new_state


def setup_inputs(seed: int = 0) -> dict:
    key = jax.random.key(seed)
    ks = iter(jax.random.split(key, 40))

    def nrm(shape, scale):
        return scale * jax.random.normal(next(ks), shape, jnp.float32)

    d = D_MODEL
    return {
        'x_prompt': nrm((BATCH, SEQ, d), 1.0),
        'x_sample': nrm((DEC_BATCH, DEC_SEQ, d), 1.0),
        'c': nrm((DEC_BATCH, d), 1.0),
        'cache_k_full': nrm((DEC_BATCH, N_FULL, PAST_LEN, KV_HEADS, HEAD_DIM), 1.0),
        'cache_v_full': nrm((DEC_BATCH, N_FULL, PAST_LEN, KV_HEADS, HEAD_DIM), 1.0),
        'cache_k_win': nrm((DEC_BATCH, N_WIN, PAST_LEN, KV_HEADS, HEAD_DIM), 1.0),
        'cache_v_win': nrm((DEC_BATCH, N_WIN, PAST_LEN, KV_HEADS, HEAD_DIM), 1.0),
        'cache_k_diff': nrm((DEC_BATCH, N_DIFF, PAST_LEN, DIFF_KV_HEADS, 2, DIFF_DIM), 1.0),
        'cache_v_diff': nrm((DEC_BATCH, N_DIFF, PAST_LEN, DIFF_KV_HEADS, 2 * DIFF_DIM), 1.0),
        'c_ctx': nrm((d,), 1.0),
        'w_ada': nrm((DEPTH, d, 6 * d), 0.5 * d ** -0.5),
        'b_ada': nrm((DEPTH, 6 * d), 0.01),
        'g_norm': 1.0 + nrm((DEPTH, 4, d), 0.02),
        'w_qkv_full': nrm((N_FULL, d, NQ + 2 * NKV), d ** -0.5),
        'w_o_full': nrm((N_FULL, NQ, d), NQ ** -0.5),
        'g_q_full': 1.0 + nrm((N_FULL, HEAD_DIM), 0.02),
        'g_k_full': 1.0 + nrm((N_FULL, HEAD_DIM), 0.02),
        'w_qkv_win': nrm((N_WIN, d, NQ + 2 * NKV), d ** -0.5),
        'w_o_win': nrm((N_WIN, NQ, d), NQ ** -0.5),
        'sink_win': nrm((N_WIN, N_HEADS), 0.5),
        'w_qkv_diff': nrm((N_DIFF, d, NQD + 2 * NKD), d ** -0.5),
        'w_o_diff': nrm((N_DIFF, NQD, d), NQD ** -0.5),
        'lam_q1': nrm((N_DIFF, DIFF_DIM), 0.1),
        'lam_k1': nrm((N_DIFF, DIFF_DIM), 0.1),
        'lam_q2': nrm((N_DIFF, DIFF_DIM), 0.1),
        'lam_k2': nrm((N_DIFF, DIFF_DIM), 0.1),
        'g_subln_diff': 1.0 + nrm((N_DIFF, 2 * DIFF_DIM), 0.02),
        'w_gate': nrm((DEPTH, d, D_FF), d ** -0.5),
        'w_up': nrm((DEPTH, d, D_FF), d ** -0.5),
        'w_down': nrm((DEPTH, D_FF, d), D_FF ** -0.5),
    }


def reference(x_prompt, x_sample, c, cache_k_full, cache_v_full, cache_k_win, cache_v_win,
              cache_k_diff, cache_v_diff, c_ctx, w_ada, b_ada, g_norm, w_qkv_full, w_o_full,
              g_q_full, g_k_full, w_qkv_win, w_o_win, sink_win, w_qkv_diff, w_o_diff,
              lam_q1, lam_k1, lam_q2, lam_k2, g_subln_diff, w_gate, w_up, w_down):
    p = {'w_ada': w_ada, 'b_ada': b_ada, 'g_norm': g_norm,
         'w_qkv_full': w_qkv_full, 'w_o_full': w_o_full, 'g_q_full': g_q_full, 'g_k_full': g_k_full,
         'w_qkv_win': w_qkv_win, 'w_o_win': w_o_win, 'sink_win': sink_win,
         'w_qkv_diff': w_qkv_diff, 'w_o_diff': w_o_diff, 'lam_q1': lam_q1, 'lam_k1': lam_k1,
         'lam_q2': lam_q2, 'lam_k2': lam_k2, 'g_subln_diff': g_subln_diff,
         'w_gate': w_gate, 'w_up': w_up, 'w_down': w_down}
    y_prompt, ns = run_trunk(x_prompt, c_ctx[None, :], None, None, p)
    caches = (cache_k_full, cache_v_full, cache_k_win, cache_v_win, cache_k_diff, cache_v_diff)
    pos = grid_positions(x_sample.shape[1])
    y_sample, _ = run_trunk(x_sample, c, caches, pos, p)
    return (y_prompt, y_sample, ns[0], ns[1], ns[2], ns[3], ns[4], ns[5])
```

```cpp
#include <hip/hip_runtime.h>
#include <cstdio>
#include <cstdint>
namespace pg8 {
#define PG8_LAS __attribute__((address_space(3)))
typedef unsigned short bf16_t;
typedef short bf16x8 __attribute__((ext_vector_type(8)));
typedef float f32x4 __attribute__((ext_vector_type(4)));
typedef unsigned u32x4 __attribute__((ext_vector_type(4)));
constexpr int BM = 256, BK = 64, HALF = 128, HTB = HALF * BK * 2  , STAGE_BYTES = 8 * HTB, NXCD = 8, WGM = 8;

__host__ __device__ __forceinline__ int lds_byte(int r, int c) { const int st = (r >> 4) * 2 + (c >> 5), rr = r & 15, cc = c & 31, ob = rr * 64 + cc * 2; return st * 1024 + (ob ^ (((ob >> 9) & 1) << 5)); }
__host__ __device__ __forceinline__ void stage_rc(int b, int& R, int& C) { const int st = b / 1024, sb = b % 1024, swz = sb ^ (((sb >> 9) & 1) << 5); R = (st >> 1) * 16 + swz / 64; C = (st & 1) * 32 + (swz % 64) / 2; }
__host__ __device__ __forceinline__ int perm32(int rho) { const int n = rho >> 4, i = rho & 15; return 8 * (i >> 2) + 4 * n + (i & 3); }

struct Unit { int pm, pn; };
struct Gemm { const bf16_t* A; const bf16_t* Bt; int M, N, K; };

struct StaticOrder {
    int nM, nN, nwg, G, c;
    __host__ __device__ void init(int M, int N, int G_, int c_) { nM = M / BM; nN = N / BM; nwg = nM * nN; G = G_; c = c_; }
    __host__ __device__ bool next(int i, Unit& u) const {
        const long L = (long)i * G + c; if (L >= nwg) return false;
        int wgid = (int)L; { const int q = nwg / NXCD, r = nwg % NXCD, xcd = wgid % NXCD, off = wgid / NXCD; wgid = (xcd < r ? xcd * (q + 1) : r * (q + 1) + (xcd - r) * q) + off; }
        const int nig = WGM * nN, gid = wgid / nig, fm = gid * WGM, gsz = (nM - fm) < WGM ? (nM - fm) : WGM;
        u.pm = fm + ((wgid % nig) % gsz); u.pn = (wgid % nig) / gsz; return true;
    }
    __device__ __forceinline__ void a_ready(const Unit&) const {}
    __device__ __forceinline__ void done(const Unit&) const {}
};

__device__ __forceinline__ unsigned cvt_pk_bf16(float lo, float hi) { unsigned r; asm volatile("v_cvt_pk_bf16_f32 %0, %1, %2" : "=v"(r) : "v"(lo), "v"(hi)); return r; }

struct EpiStore {
    static constexpr bool PERM = true, AFTER_DRAIN = false;
    bf16_t* O; int ldc;
    __device__ __forceinline__ void operator()(const f32x4 (&acc)[2][2][4][2], const Unit& u, int wr, int wc, int fr, int fq) const {
        const int row0 = u.pm * BM + wr * 64 + fr, col0 = u.pn * BM + wc * 32 + 8 * fq;
#pragma unroll
        for (int ai = 0; ai < 2; ++ai)
#pragma unroll
            for (int m = 0; m < 4; ++m) { bf16_t* rowp = O + (size_t)(row0 + ai * HALF + m * 16) * ldc + col0;
#pragma unroll
                for (int bj = 0; bj < 2; ++bj) { const f32x4 v0 = acc[ai][bj][m][0], v1 = acc[ai][bj][m][1];
                    u32x4 w; w.x = cvt_pk_bf16(v0[0], v0[1]); w.y = cvt_pk_bf16(v0[2], v0[3]); w.z = cvt_pk_bf16(v1[0], v1[1]); w.w = cvt_pk_bf16(v1[2], v1[3]);
                    *(u32x4*)(rowp + bj * HALF) = w; } }
    }
};
struct EpiSwiglu {
    static constexpr bool PERM = true, AFTER_DRAIN = false;
    bf16_t* O; int ldc;
    __device__ __forceinline__ static float swi(float g, float u) { const float e = __builtin_amdgcn_exp2f(g * -1.4426950408889634f); return g * u * __builtin_amdgcn_rcpf(1.0f + e); }
    __device__ __forceinline__ void operator()(const f32x4 (&acc)[2][2][4][2], const Unit& u, int wr, int wc, int fr, int fq) const {
        const int row0 = u.pm * BM + wr * 64 + fr, col0 = u.pn * HALF + wc * 32 + 8 * fq;
#pragma unroll
        for (int ai = 0; ai < 2; ++ai)
#pragma unroll
            for (int m = 0; m < 4; ++m) { bf16_t* rowp = O + (size_t)(row0 + ai * HALF + m * 16) * ldc + col0;
                const f32x4 g0 = acc[ai][0][m][0], g1 = acc[ai][0][m][1], u0 = acc[ai][1][m][0], u1 = acc[ai][1][m][1];
                u32x4 w; w.x = cvt_pk_bf16(swi(g0[0], u0[0]), swi(g0[1], u0[1])); w.y = cvt_pk_bf16(swi(g0[2], u0[2]), swi(g0[3], u0[3]));
                w.z = cvt_pk_bf16(swi(g1[0], u1[0]), swi(g1[1], u1[1])); w.w = cvt_pk_bf16(swi(g1[2], u1[2]), swi(g1[3], u1[3]));
                *(u32x4*)rowp = w; }
    }
};

template <class Epi, class Sched, bool ALIGN_EPI = false, bool SP2 = false>
__device__ __forceinline__ void gemm_phase(PG8_LAS unsigned char* lds, const Gemm g, const Sched& S, const Epi& E) {
    int tid_l = threadIdx.x; asm volatile("" : "+v"(tid_l));
    const int tid = tid_l, wid = __builtin_amdgcn_readfirstlane(tid >> 6), lane = tid & 63, wr = wid >> 2, wc = wid & 3, fr = lane & 15, fq = lane >> 4;
    const int K = g.K, nt = K / BK;
    unsigned voffA[2], voffB[2];
#pragma unroll
    for (int i = 0; i < 2; ++i) { int R, C; stage_rc(tid * 16 + i * 8192, R, C); const int Rb = Epi::PERM ? ((R & ~31) + perm32(R & 31)) : R;
        voffA[i] = (unsigned)(R * K + C) * 2u; voffB[i] = (unsigned)(Rb * K + C) * 2u; }
    const size_t kstep = (size_t)(BK * 2);
    const size_t hstep = (size_t)HALF * K * 2;
    const size_t tstep = 2 * hstep;
    const unsigned ldsw = (unsigned)wid * 1024u;
    const int aoff = lds_byte(wr * 64 + fr, fq * 8), boff = lds_byte(wc * 32 + fr, fq * 8);
#define PG8_SA(b, h) (((b) * 2 + (h)) * HTB)
#define PG8_SB(b, h) ((4 + (b) * 2 + (h)) * HTB)
#define PG8_STAGE(bufoff, gbase, voff) do { _Pragma("unroll") for (int _i = 0; _i < 2; ++_i) \
        __builtin_amdgcn_global_load_lds((const unsigned*)((const char*)(gbase) + (voff)[_i]), (PG8_LAS unsigned*)(lds + (bufoff) + ldsw + _i * 8192), 16, 0, 0); } while (0)
#define PG8_LDA(dst, b, h) do { _Pragma("unroll") for (int m = 0; m < 4; ++m) _Pragma("unroll") for (int k = 0; k < 2; ++k) dst[m][k] = *(const PG8_LAS bf16x8*)(lds + PG8_SA(b, h) + aoff + m * 2048 + k * 1024); } while (0)
#define PG8_LDB(dst, b, h) do { _Pragma("unroll") for (int n = 0; n < 2; ++n) _Pragma("unroll") for (int k = 0; k < 2; ++k) dst[n][k] = *(const PG8_LAS bf16x8*)(lds + PG8_SB(b, h) + boff + n * 2048 + k * 1024); } while (0)
#define PG8_MMA(ai, bj, At, Bt) do { __builtin_amdgcn_s_setprio(1); _Pragma("unroll") for (int m = 0; m < 4; ++m) _Pragma("unroll") for (int n = 0; n < 2; ++n) _Pragma("unroll") for (int k = 0; k < 2; ++k) \
        acc[ai][bj][m][n] = __builtin_amdgcn_mfma_f32_16x16x32_bf16(Bt[n][k], At[m][k], acc[ai][bj][m][n], 0, 0, 0); __builtin_amdgcn_s_setprio(0); } while (0)
#define PG8_WAIT_V(n) asm volatile("s_waitcnt vmcnt(" #n ")" ::: "memory")
#define PG8_WAIT_L(n) asm volatile("s_waitcnt lgkmcnt(" #n ")" ::: "memory")
#define PG8_BAR __builtin_amdgcn_s_barrier()
#define PG8_SCHED __builtin_amdgcn_sched_barrier(0)
    Unit cur, nxt; int ui = 0;
    if (!S.next(0, cur)) return;
    f32x4 acc[2][2][4][2];
#pragma unroll
    for (int a = 0; a < 2; ++a)
#pragma unroll
        for (int b = 0; b < 2; ++b)
#pragma unroll
            for (int m = 0; m < 4; ++m)
#pragma unroll
                for (int n = 0; n < 2; ++n) acc[a][b][m][n] = (f32x4){0.f, 0.f, 0.f, 0.f};
    bf16x8 At[4][2], B0[2][2], B1[2][2];
    const char* cA = (const char*)g.A + (size_t)cur.pm * tstep; const char* cB = (const char*)g.Bt + (size_t)cur.pn * tstep;
    S.a_ready(cur);
    if constexpr (SP2) {
        PG8_STAGE(PG8_SB(0, 0), cB, voffB); PG8_STAGE(PG8_SB(0, 1), cB + hstep, voffB); PG8_STAGE(PG8_SA(0, 0), cA, voffA); PG8_STAGE(PG8_SA(0, 1), cA + hstep, voffA);
        if (wr == 1) PG8_BAR;
        PG8_WAIT_V(2); PG8_BAR;
        PG8_STAGE(PG8_SB(1, 0), cB + kstep, voffB); PG8_STAGE(PG8_SA(1, 0), cA + kstep, voffA); PG8_STAGE(PG8_SB(1, 1), cB + hstep + kstep, voffB);
        PG8_WAIT_V(6); PG8_BAR;
    } else {
        PG8_STAGE(PG8_SB(0, 0), cB, voffB); PG8_STAGE(PG8_SA(0, 0), cA, voffA); PG8_STAGE(PG8_SB(0, 1), cB + hstep, voffB); PG8_STAGE(PG8_SA(0, 1), cA + hstep, voffA);
        if (wr == 1) PG8_BAR;
        PG8_WAIT_V(4); PG8_BAR;
        PG8_STAGE(PG8_SB(1, 0), cB + kstep, voffB); PG8_STAGE(PG8_SA(1, 0), cA + kstep, voffA); PG8_STAGE(PG8_SB(1, 1), cB + hstep + kstep, voffB);
        PG8_WAIT_V(6); PG8_BAR;
    }
    for (;;) {
        const bool has_next = S.next(ui + 1, nxt);
        const char* nA = has_next ? (const char*)g.A + (size_t)nxt.pm * tstep : cA; const char* nB = has_next ? (const char*)g.Bt + (size_t)nxt.pn * tstep : cB;
        for (int t = 0; t < nt; t += 2) {
            const bool last = (t == nt - 2);
            const char* a1 = cA + (size_t)(t + 1) * kstep;
            const char* a2 = last ? nA : cA + (size_t)(t + 2) * kstep; const char* b2 = last ? nB : cB + (size_t)(t + 2) * kstep;
            const char* a3 = a2 + kstep; const char* b3 = b2 + kstep;
            if (last && has_next) S.a_ready(nxt);
            if constexpr (SP2) {
            PG8_LDB(B0, 0, 0); PG8_LDB(B1, 0, 1); PG8_SCHED; PG8_LDA(At, 0, 0); PG8_STAGE(PG8_SA(1, 1), a1 + hstep, voffA);
            PG8_WAIT_V(8); PG8_WAIT_L(0); PG8_BAR; PG8_MMA(0, 0, At, B0); PG8_MMA(0, 1, At, B1); PG8_BAR; PG8_SCHED;
            PG8_LDA(At, 0, 1); PG8_STAGE(PG8_SB(0, 0), b2, voffB); PG8_STAGE(PG8_SB(0, 1), b2 + hstep, voffB); PG8_STAGE(PG8_SA(0, 0), a2, voffA);
            PG8_WAIT_V(8); PG8_WAIT_L(0); PG8_BAR; PG8_MMA(1, 0, At, B0); PG8_MMA(1, 1, At, B1); PG8_BAR; PG8_SCHED;
            PG8_LDB(B0, 1, 0); PG8_LDB(B1, 1, 1); PG8_SCHED; PG8_LDA(At, 1, 0); PG8_STAGE(PG8_SA(0, 1), a2 + hstep, voffA);
            PG8_WAIT_V(8); PG8_WAIT_L(0); PG8_BAR; PG8_MMA(0, 0, At, B0); PG8_MMA(0, 1, At, B1); PG8_BAR; PG8_SCHED;
            PG8_LDA(At, 1, 1); PG8_STAGE(PG8_SB(1, 0), b3, voffB); PG8_STAGE(PG8_SB(1, 1), b3 + hstep, voffB); PG8_STAGE(PG8_SA(1, 0), a3, voffA);
            PG8_WAIT_V(8); PG8_WAIT_L(0); PG8_BAR; PG8_MMA(1, 0, At, B0); PG8_MMA(1, 1, At, B1); PG8_BAR; PG8_SCHED;
            } else {
            PG8_LDB(B0, 0, 0); PG8_SCHED; PG8_LDA(At, 0, 0); PG8_STAGE(PG8_SA(1, 1), a1 + hstep, voffA);
            PG8_WAIT_L(8); PG8_BAR; PG8_WAIT_L(0); PG8_MMA(0, 0, At, B0); PG8_BAR; PG8_SCHED;
            PG8_LDB(B1, 0, 1); PG8_STAGE(PG8_SB(0, 0), b2, voffB);
            PG8_BAR; PG8_WAIT_L(0); PG8_MMA(0, 1, At, B1); PG8_BAR;
            PG8_LDA(At, 0, 1); PG8_STAGE(PG8_SA(0, 0), a2, voffA);
            PG8_BAR; PG8_WAIT_L(0); PG8_MMA(1, 0, At, B0); PG8_BAR; PG8_SCHED;
            PG8_STAGE(PG8_SB(0, 1), b2 + hstep, voffB);
            PG8_WAIT_V(6); PG8_BAR; PG8_MMA(1, 1, At, B1); PG8_BAR;
            PG8_LDB(B0, 1, 0); PG8_SCHED; PG8_LDA(At, 1, 0); PG8_STAGE(PG8_SA(0, 1), a2 + hstep, voffA);
            PG8_WAIT_L(8); PG8_BAR; PG8_WAIT_L(0); PG8_MMA(0, 0, At, B0); PG8_BAR; PG8_SCHED;
            PG8_LDB(B1, 1, 1); PG8_STAGE(PG8_SB(1, 0), b3, voffB);
            PG8_BAR; PG8_WAIT_L(0); PG8_MMA(0, 1, At, B1); PG8_BAR;
            PG8_LDA(At, 1, 1); PG8_STAGE(PG8_SA(1, 0), a3, voffA);
            PG8_BAR; PG8_WAIT_L(0); PG8_MMA(1, 0, At, B0); PG8_BAR; PG8_SCHED;
            PG8_STAGE(PG8_SB(1, 1), b3 + hstep, voffB);
            PG8_WAIT_V(6); PG8_BAR; PG8_MMA(1, 1, At, B1); PG8_BAR;
            }
        }
        if constexpr (ALIGN_EPI) { if (wr == 0) PG8_BAR; }
        if constexpr (!Epi::AFTER_DRAIN) { E(acc, cur, wr, wc, fr, fq); S.done(cur); }
        if (!has_next) break;
#pragma unroll
        for (int a = 0; a < 2; ++a)
#pragma unroll
            for (int b = 0; b < 2; ++b)
#pragma unroll
                for (int m = 0; m < 4; ++m)
#pragma unroll
                    for (int n = 0; n < 2; ++n) acc[a][b][m][n] = (f32x4){0.f, 0.f, 0.f, 0.f};
        cur = nxt; cA = nA; cB = nB; ++ui;
        if constexpr (ALIGN_EPI) { if (wr == 1) PG8_BAR; }
    }
    PG8_WAIT_V(0);
    if constexpr (!ALIGN_EPI) { if (wr == 0) PG8_BAR; }
    PG8_BAR;
    if constexpr (Epi::AFTER_DRAIN) { E.fused(acc, cur, wr, wc, fr, fq, lds, wid, lane); S.done(cur); }
#undef PG8_SA
#undef PG8_SB
#undef PG8_STAGE
#undef PG8_LDA
#undef PG8_LDB
#undef PG8_MMA
#undef PG8_WAIT_V
#undef PG8_WAIT_L
#undef PG8_BAR
#undef PG8_SCHED
}
}

namespace att {
#define ALAS __attribute__((address_space(3)))
typedef unsigned short bf16_t;
using bf16x8 = __attribute__((ext_vector_type(8))) short;
using s16x4  = __attribute__((ext_vector_type(4))) short;
using f32x16 = __attribute__((ext_vector_type(16))) float;
using u32x4  = __attribute__((ext_vector_type(4))) unsigned;
constexpr int   D = 128, NW = 8, QBLK = 32, KVBLK = 64;
constexpr float SCALE = 0.088388347648318440f;
constexpr float THR = 8.f;
constexpr int SHM_V = KVBLK * D * 2, SHM_K = KVBLK * D * 2, SHM_ATTN = 2 * SHM_V + 2 * SHM_K + NW * 64 * 4;
#define KSWZ(row, colB) ((row) * 256 + ((colB) ^ (((row) & 7) << 4)))
#define SBAR() __builtin_amdgcn_sched_barrier(0)
__device__ __forceinline__ int crow(int r, int hi) { return (r & 3) + 8 * (r >> 2) + 4 * hi; }
__device__ __forceinline__ unsigned cvtpk(float lo, float hi) { unsigned r; asm volatile("v_cvt_pk_bf16_f32 %0, %1, %2" : "=v"(r) : "v"(lo), "v"(hi)); return r; }

__device__ __forceinline__ void partialSM(f32x16& p0, f32x16& p1, float& m_reg, float& mn, float& alpha) {
  constexpr float C = SCALE * 1.4426950408889634f;
  float pmax = p0[0];
#pragma unroll
  for (int r = 1; r < 16; ++r) pmax = fmaxf(pmax, p0[r]);
#pragma unroll
  for (int r = 0; r < 16; ++r) pmax = fmaxf(pmax, p1[r]);
  { auto rr = __builtin_amdgcn_permlane32_swap(__float_as_uint(pmax), __float_as_uint(pmax), false, false);
    pmax = fmaxf(__uint_as_float(rr[0]), __uint_as_float(rr[1])); }
  if (__builtin_expect(__all(pmax - m_reg <= THR / SCALE), 1)) { mn = m_reg; alpha = 1.f; }
  else { mn = fmaxf(m_reg, pmax); alpha = __builtin_amdgcn_exp2f((m_reg - mn) * C); m_reg = mn; }
  float mnC = -mn * C;
#pragma unroll
  for (int r = 0; r < 16; ++r) p0[r] = fmaf(p0[r], C, mnC);
#pragma unroll
  for (int r = 0; r < 16; ++r) p1[r] = fmaf(p1[r], C, mnC);
#pragma unroll
  for (int r = 0; r < 16; ++r) p0[r] = __builtin_amdgcn_exp2f(p0[r]);
}
__device__ __forceinline__ void finishSM(f32x16& p0, f32x16& p1, float alpha, float& l_reg, bf16x8& pa0, bf16x8& pa1, bf16x8& pa2, bf16x8& pa3) {
#pragma unroll
  for (int r = 0; r < 16; ++r) p1[r] = __builtin_amdgcn_exp2f(p1[r]);
  float ps = 0;
#pragma unroll
  for (int r = 0; r < 16; ++r) ps += p0[r];
#pragma unroll
  for (int r = 0; r < 16; ++r) ps += p1[r];
  { auto rr = __builtin_amdgcn_permlane32_swap(__float_as_uint(ps), __float_as_uint(ps), false, false);
    ps = __uint_as_float(rr[0]) + __uint_as_float(rr[1]); }
  l_reg = l_reg * alpha + ps;
#define PK4(P, BASE, OUT) do { unsigned a0 = cvtpk(P[BASE + 0], P[BASE + 1]), a1 = cvtpk(P[BASE + 2], P[BASE + 3]);   \
    unsigned b0 = cvtpk(P[BASE + 4], P[BASE + 5]), b1 = cvtpk(P[BASE + 6], P[BASE + 7]);                              \
    auto r0 = __builtin_amdgcn_permlane32_swap(a0, b0, false, false); auto r1 = __builtin_amdgcn_permlane32_swap(a1, b1, false, false); \
    u32x4 w = {r0[0], r1[0], r0[1], r1[1]}; OUT = *reinterpret_cast<bf16x8*>(&w); } while (0)
  PK4(p0, 0, pa0); PK4(p0, 8, pa1); PK4(p1, 0, pa2); PK4(p1, 8, pa3);
#undef PK4
}
__device__ __forceinline__ void qkt(f32x16& p0, f32x16& p1, const ALAS char* Ks, const bf16x8* qr, int r32, int hi) {
  p0 = f32x16{}; p1 = f32x16{};
#pragma unroll
  for (int d0 = 0; d0 < 8; ++d0) { int cb = (d0 * 16 + hi * 8) * 2;
    bf16x8 b0 = *reinterpret_cast<const ALAS bf16x8*>(Ks + KSWZ(r32, cb));
    bf16x8 b1 = *reinterpret_cast<const ALAS bf16x8*>(Ks + KSWZ(32 + r32, cb));
    p0 = __builtin_amdgcn_mfma_f32_32x32x16_bf16(b0, qr[d0], p0, 0, 0, 0);
    p1 = __builtin_amdgcn_mfma_f32_32x32x16_bf16(b1, qr[d0], p1, 0, 0, 0); }
}
__device__ __forceinline__ void band_mask(f32x16& p0, f32x16& p1, int dj, int hi) {
#pragma unroll
  for (int r = 0; r < 16; ++r) { const int d = dj + crow(r, hi);
    if ((unsigned)(d + 128) > 256u) p0[r] = -1e30f;
    if ((unsigned)(d + 160) > 256u) p1[r] = -1e30f; }
}
__device__ __forceinline__ int v_st(int k, int c) { const int kk = (k & ~0xC) | ((k & 4) << 1) | ((k & 8) >> 1); return ((kk >> 3) * 4 + (c >> 5)) * 512 + ((kk & 7) * 32 + (c & 31)) * 2; }
__device__ __forceinline__ int v_rd_base(int lane) { return ((lane & 3) << 3) | (((lane >> 2) & 3) << 6) | (((lane >> 4) & 1) << 5) | (((lane >> 5) & 1) << 8); }
constexpr int v_rd_off(int d0, int ks, int half) { return d0 * 512 + ks * 4096 + half * 2048; }
template <int OFF> __device__ __forceinline__ s16x4 tr_read(int vb) {
  s16x4 r; asm volatile("ds_read_b64_tr_b16 %0, %1 offset:%2" : "=&v"(r) : "v"(vb), "i"(OFF) : "memory"); return r;
}
template <int D0> __device__ __forceinline__ void pv_one(f32x16& od, int vb, bf16x8 pa0, bf16x8 pa1, bf16x8 pa2, bf16x8 pa3) {
  const s16x4 l0 = tr_read<v_rd_off(D0, 0, 0)>(vb), h0 = tr_read<v_rd_off(D0, 0, 1)>(vb), l1 = tr_read<v_rd_off(D0, 1, 0)>(vb), h1 = tr_read<v_rd_off(D0, 1, 1)>(vb);
  const s16x4 l2 = tr_read<v_rd_off(D0, 2, 0)>(vb), h2 = tr_read<v_rd_off(D0, 2, 1)>(vb), l3 = tr_read<v_rd_off(D0, 3, 0)>(vb), h3 = tr_read<v_rd_off(D0, 3, 1)>(vb);
  asm volatile("s_waitcnt lgkmcnt(0)" ::: "memory"); SBAR();
#define PK(L, H) (bf16x8){L[0], L[1], L[2], L[3], H[0], H[1], H[2], H[3]}
  od = __builtin_amdgcn_mfma_f32_32x32x16_bf16(pa0, PK(l0, h0), od, 0, 0, 0);
  od = __builtin_amdgcn_mfma_f32_32x32x16_bf16(pa1, PK(l1, h1), od, 0, 0, 0);
  od = __builtin_amdgcn_mfma_f32_32x32x16_bf16(pa2, PK(l2, h2), od, 0, 0, 0);
  od = __builtin_amdgcn_mfma_f32_32x32x16_bf16(pa3, PK(l3, h3), od, 0, 0, 0);
#undef PK
}
__device__ __forceinline__ void pv_d0(f32x16* o, int vb, bf16x8 pa0, bf16x8 pa1, bf16x8 pa2, bf16x8 pa3) {
  pv_one<0>(o[0], vb, pa0, pa1, pa2, pa3); pv_one<1>(o[1], vb, pa0, pa1, pa2, pa3); pv_one<2>(o[2], vb, pa0, pa1, pa2, pa3); pv_one<3>(o[3], vb, pa0, pa1, pa2, pa3);
}

__device__ __forceinline__ void attn_unit(const bf16_t* __restrict__ Q, const bf16_t* __restrict__ K, const bf16_t* __restrict__ V, bf16_t* __restrict__ O,
                                          int ldq, int ldk, int ldo, int nt, int nfirst, int skip, int qpos0, float sinkl2, ALAS char* lds) {
  int tid_l = threadIdx.x; asm volatile("" : "+v"(tid_l));
  const int tid = tid_l, wid = tid >> 6, lane = tid & 63, r32 = lane & 31, hi = lane >> 5;
  ALAS char* V_lds = lds; ALAS char* K_lds = lds + 2 * SHM_V;
  ALAS float* ws = (ALAS float*)(lds + 2 * SHM_V + 2 * SHM_K) + wid * 64; ALAS float* li_l = ws; ALAS float* al_l = ws + 32;
  float m_reg = -1e30f, l_reg = 0; f32x16 o[4] = {}; bf16x8 qr[8];
  const bf16_t* Qw = Q + (long)(wid * QBLK + r32) * ldq + hi * 8;
#pragma unroll
  for (int d0 = 0; d0 < 8; ++d0) qr[d0] = *reinterpret_cast<const bf16x8*>(Qw + d0 * 16);
  const int sr = tid >> 4, sc = (tid & 15) * 8, vst0 = v_st(sr, sc), vst1 = v_st(32 + sr, sc);
  const int vb0 = (int)(uintptr_t)V_lds + v_rd_base(lane);
  const long ko0 = (long)sr * ldk + sc, ko1 = ko0 + 32L * ldk;
  const int qi = qpos0 + wid * QBLK + r32;
  struct { bf16x8 vs0, vs1, ks0, ks1; } sr_[2];
#define KROW(t) ((t) * KVBLK + (((t) >= nfirst) ? skip : 0))
#define SLOAD(i, t) do { const long ro_ = (long)KROW(t) * ldk; sr_[i].vs0 = *reinterpret_cast<const bf16x8*>(V + ro_ + ko0); sr_[i].vs1 = *reinterpret_cast<const bf16x8*>(V + ro_ + ko1); \
    sr_[i].ks0 = *reinterpret_cast<const bf16x8*>(K + ro_ + ko0); sr_[i].ks1 = *reinterpret_cast<const bf16x8*>(K + ro_ + ko1); } while (0)
#define SWRITE(b, i) do { *(ALAS bf16x8*)(V_lds + (b) * SHM_V + vst0) = sr_[i].vs0;          \
    *(ALAS bf16x8*)(V_lds + (b) * SHM_V + vst1) = sr_[i].vs1; const int kc_ = sc * 2;               \
    *(ALAS bf16x8*)(K_lds + (b) * SHM_K + KSWZ(sr, kc_)) = sr_[i].ks0;                       \
    *(ALAS bf16x8*)(K_lds + (b) * SHM_K + KSWZ(32 + sr, kc_)) = sr_[i].ks1; } while (0)
#define SWAIT() asm volatile("s_waitcnt vmcnt(4)" ::: "memory")
#define RESC(a) do { if (__any((a) < 1.f)) { if (hi == 0) al_l[r32] = (a); asm volatile("s_waitcnt lgkmcnt(0)" ::: "memory"); \
    _Pragma("unroll") for (int d = 0; d < 4; ++d) _Pragma("unroll") for (int r = 0; r < 16; ++r) o[d][r] *= al_l[crow(r, hi)]; } } while (0)
#define MASK(P0, P1, t) do { if ((t) >= nfirst) band_mask(P0, P1, KROW(t) - 512 - qi, hi); } while (0)
  f32x16 pA0, pA1, pB0, pB1; float mnA, mnB, alA, alB; bf16x8 pa0, pa1, pa2, pa3; const int NT = nt;
  constexpr int SE = 0, SO = 1;
  SLOAD(SE, 0); asm volatile("s_waitcnt vmcnt(0)" ::: "memory"); SWRITE(0, SE); __syncthreads();
  qkt(pA0, pA1, K_lds, qr, r32, hi); MASK(pA0, pA1, 0); partialSM(pA0, pA1, m_reg, mnA, alA);
  SLOAD(SO, 1); if (2 < NT) SLOAD(SE, 2);
  SWAIT(); SWRITE(1, SO); __syncthreads();
  for (int j = 1; j + 1 < NT; j += 2) {
    SBAR(); qkt(pB0, pB1, K_lds + SHM_K, qr, r32, hi);
    finishSM(pA0, pA1, alA, l_reg, pa0, pa1, pa2, pa3); SBAR();
    SLOAD(SO, j + 2); SBAR();
    pv_d0(o, vb0, pa0, pa1, pa2, pa3); MASK(pB0, pB1, j); partialSM(pB0, pB1, m_reg, mnB, alB);
    __syncthreads(); SWAIT(); SWRITE(0, SE);
    RESC(alB); __syncthreads();
    SBAR(); qkt(pA0, pA1, K_lds, qr, r32, hi);
    finishSM(pB0, pB1, alB, l_reg, pa0, pa1, pa2, pa3); SBAR();
    if (j + 3 < NT) SLOAD(SE, j + 3); SBAR();
    pv_d0(o, vb0 + (int)SHM_V, pa0, pa1, pa2, pa3); MASK(pA0, pA1, j + 1); partialSM(pA0, pA1, m_reg, mnA, alA);
    __syncthreads(); SWAIT(); SWRITE(1, SO);
    RESC(alA); __syncthreads();
  }
  SBAR(); qkt(pB0, pB1, K_lds + SHM_K, qr, r32, hi);
  finishSM(pA0, pA1, alA, l_reg, pa0, pa1, pa2, pa3); SBAR();
  pv_d0(o, vb0, pa0, pa1, pa2, pa3); MASK(pB0, pB1, NT - 1); partialSM(pB0, pB1, m_reg, mnB, alB);
  __syncthreads(); RESC(alB);
  finishSM(pB0, pB1, alB, l_reg, pa0, pa1, pa2, pa3); SBAR();
  pv_d0(o, vb0 + (int)SHM_V, pa0, pa1, pa2, pa3);
  l_reg += __builtin_amdgcn_exp2f(sinkl2 - m_reg * (SCALE * 1.4426950408889634f));
  if (hi == 0) li_l[r32] = l_reg; asm volatile("s_waitcnt lgkmcnt(0)" ::: "memory");
  float rli[16];
#pragma unroll
  for (int r = 0; r < 16; ++r) rli[r] = __builtin_amdgcn_rcpf(li_l[crow(r, hi)]);
  bf16_t* Ow = O + (long)(wid * QBLK) * ldo + r32;
#pragma unroll
  for (int r = 0; r < 16; ++r) { const int orow = crow(r, hi);
#pragma unroll
    for (int d0 = 0; d0 < 4; ++d0) { const unsigned w = cvtpk(o[d0][r] * rli[r], 0.f); Ow[(long)orow * ldo + d0 * 32] = (bf16_t)(w & 0xffffu); } }
#undef KROW
#undef SLOAD
#undef SWRITE
#undef SWAIT
#undef RESC
#undef MASK
}
}
#define GAS __attribute__((address_space(1)))
#define LAS __attribute__((address_space(3)))
typedef unsigned short bf16;
typedef unsigned v4u __attribute__((ext_vector_type(4)));
typedef float f32x4 __attribute__((ext_vector_type(4)));
typedef short bf16x8 __attribute__((ext_vector_type(8)));
typedef GAS unsigned gu32;
typedef GAS unsigned long long gu64;
#define RLX_AGENT __ATOMIC_RELAXED, __HIP_MEMORY_SCOPE_AGENT
#define LDS_WAIT() asm volatile("s_waitcnt lgkmcnt(0)" ::: "memory")
#define VM_WAIT() asm volatile("s_waitcnt vmcnt(0)" ::: "memory")
__device__ __forceinline__ unsigned long long rt() { return __builtin_amdgcn_s_memrealtime(); }
__device__ __forceinline__ unsigned f2bf(float f) { unsigned u = __builtin_bit_cast(unsigned, f); return (u + 0x7fffu + ((u >> 16) & 1u)) >> 16; }
__device__ __forceinline__ unsigned pk2(float lo, float hi) { return f2bf(lo) | (f2bf(hi) << 16); }

#define XB_TMO      128
#define XB_XCNT(j)  (256  + 64 * (j))
#define XB_XSUB(j)  (1280 + 64 * (j))
#define XB_XGEN(j)  (2304 + 64 * (j))
#define XB_TOP      3328
#define XB_TOPGEN   3392
#define XCD_BAR_WORDS 3456
#define XB_SPIN_CAP (1u << 18)

__device__ __forceinline__ unsigned xb_ld(unsigned* p)              { return __hip_atomic_load(p, __ATOMIC_RELAXED, __HIP_MEMORY_SCOPE_AGENT); }
__device__ __forceinline__ unsigned xb_add(unsigned* p, unsigned v) { return __hip_atomic_fetch_add(p, v, __ATOMIC_RELAXED, __HIP_MEMORY_SCOPE_AGENT); }
__device__ __forceinline__ unsigned xb_xcc_id() { return (unsigned)__builtin_amdgcn_s_getreg((3 << 11) | 20) & 0xFu; }
#define XB_SPIN(cond, bar) do { unsigned _sp = 0; while (cond) { __builtin_amdgcn_s_sleep(1); \
    if ((++_sp & 255u) == 0u) { if (xb_ld(&(bar)[XB_TMO])) break; if (_sp > XB_SPIN_CAP) { atomicAdd(&(bar)[XB_TMO], 1u); break; } } } } while (0)

struct XcdBarrier {
    unsigned* bar; unsigned x;
    volatile LAS unsigned* st;
};

__device__ __forceinline__ XcdBarrier xcd_barrier_post(unsigned* bar, volatile LAS unsigned* st) {
    XcdBarrier b; b.bar = bar; b.x = xb_xcc_id(); b.st = st;
    if (threadIdx.x == 0) (void)xb_add(&bar[XB_XCNT(b.x)], 1u);
    return b;
}
__device__ __forceinline__ void xcd_barrier_complete(unsigned* bar, unsigned x, unsigned& nloc, unsigned& nx) {
    const unsigned G = gridDim.x * gridDim.y * gridDim.z;
    asm volatile("" : "+s"(x));
    unsigned sum, cnt, mine, sp = 0u;
    for (;;) {
        sum = 0u; cnt = 0u; mine = 0u;
#pragma unroll
        for (unsigned j = 0; j < 16; ++j) { const unsigned c = xb_ld(&bar[XB_XCNT(j)]); sum += c; cnt += (c > 0u) ? 1u : 0u; mine = (j == x) ? c : mine; }
        if (sum == G) break;
        __builtin_amdgcn_s_sleep(1);
        if ((++sp & 255u) == 0u) { if (xb_ld(&bar[XB_TMO])) break; if (sp > XB_SPIN_CAP) { atomicAdd(&bar[XB_TMO], 1u); break; } }
    }
    nloc = mine > 0u ? mine : 1u; nx = cnt > 0u ? cnt : 1u;
}

__device__ __forceinline__ void xcd_barrier(const XcdBarrier& b) {
    asm volatile("s_waitcnt vmcnt(0)" ::: "memory");
    __syncthreads();
    if (threadIdx.x == 0) {
        unsigned* bar = b.bar;
        __builtin_amdgcn_s_waitcnt(0);
        unsigned nloc = b.st[0], nx = b.st[1];
        if (nloc == 0u) { xcd_barrier_complete(bar, b.x, nloc, nx); b.st[0] = nloc; b.st[1] = nx; }
        const unsigned old = xb_add(&bar[XB_XSUB(b.x)], 1u);
        const unsigned gen = old / nloc;
        if (old + 1u == (gen + 1u) * nloc) {
            __builtin_amdgcn_fence(__ATOMIC_RELEASE, "agent");
            asm volatile("s_waitcnt vmcnt(0)" ::: "memory");
            const unsigned og = xb_add(&bar[XB_TOP], 1u);
            const unsigned tg = og / nx;
            if (og + 1u == (tg + 1u) * nx) xb_add(&bar[XB_TOPGEN], 1u);
            else XB_SPIN(xb_ld(&bar[XB_TOPGEN]) == tg, bar);
            __builtin_amdgcn_fence(__ATOMIC_ACQUIRE, "agent");
            xb_add(&bar[XB_XGEN(b.x)], 1u);
            asm volatile("s_waitcnt vmcnt(0)" ::: "memory");
        } else {
            XB_SPIN(xb_ld(&bar[XB_XGEN(b.x)]) == gen, bar);
            __builtin_amdgcn_fence(__ATOMIC_ACQUIRE, "agent");
            asm volatile("s_waitcnt vmcnt(0)" ::: "memory");
        }
    }
    __syncthreads();
}

constexpr int NWAVES = 8;
constexpr int DM = 2048, TP = 8192, TS = 16384, TT = TP + TS;
constexpr int SP = 256, SS = 2048, PAST = 512, SKV = PAST + SS;
constexpr int NQKV = 3072, KVW = 512, FF = 5632, NGU = 2 * FF;
constexpr float EPS = 1e-6f;
constexpr float LAM_INIT2 = 0.47071301834358414f;
enum { I_XP = 0, I_XS, I_C, I_CKF, I_CVF, I_CKW, I_CVW, I_CKD, I_CVD, I_CCTX, I_WADA, I_BADA, I_GNORM, I_WQKVF, I_WOF, I_GQF, I_GKF, I_WQKVW, I_WOW, I_SINKW,
       I_WQKVD, I_WOD, I_LQ1, I_LK1, I_LQ2, I_LK2, I_GSUB, I_WG, I_WU, I_WD, N_IN };
constexpr size_t O_YP = 0, O_YS = (size_t)TP * DM, O_KF = (size_t)TT * DM, O_VF = O_KF + (size_t)32 * 2 * SP * KVW, O_KW = O_VF + (size_t)32 * 2 * SP * KVW,
                 O_VW = O_KW + (size_t)32 * SP * KVW, O_KD = O_VW + (size_t)32 * SP * KVW, O_VD = O_KD + (size_t)32 * SP * KVW, O_END = O_VD + (size_t)32 * SP * KVW;
static_assert(O_END == 83886080, "output size");
constexpr size_t MiB = 1u << 20;
constexpr size_t WS_CTL = 0, CTL_ZERO_BYTES = 1 * MiB;
constexpr size_t WS_ROPE = 1 * MiB;
constexpr size_t WS_VEC = 2 * MiB;
constexpr size_t WS_PART = 4 * MiB;
constexpr size_t WS_W = 20 * MiB, W_LAYER = 86 * MiB, W_QKV = 0, W_O = 12 * MiB, W_GU = 20 * MiB, W_D = 64 * MiB;
constexpr size_t WS_KC = 364 * MiB, WS_VC = 384 * MiB, WS_KP = 404 * MiB, WS_VP = 412 * MiB;
constexpr size_t WS_H = 420 * MiB, WS_MF = 516 * MiB;
constexpr size_t WS_ACT = 612 * MiB;
constexpr size_t WS_RAW = WS_ACT, WS_ATT = WS_ACT + 144 * MiB, WS_END = 876 * MiB;
static_assert(WS_W + 4 * W_LAYER == WS_KC && WS_ATT + (size_t)TT * DM * 2 <= WS_END && WS_ACT + (size_t)TT * FF * 2 <= WS_END && WS_MF + (size_t)TT * DM * 2 == WS_ACT, "ws map");
constexpr int CW_BAR = 4096;
constexpr int RING_BYTES = 131072, LDSCTL_OFF = RING_BYTES, MISC_OFF = LDSCTL_OFF + 320, LDS_BYTES = 147456;

typedef unsigned v2u __attribute__((ext_vector_type(2)));

__device__ __forceinline__ float wave_sum(float v) {
#pragma unroll
    for (int o = 1; o < 64; o <<= 1) v += __shfl_xor(v, o);
    return v;
}
__device__ __forceinline__ float bf2f(unsigned h) { return __uint_as_float(h << 16); }
__device__ __forceinline__ unsigned pkbf(float lo, float hi) { unsigned r; asm volatile("v_cvt_pk_bf16_f32 %0, %1, %2" : "=v"(r) : "v"(lo), "v"(hi)); return r; }

__device__ __forceinline__ void transpose_item(const float* __restrict__ W, int K, int N, bf16* __restrict__ WT, int k0, int n0, int drow0, LAS float* scr, int lane) {
#pragma unroll 8
    for (int i = 0; i < 32; ++i) { const int kk = 2 * i + (lane >> 5); scr[kk * 33 + (lane & 31)] = W[(size_t)(k0 + kk) * N + n0 + (lane & 31)]; }
    LDS_WAIT(); asm volatile("" ::: "memory");
    const int c = lane & 7;
#pragma unroll
    for (int j = 0; j < 4; ++j) { const int n = (lane >> 3) + 8 * j; const LAS float* s = scr + (8 * c) * 33 + n;
        v4u o; o.x = pkbf(s[0 * 33], s[1 * 33]); o.y = pkbf(s[2 * 33], s[3 * 33]); o.z = pkbf(s[4 * 33], s[5 * 33]); o.w = pkbf(s[6 * 33], s[7 * 33]);
        *(v4u*)(WT + (size_t)(drow0 + n) * K + k0 + 8 * c) = o; }
    LDS_WAIT(); asm volatile("" ::: "memory");
}

struct Args { const float* in[N_IN]; float* out; unsigned char* ws; };

typedef const float* cfp;
#define KAS __attribute__((address_space(4)))
__device__ __forceinline__ const KAS cfp* kargs() { const KAS cfp* p = (const KAS cfp*)__builtin_amdgcn_kernarg_segment_ptr(); asm volatile("" : "+s"(p)); return p; }
#define PHASE_ENV \
    const KAS cfp* const ka = kargs(); unsigned char* const ws = (unsigned char*)ka[N_IN + 1]; float* const out = (float*)ka[N_IN]; (void)out; \
    int tid_ = threadIdx.x; asm volatile("" : "+v"(tid_)); const int tid = tid_, lane = tid & 63, wave = __builtin_amdgcn_readfirstlane(tid >> 6); \
    const int G = gridDim.x, bx = blockIdx.x, vcu = (G % 8 == 0) ? (bx % 8) * (G / 8) + bx / 8 : bx, gw = vcu * NWAVES + wave, NGW = G * NWAVES; \
    (void)tid; (void)lane; (void)wave; (void)gw; (void)NGW; (void)vcu; \
    float* const ropeC = (float*)(ws + WS_ROPE); float* const ropeS = ropeC + 64 * 32; float* const VEC = (float*)(ws + WS_VEC); float* const PART = (float*)(ws + WS_PART); \
    bf16* const KC = (bf16*)(ws + WS_KC); bf16* const VC = (bf16*)(ws + WS_VC); bf16* const KP = (bf16*)(ws + WS_KP); bf16* const VP = (bf16*)(ws + WS_VP); \
    bf16* const H = (bf16*)(ws + WS_H); bf16* const MF = (bf16*)(ws + WS_MF); bf16* const ACT = (bf16*)(ws + WS_ACT); \
    bf16* const RAW = (bf16*)(ws + WS_RAW); bf16* const ATT = (bf16*)(ws + WS_ATT); bf16* const ADIF = (bf16*)(ws + WS_H); \
    (void)ropeC; (void)ropeS; (void)VEC; (void)PART; (void)KC; (void)VC; (void)KP; (void)VP; (void)H; (void)MF; (void)ACT; (void)RAW; (void)ATT; (void)ADIF;
#define IN(i) (ka[i])

__global__ void __launch_bounds__(NWAVES * 64, 2) trunk_fwd(Args args) {
    extern __shared__ __attribute__((aligned(16))) unsigned char lds_raw[];
    LAS unsigned char* const lds = (LAS unsigned char*)lds_raw;
    XcdBarrier bar;
    {
        volatile LAS unsigned* MISC = (volatile LAS unsigned*)(lds + MISC_OFF);
        for (int u = threadIdx.x; u < (LDS_BYTES - LDSCTL_OFF) / 4; u += NWAVES * 64) ((LAS unsigned*)(lds + LDSCTL_OFF))[u] = 0u;
        __syncthreads();
        bar = xcd_barrier_post((unsigned*)(args.ws + WS_CTL) + CW_BAR, MISC + 8);
    }

    {
        PHASE_ENV
        LAS float* sl = (LAS float*)lds;
        for (int i = tid; i < 9 * DM; i += NWAVES * 64) { const int r = i >> 11, k = i & (DM - 1);
            const float cv = (r == 0) ? IN(I_CCTX)[k] : IN(I_C)[(r - 1) * DM + k]; sl[i] = cv / (1.0f + expf(-cv)); }
        __syncthreads();
        for (int t = gw; t < 2048; t += NGW) {
            const int l = t >> 9, cc = (t >> 3) & 63, kc = t & 7;
            if (lane < 48) {
                const float* Wp = IN(I_WADA) + ((size_t)l * DM + kc * 256) * (6 * DM) + cc * 192 + lane * 4;
                const LAS float* sp = sl + kc * 256;
                f32x4 acc[9];
#pragma unroll
                for (int r = 0; r < 9; ++r) acc[r] = (f32x4){0.f, 0.f, 0.f, 0.f};
#pragma unroll 4
                for (int k = 0; k < 256; ++k) { const f32x4 w = *(const f32x4*)(Wp + (size_t)k * (6 * DM));
#pragma unroll
                    for (int r = 0; r < 9; ++r) acc[r] += w * sp[r * DM + k]; }
#pragma unroll
                for (int r = 0; r < 9; ++r) *(f32x4*)(PART + ((size_t)((kc * 4 + l) * 9 + r)) * (6 * DM) + cc * 192 + lane * 4) = acc[r];
            }
        }
        __syncthreads();
        LAS float* scr = (LAS float*)(lds + wave * 16384);
        constexpr int IT_QKV = 32 * 96, IT_O = 32 * 64, IT_G = 32 * 176, IT_D = 88 * 64, IT_LAYER = IT_QKV + IT_O + 2 * IT_G + IT_D;
        for (int it = gw; it < 4 * IT_LAYER; it += NGW) {
            const int l = it / IT_LAYER; int r = it - l * IT_LAYER; const int kind = l % 3, slot = l / 3;
            unsigned char* wl = ws + WS_W + (size_t)l * W_LAYER;
            if (r < IT_QKV) { const float* W = (kind == 0 ? IN(I_WQKVF) + (size_t)slot * DM * NQKV : kind == 1 ? IN(I_WQKVW) : IN(I_WQKVD));
                const int kb = r / 96, nb = r % 96; transpose_item(W, DM, NQKV, (bf16*)(wl + W_QKV), 64 * kb, 32 * nb, 32 * nb, scr, lane); continue; } r -= IT_QKV;
            if (r < IT_O) { const float* W = (kind == 0 ? IN(I_WOF) + (size_t)slot * DM * DM : kind == 1 ? IN(I_WOW) : IN(I_WOD));
                const int kb = r / 64, nb = r % 64; transpose_item(W, DM, DM, (bf16*)(wl + W_O), 64 * kb, 32 * nb, 32 * nb, scr, lane); continue; } r -= IT_O;
            if (r < 2 * IT_G) { const int up = r >= IT_G; if (up) r -= IT_G; const float* W = IN(up ? I_WU : I_WG) + (size_t)l * DM * FF;
                const int kb = r / 176, nb = r % 176, n0 = 32 * nb; transpose_item(W, DM, FF, (bf16*)(wl + W_GU), 64 * kb, n0, (n0 >> 7) * 256 + (n0 & 127) + up * 128, scr, lane); continue; } r -= 2 * IT_G;
            { const float* W = IN(I_WD) + (size_t)l * FF * DM; const int kb = r / 64, nb = r % 64; transpose_item(W, FF, DM, (bf16*)(wl + W_D), 64 * kb, 32 * nb, 32 * nb, scr, lane); }
        }
        { const int gt = bx * (NWAVES * 64) + tid;
          if (gt < 64 * 32) { const int p = gt >> 5, i = gt & 31; double inv = 1.0; for (int q = 0; q < i; ++q) inv *= 0.7498942093324559;
            const float ang = (float)p * (float)inv; const double a = (double)ang; const double n = __builtin_rint(a * 0.6366197723675814);
            double rr = __builtin_fma(-n, 1.5707963267948966, a); rr = __builtin_fma(-n, 6.123233995736766e-17, rr);
            const double r2 = rr * rr;
            const double sn = rr * (1.0 + r2 * (-1.0 / 6 + r2 * (1.0 / 120 + r2 * (-1.0 / 5040 + r2 * (1.0 / 362880 + r2 * (-1.0 / 39916800 + r2 * (1.0 / 6227020800.0)))))));
            const double cs = 1.0 + r2 * (-0.5 + r2 * (1.0 / 24 + r2 * (-1.0 / 720 + r2 * (1.0 / 40320 + r2 * (-1.0 / 3628800 + r2 * (1.0 / 479001600.0))))));
            const int q4 = ((int)n) & 3; const double s_ = (q4 == 0) ? sn : (q4 == 1) ? cs : (q4 == 2) ? -sn : -cs, c_ = (q4 == 0) ? cs : (q4 == 1) ? -sn : (q4 == 2) ? -cs : sn;
            ropeC[gt] = (float)c_; ropeS[gt] = (float)s_; } }
    }
    xcd_barrier(bar);
    {
    PHASE_ENV
    for (int e = bx * (NWAVES * 64) + tid; e < 4 * 9 * DM; e += G * NWAVES * 64) {
        const int l = e / (9 * DM), r = (e / DM) % 9, c = e & (DM - 1);
        float mod[6];
#pragma unroll
        for (int j = 0; j < 6; ++j) { float s = IN(I_BADA)[(size_t)l * 6 * DM + j * DM + c];
#pragma unroll
            for (int kc = 0; kc < 8; ++kc) s += PART[((size_t)((kc * 4 + l) * 9 + r)) * (6 * DM) + j * DM + c];
            mod[j] = s; }
        const float* gn = IN(I_GNORM) + (size_t)l * 4 * DM;
        float* vb = VEC + (size_t)l * 6 * 9 * DM + (size_t)r * DM + c;
        vb[0 * 9 * DM] = gn[0 * DM + c] * (1.0f + mod[1]); vb[1 * 9 * DM] = mod[0]; vb[2 * 9 * DM] = mod[2] * gn[1 * DM + c];
        vb[3 * 9 * DM] = gn[2 * DM + c] * (1.0f + mod[4]); vb[4 * 9 * DM] = mod[3]; vb[5 * 9 * DM] = mod[5] * gn[3 * DM + c];
    }
    }
    xcd_barrier(bar);

#define THIN_PHASE(XP, XS, RES, GV, HOUT, AV, BV) do { \
    for (int row = gw; row < TT; row += NGW) { \
        const int cls = row < TP ? 0 : 1 + ((row - TP) >> 11); \
        const float* xr = row < TP ? (XP) + (size_t)row * DM : (XS) + (size_t)(row - TP) * DM; \
        f32x4 xv[8]; \
        _Pragma("unroll") for (int j = 0; j < 8; ++j) xv[j] = ((const f32x4*)xr)[64 * j + lane]; \
        if (RES) { \
            f32x4 mv[8]; float ss = 0.f; \
            _Pragma("unroll") for (int j = 0; j < 8; ++j) { const v2u w = ((const v2u*)(MF + (size_t)row * DM))[64 * j + lane]; \
                mv[j] = (f32x4){bf2f(w.x & 0xffffu), bf2f(w.x >> 16), bf2f(w.y & 0xffffu), bf2f(w.y >> 16)}; \
                ss += (mv[j].x * mv[j].x + mv[j].y * mv[j].y) + (mv[j].z * mv[j].z + mv[j].w * mv[j].w); } \
            const float rstd = 1.0f / sqrtf(wave_sum(ss) * (1.0f / DM) + EPS); \
            _Pragma("unroll") for (int j = 0; j < 8; ++j) { const f32x4 g = ((const f32x4*)((GV) + (size_t)cls * DM))[64 * j + lane]; xv[j] += g * (mv[j] * rstd); \
                ((f32x4*)(out + (size_t)row * DM))[64 * j + lane] = xv[j]; } \
        } \
        if (HOUT) { \
            float s2 = 0.f; \
            _Pragma("unroll") for (int j = 0; j < 8; ++j) s2 += (xv[j].x * xv[j].x + xv[j].y * xv[j].y) + (xv[j].z * xv[j].z + xv[j].w * xv[j].w); \
            const float r2 = 1.0f / sqrtf(wave_sum(s2) * (1.0f / DM) + EPS); \
            _Pragma("unroll") for (int j = 0; j < 8; ++j) { const f32x4 a = ((const f32x4*)((AV) + (size_t)cls * DM))[64 * j + lane], b = ((const f32x4*)((BV) + (size_t)cls * DM))[64 * j + lane]; \
                const f32x4 hv = xv[j] * r2 * a + b; v2u w; w.x = pkbf(hv.x, hv.y); w.y = pkbf(hv.z, hv.w); ((v2u*)(H + (size_t)row * DM))[64 * j + lane] = w; } \
        } \
    } } while (0)

    { PHASE_ENV
      THIN_PHASE(IN(I_XP), IN(I_XS), false, VEC, true, VEC + 0 * 9 * DM, VEC + 1 * 9 * DM); }
    xcd_barrier(bar);

    for (int L = 0; L < 4; ++L) {
        const int kind = L % 3, slot = L / 3, nslot = (kind == 0) ? 2 : 1;
#define LAYER_ENV PHASE_ENV unsigned char* const wl = ws + WS_W + (size_t)L * W_LAYER; const float* const vecL = VEC + (size_t)L * 6 * 9 * DM; (void)wl; (void)vecL;
        { LAYER_ENV pg8::Gemm g{H, (const bf16*)(wl + W_QKV), TT, NQKV, DM}; pg8::StaticOrder S; S.init(TT, NQKV, G, bx);
          pg8::EpiStore E{RAW, NQKV};
          pg8::gemm_phase<pg8::EpiStore, pg8::StaticOrder, true, true>(lds, g, S, E); }
        xcd_barrier(bar);
        {
            LAYER_ENV
            const float* ck = (kind == 0) ? IN(I_CKF) : (kind == 1) ? IN(I_CKW) : IN(I_CKD);
            const float* cv = (kind == 0) ? IN(I_CVF) : (kind == 1) ? IN(I_CVW) : IN(I_CVD);
            float* const ok = out + ((kind == 0) ? O_KF : (kind == 1) ? O_KW : O_KD);
            float* const ov = out + ((kind == 0) ? O_VF : (kind == 1) ? O_VW : O_VD);
            const int l16 = lane & 15;
            for (int row = gw; row < TT + 8192; row += NGW) {
                if (row < TT) {
                    const bool is_s = row >= TP; const int b = is_s ? (row - TP) >> 11 : row >> 8, s = is_s ? (row - TP) & (SS - 1) : row & (SP - 1);
                    float cs[8], sn[8];
                    if (is_s) { const int p = (lane & 8) ? (s & 63) : (s >> 6); const int i0 = (lane & 3) * 8;
                        const f32x4 c0 = *(const f32x4*)(ropeC + p * 32 + i0), c1 = *(const f32x4*)(ropeC + p * 32 + i0 + 4), s0 = *(const f32x4*)(ropeS + p * 32 + i0), s1 = *(const f32x4*)(ropeS + p * 32 + i0 + 4);
                        cs[0] = c0.x; cs[1] = c0.y; cs[2] = c0.z; cs[3] = c0.w; cs[4] = c1.x; cs[5] = c1.y; cs[6] = c1.z; cs[7] = c1.w;
                        sn[0] = s0.x; sn[1] = s0.y; sn[2] = s0.z; sn[3] = s0.w; sn[4] = s1.x; sn[5] = s1.y; sn[6] = s1.z; sn[7] = s1.w; }
                    else {
#pragma unroll
                        for (int j = 0; j < 8; ++j) { cs[j] = 1.f; sn[j] = 0.f; } }
                    bf16* const rawr = RAW + (size_t)row * NQKV;
                    const size_t kvrow = is_s ? ((size_t)b * SKV + PAST + s) : (size_t)row;
                    bf16* const kdst = (is_s ? KC : KP) + kvrow * KVW + lane * 8;
                    bf16* const vdst = (is_s ? VC : VP) + kvrow * KVW + lane * 8;
                    const size_t orow = ((size_t)(b * nslot + slot) * SP + s) * KVW + lane * 8;
#pragma unroll
                    for (int step = 0; step < 6; ++step) {
                        const v4u w = *(const v4u*)(rawr + step * 512 + lane * 8);
                        float f[8] = {bf2f(w.x & 0xffffu), bf2f(w.x >> 16), bf2f(w.y & 0xffffu), bf2f(w.y >> 16), bf2f(w.z & 0xffffu), bf2f(w.z >> 16), bf2f(w.w & 0xffffu), bf2f(w.w >> 16)};
                        if (step < 5) {
                            if (kind == 0) { float ss = 0.f;
#pragma unroll
                                for (int j = 0; j < 8; ++j) ss += f[j] * f[j];
                                ss += __shfl_xor(ss, 1); ss += __shfl_xor(ss, 2); ss += __shfl_xor(ss, 4); ss += __shfl_xor(ss, 8);
                                const float rstd = 1.0f / sqrtf(ss * (1.0f / 128.0f) + EPS);
                                const float* gp = IN(step < 4 ? I_GQF : I_GKF) + slot * 128 + l16 * 8;
                                const f32x4 g0 = *(const f32x4*)gp, g1 = *(const f32x4*)(gp + 4);
                                f[0] *= rstd * g0.x; f[1] *= rstd * g0.y; f[2] *= rstd * g0.z; f[3] *= rstd * g0.w; f[4] *= rstd * g1.x; f[5] *= rstd * g1.y; f[6] *= rstd * g1.z; f[7] *= rstd * g1.w; }
                            if (is_s) {
#pragma unroll
                                for (int j = 0; j < 8; ++j) { const float pf = __shfl_xor(f[j], 4); f[j] = (lane & 4) ? (pf * sn[j] + f[j] * cs[j]) : (f[j] * cs[j] - pf * sn[j]); } }
                        }
                        v4u o; o.x = pkbf(f[0], f[1]); o.y = pkbf(f[2], f[3]); o.z = pkbf(f[4], f[5]); o.w = pkbf(f[6], f[7]);
                        if (step < 4) *(v4u*)(rawr + step * 512 + lane * 8) = o;
                        else { *(v4u*)(step == 4 ? kdst : vdst) = o;
                            if (!is_s) { float* op = (step == 4 ? ok : ov) + orow; *(f32x4*)op = (f32x4){f[0], f[1], f[2], f[3]}; *(f32x4*)(op + 4) = (f32x4){f[4], f[5], f[6], f[7]}; } }
                    }
                } else {
                    const int ct = row - TT, isv = ct >> 12, rr = ct & 4095, b = rr >> 9, p = rr & 511;
                    const float* src = (isv ? cv : ck) + ((size_t)(b * nslot + slot) * PAST + p) * KVW + lane * 8;
                    const f32x4 a0 = *(const f32x4*)src, a1 = *(const f32x4*)(src + 4);
                    v4u o; o.x = pkbf(a0.x, a0.y); o.y = pkbf(a0.z, a0.w); o.z = pkbf(a1.x, a1.y); o.w = pkbf(a1.z, a1.w);
                    *(v4u*)((isv ? VC : KC) + ((size_t)b * SKV + p) * KVW + lane * 8) = o;
                }
            }
        }
        xcd_barrier(bar);
        {
            LAYER_ENV
            const int nsamp = (kind == 2) ? 2048 : 1024, nprm = (kind == 2) ? 1024 : 512;
            for (int u = vcu; u < nsamp + nprm; u += G) {
                const bf16 *Qp, *Kp_, *Vp_; bf16* Op; int ldo, nt, nfirst, skip = 0, qpos0 = 0; float sinkl2 = -1e30f;
                if (kind != 2) {
                    int b, h, qb;
                    if (u < nsamp) { qb = u & 7; h = (u >> 3) & 15; b = u >> 7; const size_t r0 = (size_t)TP + (size_t)b * SS + qb * 256;
                        Qp = RAW + r0 * NQKV + h * 128; Kp_ = KC + (size_t)b * SKV * KVW + (h >> 2) * 128; Vp_ = VC + (size_t)b * SKV * KVW + (h >> 2) * 128; Op = ATT + r0 * DM + h * 128;
                        nt = SKV / 64; nfirst = nt;
                        if (kind == 1) { const int bs = (qb * 256 - 128) < 0 ? 0 : qb * 256 - 128, be = (qb * 256 + 384) > SS ? SS : qb * 256 + 384; nfirst = PAST / 64; nt = nfirst + (be - bs) / 64; skip = bs; qpos0 = qb * 256; } }
                    else { const int v = u - nsamp; h = v & 15; b = v >> 4; const size_t r0 = (size_t)b * SP;
                        Qp = RAW + r0 * NQKV + h * 128; Kp_ = KP + r0 * KVW + (h >> 2) * 128; Vp_ = VP + r0 * KVW + (h >> 2) * 128; Op = ATT + r0 * DM + h * 128; nt = SP / 64; nfirst = nt; }
                    if (kind == 1) sinkl2 = IN(I_SINKW)[h] * 1.4426950408889634f;
                    ldo = DM;
                } else {
                    int b, hv, vh, qb; size_t r0, kr0; const bf16 *kb, *vb;
                    if (u < nsamp) { qb = u & 7; vh = (u >> 3) & 1; const int g = (u >> 4) & 3, kvv = (u >> 6) & 3; b = u >> 8; const int kv = kvv >> 1, m = kvv & 1; hv = ((kv * 4 + g) << 1) | m;
                        r0 = (size_t)TP + (size_t)b * SS + qb * 256; kr0 = (size_t)b * SKV; kb = KC; vb = VC; nt = SKV / 64;
                        Kp_ = kb + kr0 * KVW + kvv * 128; Vp_ = vb + kr0 * KVW + (kv * 2 + vh) * 128; }
                    else { const int v = u - nsamp; vh = v & 1; const int g = (v >> 1) & 3, kvv = (v >> 3) & 3; b = v >> 5; const int kv = kvv >> 1, m = kvv & 1; hv = ((kv * 4 + g) << 1) | m;
                        r0 = (size_t)b * SP; kr0 = r0; nt = SP / 64;
                        Kp_ = KP + kr0 * KVW + kvv * 128; Vp_ = VP + kr0 * KVW + (kv * 2 + vh) * 128; }
                    Qp = RAW + r0 * NQKV + hv * 128; Op = ADIF + r0 * 4096 + hv * 256 + vh * 128; ldo = 4096; nfirst = nt;
                }
                __syncthreads();
                att::attn_unit(Qp, Kp_, Vp_, Op, NQKV, KVW, ldo, nt, nfirst, skip, qpos0, sinkl2, (LAS char*)lds);
            }
        }
        xcd_barrier(bar);
        if (kind == 2) { LAYER_ENV
            float d1 = IN(I_LQ1)[lane] * IN(I_LK1)[lane] + IN(I_LQ1)[lane + 64] * IN(I_LK1)[lane + 64];
            float d2 = IN(I_LQ2)[lane] * IN(I_LK2)[lane] + IN(I_LQ2)[lane + 64] * IN(I_LK2)[lane + 64];
            const float lam = expf(wave_sum(d1)) - expf(wave_sum(d2)) + LAM_INIT2;
            const f32x4 gs = *(const f32x4*)(IN(I_GSUB) + lane * 4) * (1.0f - LAM_INIT2);
            for (int row = gw; row < TT; row += NGW) {
#pragma unroll
                for (int h = 0; h < 8; ++h) {
                    const v2u a = *(const v2u*)(ADIF + (size_t)row * 4096 + (2 * h) * 256 + lane * 4), c = *(const v2u*)(ADIF + (size_t)row * 4096 + (2 * h + 1) * 256 + lane * 4);
                    f32x4 o = (f32x4){bf2f(a.x & 0xffffu), bf2f(a.x >> 16), bf2f(a.y & 0xffffu), bf2f(a.y >> 16)} - lam * (f32x4){bf2f(c.x & 0xffffu), bf2f(c.x >> 16), bf2f(c.y & 0xffffu), bf2f(c.y >> 16)};
                    const float ss = wave_sum((o.x * o.x + o.y * o.y) + (o.z * o.z + o.w * o.w));
                    o = o * (1.0f / sqrtf(ss * (1.0f / 256.0f) + EPS)) * gs;
                    v2u w; w.x = pkbf(o.x, o.y); w.y = pkbf(o.z, o.w); *(v2u*)(ATT + (size_t)row * DM + h * 256 + lane * 4) = w;
                }
            }
            xcd_barrier(bar);
        }
        { LAYER_ENV pg8::Gemm g{ATT, (const bf16*)(wl + W_O), TT, DM, DM}; pg8::StaticOrder S; S.init(TT, DM, G, bx);
          pg8::EpiStore E{MF, DM};
          pg8::gemm_phase<pg8::EpiStore, pg8::StaticOrder, true, true>(lds, g, S, E); }
        xcd_barrier(bar);
        { LAYER_ENV const float* const xp_ = (L == 0) ? IN(I_XP) : (const float*)out; const float* const xs_ = (L == 0) ? IN(I_XS) : (const float*)(out + O_YS);
          THIN_PHASE(xp_, xs_, true, vecL + 2 * 9 * DM, true, vecL + 3 * 9 * DM, vecL + 4 * 9 * DM); }
        xcd_barrier(bar);
        { LAYER_ENV pg8::Gemm g{H, (const bf16*)(wl + W_GU), TT, NGU, DM}; pg8::StaticOrder S; S.init(TT, NGU, G, bx);
          pg8::EpiSwiglu E{ACT, FF};
          pg8::gemm_phase<pg8::EpiSwiglu, pg8::StaticOrder, true, true>(lds, g, S, E); }
        xcd_barrier(bar);
        { LAYER_ENV pg8::Gemm g{ACT, (const bf16*)(wl + W_D), TT, DM, FF}; pg8::StaticOrder S; S.init(TT, DM, G, bx);
          pg8::EpiStore E{MF, DM};
          pg8::gemm_phase<pg8::EpiStore, pg8::StaticOrder, true, true>(lds, g, S, E); }
        xcd_barrier(bar);
        { LAYER_ENV const float* vecN = VEC + (size_t)(L < 3 ? L + 1 : L) * 6 * 9 * DM; const bool hout = L < 3;
          THIN_PHASE(out, out + O_YS, true, vecL + 5 * 9 * DM, hout, vecN + 0 * 9 * DM, vecN + 1 * 9 * DM); }
        if (L < 3) xcd_barrier(bar);
    }
#undef THIN_PHASE
#undef LAYER_ENV
}

extern "C" void kernel_launch(void* const* d_in, const int* in_sizes, int n_in, void* d_out, int out_size, void* d_ws, size_t ws_size, hipStream_t stream) {
    static int grid = 0;
    if (grid == 0) {
        if (n_in != N_IN || (size_t)out_size != O_END || ws_size < WS_END) { fprintf(stderr, "kernel_launch: shape mismatch: n_in %d out %d ws %zu\n", n_in, out_size, ws_size); grid = -1; return; }
        int dev = 0, cus = 0, per_cu = 0;
        if (hipGetDevice(&dev) != hipSuccess || hipDeviceGetAttribute(&cus, hipDeviceAttributeMultiprocessorCount, dev) != hipSuccess) { grid = -1; return; }
        if (hipFuncSetAttribute((const void*)trunk_fwd, hipFuncAttributeMaxDynamicSharedMemorySize, LDS_BYTES) != hipSuccess) { fprintf(stderr, "kernel_launch: hipFuncSetAttribute failed\n"); grid = -1; return; }
        if (hipOccupancyMaxActiveBlocksPerMultiprocessor(&per_cu, (const void*)trunk_fwd, NWAVES * 64, LDS_BYTES) != hipSuccess || per_cu < 1)
            fprintf(stderr, "kernel_launch: note: occupancy query reports %d workgroups per CU\n", per_cu);
        (void)hipGetLastError();
        grid = cus;
    }
    if (grid < 0) return;
    if (hipMemsetAsync((char*)d_ws + WS_CTL, 0, CTL_ZERO_BYTES, stream) != hipSuccess) { fprintf(stderr, "kernel_launch: memset failed\n"); return; }
    Args a{};
    for (int i = 0; i < N_IN; ++i) a.in[i] = (const float*)d_in[i];
    a.out = (float*)d_out; a.ws = (unsigned char*)d_ws;
    hipLaunchKernelGGL(trunk_fwd, dim3(grid), dim3(NWAVES * 64), LDS_BYTES, stream, a);
    const hipError_t le = hipPeekAtLastError();
    if (le != hipSuccess) fprintf(stderr, "kernel_launch: launch failed: %s\n", hipGetErrorName(le));
}
```

```cpp
#include <hip/hip_runtime.h>
#include <cstdio>
#include <cstdint>
#define TIDTAB_LDS_ADDR (131072 + 3072)
__device__ __forceinline__ int tid_now() {
    const unsigned slot = (unsigned)__builtin_amdgcn_s_getreg((5 << 11) | 4) & 63u;
    const unsigned w = *(const volatile __attribute__((address_space(3))) unsigned*)(unsigned long)(TIDTAB_LDS_ADDR + slot * 4);
    unsigned ln; asm volatile("v_mbcnt_lo_u32_b32 %0, -1, 0\n\tv_mbcnt_hi_u32_b32 %0, -1, %0" : "=v"(ln));
    return (int)(__builtin_amdgcn_readfirstlane(w) * 64u + ln);
}
namespace pg8 {
#define PG8_LAS __attribute__((address_space(3)))
typedef unsigned short bf16_t;
typedef short bf16x8 __attribute__((ext_vector_type(8)));
typedef float f32x4 __attribute__((ext_vector_type(4)));
typedef unsigned u32x4 __attribute__((ext_vector_type(4)));
constexpr int BM = 256, BK = 64, HALF = 128, HTB = HALF * BK * 2  , STAGE_BYTES = 8 * HTB, NXCD = 8, WGM = 8;

__host__ __device__ __forceinline__ int lds_byte(int r, int c) { const int st = (r >> 4) * 2 + (c >> 5), rr = r & 15, cc = c & 31, ob = rr * 64 + cc * 2; return st * 1024 + (ob ^ (((ob >> 9) & 1) << 5)); }
__host__ __device__ __forceinline__ void stage_rc(int b, int& R, int& C) { const int st = b / 1024, sb = b % 1024, swz = sb ^ (((sb >> 9) & 1) << 5); R = (st >> 1) * 16 + swz / 64; C = (st & 1) * 32 + (swz % 64) / 2; }
__host__ __device__ __forceinline__ int perm32(int rho) { const int n = rho >> 4, i = rho & 15; return 8 * (i >> 2) + 4 * n + (i & 3); }

struct Unit { int pm, pn; };
struct Gemm { const bf16_t* A; const bf16_t* Bt; int M, N, K; };

struct StaticOrder {
    int nM, nN, nwg, G, c, rev;
    __host__ __device__ void init(int M, int N, int G_, int c_) { nM = M / BM; nN = N / BM; nwg = nM * nN; G = G_; c = c_; rev = 0; }
    __host__ __device__ bool next(int i, Unit& u) const {
        const long L = (long)i * G + c; if (L >= nwg) return false;
        int wgid = (int)L; { const int q = nwg / NXCD, r = nwg % NXCD, xcd = wgid % NXCD, off = wgid / NXCD; wgid = (xcd < r ? xcd * (q + 1) : r * (q + 1) + (xcd - r) * q) + (rev ? (xcd < r ? q : q - 1) - off : off); }
        const int nig = WGM * nN, gid = wgid / nig, fm = gid * WGM, gsz = (nM - fm) < WGM ? (nM - fm) : WGM;
        u.pm = fm + ((wgid % nig) % gsz); u.pn = (wgid % nig) / gsz; return true;
    }
    __device__ __forceinline__ void a_ready(const Unit&) const {}
    __device__ __forceinline__ void done(const Unit&) const {}
};

__device__ __forceinline__ unsigned cvt_pk_bf16(float lo, float hi) { unsigned r; asm volatile("v_cvt_pk_bf16_f32 %0, %1, %2" : "=v"(r) : "v"(lo), "v"(hi)); return r; }

struct EpiStore {
    static constexpr bool PERM = true, AFTER_DRAIN = false;
    bf16_t* O; int ldc;
    __device__ __forceinline__ static unsigned ror8(unsigned v) { return (unsigned)__builtin_amdgcn_update_dpp(0, (int)v, 0x128, 0xf, 0xf, false); }
    __device__ __forceinline__ void operator()(const f32x4 (&acc)[2][2][4][2], const Unit& u, int wr, int wc, int fr, int fq) const {
        const bool lo = fr < 8;
        const int row0 = u.pm * BM + wr * 64 + (fr & 7), col0 = u.pn * BM + wc * 64 + 8 * fq + (lo ? 0 : 32);
#pragma unroll
        for (int ai = 0; ai < 2; ++ai)
#pragma unroll
            for (int m = 0; m < 4; ++m) { bf16_t* rowp = O + (size_t)(row0 + ai * HALF + m * 16) * ldc + col0;
                u32x4 A, B;
                { const f32x4 v0 = acc[ai][0][m][0], v1 = acc[ai][0][m][1]; A.x = cvt_pk_bf16(v0[0], v0[1]); A.y = cvt_pk_bf16(v0[2], v0[3]); A.z = cvt_pk_bf16(v1[0], v1[1]); A.w = cvt_pk_bf16(v1[2], v1[3]); }
                { const f32x4 v0 = acc[ai][1][m][0], v1 = acc[ai][1][m][1]; B.x = cvt_pk_bf16(v0[0], v0[1]); B.y = cvt_pk_bf16(v0[2], v0[3]); B.z = cvt_pk_bf16(v1[0], v1[1]); B.w = cvt_pk_bf16(v1[2], v1[3]); }
                u32x4 R; R.x = ror8(lo ? B.x : A.x); R.y = ror8(lo ? B.y : A.y); R.z = ror8(lo ? B.z : A.z); R.w = ror8(lo ? B.w : A.w);
                u32x4 w1, w2; w1.x = lo ? A.x : R.x; w1.y = lo ? A.y : R.y; w1.z = lo ? A.z : R.z; w1.w = lo ? A.w : R.w;
                w2.x = lo ? R.x : B.x; w2.y = lo ? R.y : B.y; w2.z = lo ? R.z : B.z; w2.w = lo ? R.w : B.w;
                *(u32x4*)rowp = w1; *(u32x4*)(rowp + (size_t)8 * ldc) = w2; }
    }
};
struct EpiSwiglu {
    static constexpr bool PERM = true, AFTER_DRAIN = false;
    bf16_t* O; int ldc;
    __device__ __forceinline__ static float swi(float g, float u) { const float e = __builtin_amdgcn_exp2f(g * -1.4426950408889634f); return g * u * __builtin_amdgcn_rcpf(1.0f + e); }
    __device__ __forceinline__ void operator()(const f32x4 (&acc)[2][2][4][2], const Unit& u, int wr, int wc, int fr, int fq) const {
        const int row0 = u.pm * BM + wr * 64 + fr, col0 = u.pn * HALF + wc * 32 + 8 * fq;
#pragma unroll
        for (int ai = 0; ai < 2; ++ai)
#pragma unroll
            for (int m = 0; m < 4; ++m) { bf16_t* rowp = O + (size_t)(row0 + ai * HALF + m * 16) * ldc + col0;
                const f32x4 g0 = acc[ai][0][m][0], g1 = acc[ai][0][m][1], u0 = acc[ai][1][m][0], u1 = acc[ai][1][m][1];
                u32x4 w; w.x = cvt_pk_bf16(swi(g0[0], u0[0]), swi(g0[1], u0[1])); w.y = cvt_pk_bf16(swi(g0[2], u0[2]), swi(g0[3], u0[3]));
                w.z = cvt_pk_bf16(swi(g1[0], u1[0]), swi(g1[1], u1[1])); w.w = cvt_pk_bf16(swi(g1[2], u1[2]), swi(g1[3], u1[3]));
                *(u32x4*)rowp = w; }
    }
};

template <class Epi, class Sched, bool ALIGN_EPI = false, bool SP2 = false>
__device__ __forceinline__ void gemm_phase(PG8_LAS unsigned char* lds, const Gemm g, const Sched& S, const Epi& E) {
    int tid_l = tid_now(); asm volatile("" : "+v"(tid_l));
    const int tid = tid_l, wid = __builtin_amdgcn_readfirstlane(tid >> 6), lane = tid & 63, wr = wid >> 2, wc = wid & 3, fr = lane & 15, fq = lane >> 4;
    const int K = g.K, nt = K / BK;
    unsigned voffA[2], voffB[2];
#pragma unroll
    for (int i = 0; i < 2; ++i) { int R, C; stage_rc(tid * 16 + i * 8192, R, C); const int Rb = Epi::PERM ? (64 * (R >> 5) + perm32(R & 31)) : R;
        voffA[i] = (unsigned)(R * K + C) * 2u; voffB[i] = (unsigned)(Rb * K + C) * 2u; }
    const size_t kstep = (size_t)(BK * 2);
    const size_t hstep = (size_t)HALF * K * 2;
    const size_t tstep = 2 * hstep;
    const size_t hstepB = Epi::PERM ? (size_t)32 * K * 2 : hstep;
    const unsigned ldsw = (unsigned)wid * 1024u;
    const int aoff = lds_byte(wr * 64 + fr, fq * 8), boff = lds_byte(wc * 32 + fr, fq * 8);
#define PG8_SA(b, h) (((b) * 2 + (h)) * HTB)
#define PG8_SB(b, h) ((4 + (b) * 2 + (h)) * HTB)
    const __amdgpu_buffer_rsrc_t rs_voffA = __builtin_amdgcn_make_buffer_rsrc((void*)g.A, 0, 0x7ffffffe, 0x00020000), rs_voffB = __builtin_amdgcn_make_buffer_rsrc((void*)g.Bt, 0, 0x7ffffffe, 0x00020000);
    const char* const base_voffA = (const char*)g.A; const char* const base_voffB = (const char*)g.Bt;
#define PG8_STAGE(bufoff, gbase, voff) do { const int so_ = (int)((const char*)(gbase) - base_##voff); _Pragma("unroll") for (int _i = 0; _i < 2; ++_i) \
        __builtin_amdgcn_raw_ptr_buffer_load_lds(rs_##voff, (PG8_LAS void*)(lds + (bufoff) + ldsw + _i * 8192), 16, (int)(voff)[_i], so_, 0, 0); } while (0)
#define PG8_LDA(dst, b, h) do { _Pragma("unroll") for (int m = 0; m < 4; ++m) _Pragma("unroll") for (int k = 0; k < 2; ++k) dst[m][k] = *(const PG8_LAS bf16x8*)(lds + PG8_SA(b, h) + aoff + m * 2048 + k * 1024); } while (0)
#define PG8_LDB(dst, b, h) do { _Pragma("unroll") for (int n = 0; n < 2; ++n) _Pragma("unroll") for (int k = 0; k < 2; ++k) dst[n][k] = *(const PG8_LAS bf16x8*)(lds + PG8_SB(b, h) + boff + n * 2048 + k * 1024); } while (0)
#define PG8_MMA(ai, bj, At, Bt) do { __builtin_amdgcn_s_setprio(1); _Pragma("unroll") for (int m = 0; m < 4; ++m) _Pragma("unroll") for (int n = 0; n < 2; ++n) _Pragma("unroll") for (int k = 0; k < 2; ++k) \
        acc[ai][bj][m][n] = __builtin_amdgcn_mfma_f32_16x16x32_bf16(Bt[n][k], At[m][k], acc[ai][bj][m][n], 0, 0, 0); __builtin_amdgcn_s_setprio(0); } while (0)
#define PG8_WAIT_V(n) asm volatile("s_waitcnt vmcnt(" #n ")" ::: "memory")
#define PG8_WAIT_L(n) asm volatile("s_waitcnt lgkmcnt(" #n ")" ::: "memory")
#define PG8_BAR __builtin_amdgcn_s_barrier()
#define PG8_SCHED __builtin_amdgcn_sched_barrier(0)
    Unit cur, nxt; int ui = 0;
    if (!S.next(0, cur)) return;
    f32x4 acc[2][2][4][2];
#pragma unroll
    for (int a = 0; a < 2; ++a)
#pragma unroll
        for (int b = 0; b < 2; ++b)
#pragma unroll
            for (int m = 0; m < 4; ++m)
#pragma unroll
                for (int n = 0; n < 2; ++n) acc[a][b][m][n] = (f32x4){0.f, 0.f, 0.f, 0.f};
    bf16x8 At[4][2], B0[2][2], B1[2][2];
    const char* cA = (const char*)g.A + (size_t)cur.pm * tstep; const char* cB = (const char*)g.Bt + (size_t)cur.pn * tstep;
    S.a_ready(cur);
    if constexpr (SP2) {
        PG8_STAGE(PG8_SB(0, 0), cB, voffB); PG8_STAGE(PG8_SB(0, 1), cB + hstepB, voffB); PG8_STAGE(PG8_SA(0, 0), cA, voffA); PG8_STAGE(PG8_SA(0, 1), cA + hstep, voffA);
        if (wr == 1) PG8_BAR;
        PG8_WAIT_V(2); PG8_BAR;
        PG8_STAGE(PG8_SB(1, 0), cB + kstep, voffB); PG8_STAGE(PG8_SA(1, 0), cA + kstep, voffA); PG8_STAGE(PG8_SB(1, 1), cB + hstepB + kstep, voffB);
        PG8_WAIT_V(6); PG8_BAR;
    } else {
        PG8_STAGE(PG8_SB(0, 0), cB, voffB); PG8_STAGE(PG8_SA(0, 0), cA, voffA); PG8_STAGE(PG8_SB(0, 1), cB + hstepB, voffB); PG8_STAGE(PG8_SA(0, 1), cA + hstep, voffA);
        if (wr == 1) PG8_BAR;
        PG8_WAIT_V(4); PG8_BAR;
        PG8_STAGE(PG8_SB(1, 0), cB + kstep, voffB); PG8_STAGE(PG8_SA(1, 0), cA + kstep, voffA); PG8_STAGE(PG8_SB(1, 1), cB + hstepB + kstep, voffB);
        PG8_WAIT_V(6); PG8_BAR;
    }
    for (;;) {
        const bool has_next = S.next(ui + 1, nxt);
        const char* nA = has_next ? (const char*)g.A + (size_t)nxt.pm * tstep : cA; const char* nB = has_next ? (const char*)g.Bt + (size_t)nxt.pn * tstep : cB;
        for (int t = 0; t < nt; t += 2) {
            const bool last = (t == nt - 2);
            const char* a1 = cA + (size_t)(t + 1) * kstep;
            const char* a2 = last ? nA : cA + (size_t)(t + 2) * kstep; const char* b2 = last ? nB : cB + (size_t)(t + 2) * kstep;
            const char* a3 = a2 + kstep; const char* b3 = b2 + kstep;
            if (last && has_next) S.a_ready(nxt);
            if constexpr (SP2) {
            PG8_LDB(B0, 0, 0); PG8_LDB(B1, 0, 1); PG8_SCHED; PG8_LDA(At, 0, 0); PG8_STAGE(PG8_SA(1, 1), a1 + hstep, voffA);
            PG8_WAIT_V(8); PG8_WAIT_L(0); PG8_BAR; PG8_MMA(0, 0, At, B0); PG8_MMA(0, 1, At, B1); PG8_BAR; PG8_SCHED;
            PG8_LDA(At, 0, 1); PG8_STAGE(PG8_SB(0, 0), b2, voffB); PG8_STAGE(PG8_SB(0, 1), b2 + hstepB, voffB); PG8_STAGE(PG8_SA(0, 0), a2, voffA);
            PG8_WAIT_V(8); PG8_WAIT_L(0); PG8_BAR; PG8_MMA(1, 0, At, B0); PG8_MMA(1, 1, At, B1); PG8_BAR; PG8_SCHED;
            PG8_LDB(B0, 1, 0); PG8_LDB(B1, 1, 1); PG8_SCHED; PG8_LDA(At, 1, 0); PG8_STAGE(PG8_SA(0, 1), a2 + hstep, voffA);
            PG8_WAIT_V(8); PG8_WAIT_L(0); PG8_BAR; PG8_MMA(0, 0, At, B0); PG8_MMA(0, 1, At, B1); PG8_BAR; PG8_SCHED;
            PG8_LDA(At, 1, 1); PG8_STAGE(PG8_SB(1, 0), b3, voffB); PG8_STAGE(PG8_SB(1, 1), b3 + hstepB, voffB); PG8_STAGE(PG8_SA(1, 0), a3, voffA);
            PG8_WAIT_V(8); PG8_WAIT_L(0); PG8_BAR; PG8_MMA(1, 0, At, B0); PG8_MMA(1, 1, At, B1); PG8_BAR; PG8_SCHED;
            } else {
            PG8_LDB(B0, 0, 0); PG8_SCHED; PG8_LDA(At, 0, 0); PG8_STAGE(PG8_SA(1, 1), a1 + hstep, voffA);
            PG8_WAIT_L(8); PG8_BAR; PG8_WAIT_L(0); PG8_MMA(0, 0, At, B0); PG8_BAR; PG8_SCHED;
            PG8_LDB(B1, 0, 1); PG8_STAGE(PG8_SB(0, 0), b2, voffB);
            PG8_BAR; PG8_WAIT_L(0); PG8_MMA(0, 1, At, B1); PG8_BAR;
            PG8_LDA(At, 0, 1); PG8_STAGE(PG8_SA(0, 0), a2, voffA);
            PG8_BAR; PG8_WAIT_L(0); PG8_MMA(1, 0, At, B0); PG8_BAR; PG8_SCHED;
            PG8_STAGE(PG8_SB(0, 1), b2 + hstepB, voffB);
            PG8_WAIT_V(6); PG8_BAR; PG8_MMA(1, 1, At, B1); PG8_BAR;
            PG8_LDB(B0, 1, 0); PG8_SCHED; PG8_LDA(At, 1, 0); PG8_STAGE(PG8_SA(0, 1), a2 + hstep, voffA);
            PG8_WAIT_L(8); PG8_BAR; PG8_WAIT_L(0); PG8_MMA(0, 0, At, B0); PG8_BAR; PG8_SCHED;
            PG8_LDB(B1, 1, 1); PG8_STAGE(PG8_SB(1, 0), b3, voffB);
            PG8_BAR; PG8_WAIT_L(0); PG8_MMA(0, 1, At, B1); PG8_BAR;
            PG8_LDA(At, 1, 1); PG8_STAGE(PG8_SA(1, 0), a3, voffA);
            PG8_BAR; PG8_WAIT_L(0); PG8_MMA(1, 0, At, B0); PG8_BAR; PG8_SCHED;
            PG8_STAGE(PG8_SB(1, 1), b3 + hstepB, voffB);
            PG8_WAIT_V(6); PG8_BAR; PG8_MMA(1, 1, At, B1); PG8_BAR;
            }
        }
        if constexpr (ALIGN_EPI) { if (wr == 0) PG8_BAR; }
        if constexpr (!Epi::AFTER_DRAIN) { E(acc, cur, wr, wc, fr, fq); S.done(cur); }
        if (!has_next) break;
#pragma unroll
        for (int a = 0; a < 2; ++a)
#pragma unroll
            for (int b = 0; b < 2; ++b)
#pragma unroll
                for (int m = 0; m < 4; ++m)
#pragma unroll
                    for (int n = 0; n < 2; ++n) acc[a][b][m][n] = (f32x4){0.f, 0.f, 0.f, 0.f};
        cur = nxt; cA = nA; cB = nB; ++ui;
        if constexpr (ALIGN_EPI) { if (wr == 1) PG8_BAR; }
    }
    PG8_WAIT_V(0);
    if constexpr (!ALIGN_EPI) { if (wr == 0) PG8_BAR; }
    PG8_BAR;
    if constexpr (Epi::AFTER_DRAIN) { E.fused(acc, cur, wr, wc, fr, fq, lds, wid, lane); S.done(cur); }
#undef PG8_SA
#undef PG8_SB
#undef PG8_STAGE
#undef PG8_LDA
#undef PG8_LDB
#undef PG8_MMA
#undef PG8_WAIT_V
#undef PG8_WAIT_L
#undef PG8_BAR
#undef PG8_SCHED
}
}

namespace att {
#define ALAS __attribute__((address_space(3)))
typedef unsigned short bf16_t;
using bf16x8 = __attribute__((ext_vector_type(8))) short;
using s16x4  = __attribute__((ext_vector_type(4))) short;
using f32x16 = __attribute__((ext_vector_type(16))) float;
using u32x4  = __attribute__((ext_vector_type(4))) unsigned;
constexpr int   D = 128, NW = 8, QBLK = 32, KVBLK = 64;
constexpr float SCALE = 0.088388347648318440f;
constexpr float THR = 8.f;
constexpr int SHM_V = KVBLK * D * 2, SHM_K = KVBLK * D * 2, SHM_ATTN = 2 * SHM_V + 2 * SHM_K + NW * 64 * 4;
#define KSWZ(row, colB) ((row) * 256 + ((colB) ^ (((row) & 7) << 4)))
#define SBAR() __builtin_amdgcn_sched_barrier(0)
__device__ __forceinline__ int crow(int r, int hi) { return (r & 3) + 8 * (r >> 2) + 4 * hi; }
__device__ __forceinline__ unsigned cvtpk(float lo, float hi) { unsigned r; asm volatile("v_cvt_pk_bf16_f32 %0, %1, %2" : "=v"(r) : "v"(lo), "v"(hi)); return r; }

__device__ __forceinline__ void partialSM(f32x16& p0, f32x16& p1, float& m_reg, float& mn, float& alpha) {
  constexpr float C = SCALE * 1.4426950408889634f;
  float pmax = p0[0];
#pragma unroll
  for (int r = 1; r < 16; ++r) pmax = fmaxf(pmax, p0[r]);
#pragma unroll
  for (int r = 0; r < 16; ++r) pmax = fmaxf(pmax, p1[r]);
  { auto rr = __builtin_amdgcn_permlane32_swap(__float_as_uint(pmax), __float_as_uint(pmax), false, false);
    pmax = fmaxf(__uint_as_float(rr[0]), __uint_as_float(rr[1])); }
  if (__builtin_expect(__all(pmax - m_reg <= THR / SCALE), 1)) { mn = m_reg; alpha = 1.f; }
  else { mn = fmaxf(m_reg, pmax); alpha = __builtin_amdgcn_exp2f((m_reg - mn) * C); m_reg = mn; }
  float mnC = -mn * C;
#pragma unroll
  for (int r = 0; r < 16; ++r) p0[r] = fmaf(p0[r], C, mnC);
#pragma unroll
  for (int r = 0; r < 16; ++r) p1[r] = fmaf(p1[r], C, mnC);
#pragma unroll
  for (int r = 0; r < 16; ++r) p0[r] = __builtin_amdgcn_exp2f(p0[r]);
}
__device__ __forceinline__ void finishSM(f32x16& p0, f32x16& p1, float alpha, float& l_reg, bf16x8& pa0, bf16x8& pa1, bf16x8& pa2, bf16x8& pa3) {
#pragma unroll
  for (int r = 0; r < 16; ++r) p1[r] = __builtin_amdgcn_exp2f(p1[r]);
  float ps = 0;
#pragma unroll
  for (int r = 0; r < 16; ++r) ps += p0[r];
#pragma unroll
  for (int r = 0; r < 16; ++r) ps += p1[r];
  { auto rr = __builtin_amdgcn_permlane32_swap(__float_as_uint(ps), __float_as_uint(ps), false, false);
    ps = __uint_as_float(rr[0]) + __uint_as_float(rr[1]); }
  l_reg = l_reg * alpha + ps;
#define PK4(P, BASE, OUT) do { unsigned a0 = cvtpk(P[BASE + 0], P[BASE + 1]), a1 = cvtpk(P[BASE + 2], P[BASE + 3]);   \
    unsigned b0 = cvtpk(P[BASE + 4], P[BASE + 5]), b1 = cvtpk(P[BASE + 6], P[BASE + 7]);                              \
    auto r0 = __builtin_amdgcn_permlane32_swap(a0, b0, false, false); auto r1 = __builtin_amdgcn_permlane32_swap(a1, b1, false, false); \
    u32x4 w = {r0[0], r1[0], r0[1], r1[1]}; OUT = *reinterpret_cast<bf16x8*>(&w); } while (0)
  PK4(p0, 0, pa0); PK4(p0, 8, pa1); PK4(p1, 0, pa2); PK4(p1, 8, pa3);
#undef PK4
}
__device__ __forceinline__ void qkt(f32x16& p0, f32x16& p1, const ALAS char* Ks, const bf16x8* qr, int r32, int hi) {
  p0 = f32x16{}; p1 = f32x16{};
#pragma unroll
  for (int d0 = 0; d0 < 8; ++d0) { int cb = (d0 * 16 + hi * 8) * 2;
    bf16x8 b0 = *reinterpret_cast<const ALAS bf16x8*>(Ks + KSWZ(r32, cb));
    bf16x8 b1 = *reinterpret_cast<const ALAS bf16x8*>(Ks + KSWZ(32 + r32, cb));
    p0 = __builtin_amdgcn_mfma_f32_32x32x16_bf16(b0, qr[d0], p0, 0, 0, 0);
    p1 = __builtin_amdgcn_mfma_f32_32x32x16_bf16(b1, qr[d0], p1, 0, 0, 0); }
}
__device__ __forceinline__ void band_mask(f32x16& p0, f32x16& p1, int dj, int hi) {
#pragma unroll
  for (int r = 0; r < 16; ++r) { const int d = dj + crow(r, hi);
    if ((unsigned)(d + 128) > 256u) p0[r] = -1e30f;
    if ((unsigned)(d + 160) > 256u) p1[r] = -1e30f; }
}
__device__ __forceinline__ int v_st(int k, int c) { const int kk = (k & ~0xC) | ((k & 4) << 1) | ((k & 8) >> 1); return ((kk >> 3) * 4 + (c >> 5)) * 512 + ((kk & 7) * 32 + (c & 31)) * 2; }
__device__ __forceinline__ int v_rd_base(int lane) { return ((lane & 3) << 3) | (((lane >> 2) & 3) << 6) | (((lane >> 4) & 1) << 5) | (((lane >> 5) & 1) << 8); }
constexpr int v_rd_off(int d0, int ks, int half) { return d0 * 512 + ks * 4096 + half * 2048; }
template <int OFF> __device__ __forceinline__ s16x4 tr_read(int vb) {
  s16x4 r; asm volatile("ds_read_b64_tr_b16 %0, %1 offset:%2" : "=&v"(r) : "v"(vb), "i"(OFF) : "memory"); return r;
}
template <int D0> __device__ __forceinline__ void pv_one(f32x16& od, int vb, bf16x8 pa0, bf16x8 pa1, bf16x8 pa2, bf16x8 pa3) {
  s16x4 l0 = tr_read<v_rd_off(D0, 0, 0)>(vb), h0 = tr_read<v_rd_off(D0, 0, 1)>(vb), l1 = tr_read<v_rd_off(D0, 1, 0)>(vb), h1 = tr_read<v_rd_off(D0, 1, 1)>(vb);
  s16x4 l2 = tr_read<v_rd_off(D0, 2, 0)>(vb), h2 = tr_read<v_rd_off(D0, 2, 1)>(vb), l3 = tr_read<v_rd_off(D0, 3, 0)>(vb), h3 = tr_read<v_rd_off(D0, 3, 1)>(vb);
  asm volatile("s_waitcnt lgkmcnt(0)" : "+v"(l0), "+v"(h0), "+v"(l1), "+v"(h1), "+v"(l2), "+v"(h2), "+v"(l3), "+v"(h3) :: "memory");
#define PK(L, H) (bf16x8){L[0], L[1], L[2], L[3], H[0], H[1], H[2], H[3]}
  od = __builtin_amdgcn_mfma_f32_32x32x16_bf16(pa0, PK(l0, h0), od, 0, 0, 0);
  od = __builtin_amdgcn_mfma_f32_32x32x16_bf16(pa1, PK(l1, h1), od, 0, 0, 0);
  od = __builtin_amdgcn_mfma_f32_32x32x16_bf16(pa2, PK(l2, h2), od, 0, 0, 0);
  od = __builtin_amdgcn_mfma_f32_32x32x16_bf16(pa3, PK(l3, h3), od, 0, 0, 0);
#undef PK
}
__device__ __forceinline__ void pv_d0(f32x16* o, int vb, bf16x8 pa0, bf16x8 pa1, bf16x8 pa2, bf16x8 pa3) {
  pv_one<0>(o[0], vb, pa0, pa1, pa2, pa3); pv_one<1>(o[1], vb, pa0, pa1, pa2, pa3); pv_one<2>(o[2], vb, pa0, pa1, pa2, pa3); pv_one<3>(o[3], vb, pa0, pa1, pa2, pa3);
}
__device__ __forceinline__ void pv_sm(f32x16* o, int vb, bf16x8 pa0, bf16x8 pa1, bf16x8 pa2, bf16x8 pa3, f32x16& p0, f32x16& p1, float& m_reg, float& mn, float& alpha) {
  constexpr float C = SCALE * 1.4426950408889634f;
  pv_one<0>(o[0], vb, pa0, pa1, pa2, pa3);
  float pmax = p0[0];
#pragma unroll
  for (int r = 1; r < 16; ++r) pmax = fmaxf(pmax, p0[r]);
#pragma unroll
  for (int r = 0; r < 16; ++r) pmax = fmaxf(pmax, p1[r]);
  { auto rr = __builtin_amdgcn_permlane32_swap(__float_as_uint(pmax), __float_as_uint(pmax), false, false);
    pmax = fmaxf(__uint_as_float(rr[0]), __uint_as_float(rr[1])); }
  pv_one<1>(o[1], vb, pa0, pa1, pa2, pa3);
  if (__builtin_expect(__all(pmax - m_reg <= THR / SCALE), 1)) { mn = m_reg; alpha = 1.f; }
  else { mn = fmaxf(m_reg, pmax); alpha = __builtin_amdgcn_exp2f((m_reg - mn) * C); m_reg = mn; }
  const float mnC = -mn * C;
#pragma unroll
  for (int r = 0; r < 16; ++r) p0[r] = fmaf(p0[r], C, mnC);
  pv_one<2>(o[2], vb, pa0, pa1, pa2, pa3);
#pragma unroll
  for (int r = 0; r < 16; ++r) p1[r] = fmaf(p1[r], C, mnC);
#pragma unroll
  for (int r = 0; r < 8; ++r) p0[r] = __builtin_amdgcn_exp2f(p0[r]);
  pv_one<3>(o[3], vb, pa0, pa1, pa2, pa3);
#pragma unroll
  for (int r = 8; r < 16; ++r) p0[r] = __builtin_amdgcn_exp2f(p0[r]);
}

__device__ __forceinline__ void attn_unit(const bf16_t* __restrict__ Q, const bf16_t* __restrict__ K, const bf16_t* __restrict__ V, bf16_t* __restrict__ O,
                                          int ldq, int ldk, int ldo, int nt, int nfirst, int skip, int qpos0, float sinkl2, ALAS char* lds,
                                          int qmode, const float* __restrict__ gq, const float* __restrict__ ropeC, const float* __restrict__ ropeS) {
  int tid_l = tid_now(); asm volatile("" : "+v"(tid_l));
  const int tid = tid_l, wid = tid >> 6, lane = tid & 63, r32 = lane & 31, hi = lane >> 5;
  ALAS char* V_lds = lds; ALAS char* K_lds = lds + 2 * SHM_V;
  ALAS float* ws = (ALAS float*)(lds + 2 * SHM_V + 2 * SHM_K) + wid * 64; ALAS float* li_l = ws; ALAS float* al_l = ws + 32;
  float m_reg = -1e30f, l_reg = 0; f32x16 o[4] = {}; bf16x8 qr[8];
  const bf16_t* Qw = Q + (long)(wid * QBLK + r32) * ldq + hi * 8;
#pragma unroll
  for (int d0 = 0; d0 < 8; ++d0) qr[d0] = *reinterpret_cast<const bf16x8*>(Qw + d0 * 16);
  if (qmode) {
    float qf[8][8];
#pragma unroll
    for (int d0 = 0; d0 < 8; ++d0)
#pragma unroll
      for (int j = 0; j < 8; ++j) qf[d0][j] = __uint_as_float(((unsigned)(unsigned short)qr[d0][j]) << 16);
    if (qmode & 1) { float ss = 0.f;
#pragma unroll
      for (int d0 = 0; d0 < 8; ++d0)
#pragma unroll
        for (int j = 0; j < 8; ++j) ss += qf[d0][j] * qf[d0][j];
      ss += __shfl_xor(ss, 32);
      const float rstd = 1.0f / sqrtf(ss * (1.0f / 128.0f) + 1e-6f);
#pragma unroll
      for (int d0 = 0; d0 < 8; ++d0) { const float* gp = gq + d0 * 16 + hi * 8; const float4 g0 = *reinterpret_cast<const float4*>(gp), g1 = *reinterpret_cast<const float4*>(gp + 4);
        qf[d0][0] *= rstd * g0.x; qf[d0][1] *= rstd * g0.y; qf[d0][2] *= rstd * g0.z; qf[d0][3] *= rstd * g0.w; qf[d0][4] *= rstd * g1.x; qf[d0][5] *= rstd * g1.y; qf[d0][6] *= rstd * g1.z; qf[d0][7] *= rstd * g1.w; } }
    if (qmode & 2) { const int t = qpos0 + wid * QBLK + r32;
#pragma unroll
      for (int hf = 0; hf < 2; ++hf) { const int p = hf ? (t & 63) : (t >> 6);
#pragma unroll
        for (int dd = 0; dd < 2; ++dd) { const int d0 = hf * 4 + dd, i0 = dd * 16 + hi * 8;
          const float4 c0 = *reinterpret_cast<const float4*>(ropeC + p * 32 + i0), c1 = *reinterpret_cast<const float4*>(ropeC + p * 32 + i0 + 4);
          const float4 s0 = *reinterpret_cast<const float4*>(ropeS + p * 32 + i0), s1 = *reinterpret_cast<const float4*>(ropeS + p * 32 + i0 + 4);
          const float cs[8] = {c0.x, c0.y, c0.z, c0.w, c1.x, c1.y, c1.z, c1.w}, sn[8] = {s0.x, s0.y, s0.z, s0.w, s1.x, s1.y, s1.z, s1.w};
#pragma unroll
          for (int j = 0; j < 8; ++j) { const float x1 = qf[d0][j], x2 = qf[d0 + 2][j]; qf[d0][j] = x1 * cs[j] - x2 * sn[j]; qf[d0 + 2][j] = x1 * sn[j] + x2 * cs[j]; } } } }
#pragma unroll
    for (int d0 = 0; d0 < 8; ++d0) { u32x4 w = {cvtpk(qf[d0][0], qf[d0][1]), cvtpk(qf[d0][2], qf[d0][3]), cvtpk(qf[d0][4], qf[d0][5]), cvtpk(qf[d0][6], qf[d0][7])}; qr[d0] = *reinterpret_cast<bf16x8*>(&w); }
  }
  const int sr = tid >> 4, sc = (tid & 15) * 8, vst0 = v_st(sr, sc), vst1 = v_st(32 + sr, sc);
  const int vb0 = (int)(uintptr_t)V_lds + v_rd_base(lane);
  const long ko0 = (long)sr * ldk + sc, ko1 = ko0 + 32L * ldk;
  const int qi = qpos0 + wid * QBLK + r32;
  struct { bf16x8 vs0, vs1, ks0, ks1; } sr_[2];
#define KROW(t) ((t) * KVBLK + (((t) >= nfirst) ? skip : 0))
#define SLOAD(i, t) do { const long ro_ = (long)KROW(t) * ldk; sr_[i].vs0 = *reinterpret_cast<const bf16x8*>(V + ro_ + ko0); sr_[i].vs1 = *reinterpret_cast<const bf16x8*>(V + ro_ + ko1); \
    sr_[i].ks0 = *reinterpret_cast<const bf16x8*>(K + ro_ + ko0); sr_[i].ks1 = *reinterpret_cast<const bf16x8*>(K + ro_ + ko1); } while (0)
#define SWRITE(b, i) do { *(ALAS bf16x8*)(V_lds + (b) * SHM_V + vst0) = sr_[i].vs0;          \
    *(ALAS bf16x8*)(V_lds + (b) * SHM_V + vst1) = sr_[i].vs1; const int kc_ = sc * 2;               \
    *(ALAS bf16x8*)(K_lds + (b) * SHM_K + KSWZ(sr, kc_)) = sr_[i].ks0;                       \
    *(ALAS bf16x8*)(K_lds + (b) * SHM_K + KSWZ(32 + sr, kc_)) = sr_[i].ks1; } while (0)
#define SWAIT() asm volatile("s_waitcnt vmcnt(4)" ::: "memory")
#define RESC(a) do { if (__any((a) < 1.f)) { if (hi == 0) al_l[r32] = (a); asm volatile("s_waitcnt lgkmcnt(0)" ::: "memory"); \
    _Pragma("unroll") for (int d = 0; d < 4; ++d) _Pragma("unroll") for (int r = 0; r < 16; ++r) o[d][r] *= al_l[crow(r, hi)]; } } while (0)
#define MASK(P0, P1, t) do { if ((t) >= nfirst) band_mask(P0, P1, KROW(t) - 512 - qi, hi); } while (0)
  f32x16 pA0, pA1, pB0, pB1; float mnA, mnB, alA, alB; bf16x8 pa0, pa1, pa2, pa3; const int NT = nt;
  constexpr int SE = 0, SO = 1;
  SLOAD(SE, 0); asm volatile("s_waitcnt vmcnt(0)" ::: "memory"); SWRITE(0, SE); __syncthreads();
  qkt(pA0, pA1, K_lds, qr, r32, hi); MASK(pA0, pA1, 0); partialSM(pA0, pA1, m_reg, mnA, alA);
  SLOAD(SO, 1); if (2 < NT) SLOAD(SE, 2);
  SWAIT(); SWRITE(1, SO); __syncthreads();
  for (int j = 1; j + 1 < NT; j += 2) {
    SBAR(); qkt(pB0, pB1, K_lds + SHM_K, qr, r32, hi);
    finishSM(pA0, pA1, alA, l_reg, pa0, pa1, pa2, pa3); SBAR();
    SLOAD(SO, j + 2); SBAR();
    MASK(pB0, pB1, j); pv_sm(o, vb0, pa0, pa1, pa2, pa3, pB0, pB1, m_reg, mnB, alB);
    __syncthreads(); SWAIT(); SWRITE(0, SE);
    RESC(alB); __syncthreads();
    SBAR(); qkt(pA0, pA1, K_lds, qr, r32, hi);
    finishSM(pB0, pB1, alB, l_reg, pa0, pa1, pa2, pa3); SBAR();
    if (j + 3 < NT) SLOAD(SE, j + 3); SBAR();
    MASK(pA0, pA1, j + 1); pv_sm(o, vb0 + (int)SHM_V, pa0, pa1, pa2, pa3, pA0, pA1, m_reg, mnA, alA);
    __syncthreads(); SWAIT(); SWRITE(1, SO);
    RESC(alA); __syncthreads();
  }
  SBAR(); qkt(pB0, pB1, K_lds + SHM_K, qr, r32, hi);
  finishSM(pA0, pA1, alA, l_reg, pa0, pa1, pa2, pa3); SBAR();
  MASK(pB0, pB1, NT - 1); pv_sm(o, vb0, pa0, pa1, pa2, pa3, pB0, pB1, m_reg, mnB, alB);
  __syncthreads(); RESC(alB);
  finishSM(pB0, pB1, alB, l_reg, pa0, pa1, pa2, pa3); SBAR();
  pv_d0(o, vb0 + (int)SHM_V, pa0, pa1, pa2, pa3);
  l_reg += __builtin_amdgcn_exp2f(sinkl2 - m_reg * (SCALE * 1.4426950408889634f));
  if (hi == 0) li_l[r32] = l_reg; asm volatile("s_waitcnt lgkmcnt(0)" ::: "memory");
  float rli[16];
#pragma unroll
  for (int r = 0; r < 16; ++r) rli[r] = __builtin_amdgcn_rcpf(li_l[crow(r, hi)]);
  bf16_t* Ow = O + (long)(wid * QBLK) * ldo + r32;
#pragma unroll
  for (int r = 0; r < 16; ++r) { const int orow = crow(r, hi);
#pragma unroll
    for (int d0 = 0; d0 < 4; ++d0) { const unsigned w = cvtpk(o[d0][r] * rli[r], 0.f); Ow[(long)orow * ldo + d0 * 32] = (bf16_t)(w & 0xffffu); } }
#undef KROW
#undef SLOAD
#undef SWRITE
#undef SWAIT
#undef RESC
#undef MASK
}

__device__ __forceinline__ void dma16(const void* gsrc, ALAS void* lds_dst_uniform) { __builtin_amdgcn_global_load_lds((const unsigned*)gsrc, (ALAS unsigned*)lds_dst_uniform, 16, 0, 0); }
template <int NVB>
__device__ __forceinline__ void attn_unit_dma(const bf16_t* __restrict__ Q, const bf16_t* __restrict__ K, const bf16_t* __restrict__ V, bf16_t* __restrict__ O,
                                              int ldq, int ldk, int ldo, int nt, int nfirst, int skip, int qpos0, float sinkl2, ALAS char* lds, ALAS float* scr,
                                              int qmode, const float* __restrict__ gq, const float* __restrict__ ropeC, const float* __restrict__ ropeS) {
  constexpr int NVP = NVB / 2;
  int tid_l = tid_now(); asm volatile("" : "+v"(tid_l));
  const int tid = tid_l, wid = __builtin_amdgcn_readfirstlane(tid >> 6), lane = tid & 63, r32 = lane & 31, hi = lane >> 5;
  ALAS char* K_lds = lds; ALAS char* V_lds = lds + 32768; ALAS char* Qs = lds + 65536 + wid * 8192;
  ALAS float* li_l = scr; ALAS float* al_l = scr + 32;
  const int qi = qpos0 + wid * QBLK + r32;
  unsigned koff[2], voff[NVP];
#pragma unroll
  for (int i = 0; i < 2; ++i) { const int L = (wid * 2 + i) * 1024 + lane * 16, row = L >> 8, cb = (L & 255) ^ ((row & 7) << 4); koff[i] = (unsigned)(row * ldk * 2 + cb); }
#pragma unroll
  for (int i = 0; i < NVP; ++i) { const int L = (wid * NVP + i) * 1024 + lane * 16, half = L >> 14, Lh = L & 16383, sub = Lh >> 9, within = Lh & 511;
    const int kk = (sub >> 2) * 8 + (within >> 6), k = (kk & ~0xC) | ((kk & 4) << 1) | ((kk & 8) >> 1), col = half * 128 + (sub & 3) * 32 + ((within & 63) >> 1);
    voff[i] = (unsigned)(k * ldk * 2 + col * 2); }
#define KROW(t) ((t) * KVBLK + (((t) >= nfirst) ? skip : 0))
#define DK_ISSUE(t, slot) do { const char* kb_ = (const char*)K + (size_t)KROW(t) * 2 * ldk; \
    _Pragma("unroll") for (int i = 0; i < 2; ++i) dma16(kb_ + koff[i], K_lds + (slot) * 16384 + (wid * 2 + i) * 1024); } while (0)
#define DV_ISSUE(t) do { const char* vb_ = (const char*)V + (size_t)KROW(t) * 2 * ldk; \
    _Pragma("unroll") for (int i = 0; i < NVP; ++i) dma16(vb_ + voff[i], V_lds + (wid * NVP + i) * 1024); } while (0)
  DK_ISSUE(0, 0); DV_ISSUE(0); DK_ISSUE(1, 1);
  { bf16x8 qr[8];
    const bf16_t* Qw = Q + (long)(wid * QBLK + r32) * ldq + hi * 8;
#pragma unroll
    for (int d0 = 0; d0 < 8; ++d0) qr[d0] = *reinterpret_cast<const bf16x8*>(Qw + d0 * 16);
    if (qmode) {
      float qf[8][8];
#pragma unroll
      for (int d0 = 0; d0 < 8; ++d0)
#pragma unroll
        for (int j = 0; j < 8; ++j) qf[d0][j] = __uint_as_float(((unsigned)(unsigned short)qr[d0][j]) << 16);
      if (qmode & 1) { float ss = 0.f;
#pragma unroll
        for (int d0 = 0; d0 < 8; ++d0)
#pragma unroll
          for (int j = 0; j < 8; ++j) ss += qf[d0][j] * qf[d0][j];
        ss += __shfl_xor(ss, 32);
        const float rstd = 1.0f / sqrtf(ss * (1.0f / 128.0f) + 1e-6f);
#pragma unroll
        for (int d0 = 0; d0 < 8; ++d0) { const float* gp = gq + d0 * 16 + hi * 8; const float4 g0 = *reinterpret_cast<const float4*>(gp), g1 = *reinterpret_cast<const float4*>(gp + 4);
          qf[d0][0] *= rstd * g0.x; qf[d0][1] *= rstd * g0.y; qf[d0][2] *= rstd * g0.z; qf[d0][3] *= rstd * g0.w; qf[d0][4] *= rstd * g1.x; qf[d0][5] *= rstd * g1.y; qf[d0][6] *= rstd * g1.z; qf[d0][7] *= rstd * g1.w; } }
      if (qmode & 2) { const int t = qi;
#pragma unroll
        for (int hf = 0; hf < 2; ++hf) { const int p = hf ? (t & 63) : (t >> 6);
#pragma unroll
          for (int dd = 0; dd < 2; ++dd) { const int d0 = hf * 4 + dd, i0 = dd * 16 + hi * 8;
            const float4 c0 = *reinterpret_cast<const float4*>(ropeC + p * 32 + i0), c1 = *reinterpret_cast<const float4*>(ropeC + p * 32 + i0 + 4);
            const float4 s0 = *reinterpret_cast<const float4*>(ropeS + p * 32 + i0), s1 = *reinterpret_cast<const float4*>(ropeS + p * 32 + i0 + 4);
            const float cs[8] = {c0.x, c0.y, c0.z, c0.w, c1.x, c1.y, c1.z, c1.w}, sn[8] = {s0.x, s0.y, s0.z, s0.w, s1.x, s1.y, s1.z, s1.w};
#pragma unroll
            for (int j = 0; j < 8; ++j) { const float x1 = qf[d0][j], x2 = qf[d0 + 2][j]; qf[d0][j] = x1 * cs[j] - x2 * sn[j]; qf[d0 + 2][j] = x1 * sn[j] + x2 * cs[j]; } } } }
#pragma unroll
      for (int d0 = 0; d0 < 8; ++d0) { u32x4 w = {cvtpk(qf[d0][0], qf[d0][1]), cvtpk(qf[d0][2], qf[d0][3]), cvtpk(qf[d0][4], qf[d0][5]), cvtpk(qf[d0][6], qf[d0][7])}; qr[d0] = *reinterpret_cast<bf16x8*>(&w); }
    }
#pragma unroll
    for (int d0 = 0; d0 < 8; ++d0) *(ALAS bf16x8*)(Qs + (d0 * 64 + lane) * 16) = qr[d0];
  }
  float m_reg = -1e30f, l_reg = 0.f; f32x16 o[NVB] = {};
  const int vb0 = (int)(uintptr_t)V_lds + v_rd_base(lane);
  if (NVP == 4) asm volatile("s_waitcnt vmcnt(6)" ::: "memory"); else asm volatile("s_waitcnt vmcnt(4)" ::: "memory");
  asm volatile("s_waitcnt lgkmcnt(0)" ::: "memory"); __builtin_amdgcn_s_barrier();
  for (int j = 0; j < nt; ++j) {
    f32x16 p0 = f32x16{}, p1 = f32x16{}; float mn, alpha; bf16x8 pa0, pa1, pa2, pa3;
    { const ALAS char* Ks = K_lds + (j & 1) * 16384;
#pragma unroll
      for (int d0 = 0; d0 < 8; ++d0) { const int cb = (d0 * 16 + hi * 8) * 2;
        const bf16x8 qd = *(const ALAS bf16x8*)(Qs + (d0 * 64 + lane) * 16);
        const bf16x8 b0 = *reinterpret_cast<const ALAS bf16x8*>(Ks + KSWZ(r32, cb));
        const bf16x8 b1 = *reinterpret_cast<const ALAS bf16x8*>(Ks + KSWZ(32 + r32, cb));
        p0 = __builtin_amdgcn_mfma_f32_32x32x16_bf16(b0, qd, p0, 0, 0, 0);
        p1 = __builtin_amdgcn_mfma_f32_32x32x16_bf16(b1, qd, p1, 0, 0, 0); } }
    if (j >= nfirst) band_mask(p0, p1, KROW(j) - 512 - qi, hi);
    partialSM(p0, p1, m_reg, mn, alpha);
    if (__any(alpha < 1.f)) { if (hi == 0) al_l[r32] = alpha; asm volatile("s_waitcnt lgkmcnt(0)" ::: "memory");
#pragma unroll
      for (int d = 0; d < NVB; ++d)
#pragma unroll
        for (int r = 0; r < 16; ++r) o[d][r] *= al_l[crow(r, hi)]; }
    finishSM(p0, p1, alpha, l_reg, pa0, pa1, pa2, pa3);
    asm volatile("s_waitcnt vmcnt(0) lgkmcnt(0)" ::: "memory"); __builtin_amdgcn_s_barrier();
    pv_one<0>(o[0], vb0, pa0, pa1, pa2, pa3); pv_one<1>(o[1], vb0, pa0, pa1, pa2, pa3); pv_one<2>(o[2], vb0, pa0, pa1, pa2, pa3); pv_one<3>(o[3], vb0, pa0, pa1, pa2, pa3);
    if constexpr (NVB == 8) { pv_one<0>(o[4], vb0 + 16384, pa0, pa1, pa2, pa3); pv_one<1>(o[5], vb0 + 16384, pa0, pa1, pa2, pa3); pv_one<2>(o[6], vb0 + 16384, pa0, pa1, pa2, pa3); pv_one<3>(o[7], vb0 + 16384, pa0, pa1, pa2, pa3); }
    asm volatile("s_waitcnt lgkmcnt(0)" ::: "memory"); __builtin_amdgcn_s_barrier();
    if (j + 1 < nt) DV_ISSUE(j + 1);
    if (j + 2 < nt) DK_ISSUE(j + 2, j & 1);
  }
#undef DK_ISSUE
#undef DV_ISSUE
#undef KROW
  l_reg += __builtin_amdgcn_exp2f(sinkl2 - m_reg * (SCALE * 1.4426950408889634f));
  if (hi == 0) li_l[r32] = l_reg; asm volatile("s_waitcnt lgkmcnt(0)" ::: "memory");
  float rli[16];
#pragma unroll
  for (int r = 0; r < 16; ++r) rli[r] = __builtin_amdgcn_rcpf(li_l[crow(r, hi)]);
  { constexpr int RB = NVB * 64, NPASS = RB / 256, RPP = 32 / NPASS, PPR = RB / 16;
    ALAS char* og = Qs; bf16_t* Og = O + (long)(wid * QBLK) * ldo;
#pragma unroll
    for (int ps = 0; ps < NPASS; ++ps) {
#pragma unroll
      for (int r = 0; r < 16; ++r) { const int row = crow(r, hi); if (row / RPP != ps) continue; const int lrow = row - RPP * ps;
#pragma unroll
        for (int d = 0; d < NVB; ++d) { const unsigned w = cvtpk(o[d][r] * rli[r], 0.f); *(ALAS unsigned short*)(og + lrow * RB + (d * 32 + r32) * 2) = (unsigned short)(w & 0xffffu); } }
#pragma unroll
      for (int k = 0; k < 8; ++k) { const int p = lane + 64 * k; const u32x4 v = *(const ALAS u32x4*)(og + p * 16);
        *reinterpret_cast<u32x4*>(Og + (long)(RPP * ps + p / PPR) * ldo + (p % PPR) * 8) = v; }
    } }
}

#define PP_WAIT2(N, A, B) asm volatile("s_waitcnt lgkmcnt(" #N ")" : "+v"(A), "+v"(B) :: "memory")
__device__ __forceinline__ void qk_seg(f32x16& p0, f32x16& p1, const ALAS char* Ks, const bf16x8* qr, const f32x16& negm, int r32, int hi) {
  int sw = ((r32 & 7) << 4) ^ (hi * 16); asm volatile("" : "+v"(sw));
  const int r0 = (int)(uintptr_t)Ks + r32 * 256;
#define KRD(DST0, DST1, d0) do { const int ad_ = r0 + (((d0) * 32) ^ sw); asm volatile("ds_read_b128 %0, %2\n\tds_read_b128 %1, %2 offset:8192" : "=&v"(DST0), "=&v"(DST1) : "v"(ad_) : "memory"); } while (0)
  bf16x8 a[3], b[3];
  KRD(a[0], b[0], 0); KRD(a[1], b[1], 1); KRD(a[2], b[2], 2);
  SBAR(); __builtin_amdgcn_s_setprio(1);
#pragma unroll
  for (int d0 = 0; d0 < 8; ++d0) {
    if (d0 < 6) PP_WAIT2(4, a[d0 % 3], b[d0 % 3]); else if (d0 == 6) PP_WAIT2(2, a[d0 % 3], b[d0 % 3]); else PP_WAIT2(0, a[d0 % 3], b[d0 % 3]);
    p0 = __builtin_amdgcn_mfma_f32_32x32x16_bf16(a[d0 % 3], qr[d0], d0 == 0 ? negm : p0, 0, 0, 0);
    p1 = __builtin_amdgcn_mfma_f32_32x32x16_bf16(b[d0 % 3], qr[d0], d0 == 0 ? negm : p1, 0, 0, 0);
    SBAR();
    if (d0 + 3 < 8) { KRD(a[d0 % 3], b[d0 % 3], d0 + 3); SBAR(); }
  }
  __builtin_amdgcn_s_setprio(0);
#undef KRD
}
__device__ __forceinline__ void pv_seg(f32x16* o, const ALAS char* vbp, bf16x8 pa0, bf16x8 pa1, bf16x8 pa2, bf16x8 pa3) {
  const int vb = (int)(uintptr_t)vbp;
#define PK(L, H) (bf16x8){L[0], L[1], L[2], L[3], H[0], H[1], H[2], H[3]}
  s16x4 lo[4], hh[4];
  lo[0] = tr_read<v_rd_off(0, 0, 0)>(vb); hh[0] = tr_read<v_rd_off(0, 0, 1)>(vb); lo[1] = tr_read<v_rd_off(0, 1, 0)>(vb); hh[1] = tr_read<v_rd_off(0, 1, 1)>(vb);
  lo[2] = tr_read<v_rd_off(0, 2, 0)>(vb); hh[2] = tr_read<v_rd_off(0, 2, 1)>(vb); lo[3] = tr_read<v_rd_off(0, 3, 0)>(vb); hh[3] = tr_read<v_rd_off(0, 3, 1)>(vb);
  SBAR(); __builtin_amdgcn_s_setprio(1);
#define PVSTEP(d, ks, PA, WN, NEXT) do { PP_WAIT2(WN, lo[ks], hh[ks]); o[d] = __builtin_amdgcn_mfma_f32_32x32x16_bf16(PA, PK(lo[ks], hh[ks]), o[d], 0, 0, 0); SBAR(); \
    if (NEXT) { lo[ks] = tr_read<v_rd_off(((d) + 1) & 3, ks, 0)>(vb); hh[ks] = tr_read<v_rd_off(((d) + 1) & 3, ks, 1)>(vb); SBAR(); } } while (0)
  PVSTEP(0, 0, pa0, 6, 1); PVSTEP(0, 1, pa1, 6, 1); PVSTEP(0, 2, pa2, 6, 1); PVSTEP(0, 3, pa3, 6, 1);
  PVSTEP(1, 0, pa0, 6, 1); PVSTEP(1, 1, pa1, 6, 1); PVSTEP(1, 2, pa2, 6, 1); PVSTEP(1, 3, pa3, 6, 1);
  PVSTEP(2, 0, pa0, 6, 1); PVSTEP(2, 1, pa1, 6, 1); PVSTEP(2, 2, pa2, 6, 1); PVSTEP(2, 3, pa3, 6, 1);
  PVSTEP(3, 0, pa0, 6, 0); PVSTEP(3, 1, pa1, 4, 0); PVSTEP(3, 2, pa2, 2, 0); PVSTEP(3, 3, pa3, 0, 0);
  { const bf16x8 ones = {0x3F80, 0x3F80, 0x3F80, 0x3F80, 0x3F80, 0x3F80, 0x3F80, 0x3F80};
    o[4] = __builtin_amdgcn_mfma_f32_32x32x16_bf16(pa0, ones, o[4], 0, 0, 0); o[4] = __builtin_amdgcn_mfma_f32_32x32x16_bf16(pa1, ones, o[4], 0, 0, 0);
    o[4] = __builtin_amdgcn_mfma_f32_32x32x16_bf16(pa2, ones, o[4], 0, 0, 0); o[4] = __builtin_amdgcn_mfma_f32_32x32x16_bf16(pa3, ones, o[4], 0, 0, 0); SBAR(); }
  __builtin_amdgcn_s_setprio(0);
#undef PVSTEP
#undef PK
}
constexpr float THRL2 = THR * 1.4426950408889634f;
__device__ __forceinline__ void psm_n(f32x16& p0, f32x16& p1, float& m_reg, float& alpha, f32x16& negm, bool first) {
  float pmax = fmaxf(p0[0], p1[0]);
#pragma unroll
  for (int r = 1; r < 16; ++r) pmax = fmaxf(pmax, fmaxf(p0[r], p1[r]));
  { auto rr = __builtin_amdgcn_permlane32_swap(__float_as_uint(pmax), __float_as_uint(pmax), false, false); pmax = fmaxf(__uint_as_float(rr[0]), __uint_as_float(rr[1])); }
  alpha = 1.f;
  if (first || !__all(pmax <= THRL2)) { const float delta = first ? pmax : fmaxf(pmax, 0.f); if (!first) alpha = __builtin_amdgcn_exp2f(-delta); m_reg += delta;
#pragma unroll
    for (int r = 0; r < 16; ++r) { p0[r] -= delta; p1[r] -= delta; negm[r] = -m_reg; } }
#pragma unroll
  for (int r = 0; r < 16; ++r) p0[r] = __builtin_amdgcn_exp2f(p0[r]);
}
__device__ __forceinline__ void fsm_n(f32x16& p0, f32x16& p1, bf16x8& pa0, bf16x8& pa1, bf16x8& pa2, bf16x8& pa3) {
#pragma unroll
  for (int r = 0; r < 16; ++r) p1[r] = __builtin_amdgcn_exp2f(p1[r]);
#define PK4(P, BASE, OUT) do { unsigned a0 = cvtpk(P[BASE + 0], P[BASE + 1]), a1 = cvtpk(P[BASE + 2], P[BASE + 3]);   \
    unsigned b0 = cvtpk(P[BASE + 4], P[BASE + 5]), b1 = cvtpk(P[BASE + 6], P[BASE + 7]);                              \
    auto r0 = __builtin_amdgcn_permlane32_swap(a0, b0, false, false); auto r1 = __builtin_amdgcn_permlane32_swap(a1, b1, false, false); \
    u32x4 w = {r0[0], r1[0], r0[1], r1[1]}; OUT = *reinterpret_cast<bf16x8*>(&w); } while (0)
  PK4(p0, 0, pa0); PK4(p0, 8, pa1); PK4(p1, 0, pa2); PK4(p1, 8, pa3);
#undef PK4
}
__device__ __forceinline__ void attn_unit_dma2(const bf16_t* __restrict__ Q, const bf16_t* __restrict__ K, const bf16_t* __restrict__ V, bf16_t* __restrict__ O,
                                               int ldq, int ldk, int ldo, int nt, int nfirst, int skip, int qpos0, float sinkl2, ALAS char* lds, ALAS float* scr,
                                               int qmode, const float* __restrict__ gq, const float* __restrict__ ropeC, const float* __restrict__ ropeS) {
  int tid_l = tid_now(); asm volatile("" : "+v"(tid_l));
  const int tid = tid_l, wid = __builtin_amdgcn_readfirstlane(tid >> 6), lane = tid & 63, r32 = lane & 31, hi = lane >> 5;
  ALAS char* K_lds = lds; ALAS char* V_lds = lds + 32768;
  ALAS float* li_l = scr; ALAS float* al_l = scr + 32;
  const int qi = qpos0 + wid * QBLK + r32;
  unsigned koff[2], voff[2];
#pragma unroll
  for (int i = 0; i < 2; ++i) { const int L = (wid * 2 + i) * 1024 + lane * 16, row = L >> 8, cb = (L & 255) ^ ((row & 7) << 4); koff[i] = (unsigned)(row * ldk * 2 + cb); }
#pragma unroll
  for (int i = 0; i < 2; ++i) { const int L = (wid * 2 + i) * 1024 + lane * 16, sub = L >> 9, within = L & 511;
    const int kk = (sub >> 2) * 8 + (within >> 6), k = (kk & ~0xC) | ((kk & 4) << 1) | ((kk & 8) >> 1), col = (sub & 3) * 32 + ((within & 63) >> 1);
    voff[i] = (unsigned)(k * ldk * 2 + col * 2); }
#define KROW(t) ((t) * KVBLK + (((t) >= nfirst) ? skip : 0))
#define DK_ISSUE(t, slot) do { const char* kb_ = (const char*)K + (size_t)KROW(t) * 2 * ldk; \
    _Pragma("unroll") for (int i = 0; i < 2; ++i) dma16(kb_ + koff[i], K_lds + (slot) * 16384 + (wid * 2 + i) * 1024); } while (0)
#define DV_ISSUE(t, slot) do { const char* vb_ = (const char*)V + (size_t)KROW(t) * 2 * ldk; \
    _Pragma("unroll") for (int i = 0; i < 2; ++i) dma16(vb_ + voff[i], V_lds + (slot) * 16384 + (wid * 2 + i) * 1024); } while (0)
#define RESC(a) do { if (__any((a) < 1.f)) { if (hi == 0) al_l[r32] = (a); asm volatile("s_waitcnt lgkmcnt(0)" ::: "memory"); \
    _Pragma("unroll") for (int d = 0; d < 4; ++d) _Pragma("unroll") for (int r = 0; r < 16; ++r) o[d][r] *= al_l[crow(r, hi)]; } } while (0)
#define MASK(P0, P1, t) do { if ((t) >= nfirst) band_mask(P0, P1, KROW(t) - 512 - qi, hi); } while (0)
#define STEP_SYNC() do { asm volatile("s_waitcnt vmcnt(0) lgkmcnt(0)" ::: "memory"); __builtin_amdgcn_s_barrier(); } while (0)
  DK_ISSUE(0, 0); DV_ISSUE(0, 0); DK_ISSUE(1, 1);
  bf16x8 qr[8];
  { const bf16_t* Qw = Q + (long)(wid * QBLK + r32) * ldq + hi * 8;
#pragma unroll
    for (int d0 = 0; d0 < 8; ++d0) qr[d0] = *reinterpret_cast<const bf16x8*>(Qw + d0 * 16);
    if (qmode) {
      float qf[8][8];
#pragma unroll
      for (int d0 = 0; d0 < 8; ++d0)
#pragma unroll
        for (int j = 0; j < 8; ++j) qf[d0][j] = __uint_as_float(((unsigned)(unsigned short)qr[d0][j]) << 16);
      if (qmode & 1) { float ss = 0.f;
#pragma unroll
        for (int d0 = 0; d0 < 8; ++d0)
#pragma unroll
          for (int j = 0; j < 8; ++j) ss += qf[d0][j] * qf[d0][j];
        ss += __shfl_xor(ss, 32);
        const float rstd = 1.0f / sqrtf(ss * (1.0f / 128.0f) + 1e-6f);
#pragma unroll
        for (int d0 = 0; d0 < 8; ++d0) { const float* gp = gq + d0 * 16 + hi * 8; const float4 g0 = *reinterpret_cast<const float4*>(gp), g1 = *reinterpret_cast<const float4*>(gp + 4);
          qf[d0][0] *= rstd * g0.x; qf[d0][1] *= rstd * g0.y; qf[d0][2] *= rstd * g0.z; qf[d0][3] *= rstd * g0.w; qf[d0][4] *= rstd * g1.x; qf[d0][5] *= rstd * g1.y; qf[d0][6] *= rstd * g1.z; qf[d0][7] *= rstd * g1.w; } }
      if (qmode & 2) { const int t = qi;
#pragma unroll
        for (int hf = 0; hf < 2; ++hf) { const int p = hf ? (t & 63) : (t >> 6);
#pragma unroll
          for (int dd = 0; dd < 2; ++dd) { const int d0 = hf * 4 + dd, i0 = dd * 16 + hi * 8;
            const float4 c0 = *reinterpret_cast<const float4*>(ropeC + p * 32 + i0), c1 = *reinterpret_cast<const float4*>(ropeC + p * 32 + i0 + 4);
            const float4 s0 = *reinterpret_cast<const float4*>(ropeS + p * 32 + i0), s1 = *reinterpret_cast<const float4*>(ropeS + p * 32 + i0 + 4);
            const float cs[8] = {c0.x, c0.y, c0.z, c0.w, c1.x, c1.y, c1.z, c1.w}, sn[8] = {s0.x, s0.y, s0.z, s0.w, s1.x, s1.y, s1.z, s1.w};
#pragma unroll
            for (int j = 0; j < 8; ++j) { const float x1 = qf[d0][j], x2 = qf[d0 + 2][j]; qf[d0][j] = x1 * cs[j] - x2 * sn[j]; qf[d0 + 2][j] = x1 * sn[j] + x2 * cs[j]; } } } }
#pragma unroll
      for (int d0 = 0; d0 < 8; ++d0) { u32x4 w = {cvtpk(qf[d0][0], qf[d0][1]), cvtpk(qf[d0][2], qf[d0][3]), cvtpk(qf[d0][4], qf[d0][5]), cvtpk(qf[d0][6], qf[d0][7])}; qr[d0] = *reinterpret_cast<bf16x8*>(&w); }
    } }
  float m_reg = -1e30f, l_reg = 0.f; f32x16 o[4] = {};
  const int vb0 = (int)(uintptr_t)V_lds + v_rd_base(lane);
  f32x16 pA0, pA1, pB0, pB1; float mnA, mnB, alA, alB; bf16x8 pa0, pa1, pa2, pa3;
  STEP_SYNC();
  qkt(pA0, pA1, K_lds, qr, r32, hi); MASK(pA0, pA1, 0); partialSM(pA0, pA1, m_reg, mnA, alA);
  STEP_SYNC();
  int j = 0;
  for (; j + 2 < nt; j += 2) {
    DK_ISSUE(j + 2, 0); DV_ISSUE(j + 1, 1);
    SBAR(); qkt(pB0, pB1, K_lds + 16384, qr, r32, hi);
    finishSM(pA0, pA1, alA, l_reg, pa0, pa1, pa2, pa3); SBAR();
    MASK(pB0, pB1, j + 1); pv_sm(o, vb0, pa0, pa1, pa2, pa3, pB0, pB1, m_reg, mnB, alB);
    STEP_SYNC();
    RESC(alB);
    if (j + 3 < nt) DK_ISSUE(j + 3, 1);
    DV_ISSUE(j + 2, 0);
    SBAR(); qkt(pA0, pA1, K_lds, qr, r32, hi);
    finishSM(pB0, pB1, alB, l_reg, pa0, pa1, pa2, pa3); SBAR();
    MASK(pA0, pA1, j + 2); pv_sm(o, vb0 + 16384, pa0, pa1, pa2, pa3, pA0, pA1, m_reg, mnA, alA);
    STEP_SYNC();
    RESC(alA);
  }
  DV_ISSUE(j + 1, 1);
  SBAR(); qkt(pB0, pB1, K_lds + 16384, qr, r32, hi);
  finishSM(pA0, pA1, alA, l_reg, pa0, pa1, pa2, pa3); SBAR();
  MASK(pB0, pB1, j + 1); pv_sm(o, vb0, pa0, pa1, pa2, pa3, pB0, pB1, m_reg, mnB, alB);
  STEP_SYNC();
  RESC(alB);
  finishSM(pB0, pB1, alB, l_reg, pa0, pa1, pa2, pa3); SBAR();
  pv_d0(o, vb0 + 16384, pa0, pa1, pa2, pa3);
  STEP_SYNC();
#undef DK_ISSUE
#undef DV_ISSUE
#undef KROW
#undef RESC
#undef MASK
#undef STEP_SYNC
  l_reg += __builtin_amdgcn_exp2f(sinkl2 - m_reg * (SCALE * 1.4426950408889634f));
  if (hi == 0) li_l[r32] = l_reg; asm volatile("s_waitcnt lgkmcnt(0)" ::: "memory");
  float rli[16];
#pragma unroll
  for (int r = 0; r < 16; ++r) rli[r] = __builtin_amdgcn_rcpf(li_l[crow(r, hi)]);
  { ALAS char* og = lds + wid * 8192; bf16_t* Og = O + (long)(wid * QBLK) * ldo;
#pragma unroll
    for (int r = 0; r < 16; ++r) { const int row = crow(r, hi);
#pragma unroll
      for (int d = 0; d < 4; ++d) { const unsigned w = cvtpk(o[d][r] * rli[r], 0.f); *(ALAS unsigned short*)(og + row * 256 + (d * 32 + r32) * 2) = (unsigned short)(w & 0xffffu); } }
#pragma unroll
    for (int k = 0; k < 8; ++k) { const int p = lane + 64 * k; const u32x4 v = *(const ALAS u32x4*)(og + p * 16);
      *reinterpret_cast<u32x4*>(Og + (long)(p >> 4) * ldo + (p & 15) * 8) = v; }
  }
}

__device__ __forceinline__ void attn_unit_pp(const bf16_t* __restrict__ Q, const bf16_t* __restrict__ K, const bf16_t* __restrict__ V, bf16_t* __restrict__ O,
                                               int ldq, int ldk, int ldo, int nt, int nfirst, int skip, int qpos0, float sinkl2, ALAS char* lds, ALAS float* scr,
                                               int qmode, const float* __restrict__ gq, const float* __restrict__ ropeC, const float* __restrict__ ropeS) {
  int tid_l = tid_now(); asm volatile("" : "+v"(tid_l));
  const int tid = tid_l, wid = __builtin_amdgcn_readfirstlane(tid >> 6), lane = tid & 63, r32 = lane & 31, hi = lane >> 5;
  ALAS char* K_lds = lds; ALAS char* V_lds = lds + 32768;
  ALAS float* li_l = scr; ALAS float* al_l = scr + 32;
  const int qi = qpos0 + wid * QBLK + r32;
  unsigned koff[2], voff[2];
#pragma unroll
  for (int i = 0; i < 2; ++i) { const int L = (wid * 2 + i) * 1024 + lane * 16, row = L >> 8, cb = (L & 255) ^ ((row & 7) << 4); koff[i] = (unsigned)(row * ldk * 2 + cb); }
#pragma unroll
  for (int i = 0; i < 2; ++i) { const int L = (wid * 2 + i) * 1024 + lane * 16, sub = L >> 9, within = L & 511;
    const int kk = (sub >> 2) * 8 + (within >> 6), k = (kk & ~0xC) | ((kk & 4) << 1) | ((kk & 8) >> 1), col = (sub & 3) * 32 + ((within & 63) >> 1);
    voff[i] = (unsigned)(k * ldk * 2 + col * 2); }
#define KROW(t) ((t) * KVBLK + (((t) >= nfirst) ? skip : 0))
#define DK_ISSUE(t, slot) do { const char* kb_ = (const char*)K + (size_t)KROW(t) * 2 * ldk; \
    _Pragma("unroll") for (int i = 0; i < 2; ++i) dma16(kb_ + koff[i], K_lds + (slot) * 16384 + (wid * 2 + i) * 1024); } while (0)
#define DV_ISSUE(t, slot) do { const char* vb_ = (const char*)V + (size_t)KROW(t) * 2 * ldk; \
    _Pragma("unroll") for (int i = 0; i < 2; ++i) dma16(vb_ + voff[i], V_lds + (slot) * 16384 + (wid * 2 + i) * 1024); } while (0)
#define RESC(a) do { if (__any((a) < 1.f)) { if (hi == 0) al_l[r32] = (a); asm volatile("s_waitcnt lgkmcnt(0)" ::: "memory"); \
    _Pragma("unroll") for (int d = 0; d < 5; ++d) _Pragma("unroll") for (int r = 0; r < 16; ++r) o[d][r] *= al_l[crow(r, hi)]; } } while (0)
#define MASK(P0, P1, t) do { if ((t) >= nfirst) band_mask(P0, P1, KROW(t) - 512 - qi, hi); } while (0)
#define STEP_SYNC() do { asm volatile("s_waitcnt vmcnt(0) lgkmcnt(0)" ::: "memory"); __builtin_amdgcn_s_barrier(); } while (0)
  DK_ISSUE(0, 0);
  bf16x8 qr[8];
  { const bf16_t* Qw = Q + (long)(wid * QBLK + r32) * ldq + hi * 8;
#pragma unroll
    for (int d0 = 0; d0 < 8; ++d0) qr[d0] = *reinterpret_cast<const bf16x8*>(Qw + d0 * 16);
    {
      constexpr float CQ = SCALE * 1.4426950408889634f;
      float qf[8][8];
#pragma unroll
      for (int d0 = 0; d0 < 8; ++d0)
#pragma unroll
        for (int j = 0; j < 8; ++j) qf[d0][j] = __uint_as_float(((unsigned)(unsigned short)qr[d0][j]) << 16);
      if (qmode & 1) { float ss = 0.f;
#pragma unroll
        for (int d0 = 0; d0 < 8; ++d0)
#pragma unroll
          for (int j = 0; j < 8; ++j) ss += qf[d0][j] * qf[d0][j];
        ss += __shfl_xor(ss, 32);
        const float rstd = 1.0f / sqrtf(ss * (1.0f / 128.0f) + 1e-6f);
#pragma unroll
        for (int d0 = 0; d0 < 8; ++d0) { const float* gp = gq + d0 * 16 + hi * 8; const float4 g0 = *reinterpret_cast<const float4*>(gp), g1 = *reinterpret_cast<const float4*>(gp + 4);
          qf[d0][0] *= rstd * g0.x; qf[d0][1] *= rstd * g0.y; qf[d0][2] *= rstd * g0.z; qf[d0][3] *= rstd * g0.w; qf[d0][4] *= rstd * g1.x; qf[d0][5] *= rstd * g1.y; qf[d0][6] *= rstd * g1.z; qf[d0][7] *= rstd * g1.w; } }
      if (qmode & 2) { const int t = qi;
#pragma unroll
        for (int hf = 0; hf < 2; ++hf) { const int p = hf ? (t & 63) : (t >> 6);
#pragma unroll
          for (int dd = 0; dd < 2; ++dd) { const int d0 = hf * 4 + dd, i0 = dd * 16 + hi * 8;
            const float4 c0 = *reinterpret_cast<const float4*>(ropeC + p * 32 + i0), c1 = *reinterpret_cast<const float4*>(ropeC + p * 32 + i0 + 4);
            const float4 s0 = *reinterpret_cast<const float4*>(ropeS + p * 32 + i0), s1 = *reinterpret_cast<const float4*>(ropeS + p * 32 + i0 + 4);
            const float cs[8] = {c0.x, c0.y, c0.z, c0.w, c1.x, c1.y, c1.z, c1.w}, sn[8] = {s0.x, s0.y, s0.z, s0.w, s1.x, s1.y, s1.z, s1.w};
#pragma unroll
            for (int j = 0; j < 8; ++j) { const float x1 = qf[d0][j], x2 = qf[d0 + 2][j]; qf[d0][j] = x1 * cs[j] - x2 * sn[j]; qf[d0 + 2][j] = x1 * sn[j] + x2 * cs[j]; } } } }
#pragma unroll
      for (int d0 = 0; d0 < 8; ++d0) { u32x4 w = {cvtpk(qf[d0][0] * CQ, qf[d0][1] * CQ), cvtpk(qf[d0][2] * CQ, qf[d0][3] * CQ), cvtpk(qf[d0][4] * CQ, qf[d0][5] * CQ), cvtpk(qf[d0][6] * CQ, qf[d0][7] * CQ)}; qr[d0] = *reinterpret_cast<bf16x8*>(&w); }
    } }
  float m_reg = 0.f; f32x16 o[5] = {}; f32x16 negm = {};
  const ALAS char* vbp = V_lds + v_rd_base(lane);
  f32x16 p0 = {}, p1 = {}; float al = 1.f; bf16x8 pa0 = {}, pa1 = {}, pa2 = {}, pa3 = {};
  const int grp = wid >> 2;
#define SEG_END() do { SBAR(); __builtin_amdgcn_s_barrier(); SBAR(); } while (0)
#define PSEG(t) do { MASK(p0, p1, t); psm_n(p0, p1, m_reg, al, negm, (t) == 0); RESC(al); } while (0)
  STEP_SYNC();
#define SEG_END_V() do { SBAR(); asm volatile("s_waitcnt vmcnt(0)" ::: "memory"); __builtin_amdgcn_s_barrier(); SBAR(); } while (0)
  if (grp == 0) {
    for (int j = 0; j < nt; ++j) {
      const int sc = (j & 1) * 16384, sn = 16384 - sc;
      if (j + 1 < nt) DK_ISSUE(j + 1, (j + 1) & 1);
      DV_ISSUE(j, j & 1);
      if (j > 0) { pv_seg(o, vbp + sn, pa0, pa1, pa2, pa3); SBAR(); }
      qk_seg(p0, p1, K_lds + sc, qr, negm, r32, hi);
      SEG_END();
      PSEG(j);
      fsm_n(p0, p1, pa0, pa1, pa2, pa3);
      SEG_END_V();
    }
    pv_seg(o, vbp + ((nt - 1) & 1) * 16384, pa0, pa1, pa2, pa3);
    SEG_END();
  } else {
    DK_ISSUE(1, 1);
    DV_ISSUE(0, 0);
    SEG_END();
    for (int j = 0; j < nt; ++j) {
      const int sc = (j & 1) * 16384, sn = 16384 - sc;
      if (j > 0) { pv_seg(o, vbp + sn, pa0, pa1, pa2, pa3); SBAR(); }
      qk_seg(p0, p1, K_lds + sc, qr, negm, r32, hi);
      SEG_END_V();
      if (j + 2 < nt) DK_ISSUE(j + 2, j & 1);
      if (j + 1 < nt) DV_ISSUE(j + 1, (j + 1) & 1);
      PSEG(j);
      fsm_n(p0, p1, pa0, pa1, pa2, pa3);
      SEG_END();
    }
    pv_seg(o, vbp + ((nt - 1) & 1) * 16384, pa0, pa1, pa2, pa3);
  }
  STEP_SYNC();
#undef SEG_END_V
#undef PSEG
#undef SEG_END
#undef DK_ISSUE
#undef DV_ISSUE
#undef KROW
#undef RESC
#undef MASK
#undef STEP_SYNC
  if (hi == 0) li_l[r32] = m_reg; asm volatile("s_waitcnt lgkmcnt(0)" ::: "memory");
  float rli[16];
#pragma unroll
  for (int r = 0; r < 16; ++r) rli[r] = __builtin_amdgcn_rcpf(o[4][r] + __builtin_amdgcn_exp2f(sinkl2 - li_l[crow(r, hi)]));
  { ALAS char* og = lds + wid * 8192; bf16_t* Og = O + (long)(wid * QBLK) * ldo;
#pragma unroll
    for (int r = 0; r < 16; ++r) { const int row = crow(r, hi);
#pragma unroll
      for (int d = 0; d < 4; ++d) { const unsigned w = cvtpk(o[d][r] * rli[r], 0.f); *(ALAS unsigned short*)(og + row * 256 + (d * 32 + r32) * 2) = (unsigned short)(w & 0xffffu); } }
#pragma unroll
    for (int k = 0; k < 8; ++k) { const int p = lane + 64 * k; const u32x4 v = *(const ALAS u32x4*)(og + p * 16);
      *reinterpret_cast<u32x4*>(Og + (long)(p >> 4) * ldo + (p & 15) * 8) = v; }
  }
}

#define G_CVT4(P, BASE) do { t0 = cvtpk(P[BASE + 0], P[BASE + 1]); t1 = cvtpk(P[BASE + 2], P[BASE + 3]); t2 = cvtpk(P[BASE + 4], P[BASE + 5]); t3 = cvtpk(P[BASE + 6], P[BASE + 7]); } while (0)
#define G_SWP4(OUT) do { auto r0_ = __builtin_amdgcn_permlane32_swap(t0, t2, false, false); auto r1_ = __builtin_amdgcn_permlane32_swap(t1, t3, false, false); \
    u32x4 w_ = {r0_[0], r1_[0], r0_[1], r1_[1]}; OUT = *reinterpret_cast<bf16x8*>(&w_); } while (0)
__device__ __forceinline__ void blk_qk_fin(f32x16& n0, f32x16& n1, const ALAS char* Ks, const bf16x8* qr, const f32x16& negm, int r32, int hi,
                                           const f32x16& c0, f32x16& c1, bf16x8& pa0, bf16x8& pa1, bf16x8& pa2, float alpha_c, float& l_reg) {
  int sw = ((r32 & 7) << 4) ^ (hi * 16); asm volatile("" : "+v"(sw));
  const int r0 = (int)(uintptr_t)Ks + r32 * 256;
#define KRD(DST0, DST1, d0) do { const int ad_ = r0 + (((d0) * 32) ^ sw); asm volatile("ds_read_b128 %0, %2\n\tds_read_b128 %1, %2 offset:8192" : "=&v"(DST0), "=&v"(DST1) : "v"(ad_) : "memory"); } while (0)
  bf16x8 a[2], b[2]; unsigned t0 = 0, t1 = 0, t2 = 0, t3 = 0; float psA = 0.f, psB = 0.f;
  KRD(a[0], b[0], 0); KRD(a[1], b[1], 1);
  SBAR();
#pragma unroll
  for (int d0 = 0; d0 < 8; ++d0) {
    if (d0 < 7) PP_WAIT2(2, a[d0 & 1], b[d0 & 1]); else PP_WAIT2(0, a[d0 & 1], b[d0 & 1]);
    n0 = __builtin_amdgcn_mfma_f32_32x32x16_bf16(a[d0 & 1], qr[d0], d0 == 0 ? negm : n0, 0, 0, 0);
    n1 = __builtin_amdgcn_mfma_f32_32x32x16_bf16(b[d0 & 1], qr[d0], d0 == 0 ? negm : n1, 0, 0, 0);
    SBAR();
    if (d0 + 2 < 8) { KRD(a[d0 & 1], b[d0 & 1], d0 + 2); SBAR(); }
    c1[2 * d0] = __builtin_amdgcn_exp2f(c1[2 * d0]); c1[2 * d0 + 1] = __builtin_amdgcn_exp2f(c1[2 * d0 + 1]);
    psA += c0[2 * d0] + c0[2 * d0 + 1]; if (d0 > 0) psB += c1[2 * d0 - 2] + c1[2 * d0 - 1];
    if (d0 == 0) G_CVT4(c0, 0); if (d0 == 1) G_SWP4(pa0); if (d0 == 2) G_CVT4(c0, 8); if (d0 == 3) G_SWP4(pa1); if (d0 == 4) G_CVT4(c1, 0); if (d0 == 5) G_SWP4(pa2);
    SBAR();
  }
  { float ps = (psA + psB) + (c1[14] + c1[15]); auto rr = __builtin_amdgcn_permlane32_swap(__float_as_uint(ps), __float_as_uint(ps), false, false);
    l_reg = l_reg * alpha_c + (__uint_as_float(rr[0]) + __uint_as_float(rr[1])); }
#undef KRD
}
__device__ __forceinline__ void blk_pv_par(f32x16* o, const ALAS char* vbp, bf16x8 pa0, bf16x8 pa1, bf16x8 pa2, const f32x16& c1,
                                           f32x16& n0, f32x16& n1, float& m_reg, float& alpha, f32x16& negm, bool domask, int dj, int hi) {
  const int vb = (int)(uintptr_t)vbp;
#define PK(L, H) (bf16x8){L[0], L[1], L[2], L[3], H[0], H[1], H[2], H[3]}
  s16x4 lo[3], hh[3]; bf16x8 pa3 = {}; unsigned t0 = 0, t1 = 0, t2 = 0, t3 = 0; float mA = 0.f, mB = 0.f, pmax = 0.f;
  lo[0] = tr_read<v_rd_off(0, 0, 0)>(vb); hh[0] = tr_read<v_rd_off(0, 0, 1)>(vb); lo[1] = tr_read<v_rd_off(0, 1, 0)>(vb); hh[1] = tr_read<v_rd_off(0, 1, 1)>(vb);
  lo[2] = tr_read<v_rd_off(0, 2, 0)>(vb); hh[2] = tr_read<v_rd_off(0, 2, 1)>(vb);
  if (domask) band_mask(n0, n1, dj, hi);
  SBAR();
#define PVSTEP(d, ks, PA, WN, NEXT) do { constexpr int i_ = (d) * 4 + (ks), s_ = i_ % 3, n_ = i_ + 3; PP_WAIT2(WN, lo[s_], hh[s_]); o[d] = __builtin_amdgcn_mfma_f32_32x32x16_bf16(PA, PK(lo[s_], hh[s_]), o[d], 0, 0, 0); SBAR(); \
    if (NEXT) { lo[s_] = tr_read<v_rd_off((n_ >> 2) & 3, n_ & 3, 0)>(vb); hh[s_] = tr_read<v_rd_off((n_ >> 2) & 3, n_ & 3, 1)>(vb); SBAR(); } } while (0)
#define MX3(M, P, i) M = fmaxf(fmaxf(M, P[i]), P[(i) + 1])
  PVSTEP(0, 0, pa0, 4, 1); G_CVT4(c1, 8); SBAR();
  PVSTEP(0, 1, pa1, 4, 1); G_SWP4(pa3); SBAR();
  PVSTEP(0, 2, pa2, 4, 1); mA = fmaxf(fmaxf(n0[0], n0[1]), n0[2]); mB = fmaxf(fmaxf(n1[0], n1[1]), n1[2]); SBAR();
  PVSTEP(0, 3, pa3, 4, 1); MX3(mA, n0, 3); MX3(mB, n1, 3); SBAR();
  PVSTEP(1, 0, pa0, 4, 1); MX3(mA, n0, 5); MX3(mB, n1, 5); SBAR();
  PVSTEP(1, 1, pa1, 4, 1); MX3(mA, n0, 7); MX3(mB, n1, 7); SBAR();
  PVSTEP(1, 2, pa2, 4, 1); MX3(mA, n0, 9); MX3(mB, n1, 9); SBAR();
  PVSTEP(1, 3, pa3, 4, 1); MX3(mA, n0, 11); MX3(mB, n1, 11); SBAR();
  PVSTEP(2, 0, pa0, 4, 1); MX3(mA, n0, 13); MX3(mB, n1, 13); SBAR();
  PVSTEP(2, 1, pa1, 4, 1); pmax = fmaxf(fmaxf(mA, n0[15]), fmaxf(mB, n1[15]));
  { auto rr = __builtin_amdgcn_permlane32_swap(__float_as_uint(pmax), __float_as_uint(pmax), false, false); pmax = fmaxf(__uint_as_float(rr[0]), __uint_as_float(rr[1])); } SBAR();
  PVSTEP(2, 2, pa2, 4, 1);
  alpha = 1.f;
  if (__builtin_expect(!__all(pmax <= THRL2), 0)) { const float delta = fmaxf(pmax, 0.f); alpha = __builtin_amdgcn_exp2f(-delta); m_reg += delta;
#pragma unroll
    for (int r = 0; r < 16; ++r) { n0[r] -= delta; n1[r] -= delta; negm[r] = -m_reg; } }
  SBAR();
  PVSTEP(2, 3, pa3, 4, 1); n0[0] = __builtin_amdgcn_exp2f(n0[0]); n0[1] = __builtin_amdgcn_exp2f(n0[1]); SBAR();
  PVSTEP(3, 0, pa0, 4, 1); n0[2] = __builtin_amdgcn_exp2f(n0[2]); n0[3] = __builtin_amdgcn_exp2f(n0[3]); SBAR();
  PVSTEP(3, 1, pa1, 4, 0); n0[4] = __builtin_amdgcn_exp2f(n0[4]); n0[5] = __builtin_amdgcn_exp2f(n0[5]); SBAR();
  PVSTEP(3, 2, pa2, 2, 0); n0[6] = __builtin_amdgcn_exp2f(n0[6]); n0[7] = __builtin_amdgcn_exp2f(n0[7]); SBAR();
  PVSTEP(3, 3, pa3, 0, 0); n0[8] = __builtin_amdgcn_exp2f(n0[8]); n0[9] = __builtin_amdgcn_exp2f(n0[9]); SBAR();
  n0[10] = __builtin_amdgcn_exp2f(n0[10]); n0[11] = __builtin_amdgcn_exp2f(n0[11]); n0[12] = __builtin_amdgcn_exp2f(n0[12]); n0[13] = __builtin_amdgcn_exp2f(n0[13]);
  n0[14] = __builtin_amdgcn_exp2f(n0[14]); n0[15] = __builtin_amdgcn_exp2f(n0[15]); SBAR();
#undef MX3
#undef PVSTEP
#undef PK
}
__device__ __forceinline__ void attn_unit_g(const bf16_t* __restrict__ Q, const bf16_t* __restrict__ K, const bf16_t* __restrict__ V, bf16_t* __restrict__ O,
                                               int ldq, int ldk, int ldo, int nt, int nfirst, int skip, int qpos0, float sinkl2, ALAS char* lds, ALAS float* scr,
                                               int qmode  , float sinkB, const float* __restrict__ gq, const float* __restrict__ ropeC, const float* __restrict__ ropeS) {
  int tid_l = tid_now(); asm volatile("" : "+v"(tid_l));
  const int tid = tid_l, wid = __builtin_amdgcn_readfirstlane(tid >> 6), lane = tid & 63, r32 = lane & 31, hi = lane >> 5;
  ALAS char* K_lds = lds; ALAS char* V_lds = lds + 32768;
  ALAS float* li_l = scr; ALAS float* al_l = scr + 32;
  const int wrow = (qmode & 4) ? (wid & 3) : wid, hoff = (qmode & 4) ? (wid >> 2) * 128 : 0;
  const int qi = qpos0 + wrow * QBLK + r32;
  unsigned koff[2], voff[2];
#pragma unroll
  for (int i = 0; i < 2; ++i) { const int L = (wid * 2 + i) * 1024 + lane * 16, row = L >> 8, cb = (L & 255) ^ ((row & 7) << 4); koff[i] = (unsigned)(row * ldk * 2 + cb); }
#pragma unroll
  for (int i = 0; i < 2; ++i) { const int L = (wid * 2 + i) * 1024 + lane * 16, sub = L >> 9, within = L & 511;
    const int kk = (sub >> 2) * 8 + (within >> 6), k = (kk & ~0xC) | ((kk & 4) << 1) | ((kk & 8) >> 1), col = (sub & 3) * 32 + ((within & 63) >> 1);
    voff[i] = (unsigned)(k * ldk * 2 + col * 2); }
#define KROW(t) ((t) * KVBLK + (((t) >= nfirst) ? skip : 0))
  ALAS char* const offs = lds + 65536 + wid * 1024 + lane * 16;
  { u32x4 ov = {koff[0], koff[1], voff[0], voff[1]}; *(ALAS u32x4*)offs = ov; asm volatile("s_waitcnt lgkmcnt(0)" ::: "memory"); }
#define DK_ISSUE(t, slot) do { const char* kb_ = (const char*)K + (size_t)KROW(t) * 2 * ldk; const u32x4 ov_ = *(const ALAS u32x4*)offs; \
    dma16(kb_ + ov_[0], K_lds + (slot) * 16384 + (wid * 2 + 0) * 1024); dma16(kb_ + ov_[1], K_lds + (slot) * 16384 + (wid * 2 + 1) * 1024); } while (0)
#define DV_ISSUE(t, slot) do { const char* vb_ = (const char*)V + (size_t)KROW(t) * 2 * ldk; const u32x4 ov_ = *(const ALAS u32x4*)offs; \
    dma16(vb_ + ov_[2], V_lds + (slot) * 16384 + (wid * 2 + 0) * 1024); dma16(vb_ + ov_[3], V_lds + (slot) * 16384 + (wid * 2 + 1) * 1024); } while (0)
#define RESC(a) do { if (__any((a) < 1.f)) { if (hi == 0) al_l[r32] = (a); asm volatile("s_waitcnt lgkmcnt(0)" ::: "memory"); \
    _Pragma("unroll") for (int d = 0; d < 4; ++d) _Pragma("unroll") for (int r = 0; r < 16; ++r) o[d][r] *= al_l[crow(r, hi)]; } } while (0)
#define MASK(P0, P1, t) do { if ((t) >= nfirst) band_mask(P0, P1, KROW(t) - 512 - qi, hi); } while (0)
#define STEP_SYNC() do { asm volatile("s_waitcnt vmcnt(0) lgkmcnt(0)" ::: "memory"); __builtin_amdgcn_s_barrier(); } while (0)
  DK_ISSUE(0, 0); DV_ISSUE(0, 0); DK_ISSUE(1, 1);
  bf16x8 qr[8];
  { const bf16_t* Qw = Q + hoff + (long)(wrow * QBLK + r32) * ldq + hi * 8;
#pragma unroll
    for (int d0 = 0; d0 < 8; ++d0) qr[d0] = *reinterpret_cast<const bf16x8*>(Qw + d0 * 16);
    {
      constexpr float CQ = SCALE * 1.4426950408889634f;
      float qf[8][8];
#pragma unroll
      for (int d0 = 0; d0 < 8; ++d0)
#pragma unroll
        for (int j = 0; j < 8; ++j) qf[d0][j] = __uint_as_float(((unsigned)(unsigned short)qr[d0][j]) << 16);
      if (qmode & 1) { float ss = 0.f;
#pragma unroll
        for (int d0 = 0; d0 < 8; ++d0)
#pragma unroll
          for (int j = 0; j < 8; ++j) ss += qf[d0][j] * qf[d0][j];
        ss += __shfl_xor(ss, 32);
        const float rstd = 1.0f / sqrtf(ss * (1.0f / 128.0f) + 1e-6f);
#pragma unroll
        for (int d0 = 0; d0 < 8; ++d0) { const float* gp = gq + d0 * 16 + hi * 8; const float4 g0 = *reinterpret_cast<const float4*>(gp), g1 = *reinterpret_cast<const float4*>(gp + 4);
          qf[d0][0] *= rstd * g0.x; qf[d0][1] *= rstd * g0.y; qf[d0][2] *= rstd * g0.z; qf[d0][3] *= rstd * g0.w; qf[d0][4] *= rstd * g1.x; qf[d0][5] *= rstd * g1.y; qf[d0][6] *= rstd * g1.z; qf[d0][7] *= rstd * g1.w; } }
      if (qmode & 2) { const int t = qi;
#pragma unroll
        for (int hf = 0; hf < 2; ++hf) { const int p = hf ? (t & 63) : (t >> 6);
#pragma unroll
          for (int dd = 0; dd < 2; ++dd) { const int d0 = hf * 4 + dd, i0 = dd * 16 + hi * 8;
            const float4 c0 = *reinterpret_cast<const float4*>(ropeC + p * 32 + i0), c1 = *reinterpret_cast<const float4*>(ropeC + p * 32 + i0 + 4);
            const float4 s0 = *reinterpret_cast<const float4*>(ropeS + p * 32 + i0), s1 = *reinterpret_cast<const float4*>(ropeS + p * 32 + i0 + 4);
            const float cs[8] = {c0.x, c0.y, c0.z, c0.w, c1.x, c1.y, c1.z, c1.w}, sn[8] = {s0.x, s0.y, s0.z, s0.w, s1.x, s1.y, s1.z, s1.w};
#pragma unroll
            for (int j = 0; j < 8; ++j) { const float x1 = qf[d0][j], x2 = qf[d0 + 2][j]; qf[d0][j] = x1 * cs[j] - x2 * sn[j]; qf[d0 + 2][j] = x1 * sn[j] + x2 * cs[j]; } } } }
#pragma unroll
      for (int d0 = 0; d0 < 8; ++d0) { u32x4 w = {cvtpk(qf[d0][0] * CQ, qf[d0][1] * CQ), cvtpk(qf[d0][2] * CQ, qf[d0][3] * CQ), cvtpk(qf[d0][4] * CQ, qf[d0][5] * CQ), cvtpk(qf[d0][6] * CQ, qf[d0][7] * CQ)}; qr[d0] = *reinterpret_cast<bf16x8*>(&w); }
    } }
  float m_reg = 0.f, l_reg = 0.f; f32x16 o[4] = {}; f32x16 negm = {};
  const ALAS char* vbp = V_lds + v_rd_base(lane);
  f32x16 pA0, pA1, pB0, pB1; float alA = 1.f, alB = 1.f; bf16x8 pa0, pa1, pa2, pa3;
  STEP_SYNC();
  qk_seg(pA0, pA1, K_lds, qr, negm, r32, hi); MASK(pA0, pA1, 0); psm_n(pA0, pA1, m_reg, alA, negm, true);
  STEP_SYNC();
  int j = 0;
  for (; j + 2 < nt; j += 2) {
    DK_ISSUE(j + 2, 0); DV_ISSUE(j + 1, 1);
    SBAR(); blk_qk_fin(pB0, pB1, K_lds + 16384, qr, negm, r32, hi, pA0, pA1, pa0, pa1, pa2, alA, l_reg);
    blk_pv_par(o, vbp, pa0, pa1, pa2, pA1, pB0, pB1, m_reg, alB, negm, (j + 1) >= nfirst, KROW(j + 1) - 512 - qi, hi);
    STEP_SYNC();
    RESC(alB);
    if (j + 3 < nt) DK_ISSUE(j + 3, 1);
    DV_ISSUE(j + 2, 0);
    SBAR(); blk_qk_fin(pA0, pA1, K_lds, qr, negm, r32, hi, pB0, pB1, pa0, pa1, pa2, alB, l_reg);
    blk_pv_par(o, vbp + 16384, pa0, pa1, pa2, pB1, pA0, pA1, m_reg, alA, negm, (j + 2) >= nfirst, KROW(j + 2) - 512 - qi, hi);
    STEP_SYNC();
    RESC(alA);
  }
  DV_ISSUE(j + 1, 1);
  SBAR(); blk_qk_fin(pB0, pB1, K_lds + 16384, qr, negm, r32, hi, pA0, pA1, pa0, pa1, pa2, alA, l_reg);
  blk_pv_par(o, vbp, pa0, pa1, pa2, pA1, pB0, pB1, m_reg, alB, negm, (j + 1) >= nfirst, KROW(j + 1) - 512 - qi, hi);
  STEP_SYNC();
  RESC(alB);
  finishSM(pB0, pB1, alB, l_reg, pa0, pa1, pa2, pa3); SBAR();
  pv_d0(o, (int)(uintptr_t)(vbp + 16384), pa0, pa1, pa2, pa3);
  STEP_SYNC();
#undef DK_ISSUE
#undef DV_ISSUE
#undef KROW
#undef RESC
#undef MASK
#undef STEP_SYNC
  l_reg += __builtin_amdgcn_exp2f(((qmode & 4) && wid >= 4 ? sinkB : sinkl2) - m_reg);
  if (hi == 0) li_l[r32] = l_reg; asm volatile("s_waitcnt lgkmcnt(0)" ::: "memory");
  float rli[16];
#pragma unroll
  for (int r = 0; r < 16; ++r) rli[r] = __builtin_amdgcn_rcpf(li_l[crow(r, hi)]);
  { ALAS char* og = lds + wid * 8192; bf16_t* Og = O + hoff + (long)(wrow * QBLK) * ldo;
#pragma unroll
    for (int r = 0; r < 16; ++r) { const int row = crow(r, hi);
#pragma unroll
      for (int d = 0; d < 4; ++d) { const unsigned w = cvtpk(o[d][r] * rli[r], 0.f); *(ALAS unsigned short*)(og + row * 256 + (d * 32 + r32) * 2) = (unsigned short)(w & 0xffffu); } }
#pragma unroll
    for (int k = 0; k < 8; ++k) { const int p = lane + 64 * k; const u32x4 v = *(const ALAS u32x4*)(og + p * 16);
      *reinterpret_cast<u32x4*>(Og + (long)(p >> 4) * ldo + (p & 15) * 8) = v; }
  }
}

__device__ __forceinline__ void pv8_sm(f32x16* o, int vb, bf16x8 pa0, bf16x8 pa1, bf16x8 pa2, bf16x8 pa3, f32x16& p0, f32x16& p1, float& m_reg, float& mn, float& alpha) {
  constexpr float C = SCALE * 1.4426950408889634f;
  pv_one<0>(o[0], vb, pa0, pa1, pa2, pa3); pv_one<1>(o[1], vb, pa0, pa1, pa2, pa3);
  float pmax = p0[0];
#pragma unroll
  for (int r = 1; r < 16; ++r) pmax = fmaxf(pmax, p0[r]);
#pragma unroll
  for (int r = 0; r < 16; ++r) pmax = fmaxf(pmax, p1[r]);
  { auto rr = __builtin_amdgcn_permlane32_swap(__float_as_uint(pmax), __float_as_uint(pmax), false, false);
    pmax = fmaxf(__uint_as_float(rr[0]), __uint_as_float(rr[1])); }
  pv_one<2>(o[2], vb, pa0, pa1, pa2, pa3); pv_one<3>(o[3], vb, pa0, pa1, pa2, pa3);
  if (__builtin_expect(__all(pmax - m_reg <= THR / SCALE), 1)) { mn = m_reg; alpha = 1.f; }
  else { mn = fmaxf(m_reg, pmax); alpha = __builtin_amdgcn_exp2f((m_reg - mn) * C); m_reg = mn; }
  const float mnC = -mn * C;
#pragma unroll
  for (int r = 0; r < 16; ++r) p0[r] = fmaf(p0[r], C, mnC);
  pv_one<0>(o[4], vb + 16384, pa0, pa1, pa2, pa3); pv_one<1>(o[5], vb + 16384, pa0, pa1, pa2, pa3);
#pragma unroll
  for (int r = 0; r < 16; ++r) p1[r] = fmaf(p1[r], C, mnC);
#pragma unroll
  for (int r = 0; r < 8; ++r) p0[r] = __builtin_amdgcn_exp2f(p0[r]);
  pv_one<2>(o[6], vb + 16384, pa0, pa1, pa2, pa3); pv_one<3>(o[7], vb + 16384, pa0, pa1, pa2, pa3);
#pragma unroll
  for (int r = 8; r < 16; ++r) p0[r] = __builtin_amdgcn_exp2f(p0[r]);
}
__device__ __forceinline__ void qkt_ldsq(f32x16& p0, f32x16& p1, const ALAS char* Ks, const ALAS char* Qs, int lane, int r32, int hi) {
  p0 = f32x16{}; p1 = f32x16{};
#pragma unroll
  for (int d0 = 0; d0 < 8; ++d0) { const int cb = (d0 * 16 + hi * 8) * 2;
    const bf16x8 qd = *(const ALAS bf16x8*)(Qs + (d0 * 64 + lane) * 16);
    const bf16x8 b0 = *reinterpret_cast<const ALAS bf16x8*>(Ks + KSWZ(r32, cb));
    const bf16x8 b1 = *reinterpret_cast<const ALAS bf16x8*>(Ks + KSWZ(32 + r32, cb));
    p0 = __builtin_amdgcn_mfma_f32_32x32x16_bf16(b0, qd, p0, 0, 0, 0);
    p1 = __builtin_amdgcn_mfma_f32_32x32x16_bf16(b1, qd, p1, 0, 0, 0); }
}
__device__ __forceinline__ void attn_unit_diff2(const bf16_t* __restrict__ Q, const bf16_t* __restrict__ K, const bf16_t* __restrict__ V, bf16_t* __restrict__ O,
                                                int ldq, int ldk, int ldo, int nt, int qpos0, ALAS char* lds, ALAS float* scr,
                                                int qmode, const float* __restrict__ ropeC, const float* __restrict__ ropeS) {
  int tid_l = tid_now(); asm volatile("" : "+v"(tid_l));
  const int tid = tid_l, wid = __builtin_amdgcn_readfirstlane(tid >> 6), lane = tid & 63, r32 = lane & 31, hi = lane >> 5;
  ALAS char* K_lds = lds; ALAS char* V_lds = lds + 32768; ALAS char* Qs = lds + 65536 + wid * 8192;
  ALAS float* li_l = scr; ALAS float* al_l = scr + 32;
#define DK_ISSUE(t, slot) do { const char* kb_ = (const char*)K + (size_t)(t) * (KVBLK * 2) * ldk; int ln_ = lane; asm volatile("" : "+v"(ln_)); \
    _Pragma("unroll") for (int i = 0; i < 2; ++i) { const int L = (wid * 2 + i) * 1024 + ln_ * 16, row = L >> 8, cb = (L & 255) ^ ((row & 7) << 4); \
        dma16(kb_ + (unsigned)(row * ldk * 2 + cb), K_lds + (slot) * 16384 + (wid * 2 + i) * 1024); } } while (0)
#define DV_ISSUE(t) do { const char* vb_ = (const char*)V + (size_t)(t) * (KVBLK * 2) * ldk; int ln_ = lane; asm volatile("" : "+v"(ln_)); \
    _Pragma("unroll") for (int i = 0; i < 4; ++i) { const int L = (wid * 4 + i) * 1024 + ln_ * 16, half = L >> 14, Lh = L & 16383, sub = Lh >> 9, within = Lh & 511; \
        const int kk = (sub >> 2) * 8 + (within >> 6), k = (kk & ~0xC) | ((kk & 4) << 1) | ((kk & 8) >> 1), col = half * 128 + (sub & 3) * 32 + ((within & 63) >> 1); \
        dma16(vb_ + (unsigned)(k * ldk * 2 + col * 2), V_lds + (wid * 4 + i) * 1024); } } while (0)
#define RESC8(a) do { if (__any((a) < 1.f)) { if (hi == 0) al_l[r32] = (a); asm volatile("s_waitcnt lgkmcnt(0)" ::: "memory"); \
    _Pragma("unroll") for (int d = 0; d < 8; ++d) _Pragma("unroll") for (int r = 0; r < 16; ++r) o[d][r] *= al_l[crow(r, hi)]; } } while (0)
#define STEP_SYNC() do { asm volatile("s_waitcnt vmcnt(0) lgkmcnt(0)" ::: "memory"); __builtin_amdgcn_s_barrier(); } while (0)
  DK_ISSUE(0, 0); DK_ISSUE(1, 1);
  { bf16x8 qr[8];
    const bf16_t* Qw = Q + (long)(wid * QBLK + r32) * ldq + hi * 8;
#pragma unroll
    for (int d0 = 0; d0 < 8; ++d0) qr[d0] = *reinterpret_cast<const bf16x8*>(Qw + d0 * 16);
    if (qmode & 2) {
      float qf[8][8];
#pragma unroll
      for (int d0 = 0; d0 < 8; ++d0)
#pragma unroll
        for (int j = 0; j < 8; ++j) qf[d0][j] = __uint_as_float(((unsigned)(unsigned short)qr[d0][j]) << 16);
      const int t = qpos0 + wid * QBLK + r32;
#pragma unroll
      for (int hf = 0; hf < 2; ++hf) { const int p = hf ? (t & 63) : (t >> 6);
#pragma unroll
        for (int dd = 0; dd < 2; ++dd) { const int d0 = hf * 4 + dd, i0 = dd * 16 + hi * 8;
          const float4 c0 = *reinterpret_cast<const float4*>(ropeC + p * 32 + i0), c1 = *reinterpret_cast<const float4*>(ropeC + p * 32 + i0 + 4);
          const float4 s0 = *reinterpret_cast<const float4*>(ropeS + p * 32 + i0), s1 = *reinterpret_cast<const float4*>(ropeS + p * 32 + i0 + 4);
          const float cs[8] = {c0.x, c0.y, c0.z, c0.w, c1.x, c1.y, c1.z, c1.w}, sn[8] = {s0.x, s0.y, s0.z, s0.w, s1.x, s1.y, s1.z, s1.w};
#pragma unroll
          for (int j = 0; j < 8; ++j) { const float x1 = qf[d0][j], x2 = qf[d0 + 2][j]; qf[d0][j] = x1 * cs[j] - x2 * sn[j]; qf[d0 + 2][j] = x1 * sn[j] + x2 * cs[j]; } } }
#pragma unroll
      for (int d0 = 0; d0 < 8; ++d0) { u32x4 w = {cvtpk(qf[d0][0], qf[d0][1]), cvtpk(qf[d0][2], qf[d0][3]), cvtpk(qf[d0][4], qf[d0][5]), cvtpk(qf[d0][6], qf[d0][7])}; qr[d0] = *reinterpret_cast<bf16x8*>(&w); }
    }
#pragma unroll
    for (int d0 = 0; d0 < 8; ++d0) *(ALAS bf16x8*)(Qs + (d0 * 64 + lane) * 16) = qr[d0];
  }
  float m_reg = -1e30f, l_reg = 0.f; f32x16 o[8] = {};
  const int vb0 = (int)(uintptr_t)V_lds + v_rd_base(lane);
  f32x16 pA0, pA1, pB0, pB1; float mnA, mnB, alA, alB; bf16x8 pa0, pa1, pa2, pa3;
  STEP_SYNC();
  qkt_ldsq(pA0, pA1, K_lds, Qs, lane, r32, hi); partialSM(pA0, pA1, m_reg, mnA, alA);
  STEP_SYNC();
  int j = 0;
  for (; j + 2 < nt; j += 2) {
    DV_ISSUE(j); DK_ISSUE(j + 2, 0);
    SBAR(); qkt_ldsq(pB0, pB1, K_lds + 16384, Qs, lane, r32, hi);
    finishSM(pA0, pA1, alA, l_reg, pa0, pa1, pa2, pa3); SBAR();
    STEP_SYNC();
    pv8_sm(o, vb0, pa0, pa1, pa2, pa3, pB0, pB1, m_reg, mnB, alB);
    STEP_SYNC();
    RESC8(alB);
    DV_ISSUE(j + 1); if (j + 3 < nt) DK_ISSUE(j + 3, 1);
    SBAR(); qkt_ldsq(pA0, pA1, K_lds, Qs, lane, r32, hi);
    finishSM(pB0, pB1, alB, l_reg, pa0, pa1, pa2, pa3); SBAR();
    STEP_SYNC();
    pv8_sm(o, vb0, pa0, pa1, pa2, pa3, pA0, pA1, m_reg, mnA, alA);
    STEP_SYNC();
    RESC8(alA);
  }
  DV_ISSUE(j);
  SBAR(); qkt_ldsq(pB0, pB1, K_lds + 16384, Qs, lane, r32, hi);
  finishSM(pA0, pA1, alA, l_reg, pa0, pa1, pa2, pa3); SBAR();
  STEP_SYNC();
  pv8_sm(o, vb0, pa0, pa1, pa2, pa3, pB0, pB1, m_reg, mnB, alB);
  STEP_SYNC();
  RESC8(alB);
  DV_ISSUE(j + 1);
  finishSM(pB0, pB1, alB, l_reg, pa0, pa1, pa2, pa3); SBAR();
  STEP_SYNC();
  pv_one<0>(o[0], vb0, pa0, pa1, pa2, pa3); pv_one<1>(o[1], vb0, pa0, pa1, pa2, pa3); pv_one<2>(o[2], vb0, pa0, pa1, pa2, pa3); pv_one<3>(o[3], vb0, pa0, pa1, pa2, pa3);
  pv_one<0>(o[4], vb0 + 16384, pa0, pa1, pa2, pa3); pv_one<1>(o[5], vb0 + 16384, pa0, pa1, pa2, pa3); pv_one<2>(o[6], vb0 + 16384, pa0, pa1, pa2, pa3); pv_one<3>(o[7], vb0 + 16384, pa0, pa1, pa2, pa3);
#undef DK_ISSUE
#undef DV_ISSUE
#undef RESC8
#undef STEP_SYNC
  if (hi == 0) li_l[r32] = l_reg; asm volatile("s_waitcnt lgkmcnt(0)" ::: "memory");
  float rli[16];
#pragma unroll
  for (int r = 0; r < 16; ++r) rli[r] = __builtin_amdgcn_rcpf(li_l[crow(r, hi)]);
  { ALAS char* og = Qs; bf16_t* Og = O + (long)(wid * QBLK) * ldo;
#pragma unroll
    for (int hf = 0; hf < 2; ++hf) {
#pragma unroll
      for (int rr = 0; rr < 8; ++rr) { const int r = hf * 8 + rr, lrow = crow(r, hi) - 16 * hf;
#pragma unroll
        for (int d = 0; d < 8; ++d) { const unsigned w = cvtpk(o[d][r] * rli[r], 0.f); *(ALAS unsigned short*)(og + lrow * 512 + (d * 32 + r32) * 2) = (unsigned short)(w & 0xffffu); } }
#pragma unroll
      for (int k = 0; k < 8; ++k) { const int p = lane + 64 * k; const u32x4 v = *(const ALAS u32x4*)(og + p * 16);
        *reinterpret_cast<u32x4*>(Og + (long)(16 * hf + (p >> 5)) * ldo + (p & 31) * 8) = v; }
    } }
}
}
#define GAS __attribute__((address_space(1)))
#define LAS __attribute__((address_space(3)))
typedef unsigned short bf16;
typedef unsigned v4u __attribute__((ext_vector_type(4)));
typedef float f32x4 __attribute__((ext_vector_type(4)));
typedef short bf16x8 __attribute__((ext_vector_type(8)));
typedef GAS unsigned gu32;
typedef GAS unsigned long long gu64;
#define RLX_AGENT __ATOMIC_RELAXED, __HIP_MEMORY_SCOPE_AGENT
#define LDS_WAIT() asm volatile("s_waitcnt lgkmcnt(0)" ::: "memory")
#define VM_WAIT() asm volatile("s_waitcnt vmcnt(0)" ::: "memory")
__device__ __forceinline__ unsigned long long rt() { return __builtin_amdgcn_s_memrealtime(); }
__device__ __forceinline__ unsigned f2bf(float f) { unsigned u = __builtin_bit_cast(unsigned, f); return (u + 0x7fffu + ((u >> 16) & 1u)) >> 16; }
__device__ __forceinline__ unsigned pk2(float lo, float hi) { return f2bf(lo) | (f2bf(hi) << 16); }

#define XB_TMO      128
#define XB_XCNT(j)  (256  + 64 * (j))
#define XB_XSUB(j)  (1280 + 64 * (j))
#define XB_XGEN(j)  (2304 + 64 * (j))
#define XB_TOP      3328
#define XB_TOPGEN   3392
#define XCD_BAR_WORDS 3456
#define XB_SPIN_CAP (1u << 18)

__device__ __forceinline__ unsigned xb_ld(unsigned* p)              { return __hip_atomic_load(p, __ATOMIC_RELAXED, __HIP_MEMORY_SCOPE_AGENT); }
__device__ __forceinline__ unsigned xb_add(unsigned* p, unsigned v) { return __hip_atomic_fetch_add(p, v, __ATOMIC_RELAXED, __HIP_MEMORY_SCOPE_AGENT); }
__device__ __forceinline__ unsigned xb_xcc_id() { return (unsigned)__builtin_amdgcn_s_getreg((3 << 11) | 20) & 0xFu; }
#define XB_SPIN(cond, bar) do { unsigned _sp = 0; while (cond) { __builtin_amdgcn_s_sleep(1); \
    if ((++_sp & 255u) == 0u) { if (xb_ld(&(bar)[XB_TMO])) break; if (_sp > XB_SPIN_CAP) { atomicAdd(&(bar)[XB_TMO], 1u); break; } } } } while (0)

struct XcdBarrier {
    unsigned* bar; unsigned x;
    volatile LAS unsigned* st;
};

__device__ __forceinline__ XcdBarrier xcd_barrier_post(unsigned* bar, volatile LAS unsigned* st) {
    XcdBarrier b; b.bar = bar; b.x = xb_xcc_id(); b.st = st;
    if (tid_now() == 0) (void)xb_add(&bar[XB_XCNT(b.x)], 1u);
    return b;
}
__device__ __forceinline__ void xcd_barrier_complete(unsigned* bar, unsigned x, unsigned& nloc, unsigned& nx) {
    const unsigned G = gridDim.x * gridDim.y * gridDim.z;
    asm volatile("" : "+s"(x));
    unsigned sum, cnt, mine, sp = 0u;
    for (;;) {
        sum = 0u; cnt = 0u; mine = 0u;
#pragma unroll
        for (unsigned j = 0; j < 16; ++j) { const unsigned c = xb_ld(&bar[XB_XCNT(j)]); sum += c; cnt += (c > 0u) ? 1u : 0u; mine = (j == x) ? c : mine; }
        if (sum == G) break;
        __builtin_amdgcn_s_sleep(1);
        if ((++sp & 255u) == 0u) { if (xb_ld(&bar[XB_TMO])) break; if (sp > XB_SPIN_CAP) { atomicAdd(&bar[XB_TMO], 1u); break; } }
    }
    nloc = mine > 0u ? mine : 1u; nx = cnt > 0u ? cnt : 1u;
}

__device__ __forceinline__ void xcd_barrier(const XcdBarrier& b) {
    asm volatile("s_waitcnt vmcnt(0)" ::: "memory");
    __syncthreads();
    if (tid_now() == 0) {
        unsigned* bar = b.bar; unsigned bx_ = b.x;
        asm volatile("" : "+s"(bar), "+s"(bx_));
        __builtin_amdgcn_s_waitcnt(0);
        unsigned nloc = b.st[0], nx = b.st[1];
        if (nloc == 0u) { xcd_barrier_complete(bar, bx_, nloc, nx); b.st[0] = nloc; b.st[1] = nx; }
        const unsigned old = xb_add(&bar[XB_XSUB(bx_)], 1u);
        const unsigned gen = old / nloc;
        if (old + 1u == (gen + 1u) * nloc) {
            __builtin_amdgcn_fence(__ATOMIC_RELEASE, "agent");
            asm volatile("s_waitcnt vmcnt(0)" ::: "memory");
            const unsigned og = xb_add(&bar[XB_TOP], 1u);
            const unsigned tg = og / nx;
            if (og + 1u == (tg + 1u) * nx) xb_add(&bar[XB_TOPGEN], 1u);
            else XB_SPIN(xb_ld(&bar[XB_TOPGEN]) == tg, bar);
            __builtin_amdgcn_fence(__ATOMIC_ACQUIRE, "agent");
            xb_add(&bar[XB_XGEN(bx_)], 1u);
            asm volatile("s_waitcnt vmcnt(0)" ::: "memory");
        } else {
            XB_SPIN(xb_ld(&bar[XB_XGEN(bx_)]) == gen, bar);
            __builtin_amdgcn_fence(__ATOMIC_ACQUIRE, "agent");
            asm volatile("s_waitcnt vmcnt(0)" ::: "memory");
        }
    }
    __syncthreads();
}

#ifndef ATT_DMA_ALL
#define ATT_DMA_ALL 6
#endif
#ifndef ATT_DIFF_PIPE
#define ATT_DIFF_PIPE 1
#endif
constexpr int NWAVES = 8;
constexpr int DM = 2048, TP = 8192, TS = 16384, TT = TP + TS;
constexpr int SP = 256, SS = 2048, PAST = 512, SKV = PAST + SS;
constexpr int NQKV = 3072, KVW = 512, FF = 5632, NGU = 2 * FF;
constexpr float EPS = 1e-6f;
constexpr float LAM_INIT2 = 0.47071301834358414f;
enum { I_XP = 0, I_XS, I_C, I_CKF, I_CVF, I_CKW, I_CVW, I_CKD, I_CVD, I_CCTX, I_WADA, I_BADA, I_GNORM, I_WQKVF, I_WOF, I_GQF, I_GKF, I_WQKVW, I_WOW, I_SINKW,
       I_WQKVD, I_WOD, I_LQ1, I_LK1, I_LQ2, I_LK2, I_GSUB, I_WG, I_WU, I_WD, N_IN };
constexpr size_t O_YP = 0, O_YS = (size_t)TP * DM, O_KF = (size_t)TT * DM, O_VF = O_KF + (size_t)32 * 2 * SP * KVW, O_KW = O_VF + (size_t)32 * 2 * SP * KVW,
                 O_VW = O_KW + (size_t)32 * SP * KVW, O_KD = O_VW + (size_t)32 * SP * KVW, O_VD = O_KD + (size_t)32 * SP * KVW, O_END = O_VD + (size_t)32 * SP * KVW;
static_assert(O_END == 83886080, "output size");
constexpr size_t MiB = 1u << 20;
constexpr size_t WS_CTL = 0, CTL_ZERO_BYTES = 1 * MiB;
constexpr size_t WS_ROPE = 1 * MiB;
constexpr size_t WS_VEC = 2 * MiB;
constexpr size_t WS_PART = 4 * MiB;
constexpr size_t WS_W = 20 * MiB, W_LAYER = 86 * MiB, W_QKV = 0, W_O = 12 * MiB, W_GU = 20 * MiB, W_D = 64 * MiB;
constexpr size_t WS_KC = 364 * MiB, WS_VC = 384 * MiB, WS_KP = 404 * MiB, WS_VP = 412 * MiB;
constexpr size_t WS_H = 420 * MiB, WS_MF = 516 * MiB;
constexpr size_t WS_ACT = 612 * MiB;
constexpr size_t WS_RAW = WS_ACT, WS_ATT = WS_ACT + 144 * MiB, WS_X16 = 876 * MiB, WS_END = 972 * MiB;
static_assert(WS_W + 4 * W_LAYER == WS_KC && WS_ATT + (size_t)TT * DM * 2 <= WS_X16 && WS_ACT + (size_t)TT * FF * 2 <= WS_X16 && WS_X16 + (size_t)TT * DM * 2 <= WS_END && WS_MF + (size_t)TT * DM * 2 == WS_ACT, "ws map");
constexpr int CW_BAR = 4096;
constexpr int RING_BYTES = 131072, LDSCTL_OFF = RING_BYTES, MISC_OFF = LDSCTL_OFF + 320, LDS_BYTES = 147456;

typedef unsigned v2u __attribute__((ext_vector_type(2)));

__device__ __forceinline__ float wave_sum(float v) {
#pragma unroll
    for (int o = 1; o < 64; o <<= 1) v += __shfl_xor(v, o);
    return v;
}
__device__ __forceinline__ float bf2f(unsigned h) { return __uint_as_float(h << 16); }
__device__ __forceinline__ unsigned pkbf(float lo, float hi) { unsigned r; asm volatile("v_cvt_pk_bf16_f32 %0, %1, %2" : "=v"(r) : "v"(lo), "v"(hi)); return r; }

__device__ __forceinline__ void transpose_item(const float* __restrict__ W, int K, int N, bf16* __restrict__ WT, int k0, int n0, int drow0, LAS float* scr, int lane) {
    { const int kr = lane >> 3, c4 = (lane & 7) * 4;
      f32x4 v[8];
#pragma unroll
      for (int i = 0; i < 8; ++i) v[i] = *(const f32x4*)(W + (size_t)(k0 + 8 * i + kr) * N + n0 + c4);
#pragma unroll
      for (int i = 0; i < 8; ++i) { LAS float* d = scr + (8 * i + kr) * 33 + c4; d[0] = v[i].x; d[1] = v[i].y; d[2] = v[i].z; d[3] = v[i].w; } }
    LDS_WAIT(); asm volatile("" ::: "memory");
    const int c = lane & 7;
#pragma unroll
    for (int j = 0; j < 4; ++j) { const int n = (lane >> 3) + 8 * j; const LAS float* s = scr + (8 * c) * 33 + n;
        v4u o; o.x = pkbf(s[0 * 33], s[1 * 33]); o.y = pkbf(s[2 * 33], s[3 * 33]); o.z = pkbf(s[4 * 33], s[5 * 33]); o.w = pkbf(s[6 * 33], s[7 * 33]);
        *(v4u*)(WT + (size_t)(drow0 + n) * K + k0 + 8 * c) = o; }
    LDS_WAIT(); asm volatile("" ::: "memory");
}

struct Args { const float* in[N_IN]; float* out; unsigned char* ws; };

typedef const float* cfp;
#define KAS __attribute__((address_space(4)))
__device__ __forceinline__ const KAS cfp* kargs() { const KAS cfp* p = (const KAS cfp*)__builtin_amdgcn_kernarg_segment_ptr(); asm volatile("" : "+s"(p)); return p; }
#define PHASE_ENV \
    const KAS cfp* const ka = kargs(); unsigned char* const ws = (unsigned char*)ka[N_IN + 1]; float* const out = (float*)ka[N_IN]; (void)out; \
    int tid_ = tid_now(); asm volatile("" : "+v"(tid_)); const int tid = tid_, lane = tid & 63, wave = __builtin_amdgcn_readfirstlane(tid >> 6); \
    const int G = gridDim.x, bx = blockIdx.x, vcu = (G % 8 == 0) ? (bx % 8) * (G / 8) + bx / 8 : bx, gw = vcu * NWAVES + wave, NGW = G * NWAVES; \
    (void)tid; (void)lane; (void)wave; (void)gw; (void)NGW; (void)vcu; \
    float* const ropeC = (float*)(ws + WS_ROPE); float* const ropeS = ropeC + 64 * 32; float* const VEC = (float*)(ws + WS_VEC); float* const PART = (float*)(ws + WS_PART); \
    bf16* const KC = (bf16*)(ws + WS_KC); bf16* const VC = (bf16*)(ws + WS_VC); bf16* const KP = (bf16*)(ws + WS_KP); bf16* const VP = (bf16*)(ws + WS_VP); \
    bf16* const H = (bf16*)(ws + WS_H); bf16* const MF = (bf16*)(ws + WS_MF); bf16* const ACT = (bf16*)(ws + WS_ACT); \
    bf16* const RAW = (bf16*)(ws + WS_RAW); bf16* const ATT = (bf16*)(ws + WS_ATT); bf16* const ADIF = (bf16*)(ws + WS_H); bf16* const X16 = (bf16*)(ws + WS_X16); (void)X16; \
    (void)ropeC; (void)ropeS; (void)VEC; (void)PART; (void)KC; (void)VC; (void)KP; (void)VP; (void)H; (void)MF; (void)ACT; (void)RAW; (void)ATT; (void)ADIF;
#define IN(i) (ka[i])

__global__ void __launch_bounds__(NWAVES * 64, 2) trunk_fwd(Args args) {
    extern __shared__ __attribute__((aligned(16))) unsigned char lds_raw[];
    LAS unsigned char* const lds = (LAS unsigned char*)lds_raw;
    XcdBarrier bar;
    {
        volatile LAS unsigned* MISC = (volatile LAS unsigned*)(lds + MISC_OFF);
        for (int u = threadIdx.x; u < (LDS_BYTES - LDSCTL_OFF) / 4; u += NWAVES * 64) ((LAS unsigned*)(lds + LDSCTL_OFF))[u] = 0u;
        __syncthreads();
        { const unsigned slot_ = (unsigned)__builtin_amdgcn_s_getreg((5 << 11) | 4) & 63u;
          if ((threadIdx.x & 63) == 0) *(volatile LAS unsigned*)(lds + (TIDTAB_LDS_ADDR - 0) + slot_ * 4) = threadIdx.x >> 6; }
        __syncthreads();
        bar = xcd_barrier_post((unsigned*)(args.ws + WS_CTL) + CW_BAR, MISC + 8);
    }

    {
        PHASE_ENV
        LAS float* sl = (LAS float*)lds;
        for (int i = tid; i < 9 * DM; i += NWAVES * 64) { const int r = i >> 11, k = i & (DM - 1);
            const float cv = (r == 0) ? IN(I_CCTX)[k] : IN(I_C)[(r - 1) * DM + k]; sl[i] = cv / (1.0f + expf(-cv)); }
        __syncthreads();
        for (int t = gw; t < 2048; t += NGW) {
            const int l = t >> 9, cc = (t >> 3) & 63, kc = t & 7;
            if (lane < 48) {
                const float* Wp = IN(I_WADA) + ((size_t)l * DM + kc * 256) * (6 * DM) + cc * 192 + lane * 4;
                const LAS float* sp = sl + kc * 256;
                f32x4 acc[9];
#pragma unroll
                for (int r = 0; r < 9; ++r) acc[r] = (f32x4){0.f, 0.f, 0.f, 0.f};
#pragma unroll 16
                for (int k = 0; k < 256; ++k) { const f32x4 w = *(const f32x4*)(Wp + (size_t)k * (6 * DM));
#pragma unroll
                    for (int r = 0; r < 9; ++r) acc[r] += w * sp[r * DM + k]; }
#pragma unroll
                for (int r = 0; r < 9; ++r) *(f32x4*)(PART + ((size_t)((kc * 4 + l) * 9 + r)) * (6 * DM) + cc * 192 + lane * 4) = acc[r];
            }
        }
        __syncthreads();
        LAS float* scr = (LAS float*)(lds + wave * 16384);
        constexpr int IT_QKV = 32 * 96, IT_O = 32 * 64, IT_G = 32 * 176, IT_D = 88 * 64, IT_LAYER = IT_QKV + IT_O + 2 * IT_G + IT_D;
        for (int it = gw; it < 4 * IT_LAYER; it += NGW) {
            const int l = it / IT_LAYER; int r = it - l * IT_LAYER; const int kind = l % 3, slot = l / 3;
            unsigned char* wl = ws + WS_W + (size_t)l * W_LAYER;
            if (r < IT_QKV) { const float* W = (kind == 0 ? IN(I_WQKVF) + (size_t)slot * DM * NQKV : kind == 1 ? IN(I_WQKVW) : IN(I_WQKVD));
                const int kb = r / 96, nb = r % 96; transpose_item(W, DM, NQKV, (bf16*)(wl + W_QKV), 64 * kb, 32 * nb, 32 * nb, scr, lane); continue; } r -= IT_QKV;
            if (r < IT_O) { const float* W = (kind == 0 ? IN(I_WOF) + (size_t)slot * DM * DM : kind == 1 ? IN(I_WOW) : IN(I_WOD));
                const int kb = r / 64, nb = r % 64; transpose_item(W, DM, DM, (bf16*)(wl + W_O), 64 * kb, 32 * nb, 32 * nb, scr, lane); continue; } r -= IT_O;
            if (r < 2 * IT_G) { const int up = r >= IT_G; if (up) r -= IT_G; const float* W = IN(up ? I_WU : I_WG) + (size_t)l * DM * FF;
                const int kb = r / 176, nb = r % 176, n0 = 32 * nb; transpose_item(W, DM, FF, (bf16*)(wl + W_GU), 64 * kb, n0, (n0 >> 5) * 64 + up * 32, scr, lane); continue; } r -= 2 * IT_G;
            { const float* W = IN(I_WD) + (size_t)l * FF * DM; const int kb = r / 64, nb = r % 64; transpose_item(W, FF, DM, (bf16*)(wl + W_D), 64 * kb, 32 * nb, 32 * nb, scr, lane); }
        }
        { const int gt = bx * (NWAVES * 64) + tid;
          if (gt < 64 * 32) { const int p = gt >> 5, i = gt & 31; double inv = 1.0; for (int q = 0; q < i; ++q) inv *= 0.7498942093324559;
            const float ang = (float)p * (float)inv; const double a = (double)ang; const double n = __builtin_rint(a * 0.6366197723675814);
            double rr = __builtin_fma(-n, 1.5707963267948966, a); rr = __builtin_fma(-n, 6.123233995736766e-17, rr);
            const double r2 = rr * rr;
            const double sn = rr * (1.0 + r2 * (-1.0 / 6 + r2 * (1.0 / 120 + r2 * (-1.0 / 5040 + r2 * (1.0 / 362880 + r2 * (-1.0 / 39916800 + r2 * (1.0 / 6227020800.0)))))));
            const double cs = 1.0 + r2 * (-0.5 + r2 * (1.0 / 24 + r2 * (-1.0 / 720 + r2 * (1.0 / 40320 + r2 * (-1.0 / 3628800 + r2 * (1.0 / 479001600.0))))));
            const int q4 = ((int)n) & 3; const double s_ = (q4 == 0) ? sn : (q4 == 1) ? cs : (q4 == 2) ? -sn : -cs, c_ = (q4 == 0) ? cs : (q4 == 1) ? -sn : (q4 == 2) ? -cs : sn;
            ropeC[gt] = (float)c_; ropeS[gt] = (float)s_; } }
    }
    xcd_barrier(bar);
    {
    PHASE_ENV
    for (int e = bx * (NWAVES * 64) + tid; e < 4 * 9 * DM; e += G * NWAVES * 64) {
        const int l = e / (9 * DM), r = (e / DM) % 9, c = e & (DM - 1);
        float mod[6];
#pragma unroll
        for (int j = 0; j < 6; ++j) { float s = IN(I_BADA)[(size_t)l * 6 * DM + j * DM + c];
#pragma unroll
            for (int kc = 0; kc < 8; ++kc) s += PART[((size_t)((kc * 4 + l) * 9 + r)) * (6 * DM) + j * DM + c];
            mod[j] = s; }
        const float* gn = IN(I_GNORM) + (size_t)l * 4 * DM;
        float* vb = VEC + (size_t)l * 6 * 9 * DM + (size_t)r * DM + c;
        vb[0 * 9 * DM] = gn[0 * DM + c] * (1.0f + mod[1]); vb[1 * 9 * DM] = mod[0]; vb[2 * 9 * DM] = mod[2] * gn[1 * DM + c];
        vb[3 * 9 * DM] = gn[2 * DM + c] * (1.0f + mod[4]); vb[4 * 9 * DM] = mod[3]; vb[5 * 9 * DM] = mod[5] * gn[3 * DM + c];
    }
    }
    xcd_barrier(bar);

#define BF8_TO_F(W, LO, HI) do { LO = (f32x4){bf2f(W.x & 0xffffu), bf2f(W.x >> 16), bf2f(W.y & 0xffffu), bf2f(W.y >> 16)}; HI = (f32x4){bf2f(W.z & 0xffffu), bf2f(W.z >> 16), bf2f(W.w & 0xffffu), bf2f(W.w >> 16)}; } while (0)
#define THIN_LOADX(ROW, XV, XW, MW, XP, XS, XIN16, RES) do { const int r_ = (ROW); \
        if (XIN16) { _Pragma("unroll") for (int c = 0; c < 4; ++c) XW[c] = __builtin_nontemporal_load(&((const v4u*)(X16 + (size_t)r_ * DM))[64 * c + lane]); } \
        else { const float* xb_ = (XP), * xs_m = (XS) - (size_t)TP * DM; const float* xr_ = (r_ < TP ? xb_ : xs_m) + (size_t)r_ * DM; \
            _Pragma("unroll") for (int c = 0; c < 4; ++c) { XV[2 * c] = __builtin_nontemporal_load(&((const f32x4*)xr_)[128 * c + 2 * lane]); XV[2 * c + 1] = __builtin_nontemporal_load(&((const f32x4*)xr_)[128 * c + 2 * lane + 1]); } } \
        if (RES) { _Pragma("unroll") for (int c = 0; c < 4; ++c) MW[c] = __builtin_nontemporal_load(&((const v4u*)(MF + (size_t)r_ * DM))[64 * c + lane]); } } while (0)
#define THIN_ROW(ROW, XV, XW, MW, XIN16, XOUT16, RES, HOUT) do { const int r_ = (ROW); \
        if (XIN16) { _Pragma("unroll") for (int c = 0; c < 4; ++c) BF8_TO_F(XW[c], XV[2 * c], XV[2 * c + 1]); } \
        if (RES) { \
            f32x4 mv[8]; float ss = 0.f; \
            _Pragma("unroll") for (int c = 0; c < 4; ++c) BF8_TO_F(MW[c], mv[2 * c], mv[2 * c + 1]); \
            _Pragma("unroll") for (int j = 0; j < 8; ++j) ss += (mv[j].x * mv[j].x + mv[j].y * mv[j].y) + (mv[j].z * mv[j].z + mv[j].w * mv[j].w); \
            const float rstd = 1.0f / sqrtf(wave_sum(ss) * (1.0f / DM) + EPS); \
            _Pragma("unroll") for (int j = 0; j < 8; ++j) XV[j] += gv[j] * (mv[j] * rstd); \
            if (XOUT16) { _Pragma("unroll") for (int c = 0; c < 4; ++c) { v4u w; w.x = pkbf(XV[2 * c].x, XV[2 * c].y); w.y = pkbf(XV[2 * c].z, XV[2 * c].w); w.z = pkbf(XV[2 * c + 1].x, XV[2 * c + 1].y); w.w = pkbf(XV[2 * c + 1].z, XV[2 * c + 1].w); \
                    __builtin_nontemporal_store(w, &((v4u*)(X16 + (size_t)r_ * DM))[64 * c + lane]); } } \
            else { _Pragma("unroll") for (int c = 0; c < 4; ++c) { __builtin_nontemporal_store(XV[2 * c], &((f32x4*)(out + (size_t)r_ * DM))[128 * c + 2 * lane]); __builtin_nontemporal_store(XV[2 * c + 1], &((f32x4*)(out + (size_t)r_ * DM))[128 * c + 2 * lane + 1]); } } \
        } \
        if (HOUT) { \
            float s2 = 0.f; \
            _Pragma("unroll") for (int j = 0; j < 8; ++j) s2 += (XV[j].x * XV[j].x + XV[j].y * XV[j].y) + (XV[j].z * XV[j].z + XV[j].w * XV[j].w); \
            const float r2 = 1.0f / sqrtf(wave_sum(s2) * (1.0f / DM) + EPS); \
            _Pragma("unroll") for (int c = 0; c < 4; ++c) { const f32x4 h0 = XV[2 * c] * r2 * av[2 * c] + bv[2 * c], h1 = XV[2 * c + 1] * r2 * av[2 * c + 1] + bv[2 * c + 1]; \
                v4u w; w.x = pkbf(h0.x, h0.y); w.y = pkbf(h0.z, h0.w); w.z = pkbf(h1.x, h1.y); w.w = pkbf(h1.z, h1.w); ((v4u*)(H + (size_t)r_ * DM))[64 * c + lane] = w; } \
        } } while (0)
#define THIN_PHASE(XP, XS, XIN16, XOUT16, RES, GV, HOUT, AV, BV) do { \
    for (int row = 2 * gw; row < TT; row += 2 * NGW) { \
        const int cls = row < TP ? 0 : 1 + ((row - TP) >> 11); \
        f32x4 xa[8], xb[8], gv[8], av[8], bv[8]; v4u xwa[4], xwb[4], mwa[4], mwb[4]; \
        THIN_LOADX(row, xa, xwa, mwa, XP, XS, XIN16, RES); THIN_LOADX(row + 1, xb, xwb, mwb, XP, XS, XIN16, RES); \
        if (RES) { _Pragma("unroll") for (int c = 0; c < 4; ++c) { gv[2 * c] = ((const f32x4*)((GV) + (size_t)cls * DM))[128 * c + 2 * lane]; gv[2 * c + 1] = ((const f32x4*)((GV) + (size_t)cls * DM))[128 * c + 2 * lane + 1]; } } \
        { _Pragma("unroll") for (int c = 0; c < 4; ++c) { av[2 * c] = ((const f32x4*)((AV) + (size_t)cls * DM))[128 * c + 2 * lane]; av[2 * c + 1] = ((const f32x4*)((AV) + (size_t)cls * DM))[128 * c + 2 * lane + 1]; \
                bv[2 * c] = ((const f32x4*)((BV) + (size_t)cls * DM))[128 * c + 2 * lane]; bv[2 * c + 1] = ((const f32x4*)((BV) + (size_t)cls * DM))[128 * c + 2 * lane + 1]; } } \
        THIN_ROW(row, xa, xwa, mwa, XIN16, XOUT16, RES, HOUT); \
        THIN_ROW(row + 1, xb, xwb, mwb, XIN16, XOUT16, RES, HOUT); \
    } } while (0)
#define THIN_DMA_ISSUE(PAIR) do { const size_t r0_ = (size_t)(PAIR) * 2; \
        _Pragma("unroll") for (int q = 0; q < 2; ++q) _Pragma("unroll") for (int c = 0; c < 4; ++c) { \
            __builtin_amdgcn_global_load_lds((const unsigned*)(X16 + (r0_ + q) * DM + c * 512 + lane * 8), (LAS unsigned*)(wl_ + q * 4096 + c * 1024), 16, 0, 2); \
            __builtin_amdgcn_global_load_lds((const unsigned*)(MF + (r0_ + q) * DM + c * 512 + lane * 8), (LAS unsigned*)(wl_ + 8192 + q * 4096 + c * 1024), 16, 0, 2); } } while (0)
#define THIN_PHASE_DMA(XOUT16, GV, HOUT, AV, BV) do { \
    LAS unsigned char* const wl_ = lds + wave * 16384; \
    const int npair_ = TT / 2; \
    if (gw < npair_) THIN_DMA_ISSUE(gw); \
    for (int pr = gw; pr < npair_; pr += NGW) { \
        const int row = 2 * pr; const int cls = row < TP ? 0 : 1 + ((row - TP) >> 11); \
        f32x4 xa[8], xb[8], gv[8], av[8], bv[8]; v4u xwa[4], xwb[4], mwa[4], mwb[4]; \
        { _Pragma("unroll") for (int c = 0; c < 4; ++c) { gv[2 * c] = ((const f32x4*)((GV) + (size_t)cls * DM))[128 * c + 2 * lane]; gv[2 * c + 1] = ((const f32x4*)((GV) + (size_t)cls * DM))[128 * c + 2 * lane + 1]; } } \
        { _Pragma("unroll") for (int c = 0; c < 4; ++c) { av[2 * c] = ((const f32x4*)((AV) + (size_t)cls * DM))[128 * c + 2 * lane]; av[2 * c + 1] = ((const f32x4*)((AV) + (size_t)cls * DM))[128 * c + 2 * lane + 1]; \
                bv[2 * c] = ((const f32x4*)((BV) + (size_t)cls * DM))[128 * c + 2 * lane]; bv[2 * c + 1] = ((const f32x4*)((BV) + (size_t)cls * DM))[128 * c + 2 * lane + 1]; } } \
        asm volatile("" ::: "memory"); __builtin_amdgcn_s_waitcnt(0x0F70); asm volatile("" ::: "memory");     \
        _Pragma("unroll") for (int c = 0; c < 4; ++c) { xwa[c] = *(const LAS v4u*)(wl_ + c * 1024 + lane * 16); xwb[c] = *(const LAS v4u*)(wl_ + 4096 + c * 1024 + lane * 16); \
            mwa[c] = *(const LAS v4u*)(wl_ + 8192 + c * 1024 + lane * 16); mwb[c] = *(const LAS v4u*)(wl_ + 12288 + c * 1024 + lane * 16); } \
        asm volatile("s_waitcnt lgkmcnt(0)" ::: "memory");     \
        if (pr + NGW < npair_) THIN_DMA_ISSUE(pr + NGW); \
        THIN_ROW(row, xa, xwa, mwa, true, XOUT16, true, HOUT); \
        THIN_ROW(row + 1, xb, xwb, mwb, true, XOUT16, true, HOUT); \
    } } while (0)
#define X_IS_BF16 1

    { PHASE_ENV
      THIN_PHASE(IN(I_XP), IN(I_XS), false, false, false, VEC, true, VEC + 0 * 9 * DM, VEC + 1 * 9 * DM); }
    xcd_barrier(bar);

    for (int L = 0; L < 4; ++L) {
        const int kind = L % 3, slot = L / 3, nslot = (kind == 0) ? 2 : 1;
#define LAYER_ENV PHASE_ENV unsigned char* const wl = ws + WS_W + (size_t)L * W_LAYER; const float* const vecL = VEC + (size_t)L * 6 * 9 * DM; (void)wl; (void)vecL;
        { LAYER_ENV pg8::Gemm g{H, (const bf16*)(wl + W_QKV), TT, NQKV, DM}; pg8::StaticOrder S; S.init(TT, NQKV, G, bx);
          pg8::EpiStore E{RAW, NQKV};
          pg8::gemm_phase<pg8::EpiStore, pg8::StaticOrder, true, true>(lds, g, S, E); }
        { LAYER_ENV
          { const int first = ((TT / 256) * (NQKV / 256)) % (int)gridDim.x, bxc = blockIdx.x;
            if (bxc >= first) {
                const float* ck = (kind == 0) ? IN(I_CKF) : (kind == 1) ? IN(I_CKW) : IN(I_CKD);
                const float* cv = (kind == 0) ? IN(I_CVF) : (kind == 1) ? IN(I_CVW) : IN(I_CVD);
                for (int it = (bxc - first) * NWAVES + wave; it < 2 * 8 * 128; it += ((int)gridDim.x - first) * NWAVES) {
                    const int p0 = (it & 127) * 4, b = (it >> 7) & 7, isv = it >> 10;
                    const float* src = (isv ? cv : ck) + ((size_t)(b * nslot + slot) * PAST + p0) * KVW + lane * 8;
                    bf16* dst = (isv ? VC : KC) + ((size_t)b * SKV + p0) * KVW + lane * 8;
                    f32x4 a[8];
#pragma unroll
                    for (int q = 0; q < 4; ++q) { a[2 * q] = *(const f32x4*)(src + q * KVW); a[2 * q + 1] = *(const f32x4*)(src + q * KVW + 4); }
#pragma unroll
                    for (int q = 0; q < 4; ++q) { v4u o; o.x = pkbf(a[2 * q].x, a[2 * q].y); o.y = pkbf(a[2 * q].z, a[2 * q].w); o.z = pkbf(a[2 * q + 1].x, a[2 * q + 1].y); o.w = pkbf(a[2 * q + 1].z, a[2 * q + 1].w); *(v4u*)(dst + q * KVW) = o; }
                } } } }
        xcd_barrier(bar);
        {
            LAYER_ENV
            const float* ck = (kind == 0) ? IN(I_CKF) : (kind == 1) ? IN(I_CKW) : IN(I_CKD);
            const float* cv = (kind == 0) ? IN(I_CVF) : (kind == 1) ? IN(I_CVW) : IN(I_CVD);
            float* const ok = out + ((kind == 0) ? O_KF : (kind == 1) ? O_KW : O_KD);
            float* const ov = out + ((kind == 0) ? O_VF : (kind == 1) ? O_VW : O_VD);
            const int l16 = lane & 15;
            f32x4 gq0, gq1, gk0, gk1;
            { const float* gqp = IN(I_GQF) + slot * 128 + l16 * 8; const float* gkp = IN(I_GKF) + slot * 128 + l16 * 8;
              gq0 = *(const f32x4*)gqp; gq1 = *(const f32x4*)(gqp + 4); gk0 = *(const f32x4*)gkp; gk1 = *(const f32x4*)(gkp + 4); }
            constexpr int LIM = TT;
#define POST_LOAD(ROW, W, CS) do { const int r_ = (ROW); \
        if (r_ < TT) { const bf16* rp_ = RAW + (size_t)r_ * NQKV + lane * 8; _Pragma("unroll") for (int q_ = 0; q_ < 2; ++q_) W[q_] = *(const v4u*)(rp_ + 2048 + q_ * 512); \
            if (r_ >= TP) { const int s_ = (r_ - TP) & (SS - 1); const int p_ = (lane & 8) ? (s_ & 63) : (s_ >> 6); const int i0_ = (lane & 3) * 8; \
                CS[0] = *(const f32x4*)(ropeC + p_ * 32 + i0_); CS[1] = *(const f32x4*)(ropeC + p_ * 32 + i0_ + 4); CS[2] = *(const f32x4*)(ropeS + p_ * 32 + i0_); CS[3] = *(const f32x4*)(ropeS + p_ * 32 + i0_ + 4); } } \
        else { const int ct_ = r_ - TT, isv_ = ct_ >> 12, rr_ = ct_ & 4095, b_ = rr_ >> 9, p_ = rr_ & 511; \
            const float* src_ = (isv_ ? cv : ck) + ((size_t)(b_ * nslot + slot) * PAST + p_) * KVW + lane * 8; W[0] = *(const v4u*)src_; W[1] = *(const v4u*)(src_ + 4); } } while (0)
#define POST_ROW(ROW, W, CS) do { const int row = (ROW); \
                if (row < TT) { \
                    const bool is_s = row >= TP; const int b = is_s ? (row - TP) >> 11 : row >> 8, s = is_s ? (row - TP) & (SS - 1) : row & (SP - 1); \
                    const float cs[8] = {CS[0].x, CS[0].y, CS[0].z, CS[0].w, CS[1].x, CS[1].y, CS[1].z, CS[1].w}; \
                    const float sn[8] = {CS[2].x, CS[2].y, CS[2].z, CS[2].w, CS[3].x, CS[3].y, CS[3].z, CS[3].w}; \
                    const size_t kvrow = is_s ? ((size_t)b * SKV + PAST + s) : (size_t)row; \
                    bf16* const kdst = (is_s ? KC : KP) + kvrow * KVW + lane * 8; \
                    bf16* const vdst = (is_s ? VC : VP) + kvrow * KVW + lane * 8; \
                    const size_t orow = ((size_t)(b * nslot + slot) * SP + s) * KVW + lane * 8; \
                    _Pragma("unroll") for (int step = 4; step < 6; ++step) {     \
                        const v4u w = W[step - 4]; \
                        float f[8] = {bf2f(w.x & 0xffffu), bf2f(w.x >> 16), bf2f(w.y & 0xffffu), bf2f(w.y >> 16), bf2f(w.z & 0xffffu), bf2f(w.z >> 16), bf2f(w.w & 0xffffu), bf2f(w.w >> 16)}; \
                        if (step < 5) { \
                            if (kind == 0) { float ss = 0.f; \
                                _Pragma("unroll") for (int j = 0; j < 8; ++j) ss += f[j] * f[j]; \
                                ss += __shfl_xor(ss, 1); ss += __shfl_xor(ss, 2); ss += __shfl_xor(ss, 4); ss += __shfl_xor(ss, 8); \
                                const float rstd = 1.0f / sqrtf(ss * (1.0f / 128.0f) + EPS); \
                                f[0] *= rstd * gk0.x; f[1] *= rstd * gk0.y; f[2] *= rstd * gk0.z; f[3] *= rstd * gk0.w; f[4] *= rstd * gk1.x; f[5] *= rstd * gk1.y; f[6] *= rstd * gk1.z; f[7] *= rstd * gk1.w; } \
                            if (is_s) { \
                                _Pragma("unroll") for (int j = 0; j < 8; ++j) { const float pf = __shfl_xor(f[j], 4); f[j] = (lane & 4) ? (pf * sn[j] + f[j] * cs[j]) : (f[j] * cs[j] - pf * sn[j]); } } \
                        } \
                        v4u o; o.x = pkbf(f[0], f[1]); o.y = pkbf(f[2], f[3]); o.z = pkbf(f[4], f[5]); o.w = pkbf(f[6], f[7]); \
                        *(v4u*)(step == 4 ? kdst : vdst) = o; \
                        if (!is_s) { float* op = (step == 4 ? ok : ov) + orow; *(f32x4*)op = (f32x4){f[0], f[1], f[2], f[3]}; *(f32x4*)(op + 4) = (f32x4){f[4], f[5], f[6], f[7]}; } \
                    } \
                } else { \
                    const int ct = row - TT, isv = ct >> 12, rr = ct & 4095, b = rr >> 9, p = rr & 511; \
                    const f32x4 a0 = __builtin_bit_cast(f32x4, W[0]), a1 = __builtin_bit_cast(f32x4, W[1]); \
                    v4u o; o.x = pkbf(a0.x, a0.y); o.y = pkbf(a0.z, a0.w); o.z = pkbf(a1.x, a1.y); o.w = pkbf(a1.z, a1.w); \
                    *(v4u*)((isv ? VC : KC) + ((size_t)b * SKV + p) * KVW + lane * 8) = o; \
                } } while (0)
            for (int q4 = gw; q4 < LIM / 4; q4 += NGW) {
                const int row0 = 4 * q4;
                v4u w0[2], w1[2], w2[2], w3[2]; f32x4 c0[4], c1[4], c2[4], c3[4];
#pragma unroll
                for (int q = 0; q < 4; ++q) { c0[q] = (f32x4){0.f, 0.f, 0.f, 0.f}; c1[q] = c0[q]; c2[q] = c0[q]; c3[q] = c0[q]; }
                POST_LOAD(row0, w0, c0); POST_LOAD(row0 + 1, w1, c1); POST_LOAD(row0 + 2, w2, c2); POST_LOAD(row0 + 3, w3, c3);
                POST_ROW(row0, w0, c0); POST_ROW(row0 + 1, w1, c1); POST_ROW(row0 + 2, w2, c2); POST_ROW(row0 + 3, w3, c3);
            }
#undef POST_ROW
#undef POST_LOAD
        }
        xcd_barrier(bar);
        {
            LAYER_ENV
            if (kind != 2) {
                const int nsamp = 1024, nprm = 512;
                for (int u = vcu; u < nsamp + nprm; u += G) {
                    const bf16 *Qp, *Kp_, *Vp_; bf16* Op; int nt, nfirst, skip = 0, qpos0 = 0; float sinkl2 = -1e30f; int b, h, qb;
                    bool hpair = false; float sinkB = -1e30f;
                    if (u < nsamp && kind == 1) {
                        hpair = true; qb = u & 15; const int hp = (u >> 4) & 7; h = 2 * hp; b = u >> 7; const size_t r0 = (size_t)TP + (size_t)b * SS + qb * 128;
                        Qp = RAW + r0 * NQKV + h * 128; Kp_ = KC + (size_t)b * SKV * KVW + (h >> 2) * 128; Vp_ = VC + (size_t)b * SKV * KVW + (h >> 2) * 128; Op = ATT + r0 * DM + h * 128;
                        qpos0 = qb * 128; const int bs = (qpos0 - 128) < 0 ? 0 : qpos0 - 128, be = (qpos0 + 256) > SS ? SS : qpos0 + 256; nfirst = PAST / 64; nt = nfirst + (be - bs) / 64; skip = bs;
                        sinkB = IN(I_SINKW)[h + 1] * 1.4426950408889634f; }
                    else
                    if (u < nsamp) { qb = u & 7; h = (u >> 3) & 15; b = u >> 7; const size_t r0 = (size_t)TP + (size_t)b * SS + qb * 256;
                        Qp = RAW + r0 * NQKV + h * 128; Kp_ = KC + (size_t)b * SKV * KVW + (h >> 2) * 128; Vp_ = VC + (size_t)b * SKV * KVW + (h >> 2) * 128; Op = ATT + r0 * DM + h * 128;
                        nt = SKV / 64; nfirst = nt; qpos0 = qb * 256; }
                    else { const int v = u - nsamp; h = v & 15; b = v >> 4; const size_t r0 = (size_t)b * SP;
                        Qp = RAW + r0 * NQKV + h * 128; Kp_ = KP + r0 * KVW + (h >> 2) * 128; Vp_ = VP + r0 * KVW + (h >> 2) * 128; Op = ATT + r0 * DM + h * 128; nt = SP / 64; nfirst = nt; }
                    if (kind == 1) sinkl2 = IN(I_SINKW)[h] * 1.4426950408889634f;
                    __syncthreads();
#if ATT_DMA_ALL == 6
                    att::attn_unit_g(Qp, Kp_, Vp_, Op, NQKV, KVW, DM, nt, nfirst, skip, qpos0, sinkl2, (LAS char*)lds, (LAS float*)(lds + LDSCTL_OFF + 1024) + wave * 64,
                                        (kind == 0 ? 1 : 0) | (u < nsamp ? 2 : 0) | (hpair ? 4 : 0), sinkB, IN(I_GQF) + slot * 128, ropeC, ropeS);
#elif ATT_DMA_ALL == 5
                    att::attn_unit_pp(Qp, Kp_, Vp_, Op, NQKV, KVW, DM, nt, nfirst, skip, qpos0, sinkl2, (LAS char*)lds, (LAS float*)(lds + LDSCTL_OFF + 1024) + wave * 64,
                                        (kind == 0 ? 1 : 0) | (u < nsamp ? 2 : 0), IN(I_GQF) + slot * 128, ropeC, ropeS);
#elif ATT_DMA_ALL == 2
                    att::attn_unit_dma2(Qp, Kp_, Vp_, Op, NQKV, KVW, DM, nt, nfirst, skip, qpos0, sinkl2, (LAS char*)lds, (LAS float*)(lds + LDSCTL_OFF + 1024) + wave * 64,
                                        (kind == 0 ? 1 : 0) | (u < nsamp ? 2 : 0), IN(I_GQF) + slot * 128, ropeC, ropeS);
#elif ATT_DMA_ALL
                    att::attn_unit_dma<4>(Qp, Kp_, Vp_, Op, NQKV, KVW, DM, nt, nfirst, skip, qpos0, sinkl2, (LAS char*)lds, (LAS float*)(lds + LDSCTL_OFF + 1024) + wave * 64,
                                          (kind == 0 ? 1 : 0) | (u < nsamp ? 2 : 0), IN(I_GQF) + slot * 128, ropeC, ropeS);
#else
                    att::attn_unit(Qp, Kp_, Vp_, Op, NQKV, KVW, DM, nt, nfirst, skip, qpos0, sinkl2, (LAS char*)lds, (kind == 0 ? 1 : 0) | (u < nsamp ? 2 : 0), IN(I_GQF) + slot * 128, ropeC, ropeS);
#endif
                }
            } else {
                const int nsamp = 1024, nprm = 512;
                for (int u = vcu; u < nsamp + nprm; u += G) {
                    int b, g, kvv, nt, qpos0 = 0; size_t r0; const bf16 *kbase, *vbase;
                    if (u < nsamp) { const int qb = u & 7; g = (u >> 3) & 3; kvv = (u >> 5) & 3; b = u >> 7; r0 = (size_t)TP + (size_t)b * SS + qb * 256; kbase = KC + (size_t)b * SKV * KVW; vbase = VC + (size_t)b * SKV * KVW; nt = SKV / 64; qpos0 = qb * 256; }
                    else { const int v = u - nsamp; g = v & 3; kvv = (v >> 2) & 3; b = v >> 4; r0 = (size_t)b * SP; kbase = KP + r0 * KVW; vbase = VP + r0 * KVW; nt = SP / 64; }
                    const int kv = kvv >> 1, m = kvv & 1, hv = ((kv * 4 + g) << 1) | m;
                    __syncthreads();
#if ATT_DIFF_PIPE
                    att::attn_unit_diff2(RAW + r0 * NQKV + hv * 128, kbase + kvv * 128, vbase + kv * 256, ADIF + r0 * 4096 + hv * 256, NQKV, KVW, 4096, nt, qpos0,
                                         (LAS char*)lds, (LAS float*)(lds + LDSCTL_OFF + 1024) + wave * 64, (u < nsamp ? 2 : 0), ropeC, ropeS);
#else
                    att::attn_unit_dma<8>(RAW + r0 * NQKV + hv * 128, kbase + kvv * 128, vbase + kv * 256, ADIF + r0 * 4096 + hv * 256, NQKV, KVW, 4096, nt, nt, 0, qpos0, -1e30f,
                                          (LAS char*)lds, (LAS float*)(lds + LDSCTL_OFF + 1024) + wave * 64, (u < nsamp ? 2 : 0), IN(I_GQF), ropeC, ropeS);
#endif
                }
            }
        }
        xcd_barrier(bar);
        if (kind == 2) { LAYER_ENV
            float d1 = IN(I_LQ1)[lane] * IN(I_LK1)[lane] + IN(I_LQ1)[lane + 64] * IN(I_LK1)[lane + 64];
            float d2 = IN(I_LQ2)[lane] * IN(I_LK2)[lane] + IN(I_LQ2)[lane + 64] * IN(I_LK2)[lane + 64];
            const float lam = expf(wave_sum(d1)) - expf(wave_sum(d2)) + LAM_INIT2;
            const f32x4 gs = *(const f32x4*)(IN(I_GSUB) + lane * 4) * (1.0f - LAM_INIT2);
            for (int row = gw; row < TT; row += NGW) {
#pragma unroll
                for (int h = 0; h < 8; ++h) {
                    const v2u a = *(const v2u*)(ADIF + (size_t)row * 4096 + (2 * h) * 256 + lane * 4), c = *(const v2u*)(ADIF + (size_t)row * 4096 + (2 * h + 1) * 256 + lane * 4);
                    f32x4 o = (f32x4){bf2f(a.x & 0xffffu), bf2f(a.x >> 16), bf2f(a.y & 0xffffu), bf2f(a.y >> 16)} - lam * (f32x4){bf2f(c.x & 0xffffu), bf2f(c.x >> 16), bf2f(c.y & 0xffffu), bf2f(c.y >> 16)};
                    const float ss = wave_sum((o.x * o.x + o.y * o.y) + (o.z * o.z + o.w * o.w));
                    o = o * (1.0f / sqrtf(ss * (1.0f / 256.0f) + EPS)) * gs;
                    v2u w; w.x = pkbf(o.x, o.y); w.y = pkbf(o.z, o.w); *(v2u*)(ATT + (size_t)row * DM + h * 256 + lane * 4) = w;
                }
            }
            xcd_barrier(bar);
        }
        { LAYER_ENV pg8::Gemm g{ATT, (const bf16*)(wl + W_O), TT, DM, DM}; pg8::StaticOrder S; S.init(TT, DM, G, bx);
          pg8::EpiStore E{MF, DM};
          pg8::gemm_phase<pg8::EpiStore, pg8::StaticOrder, true, true>(lds, g, S, E); }
        xcd_barrier(bar);
        { LAYER_ENV const float* const xp_ = (L == 0) ? IN(I_XP) : (const float*)out; const float* const xs_ = (L == 0) ? IN(I_XS) : (const float*)(out + O_YS);
          if (X_IS_BF16 && L != 0) THIN_PHASE_DMA(true, vecL + 2 * 9 * DM, true, vecL + 3 * 9 * DM, vecL + 4 * 9 * DM);
          else THIN_PHASE(xp_, xs_, false, (X_IS_BF16 != 0), true, vecL + 2 * 9 * DM, true, vecL + 3 * 9 * DM, vecL + 4 * 9 * DM); }
        xcd_barrier(bar);
        { LAYER_ENV pg8::Gemm g{H, (const bf16*)(wl + W_GU), TT, NGU, DM}; pg8::StaticOrder S; S.init(TT, NGU, G, bx);
          pg8::EpiSwiglu E{ACT, FF};
          pg8::gemm_phase<pg8::EpiSwiglu, pg8::StaticOrder, true, true>(lds, g, S, E); }
        xcd_barrier(bar);
        { LAYER_ENV pg8::Gemm g{ACT, (const bf16*)(wl + W_D), TT, DM, FF}; pg8::StaticOrder S; S.init(TT, DM, G, bx); S.rev = 1;
          pg8::EpiStore E{MF, DM};
          pg8::gemm_phase<pg8::EpiStore, pg8::StaticOrder, true, true>(lds, g, S, E); }
        xcd_barrier(bar);
        { LAYER_ENV const float* vecN = VEC + (size_t)(L < 3 ? L + 1 : L) * 6 * 9 * DM; const bool hout = L < 3;
          if (X_IS_BF16 && hout) THIN_PHASE_DMA(true, vecL + 5 * 9 * DM, true, vecN + 0 * 9 * DM, vecN + 1 * 9 * DM);
          else THIN_PHASE(out, out + O_YS, (X_IS_BF16 != 0), false, true, vecL + 5 * 9 * DM, hout, vecN + 0 * 9 * DM, vecN + 1 * 9 * DM); }
        if (L < 3) xcd_barrier(bar);
    }
#undef THIN_PHASE
#undef THIN_LOADX
#undef THIN_ROW
#undef THIN_PHASE_DMA
#undef THIN_DMA_ISSUE
#undef BF8_TO_F
#undef LAYER_ENV
}

extern "C" void kernel_launch(void* const* d_in, const int* in_sizes, int n_in, void* d_out, int out_size, void* d_ws, size_t ws_size, hipStream_t stream) {
    static int grid = 0;
    if (grid == 0) {
        if (n_in != N_IN || (size_t)out_size != O_END || ws_size < WS_END) { fprintf(stderr, "kernel_launch: shape mismatch: n_in %d out %d ws %zu\n", n_in, out_size, ws_size); grid = -1; return; }
        int dev = 0, cus = 0, per_cu = 0;
        if (hipGetDevice(&dev) != hipSuccess || hipDeviceGetAttribute(&cus, hipDeviceAttributeMultiprocessorCount, dev) != hipSuccess) { grid = -1; return; }
        if (hipFuncSetAttribute((const void*)trunk_fwd, hipFuncAttributeMaxDynamicSharedMemorySize, LDS_BYTES) != hipSuccess) { fprintf(stderr, "kernel_launch: hipFuncSetAttribute failed\n"); grid = -1; return; }
        if (hipOccupancyMaxActiveBlocksPerMultiprocessor(&per_cu, (const void*)trunk_fwd, NWAVES * 64, LDS_BYTES) != hipSuccess || per_cu < 1)
            fprintf(stderr, "kernel_launch: note: occupancy query reports %d workgroups per CU\n", per_cu);
        (void)hipGetLastError();
        grid = cus;
    }
    if (grid < 0) return;
    if (hipMemsetAsync((char*)d_ws + WS_CTL, 0, CTL_ZERO_BYTES, stream) != hipSuccess) { fprintf(stderr, "kernel_launch: memset failed\n"); return; }
    Args a{};
    for (int i = 0; i < N_IN; ++i) a.in[i] = (const float*)d_in[i];
    a.out = (float*)d_out; a.ws = (unsigned char*)d_ws;
    hipLaunchKernelGGL(trunk_fwd, dim3(grid), dim3(NWAVES * 64), LDS_BYTES, stream, a);
    const hipError_t le = hipPeekAtLastError();
    if (le != hipSuccess) fprintf(stderr, "kernel_launch: launch failed: %s\n", hipGetErrorName(le));
}
```

```cpp
#include <hip/hip_runtime.h>
#include <cstdio>
#include <cstdint>
#define TIDTAB_LDS_ADDR (131072 + 3072)
__device__ __forceinline__ int tid_now() {
    const unsigned slot = (unsigned)__builtin_amdgcn_s_getreg((5 << 11) | 4) & 63u;
    const unsigned w = *(const volatile __attribute__((address_space(3))) unsigned*)(unsigned long)(TIDTAB_LDS_ADDR + slot * 4);
    unsigned ln; asm volatile("v_mbcnt_lo_u32_b32 %0, -1, 0\n\tv_mbcnt_hi_u32_b32 %0, -1, %0" : "=v"(ln));
    return (int)(__builtin_amdgcn_readfirstlane(w) * 64u + ln);
}
namespace pg8 {
#define PG8_LAS __attribute__((address_space(3)))
typedef unsigned short bf16_t;
typedef short bf16x8 __attribute__((ext_vector_type(8)));
typedef float f32x4 __attribute__((ext_vector_type(4)));
typedef unsigned u32x4 __attribute__((ext_vector_type(4)));
constexpr int BM = 256, BK = 64, HALF = 128, HTB = HALF * BK * 2  , STAGE_BYTES = 8 * HTB, NXCD = 8, WGM = 8;

__host__ __device__ __forceinline__ int lds_byte(int r, int c) { const int st = (r >> 4) * 2 + (c >> 5), rr = r & 15, cc = c & 31, ob = rr * 64 + cc * 2; return st * 1024 + (ob ^ (((ob >> 9) & 1) << 5)); }
__host__ __device__ __forceinline__ void stage_rc(int b, int& R, int& C) { const int st = b / 1024, sb = b % 1024, swz = sb ^ (((sb >> 9) & 1) << 5); R = (st >> 1) * 16 + swz / 64; C = (st & 1) * 32 + (swz % 64) / 2; }
__host__ __device__ __forceinline__ int perm32(int rho) { const int n = rho >> 4, i = rho & 15; return 8 * (i >> 2) + 4 * n + (i & 3); }

struct Unit { int pm, pn; };
struct Gemm { const bf16_t* A; const bf16_t* Bt; int M, N, K; };

struct StaticOrder {
    int nM, nN, nwg, G, c, rev;
    __host__ __device__ void init(int M, int N, int G_, int c_) { nM = M / BM; nN = N / BM; nwg = nM * nN; G = G_; c = c_; rev = 0; }
    __host__ __device__ bool next(int i, Unit& u) const {
        const long L = (long)i * G + c; if (L >= nwg) return false;
        int wgid = (int)L; { const int q = nwg / NXCD, r = nwg % NXCD, xcd = wgid % NXCD, off = wgid / NXCD; wgid = (xcd < r ? xcd * (q + 1) : r * (q + 1) + (xcd - r) * q) + (rev ? (xcd < r ? q : q - 1) - off : off); }
        const int nig = WGM * nN, gid = wgid / nig, fm = gid * WGM, gsz = (nM - fm) < WGM ? (nM - fm) : WGM;
        u.pm = fm + ((wgid % nig) % gsz); u.pn = (wgid % nig) / gsz; return true;
    }
    __device__ __forceinline__ void a_ready(const Unit&) const {}
    __device__ __forceinline__ void done(const Unit&) const {}
};

__device__ __forceinline__ unsigned cvt_pk_bf16(float lo, float hi) { unsigned r; asm volatile("v_cvt_pk_bf16_f32 %0, %1, %2" : "=v"(r) : "v"(lo), "v"(hi)); return r; }

struct EpiStore {
    static constexpr bool PERM = true, AFTER_DRAIN = false;
    bf16_t* O; int ldc;
    __device__ __forceinline__ static unsigned ror8(unsigned v) { return (unsigned)__builtin_amdgcn_update_dpp(0, (int)v, 0x128, 0xf, 0xf, false); }
    __device__ __forceinline__ void operator()(const f32x4 (&acc)[2][2][4][2], const Unit& u, int wr, int wc, int fr, int fq) const {
        const bool lo = fr < 8;
        const int row0 = u.pm * BM + wr * 64 + (fr & 7), col0 = u.pn * BM + wc * 64 + 8 * fq + (lo ? 0 : 32);
#pragma unroll
        for (int ai = 0; ai < 2; ++ai)
#pragma unroll
            for (int m = 0; m < 4; ++m) { bf16_t* rowp = O + (size_t)(row0 + ai * HALF + m * 16) * ldc + col0;
                u32x4 A, B;
                { const f32x4 v0 = acc[ai][0][m][0], v1 = acc[ai][0][m][1]; A.x = cvt_pk_bf16(v0[0], v0[1]); A.y = cvt_pk_bf16(v0[2], v0[3]); A.z = cvt_pk_bf16(v1[0], v1[1]); A.w = cvt_pk_bf16(v1[2], v1[3]); }
                { const f32x4 v0 = acc[ai][1][m][0], v1 = acc[ai][1][m][1]; B.x = cvt_pk_bf16(v0[0], v0[1]); B.y = cvt_pk_bf16(v0[2], v0[3]); B.z = cvt_pk_bf16(v1[0], v1[1]); B.w = cvt_pk_bf16(v1[2], v1[3]); }
                u32x4 R; R.x = ror8(lo ? B.x : A.x); R.y = ror8(lo ? B.y : A.y); R.z = ror8(lo ? B.z : A.z); R.w = ror8(lo ? B.w : A.w);
                u32x4 w1, w2; w1.x = lo ? A.x : R.x; w1.y = lo ? A.y : R.y; w1.z = lo ? A.z : R.z; w1.w = lo ? A.w : R.w;
                w2.x = lo ? R.x : B.x; w2.y = lo ? R.y : B.y; w2.z = lo ? R.z : B.z; w2.w = lo ? R.w : B.w;
                *(u32x4*)rowp = w1; *(u32x4*)(rowp + (size_t)8 * ldc) = w2; }
    }
};
struct EpiSwiglu {
    static constexpr bool PERM = true, AFTER_DRAIN = false;
    bf16_t* O; int ldc;
    __device__ __forceinline__ static float swi(float g, float u) { const float e = __builtin_amdgcn_exp2f(g * -1.4426950408889634f); return g * u * __builtin_amdgcn_rcpf(1.0f + e); }
    __device__ __forceinline__ void operator()(const f32x4 (&acc)[2][2][4][2], const Unit& u, int wr, int wc, int fr, int fq) const {
        const int row0 = u.pm * BM + wr * 64 + fr, col0 = u.pn * HALF + wc * 32 + 8 * fq;
#pragma unroll
        for (int ai = 0; ai < 2; ++ai)
#pragma unroll
            for (int m = 0; m < 4; ++m) { bf16_t* rowp = O + (size_t)(row0 + ai * HALF + m * 16) * ldc + col0;
                const f32x4 g0 = acc[ai][0][m][0], g1 = acc[ai][0][m][1], u0 = acc[ai][1][m][0], u1 = acc[ai][1][m][1];
                u32x4 w; w.x = cvt_pk_bf16(swi(g0[0], u0[0]), swi(g0[1], u0[1])); w.y = cvt_pk_bf16(swi(g0[2], u0[2]), swi(g0[3], u0[3]));
                w.z = cvt_pk_bf16(swi(g1[0], u1[0]), swi(g1[1], u1[1])); w.w = cvt_pk_bf16(swi(g1[2], u1[2]), swi(g1[3], u1[3]));
                *(u32x4*)rowp = w; }
    }
};

template <class Epi, class Sched, bool ALIGN_EPI = false, bool SP2 = false>
__device__ __forceinline__ void gemm_phase(PG8_LAS unsigned char* lds, const Gemm g, const Sched& S, const Epi& E) {
    int tid_l = tid_now(); asm volatile("" : "+v"(tid_l));
    const int tid = tid_l, wid = __builtin_amdgcn_readfirstlane(tid >> 6), lane = tid & 63, wr = wid >> 2, wc = wid & 3, fr = lane & 15, fq = lane >> 4;
    const int K = g.K, nt = K / BK;
    unsigned voffA[2], voffB[2];
#pragma unroll
    for (int i = 0; i < 2; ++i) { int R, C; stage_rc(tid * 16 + i * 8192, R, C); const int Rb = Epi::PERM ? (64 * (R >> 5) + perm32(R & 31)) : R;
        voffA[i] = (unsigned)(R * K + C) * 2u; voffB[i] = (unsigned)(Rb * K + C) * 2u; }
    const size_t kstep = (size_t)(BK * 2);
    const size_t hstep = (size_t)HALF * K * 2;
    const size_t tstep = 2 * hstep;
    const size_t hstepB = Epi::PERM ? (size_t)32 * K * 2 : hstep;
    const unsigned ldsw = (unsigned)wid * 1024u;
    const int aoff = lds_byte(wr * 64 + fr, fq * 8), boff = lds_byte(wc * 32 + fr, fq * 8);
#define PG8_SA(b, h) (((b) * 2 + (h)) * HTB)
#define PG8_SB(b, h) ((4 + (b) * 2 + (h)) * HTB)
    const __amdgpu_buffer_rsrc_t rs_voffA = __builtin_amdgcn_make_buffer_rsrc((void*)g.A, 0, 0x7ffffffe, 0x00020000), rs_voffB = __builtin_amdgcn_make_buffer_rsrc((void*)g.Bt, 0, 0x7ffffffe, 0x00020000);
    const char* const base_voffA = (const char*)g.A; const char* const base_voffB = (const char*)g.Bt;
#define PG8_STAGE(bufoff, gbase, voff) do { const int so_ = (int)((const char*)(gbase) - base_##voff); _Pragma("unroll") for (int _i = 0; _i < 2; ++_i) \
        __builtin_amdgcn_raw_ptr_buffer_load_lds(rs_##voff, (PG8_LAS void*)(lds + (bufoff) + ldsw + _i * 8192), 16, (int)(voff)[_i], so_, 0, 0); } while (0)
#define PG8_LDA(dst, b, h) do { _Pragma("unroll") for (int m = 0; m < 4; ++m) _Pragma("unroll") for (int k = 0; k < 2; ++k) dst[m][k] = *(const PG8_LAS bf16x8*)(lds + PG8_SA(b, h) + aoff + m * 2048 + k * 1024); } while (0)
#define PG8_LDB(dst, b, h) do { _Pragma("unroll") for (int n = 0; n < 2; ++n) _Pragma("unroll") for (int k = 0; k < 2; ++k) dst[n][k] = *(const PG8_LAS bf16x8*)(lds + PG8_SB(b, h) + boff + n * 2048 + k * 1024); } while (0)
#define PG8_MMA(ai, bj, At, Bt) do { __builtin_amdgcn_s_setprio(1); _Pragma("unroll") for (int m = 0; m < 4; ++m) _Pragma("unroll") for (int n = 0; n < 2; ++n) _Pragma("unroll") for (int k = 0; k < 2; ++k) \
        acc[ai][bj][m][n] = __builtin_amdgcn_mfma_f32_16x16x32_bf16(Bt[n][k], At[m][k], acc[ai][bj][m][n], 0, 0, 0); __builtin_amdgcn_s_setprio(0); } while (0)
#define PG8_WAIT_V(n) asm volatile("s_waitcnt vmcnt(" #n ")" ::: "memory")
#define PG8_WAIT_L(n) asm volatile("s_waitcnt lgkmcnt(" #n ")" ::: "memory")
#define PG8_BAR __builtin_amdgcn_s_barrier()
#define PG8_SCHED __builtin_amdgcn_sched_barrier(0)
    Unit cur, nxt; int ui = 0;
    if (!S.next(0, cur)) return;
    f32x4 acc[2][2][4][2];
#pragma unroll
    for (int a = 0; a < 2; ++a)
#pragma unroll
        for (int b = 0; b < 2; ++b)
#pragma unroll
            for (int m = 0; m < 4; ++m)
#pragma unroll
                for (int n = 0; n < 2; ++n) acc[a][b][m][n] = (f32x4){0.f, 0.f, 0.f, 0.f};
    bf16x8 At[4][2], B0[2][2], B1[2][2];
    const char* cA = (const char*)g.A + (size_t)cur.pm * tstep; const char* cB = (const char*)g.Bt + (size_t)cur.pn * tstep;
    S.a_ready(cur);
    if constexpr (SP2) {
        PG8_STAGE(PG8_SB(0, 0), cB, voffB); PG8_STAGE(PG8_SB(0, 1), cB + hstepB, voffB); PG8_STAGE(PG8_SA(0, 0), cA, voffA); PG8_STAGE(PG8_SA(0, 1), cA + hstep, voffA);
        if (wr == 1) PG8_BAR;
        PG8_WAIT_V(2); PG8_BAR;
        PG8_STAGE(PG8_SB(1, 0), cB + kstep, voffB); PG8_STAGE(PG8_SA(1, 0), cA + kstep, voffA); PG8_STAGE(PG8_SB(1, 1), cB + hstepB + kstep, voffB);
        PG8_WAIT_V(6); PG8_BAR;
    } else {
        PG8_STAGE(PG8_SB(0, 0), cB, voffB); PG8_STAGE(PG8_SA(0, 0), cA, voffA); PG8_STAGE(PG8_SB(0, 1), cB + hstepB, voffB); PG8_STAGE(PG8_SA(0, 1), cA + hstep, voffA);
        if (wr == 1) PG8_BAR;
        PG8_WAIT_V(4); PG8_BAR;
        PG8_STAGE(PG8_SB(1, 0), cB + kstep, voffB); PG8_STAGE(PG8_SA(1, 0), cA + kstep, voffA); PG8_STAGE(PG8_SB(1, 1), cB + hstepB + kstep, voffB);
        PG8_WAIT_V(6); PG8_BAR;
    }
    for (;;) {
        const bool has_next = S.next(ui + 1, nxt);
        const char* nA = has_next ? (const char*)g.A + (size_t)nxt.pm * tstep : cA; const char* nB = has_next ? (const char*)g.Bt + (size_t)nxt.pn * tstep : cB;
        for (int t = 0; t < nt; t += 2) {
            const bool last = (t == nt - 2);
            const char* a1 = cA + (size_t)(t + 1) * kstep;
            const char* a2 = last ? nA : cA + (size_t)(t + 2) * kstep; const char* b2 = last ? nB : cB + (size_t)(t + 2) * kstep;
            const char* a3 = a2 + kstep; const char* b3 = b2 + kstep;
            if (last && has_next) S.a_ready(nxt);
            if constexpr (SP2) {
            PG8_LDB(B0, 0, 0); PG8_LDB(B1, 0, 1); PG8_SCHED; PG8_LDA(At, 0, 0); PG8_STAGE(PG8_SA(1, 1), a1 + hstep, voffA);
            PG8_WAIT_V(8); PG8_WAIT_L(0); PG8_BAR; PG8_MMA(0, 0, At, B0); PG8_MMA(0, 1, At, B1); PG8_BAR; PG8_SCHED;
            PG8_LDA(At, 0, 1); PG8_STAGE(PG8_SB(0, 0), b2, voffB); PG8_STAGE(PG8_SB(0, 1), b2 + hstepB, voffB); PG8_STAGE(PG8_SA(0, 0), a2, voffA);
            PG8_WAIT_V(8); PG8_WAIT_L(0); PG8_BAR; PG8_MMA(1, 0, At, B0); PG8_MMA(1, 1, At, B1); PG8_BAR; PG8_SCHED;
            PG8_LDB(B0, 1, 0); PG8_LDB(B1, 1, 1); PG8_SCHED; PG8_LDA(At, 1, 0); PG8_STAGE(PG8_SA(0, 1), a2 + hstep, voffA);
            PG8_WAIT_V(8); PG8_WAIT_L(0); PG8_BAR; PG8_MMA(0, 0, At, B0); PG8_MMA(0, 1, At, B1); PG8_BAR; PG8_SCHED;
            PG8_LDA(At, 1, 1); PG8_STAGE(PG8_SB(1, 0), b3, voffB); PG8_STAGE(PG8_SB(1, 1), b3 + hstepB, voffB); PG8_STAGE(PG8_SA(1, 0), a3, voffA);
            PG8_WAIT_V(8); PG8_WAIT_L(0); PG8_BAR; PG8_MMA(1, 0, At, B0); PG8_MMA(1, 1, At, B1); PG8_BAR; PG8_SCHED;
            } else {
            PG8_LDB(B0, 0, 0); PG8_SCHED; PG8_LDA(At, 0, 0); PG8_STAGE(PG8_SA(1, 1), a1 + hstep, voffA);
            PG8_WAIT_L(8); PG8_BAR; PG8_WAIT_L(0); PG8_MMA(0, 0, At, B0); PG8_BAR; PG8_SCHED;
            PG8_LDB(B1, 0, 1); PG8_STAGE(PG8_SB(0, 0), b2, voffB);
            PG8_BAR; PG8_WAIT_L(0); PG8_MMA(0, 1, At, B1); PG8_BAR;
            PG8_LDA(At, 0, 1); PG8_STAGE(PG8_SA(0, 0), a2, voffA);
            PG8_BAR; PG8_WAIT_L(0); PG8_MMA(1, 0, At, B0); PG8_BAR; PG8_SCHED;
            PG8_STAGE(PG8_SB(0, 1), b2 + hstepB, voffB);
            PG8_WAIT_V(6); PG8_BAR; PG8_MMA(1, 1, At, B1); PG8_BAR;
            PG8_LDB(B0, 1, 0); PG8_SCHED; PG8_LDA(At, 1, 0); PG8_STAGE(PG8_SA(0, 1), a2 + hstep, voffA);
            PG8_WAIT_L(8); PG8_BAR; PG8_WAIT_L(0); PG8_MMA(0, 0, At, B0); PG8_BAR; PG8_SCHED;
            PG8_LDB(B1, 1, 1); PG8_STAGE(PG8_SB(1, 0), b3, voffB);
            PG8_BAR; PG8_WAIT_L(0); PG8_MMA(0, 1, At, B1); PG8_BAR;
            PG8_LDA(At, 1, 1); PG8_STAGE(PG8_SA(1, 0), a3, voffA);
            PG8_BAR; PG8_WAIT_L(0); PG8_MMA(1, 0, At, B0); PG8_BAR; PG8_SCHED;
            PG8_STAGE(PG8_SB(1, 1), b3 + hstepB, voffB);
            PG8_WAIT_V(6); PG8_BAR; PG8_MMA(1, 1, At, B1); PG8_BAR;
            }
        }
        if constexpr (ALIGN_EPI) { if (wr == 0) PG8_BAR; }
        if constexpr (!Epi::AFTER_DRAIN) { E(acc, cur, wr, wc, fr, fq); S.done(cur); }
        if (!has_next) break;
#pragma unroll
        for (int a = 0; a < 2; ++a)
#pragma unroll
            for (int b = 0; b < 2; ++b)
#pragma unroll
                for (int m = 0; m < 4; ++m)
#pragma unroll
                    for (int n = 0; n < 2; ++n) acc[a][b][m][n] = (f32x4){0.f, 0.f, 0.f, 0.f};
        cur = nxt; cA = nA; cB = nB; ++ui;
        if constexpr (ALIGN_EPI) { if (wr == 1) PG8_BAR; }
    }
    PG8_WAIT_V(0);
    if constexpr (!ALIGN_EPI) { if (wr == 0) PG8_BAR; }
    PG8_BAR;
    if constexpr (Epi::AFTER_DRAIN) { E.fused(acc, cur, wr, wc, fr, fq, lds, wid, lane); S.done(cur); }
#undef PG8_SA
#undef PG8_SB
#undef PG8_STAGE
#undef PG8_LDA
#undef PG8_LDB
#undef PG8_MMA
#undef PG8_WAIT_V
#undef PG8_WAIT_L
#undef PG8_BAR
#undef PG8_SCHED
}
}

namespace att {
#define ALAS __attribute__((address_space(3)))
typedef unsigned short bf16_t;
using bf16x8 = __attribute__((ext_vector_type(8))) short;
using s16x4  = __attribute__((ext_vector_type(4))) short;
using f32x16 = __attribute__((ext_vector_type(16))) float;
using u32x4  = __attribute__((ext_vector_type(4))) unsigned;
constexpr int   D = 128, NW = 8, QBLK = 32, KVBLK = 64;
constexpr float SCALE = 0.088388347648318440f;
constexpr float THR = 8.f;
constexpr int SHM_V = KVBLK * D * 2, SHM_K = KVBLK * D * 2, SHM_ATTN = 2 * SHM_V + 2 * SHM_K + NW * 64 * 4;
#define KSWZ(row, colB) ((row) * 256 + ((colB) ^ (((row) & 7) << 4)))
#define SBAR() __builtin_amdgcn_sched_barrier(0)
__device__ __forceinline__ int crow(int r, int hi) { return (r & 3) + 8 * (r >> 2) + 4 * hi; }
__device__ __forceinline__ unsigned cvtpk(float lo, float hi) { unsigned r; asm volatile("v_cvt_pk_bf16_f32 %0, %1, %2" : "=v"(r) : "v"(lo), "v"(hi)); return r; }

__device__ __forceinline__ void partialSM(f32x16& p0, f32x16& p1, float& m_reg, float& mn, float& alpha) {
  constexpr float C = SCALE * 1.4426950408889634f;
  float pmax = p0[0];
#pragma unroll
  for (int r = 1; r < 16; ++r) pmax = fmaxf(pmax, p0[r]);
#pragma unroll
  for (int r = 0; r < 16; ++r) pmax = fmaxf(pmax, p1[r]);
  { auto rr = __builtin_amdgcn_permlane32_swap(__float_as_uint(pmax), __float_as_uint(pmax), false, false);
    pmax = fmaxf(__uint_as_float(rr[0]), __uint_as_float(rr[1])); }
  if (__builtin_expect(__all(pmax - m_reg <= THR / SCALE), 1)) { mn = m_reg; alpha = 1.f; }
  else { mn = fmaxf(m_reg, pmax); alpha = __builtin_amdgcn_exp2f((m_reg - mn) * C); m_reg = mn; }
  float mnC = -mn * C;
#pragma unroll
  for (int r = 0; r < 16; ++r) p0[r] = fmaf(p0[r], C, mnC);
#pragma unroll
  for (int r = 0; r < 16; ++r) p1[r] = fmaf(p1[r], C, mnC);
#pragma unroll
  for (int r = 0; r < 16; ++r) p0[r] = __builtin_amdgcn_exp2f(p0[r]);
}
__device__ __forceinline__ void finishSM(f32x16& p0, f32x16& p1, float alpha, float& l_reg, bf16x8& pa0, bf16x8& pa1, bf16x8& pa2, bf16x8& pa3) {
#pragma unroll
  for (int r = 0; r < 16; ++r) p1[r] = __builtin_amdgcn_exp2f(p1[r]);
  float ps = 0;
#pragma unroll
  for (int r = 0; r < 16; ++r) ps += p0[r];
#pragma unroll
  for (int r = 0; r < 16; ++r) ps += p1[r];
  { auto rr = __builtin_amdgcn_permlane32_swap(__float_as_uint(ps), __float_as_uint(ps), false, false);
    ps = __uint_as_float(rr[0]) + __uint_as_float(rr[1]); }
  l_reg = l_reg * alpha + ps;
#define PK4(P, BASE, OUT) do { unsigned a0 = cvtpk(P[BASE + 0], P[BASE + 1]), a1 = cvtpk(P[BASE + 2], P[BASE + 3]);   \
    unsigned b0 = cvtpk(P[BASE + 4], P[BASE + 5]), b1 = cvtpk(P[BASE + 6], P[BASE + 7]);                              \
    auto r0 = __builtin_amdgcn_permlane32_swap(a0, b0, false, false); auto r1 = __builtin_amdgcn_permlane32_swap(a1, b1, false, false); \
    u32x4 w = {r0[0], r1[0], r0[1], r1[1]}; OUT = *reinterpret_cast<bf16x8*>(&w); } while (0)
  PK4(p0, 0, pa0); PK4(p0, 8, pa1); PK4(p1, 0, pa2); PK4(p1, 8, pa3);
#undef PK4
}
__device__ __forceinline__ void qkt(f32x16& p0, f32x16& p1, const ALAS char* Ks, const bf16x8* qr, int r32, int hi) {
  p0 = f32x16{}; p1 = f32x16{};
#pragma unroll
  for (int d0 = 0; d0 < 8; ++d0) { int cb = (d0 * 16 + hi * 8) * 2;
    bf16x8 b0 = *reinterpret_cast<const ALAS bf16x8*>(Ks + KSWZ(r32, cb));
    bf16x8 b1 = *reinterpret_cast<const ALAS bf16x8*>(Ks + KSWZ(32 + r32, cb));
    p0 = __builtin_amdgcn_mfma_f32_32x32x16_bf16(b0, qr[d0], p0, 0, 0, 0);
    p1 = __builtin_amdgcn_mfma_f32_32x32x16_bf16(b1, qr[d0], p1, 0, 0, 0); }
}
__device__ __forceinline__ void band_mask(f32x16& p0, f32x16& p1, int dj, int hi) {
#pragma unroll
  for (int r = 0; r < 16; ++r) { const int d = dj + crow(r, hi);
    if ((unsigned)(d + 128) > 256u) p0[r] = -1e30f;
    if ((unsigned)(d + 160) > 256u) p1[r] = -1e30f; }
}
__device__ __forceinline__ int v_st(int k, int c) { const int kk = (k & ~0xC) | ((k & 4) << 1) | ((k & 8) >> 1); return ((kk >> 3) * 4 + (c >> 5)) * 512 + ((kk & 7) * 32 + (c & 31)) * 2; }
__device__ __forceinline__ int v_rd_base(int lane) { return ((lane & 3) << 3) | (((lane >> 2) & 3) << 6) | (((lane >> 4) & 1) << 5) | (((lane >> 5) & 1) << 8); }
constexpr int v_rd_off(int d0, int ks, int half) { return d0 * 512 + ks * 4096 + half * 2048; }
template <int OFF> __device__ __forceinline__ s16x4 tr_read(int vb) {
  s16x4 r; asm volatile("ds_read_b64_tr_b16 %0, %1 offset:%2" : "=&v"(r) : "v"(vb), "i"(OFF) : "memory"); return r;
}
template <int D0> __device__ __forceinline__ void pv_one(f32x16& od, int vb, bf16x8 pa0, bf16x8 pa1, bf16x8 pa2, bf16x8 pa3) {
  s16x4 l0 = tr_read<v_rd_off(D0, 0, 0)>(vb), h0 = tr_read<v_rd_off(D0, 0, 1)>(vb), l1 = tr_read<v_rd_off(D0, 1, 0)>(vb), h1 = tr_read<v_rd_off(D0, 1, 1)>(vb);
  s16x4 l2 = tr_read<v_rd_off(D0, 2, 0)>(vb), h2 = tr_read<v_rd_off(D0, 2, 1)>(vb), l3 = tr_read<v_rd_off(D0, 3, 0)>(vb), h3 = tr_read<v_rd_off(D0, 3, 1)>(vb);
  asm volatile("s_waitcnt lgkmcnt(0)" : "+v"(l0), "+v"(h0), "+v"(l1), "+v"(h1), "+v"(l2), "+v"(h2), "+v"(l3), "+v"(h3) :: "memory");
#define PK(L, H) (bf16x8){L[0], L[1], L[2], L[3], H[0], H[1], H[2], H[3]}
  od = __builtin_amdgcn_mfma_f32_32x32x16_bf16(pa0, PK(l0, h0), od, 0, 0, 0);
  od = __builtin_amdgcn_mfma_f32_32x32x16_bf16(pa1, PK(l1, h1), od, 0, 0, 0);
  od = __builtin_amdgcn_mfma_f32_32x32x16_bf16(pa2, PK(l2, h2), od, 0, 0, 0);
  od = __builtin_amdgcn_mfma_f32_32x32x16_bf16(pa3, PK(l3, h3), od, 0, 0, 0);
#undef PK
}
__device__ __forceinline__ void pv_d0(f32x16* o, int vb, bf16x8 pa0, bf16x8 pa1, bf16x8 pa2, bf16x8 pa3) {
  pv_one<0>(o[0], vb, pa0, pa1, pa2, pa3); pv_one<1>(o[1], vb, pa0, pa1, pa2, pa3); pv_one<2>(o[2], vb, pa0, pa1, pa2, pa3); pv_one<3>(o[3], vb, pa0, pa1, pa2, pa3);
}
__device__ __forceinline__ void pv_sm(f32x16* o, int vb, bf16x8 pa0, bf16x8 pa1, bf16x8 pa2, bf16x8 pa3, f32x16& p0, f32x16& p1, float& m_reg, float& mn, float& alpha) {
  constexpr float C = SCALE * 1.4426950408889634f;
  pv_one<0>(o[0], vb, pa0, pa1, pa2, pa3);
  float pmax = p0[0];
#pragma unroll
  for (int r = 1; r < 16; ++r) pmax = fmaxf(pmax, p0[r]);
#pragma unroll
  for (int r = 0; r < 16; ++r) pmax = fmaxf(pmax, p1[r]);
  { auto rr = __builtin_amdgcn_permlane32_swap(__float_as_uint(pmax), __float_as_uint(pmax), false, false);
    pmax = fmaxf(__uint_as_float(rr[0]), __uint_as_float(rr[1])); }
  pv_one<1>(o[1], vb, pa0, pa1, pa2, pa3);
  if (__builtin_expect(__all(pmax - m_reg <= THR / SCALE), 1)) { mn = m_reg; alpha = 1.f; }
  else { mn = fmaxf(m_reg, pmax); alpha = __builtin_amdgcn_exp2f((m_reg - mn) * C); m_reg = mn; }
  const float mnC = -mn * C;
#pragma unroll
  for (int r = 0; r < 16; ++r) p0[r] = fmaf(p0[r], C, mnC);
  pv_one<2>(o[2], vb, pa0, pa1, pa2, pa3);
#pragma unroll
  for (int r = 0; r < 16; ++r) p1[r] = fmaf(p1[r], C, mnC);
#pragma unroll
  for (int r = 0; r < 8; ++r) p0[r] = __builtin_amdgcn_exp2f(p0[r]);
  pv_one<3>(o[3], vb, pa0, pa1, pa2, pa3);
#pragma unroll
  for (int r = 8; r < 16; ++r) p0[r] = __builtin_amdgcn_exp2f(p0[r]);
}

__device__ __forceinline__ void attn_unit(const bf16_t* __restrict__ Q, const bf16_t* __restrict__ K, const bf16_t* __restrict__ V, bf16_t* __restrict__ O,
                                          int ldq, int ldk, int ldo, int nt, int nfirst, int skip, int qpos0, float sinkl2, ALAS char* lds,
                                          int qmode, const float* __restrict__ gq, const float* __restrict__ ropeC, const float* __restrict__ ropeS) {
  int tid_l = tid_now(); asm volatile("" : "+v"(tid_l));
  const int tid = tid_l, wid = tid >> 6, lane = tid & 63, r32 = lane & 31, hi = lane >> 5;
  ALAS char* V_lds = lds; ALAS char* K_lds = lds + 2 * SHM_V;
  ALAS float* ws = (ALAS float*)(lds + 2 * SHM_V + 2 * SHM_K) + wid * 64; ALAS float* li_l = ws; ALAS float* al_l = ws + 32;
  float m_reg = -1e30f, l_reg = 0; f32x16 o[4] = {}; bf16x8 qr[8];
  const bf16_t* Qw = Q + (long)(wid * QBLK + r32) * ldq + hi * 8;
#pragma unroll
  for (int d0 = 0; d0 < 8; ++d0) qr[d0] = *reinterpret_cast<const bf16x8*>(Qw + d0 * 16);
  if (qmode) {
    float qf[8][8];
#pragma unroll
    for (int d0 = 0; d0 < 8; ++d0)
#pragma unroll
      for (int j = 0; j < 8; ++j) qf[d0][j] = __uint_as_float(((unsigned)(unsigned short)qr[d0][j]) << 16);
    if (qmode & 1) { float ss = 0.f;
#pragma unroll
      for (int d0 = 0; d0 < 8; ++d0)
#pragma unroll
        for (int j = 0; j < 8; ++j) ss += qf[d0][j] * qf[d0][j];
      ss += __shfl_xor(ss, 32);
      const float rstd = 1.0f / sqrtf(ss * (1.0f / 128.0f) + 1e-6f);
#pragma unroll
      for (int d0 = 0; d0 < 8; ++d0) { const float* gp = gq + d0 * 16 + hi * 8; const float4 g0 = *reinterpret_cast<const float4*>(gp), g1 = *reinterpret_cast<const float4*>(gp + 4);
        qf[d0][0] *= rstd * g0.x; qf[d0][1] *= rstd * g0.y; qf[d0][2] *= rstd * g0.z; qf[d0][3] *= rstd * g0.w; qf[d0][4] *= rstd * g1.x; qf[d0][5] *= rstd * g1.y; qf[d0][6] *= rstd * g1.z; qf[d0][7] *= rstd * g1.w; } }
    if (qmode & 2) { const int t = qpos0 + wid * QBLK + r32;
#pragma unroll
      for (int hf = 0; hf < 2; ++hf) { const int p = hf ? (t & 63) : (t >> 6);
#pragma unroll
        for (int dd = 0; dd < 2; ++dd) { const int d0 = hf * 4 + dd, i0 = dd * 16 + hi * 8;
          const float4 c0 = *reinterpret_cast<const float4*>(ropeC + p * 32 + i0), c1 = *reinterpret_cast<const float4*>(ropeC + p * 32 + i0 + 4);
          const float4 s0 = *reinterpret_cast<const float4*>(ropeS + p * 32 + i0), s1 = *reinterpret_cast<const float4*>(ropeS + p * 32 + i0 + 4);
          const float cs[8] = {c0.x, c0.y, c0.z, c0.w, c1.x, c1.y, c1.z, c1.w}, sn[8] = {s0.x, s0.y, s0.z, s0.w, s1.x, s1.y, s1.z, s1.w};
#pragma unroll
          for (int j = 0; j < 8; ++j) { const float x1 = qf[d0][j], x2 = qf[d0 + 2][j]; qf[d0][j] = x1 * cs[j] - x2 * sn[j]; qf[d0 + 2][j] = x1 * sn[j] + x2 * cs[j]; } } } }
#pragma unroll
    for (int d0 = 0; d0 < 8; ++d0) { u32x4 w = {cvtpk(qf[d0][0], qf[d0][1]), cvtpk(qf[d0][2], qf[d0][3]), cvtpk(qf[d0][4], qf[d0][5]), cvtpk(qf[d0][6], qf[d0][7])}; qr[d0] = *reinterpret_cast<bf16x8*>(&w); }
  }
  const int sr = tid >> 4, sc = (tid & 15) * 8, vst0 = v_st(sr, sc), vst1 = v_st(32 + sr, sc);
  const int vb0 = (int)(uintptr_t)V_lds + v_rd_base(lane);
  const long ko0 = (long)sr * ldk + sc, ko1 = ko0 + 32L * ldk;
  const int qi = qpos0 + wid * QBLK + r32;
  struct { bf16x8 vs0, vs1, ks0, ks1; } sr_[2];
#define KROW(t) ((t) * KVBLK + (((t) >= nfirst) ? skip : 0))
#define SLOAD(i, t) do { const long ro_ = (long)KROW(t) * ldk; sr_[i].vs0 = *reinterpret_cast<const bf16x8*>(V + ro_ + ko0); sr_[i].vs1 = *reinterpret_cast<const bf16x8*>(V + ro_ + ko1); \
    sr_[i].ks0 = *reinterpret_cast<const bf16x8*>(K + ro_ + ko0); sr_[i].ks1 = *reinterpret_cast<const bf16x8*>(K + ro_ + ko1); } while (0)
#define SWRITE(b, i) do { *(ALAS bf16x8*)(V_lds + (b) * SHM_V + vst0) = sr_[i].vs0;          \
    *(ALAS bf16x8*)(V_lds + (b) * SHM_V + vst1) = sr_[i].vs1; const int kc_ = sc * 2;               \
    *(ALAS bf16x8*)(K_lds + (b) * SHM_K + KSWZ(sr, kc_)) = sr_[i].ks0;                       \
    *(ALAS bf16x8*)(K_lds + (b) * SHM_K + KSWZ(32 + sr, kc_)) = sr_[i].ks1; } while (0)
#define SWAIT() asm volatile("s_waitcnt vmcnt(4)" ::: "memory")
#define RESC(a) do { if (__any((a) < 1.f)) { if (hi == 0) al_l[r32] = (a); asm volatile("s_waitcnt lgkmcnt(0)" ::: "memory"); \
    _Pragma("unroll") for (int d = 0; d < 4; ++d) _Pragma("unroll") for (int r = 0; r < 16; ++r) o[d][r] *= al_l[crow(r, hi)]; } } while (0)
#define MASK(P0, P1, t) do { if ((t) >= nfirst) band_mask(P0, P1, KROW(t) - 512 - qi, hi); } while (0)
  f32x16 pA0, pA1, pB0, pB1; float mnA, mnB, alA, alB; bf16x8 pa0, pa1, pa2, pa3; const int NT = nt;
  constexpr int SE = 0, SO = 1;
  SLOAD(SE, 0); asm volatile("s_waitcnt vmcnt(0)" ::: "memory"); SWRITE(0, SE); __syncthreads();
  qkt(pA0, pA1, K_lds, qr, r32, hi); MASK(pA0, pA1, 0); partialSM(pA0, pA1, m_reg, mnA, alA);
  SLOAD(SO, 1); if (2 < NT) SLOAD(SE, 2);
  SWAIT(); SWRITE(1, SO); __syncthreads();
  for (int j = 1; j + 1 < NT; j += 2) {
    SBAR(); qkt(pB0, pB1, K_lds + SHM_K, qr, r32, hi);
    finishSM(pA0, pA1, alA, l_reg, pa0, pa1, pa2, pa3); SBAR();
    SLOAD(SO, j + 2); SBAR();
    MASK(pB0, pB1, j); pv_sm(o, vb0, pa0, pa1, pa2, pa3, pB0, pB1, m_reg, mnB, alB);
    __syncthreads(); SWAIT(); SWRITE(0, SE);
    RESC(alB); __syncthreads();
    SBAR(); qkt(pA0, pA1, K_lds, qr, r32, hi);
    finishSM(pB0, pB1, alB, l_reg, pa0, pa1, pa2, pa3); SBAR();
    if (j + 3 < NT) SLOAD(SE, j + 3); SBAR();
    MASK(pA0, pA1, j + 1); pv_sm(o, vb0 + (int)SHM_V, pa0, pa1, pa2, pa3, pA0, pA1, m_reg, mnA, alA);
    __syncthreads(); SWAIT(); SWRITE(1, SO);
    RESC(alA); __syncthreads();
  }
  SBAR(); qkt(pB0, pB1, K_lds + SHM_K, qr, r32, hi);
  finishSM(pA0, pA1, alA, l_reg, pa0, pa1, pa2, pa3); SBAR();
  MASK(pB0, pB1, NT - 1); pv_sm(o, vb0, pa0, pa1, pa2, pa3, pB0, pB1, m_reg, mnB, alB);
  __syncthreads(); RESC(alB);
  finishSM(pB0, pB1, alB, l_reg, pa0, pa1, pa2, pa3); SBAR();
  pv_d0(o, vb0 + (int)SHM_V, pa0, pa1, pa2, pa3);
  l_reg += __builtin_amdgcn_exp2f(sinkl2 - m_reg * (SCALE * 1.4426950408889634f));
  if (hi == 0) li_l[r32] = l_reg; asm volatile("s_waitcnt lgkmcnt(0)" ::: "memory");
  float rli[16];
#pragma unroll
  for (int r = 0; r < 16; ++r) rli[r] = __builtin_amdgcn_rcpf(li_l[crow(r, hi)]);
  bf16_t* Ow = O + (long)(wid * QBLK) * ldo + r32;
#pragma unroll
  for (int r = 0; r < 16; ++r) { const int orow = crow(r, hi);
#pragma unroll
    for (int d0 = 0; d0 < 4; ++d0) { const unsigned w = cvtpk(o[d0][r] * rli[r], 0.f); Ow[(long)orow * ldo + d0 * 32] = (bf16_t)(w & 0xffffu); } }
#undef KROW
#undef SLOAD
#undef SWRITE
#undef SWAIT
#undef RESC
#undef MASK
}

__device__ __forceinline__ void dma16(const void* gsrc, ALAS void* lds_dst_uniform) { __builtin_amdgcn_global_load_lds((const unsigned*)gsrc, (ALAS unsigned*)lds_dst_uniform, 16, 0, 0); }
template <int NVB>
__device__ __forceinline__ void attn_unit_dma(const bf16_t* __restrict__ Q, const bf16_t* __restrict__ K, const bf16_t* __restrict__ V, bf16_t* __restrict__ O,
                                              int ldq, int ldk, int ldo, int nt, int nfirst, int skip, int qpos0, float sinkl2, ALAS char* lds, ALAS float* scr,
                                              int qmode, const float* __restrict__ gq, const float* __restrict__ ropeC, const float* __restrict__ ropeS) {
  constexpr int NVP = NVB / 2;
  int tid_l = tid_now(); asm volatile("" : "+v"(tid_l));
  const int tid = tid_l, wid = __builtin_amdgcn_readfirstlane(tid >> 6), lane = tid & 63, r32 = lane & 31, hi = lane >> 5;
  ALAS char* K_lds = lds; ALAS char* V_lds = lds + 32768; ALAS char* Qs = lds + 65536 + wid * 8192;
  ALAS float* li_l = scr; ALAS float* al_l = scr + 32;
  const int qi = qpos0 + wid * QBLK + r32;
  unsigned koff[2], voff[NVP];
#pragma unroll
  for (int i = 0; i < 2; ++i) { const int L = (wid * 2 + i) * 1024 + lane * 16, row = L >> 8, cb = (L & 255) ^ ((row & 7) << 4); koff[i] = (unsigned)(row * ldk * 2 + cb); }
#pragma unroll
  for (int i = 0; i < NVP; ++i) { const int L = (wid * NVP + i) * 1024 + lane * 16, half = L >> 14, Lh = L & 16383, sub = Lh >> 9, within = Lh & 511;
    const int kk = (sub >> 2) * 8 + (within >> 6), k = (kk & ~0xC) | ((kk & 4) << 1) | ((kk & 8) >> 1), col = half * 128 + (sub & 3) * 32 + ((within & 63) >> 1);
    voff[i] = (unsigned)(k * ldk * 2 + col * 2); }
#define KROW(t) ((t) * KVBLK + (((t) >= nfirst) ? skip : 0))
#define DK_ISSUE(t, slot) do { const char* kb_ = (const char*)K + (size_t)KROW(t) * 2 * ldk; \
    _Pragma("unroll") for (int i = 0; i < 2; ++i) dma16(kb_ + koff[i], K_lds + (slot) * 16384 + (wid * 2 + i) * 1024); } while (0)
#define DV_ISSUE(t) do { const char* vb_ = (const char*)V + (size_t)KROW(t) * 2 * ldk; \
    _Pragma("unroll") for (int i = 0; i < NVP; ++i) dma16(vb_ + voff[i], V_lds + (wid * NVP + i) * 1024); } while (0)
  DK_ISSUE(0, 0); DV_ISSUE(0); DK_ISSUE(1, 1);
  { bf16x8 qr[8];
    const bf16_t* Qw = Q + (long)(wid * QBLK + r32) * ldq + hi * 8;
#pragma unroll
    for (int d0 = 0; d0 < 8; ++d0) qr[d0] = *reinterpret_cast<const bf16x8*>(Qw + d0 * 16);
    if (qmode) {
      float qf[8][8];
#pragma unroll
      for (int d0 = 0; d0 < 8; ++d0)
#pragma unroll
        for (int j = 0; j < 8; ++j) qf[d0][j] = __uint_as_float(((unsigned)(unsigned short)qr[d0][j]) << 16);
      if (qmode & 1) { float ss = 0.f;
#pragma unroll
        for (int d0 = 0; d0 < 8; ++d0)
#pragma unroll
          for (int j = 0; j < 8; ++j) ss += qf[d0][j] * qf[d0][j];
        ss += __shfl_xor(ss, 32);
        const float rstd = 1.0f / sqrtf(ss * (1.0f / 128.0f) + 1e-6f);
#pragma unroll
        for (int d0 = 0; d0 < 8; ++d0) { const float* gp = gq + d0 * 16 + hi * 8; const float4 g0 = *reinterpret_cast<const float4*>(gp), g1 = *reinterpret_cast<const float4*>(gp + 4);
          qf[d0][0] *= rstd * g0.x; qf[d0][1] *= rstd * g0.y; qf[d0][2] *= rstd * g0.z; qf[d0][3] *= rstd * g0.w; qf[d0][4] *= rstd * g1.x; qf[d0][5] *= rstd * g1.y; qf[d0][6] *= rstd * g1.z; qf[d0][7] *= rstd * g1.w; } }
      if (qmode & 2) { const int t = qi;
#pragma unroll
        for (int hf = 0; hf < 2; ++hf) { const int p = hf ? (t & 63) : (t >> 6);
#pragma unroll
          for (int dd = 0; dd < 2; ++dd) { const int d0 = hf * 4 + dd, i0 = dd * 16 + hi * 8;
            const float4 c0 = *reinterpret_cast<const float4*>(ropeC + p * 32 + i0), c1 = *reinterpret_cast<const float4*>(ropeC + p * 32 + i0 + 4);
            const float4 s0 = *reinterpret_cast<const float4*>(ropeS + p * 32 + i0), s1 = *reinterpret_cast<const float4*>(ropeS + p * 32 + i0 + 4);
            const float cs[8] = {c0.x, c0.y, c0.z, c0.w, c1.x, c1.y, c1.z, c1.w}, sn[8] = {s0.x, s0.y, s0.z, s0.w, s1.x, s1.y, s1.z, s1.w};
#pragma unroll
            for (int j = 0; j < 8; ++j) { const float x1 = qf[d0][j], x2 = qf[d0 + 2][j]; qf[d0][j] = x1 * cs[j] - x2 * sn[j]; qf[d0 + 2][j] = x1 * sn[j] + x2 * cs[j]; } } } }
#pragma unroll
      for (int d0 = 0; d0 < 8; ++d0) { u32x4 w = {cvtpk(qf[d0][0], qf[d0][1]), cvtpk(qf[d0][2], qf[d0][3]), cvtpk(qf[d0][4], qf[d0][5]), cvtpk(qf[d0][6], qf[d0][7])}; qr[d0] = *reinterpret_cast<bf16x8*>(&w); }
    }
#pragma unroll
    for (int d0 = 0; d0 < 8; ++d0) *(ALAS bf16x8*)(Qs + (d0 * 64 + lane) * 16) = qr[d0];
  }
  float m_reg = -1e30f, l_reg = 0.f; f32x16 o[NVB] = {};
  const int vb0 = (int)(uintptr_t)V_lds + v_rd_base(lane);
  if (NVP == 4) asm volatile("s_waitcnt vmcnt(6)" ::: "memory"); else asm volatile("s_waitcnt vmcnt(4)" ::: "memory");
  asm volatile("s_waitcnt lgkmcnt(0)" ::: "memory"); __builtin_amdgcn_s_barrier();
  for (int j = 0; j < nt; ++j) {
    f32x16 p0 = f32x16{}, p1 = f32x16{}; float mn, alpha; bf16x8 pa0, pa1, pa2, pa3;
    { const ALAS char* Ks = K_lds + (j & 1) * 16384;
#pragma unroll
      for (int d0 = 0; d0 < 8; ++d0) { const int cb = (d0 * 16 + hi * 8) * 2;
        const bf16x8 qd = *(const ALAS bf16x8*)(Qs + (d0 * 64 + lane) * 16);
        const bf16x8 b0 = *reinterpret_cast<const ALAS bf16x8*>(Ks + KSWZ(r32, cb));
        const bf16x8 b1 = *reinterpret_cast<const ALAS bf16x8*>(Ks + KSWZ(32 + r32, cb));
        p0 = __builtin_amdgcn_mfma_f32_32x32x16_bf16(b0, qd, p0, 0, 0, 0);
        p1 = __builtin_amdgcn_mfma_f32_32x32x16_bf16(b1, qd, p1, 0, 0, 0); } }
    if (j >= nfirst) band_mask(p0, p1, KROW(j) - 512 - qi, hi);
    partialSM(p0, p1, m_reg, mn, alpha);
    if (__any(alpha < 1.f)) { if (hi == 0) al_l[r32] = alpha; asm volatile("s_waitcnt lgkmcnt(0)" ::: "memory");
#pragma unroll
      for (int d = 0; d < NVB; ++d)
#pragma unroll
        for (int r = 0; r < 16; ++r) o[d][r] *= al_l[crow(r, hi)]; }
    finishSM(p0, p1, alpha, l_reg, pa0, pa1, pa2, pa3);
    asm volatile("s_waitcnt vmcnt(0) lgkmcnt(0)" ::: "memory"); __builtin_amdgcn_s_barrier();
    pv_one<0>(o[0], vb0, pa0, pa1, pa2, pa3); pv_one<1>(o[1], vb0, pa0, pa1, pa2, pa3); pv_one<2>(o[2], vb0, pa0, pa1, pa2, pa3); pv_one<3>(o[3], vb0, pa0, pa1, pa2, pa3);
    if constexpr (NVB == 8) { pv_one<0>(o[4], vb0 + 16384, pa0, pa1, pa2, pa3); pv_one<1>(o[5], vb0 + 16384, pa0, pa1, pa2, pa3); pv_one<2>(o[6], vb0 + 16384, pa0, pa1, pa2, pa3); pv_one<3>(o[7], vb0 + 16384, pa0, pa1, pa2, pa3); }
    asm volatile("s_waitcnt lgkmcnt(0)" ::: "memory"); __builtin_amdgcn_s_barrier();
    if (j + 1 < nt) DV_ISSUE(j + 1);
    if (j + 2 < nt) DK_ISSUE(j + 2, j & 1);
  }
#undef DK_ISSUE
#undef DV_ISSUE
#undef KROW
  l_reg += __builtin_amdgcn_exp2f(sinkl2 - m_reg * (SCALE * 1.4426950408889634f));
  if (hi == 0) li_l[r32] = l_reg; asm volatile("s_waitcnt lgkmcnt(0)" ::: "memory");
  float rli[16];
#pragma unroll
  for (int r = 0; r < 16; ++r) rli[r] = __builtin_amdgcn_rcpf(li_l[crow(r, hi)]);
  { constexpr int RB = NVB * 64, NPASS = RB / 256, RPP = 32 / NPASS, PPR = RB / 16;
    ALAS char* og = Qs; bf16_t* Og = O + (long)(wid * QBLK) * ldo;
#pragma unroll
    for (int ps = 0; ps < NPASS; ++ps) {
#pragma unroll
      for (int r = 0; r < 16; ++r) { const int row = crow(r, hi); if (row / RPP != ps) continue; const int lrow = row - RPP * ps;
#pragma unroll
        for (int d = 0; d < NVB; ++d) { const unsigned w = cvtpk(o[d][r] * rli[r], 0.f); *(ALAS unsigned short*)(og + lrow * RB + (d * 32 + r32) * 2) = (unsigned short)(w & 0xffffu); } }
#pragma unroll
      for (int k = 0; k < 8; ++k) { const int p = lane + 64 * k; const u32x4 v = *(const ALAS u32x4*)(og + p * 16);
        *reinterpret_cast<u32x4*>(Og + (long)(RPP * ps + p / PPR) * ldo + (p % PPR) * 8) = v; }
    } }
}

#define PP_WAIT2(N, A, B) asm volatile("s_waitcnt lgkmcnt(" #N ")" : "+v"(A), "+v"(B) :: "memory")
__device__ __forceinline__ void qk_seg(f32x16& p0, f32x16& p1, const ALAS char* Ks, const bf16x8* qr, const f32x16& negm, int r32, int hi) {
  int sw = ((r32 & 7) << 4) ^ (hi * 16); asm volatile("" : "+v"(sw));
  const int r0 = (int)(uintptr_t)Ks + r32 * 256;
#define KRD(DST0, DST1, d0) do { const int ad_ = r0 + (((d0) * 32) ^ sw); asm volatile("ds_read_b128 %0, %2\n\tds_read_b128 %1, %2 offset:8192" : "=&v"(DST0), "=&v"(DST1) : "v"(ad_) : "memory"); } while (0)
  bf16x8 a[3], b[3];
  KRD(a[0], b[0], 0); KRD(a[1], b[1], 1); KRD(a[2], b[2], 2);
  SBAR(); __builtin_amdgcn_s_setprio(1);
#pragma unroll
  for (int d0 = 0; d0 < 8; ++d0) {
    if (d0 < 6) PP_WAIT2(4, a[d0 % 3], b[d0 % 3]); else if (d0 == 6) PP_WAIT2(2, a[d0 % 3], b[d0 % 3]); else PP_WAIT2(0, a[d0 % 3], b[d0 % 3]);
    p0 = __builtin_amdgcn_mfma_f32_32x32x16_bf16(a[d0 % 3], qr[d0], d0 == 0 ? negm : p0, 0, 0, 0);
    p1 = __builtin_amdgcn_mfma_f32_32x32x16_bf16(b[d0 % 3], qr[d0], d0 == 0 ? negm : p1, 0, 0, 0);
    SBAR();
    if (d0 + 3 < 8) { KRD(a[d0 % 3], b[d0 % 3], d0 + 3); SBAR(); }
  }
  __builtin_amdgcn_s_setprio(0);
#undef KRD
}
__device__ __forceinline__ void pv_seg(f32x16* o, const ALAS char* vbp, bf16x8 pa0, bf16x8 pa1, bf16x8 pa2, bf16x8 pa3) {
  const int vb = (int)(uintptr_t)vbp;
#define PK(L, H) (bf16x8){L[0], L[1], L[2], L[3], H[0], H[1], H[2], H[3]}
  s16x4 lo[4], hh[4];
  lo[0] = tr_read<v_rd_off(0, 0, 0)>(vb); hh[0] = tr_read<v_rd_off(0, 0, 1)>(vb); lo[1] = tr_read<v_rd_off(0, 1, 0)>(vb); hh[1] = tr_read<v_rd_off(0, 1, 1)>(vb);
  lo[2] = tr_read<v_rd_off(0, 2, 0)>(vb); hh[2] = tr_read<v_rd_off(0, 2, 1)>(vb); lo[3] = tr_read<v_rd_off(0, 3, 0)>(vb); hh[3] = tr_read<v_rd_off(0, 3, 1)>(vb);
  SBAR(); __builtin_amdgcn_s_setprio(1);
#define PVSTEP(d, ks, PA, WN, NEXT) do { PP_WAIT2(WN, lo[ks], hh[ks]); o[d] = __builtin_amdgcn_mfma_f32_32x32x16_bf16(PA, PK(lo[ks], hh[ks]), o[d], 0, 0, 0); SBAR(); \
    if (NEXT) { lo[ks] = tr_read<v_rd_off(((d) + 1) & 3, ks, 0)>(vb); hh[ks] = tr_read<v_rd_off(((d) + 1) & 3, ks, 1)>(vb); SBAR(); } } while (0)
  PVSTEP(0, 0, pa0, 6, 1); PVSTEP(0, 1, pa1, 6, 1); PVSTEP(0, 2, pa2, 6, 1); PVSTEP(0, 3, pa3, 6, 1);
  PVSTEP(1, 0, pa0, 6, 1); PVSTEP(1, 1, pa1, 6, 1); PVSTEP(1, 2, pa2, 6, 1); PVSTEP(1, 3, pa3, 6, 1);
  PVSTEP(2, 0, pa0, 6, 1); PVSTEP(2, 1, pa1, 6, 1); PVSTEP(2, 2, pa2, 6, 1); PVSTEP(2, 3, pa3, 6, 1);
  PVSTEP(3, 0, pa0, 6, 0); PVSTEP(3, 1, pa1, 4, 0); PVSTEP(3, 2, pa2, 2, 0); PVSTEP(3, 3, pa3, 0, 0);
  { const bf16x8 ones = {0x3F80, 0x3F80, 0x3F80, 0x3F80, 0x3F80, 0x3F80, 0x3F80, 0x3F80};
    o[4] = __builtin_amdgcn_mfma_f32_32x32x16_bf16(pa0, ones, o[4], 0, 0, 0); o[4] = __builtin_amdgcn_mfma_f32_32x32x16_bf16(pa1, ones, o[4], 0, 0, 0);
    o[4] = __builtin_amdgcn_mfma_f32_32x32x16_bf16(pa2, ones, o[4], 0, 0, 0); o[4] = __builtin_amdgcn_mfma_f32_32x32x16_bf16(pa3, ones, o[4], 0, 0, 0); SBAR(); }
  __builtin_amdgcn_s_setprio(0);
#undef PVSTEP
#undef PK
}
constexpr float THRL2 = THR * 1.4426950408889634f;
__device__ __forceinline__ void psm_n(f32x16& p0, f32x16& p1, float& m_reg, float& alpha, f32x16& negm, bool first) {
  float pmax = fmaxf(p0[0], p1[0]);
#pragma unroll
  for (int r = 1; r < 16; ++r) pmax = fmaxf(pmax, fmaxf(p0[r], p1[r]));
  { auto rr = __builtin_amdgcn_permlane32_swap(__float_as_uint(pmax), __float_as_uint(pmax), false, false); pmax = fmaxf(__uint_as_float(rr[0]), __uint_as_float(rr[1])); }
  alpha = 1.f;
  if (first || !__all(pmax <= THRL2)) { const float delta = first ? pmax : fmaxf(pmax, 0.f); if (!first) alpha = __builtin_amdgcn_exp2f(-delta); m_reg += delta;
#pragma unroll
    for (int r = 0; r < 16; ++r) { p0[r] -= delta; p1[r] -= delta; negm[r] = -m_reg; } }
#pragma unroll
  for (int r = 0; r < 16; ++r) p0[r] = __builtin_amdgcn_exp2f(p0[r]);
}
__device__ __forceinline__ void fsm_n(f32x16& p0, f32x16& p1, bf16x8& pa0, bf16x8& pa1, bf16x8& pa2, bf16x8& pa3) {
#pragma unroll
  for (int r = 0; r < 16; ++r) p1[r] = __builtin_amdgcn_exp2f(p1[r]);
#define PK4(P, BASE, OUT) do { unsigned a0 = cvtpk(P[BASE + 0], P[BASE + 1]), a1 = cvtpk(P[BASE + 2], P[BASE + 3]);   \
    unsigned b0 = cvtpk(P[BASE + 4], P[BASE + 5]), b1 = cvtpk(P[BASE + 6], P[BASE + 7]);                              \
    auto r0 = __builtin_amdgcn_permlane32_swap(a0, b0, false, false); auto r1 = __builtin_amdgcn_permlane32_swap(a1, b1, false, false); \
    u32x4 w = {r0[0], r1[0], r0[1], r1[1]}; OUT = *reinterpret_cast<bf16x8*>(&w); } while (0)
  PK4(p0, 0, pa0); PK4(p0, 8, pa1); PK4(p1, 0, pa2); PK4(p1, 8, pa3);
#undef PK4
}
__device__ __forceinline__ void attn_unit_dma2(const bf16_t* __restrict__ Q, const bf16_t* __restrict__ K, const bf16_t* __restrict__ V, bf16_t* __restrict__ O,
                                               int ldq, int ldk, int ldo, int nt, int nfirst, int skip, int qpos0, float sinkl2, ALAS char* lds, ALAS float* scr,
                                               int qmode, const float* __restrict__ gq, const float* __restrict__ ropeC, const float* __restrict__ ropeS) {
  int tid_l = tid_now(); asm volatile("" : "+v"(tid_l));
  const int tid = tid_l, wid = __builtin_amdgcn_readfirstlane(tid >> 6), lane = tid & 63, r32 = lane & 31, hi = lane >> 5;
  ALAS char* K_lds = lds; ALAS char* V_lds = lds + 32768;
  ALAS float* li_l = scr; ALAS float* al_l = scr + 32;
  const int qi = qpos0 + wid * QBLK + r32;
  unsigned koff[2], voff[2];
#pragma unroll
  for (int i = 0; i < 2; ++i) { const int L = (wid * 2 + i) * 1024 + lane * 16, row = L >> 8, cb = (L & 255) ^ ((row & 7) << 4); koff[i] = (unsigned)(row * ldk * 2 + cb); }
#pragma unroll
  for (int i = 0; i < 2; ++i) { const int L = (wid * 2 + i) * 1024 + lane * 16, sub = L >> 9, within = L & 511;
    const int kk = (sub >> 2) * 8 + (within >> 6), k = (kk & ~0xC) | ((kk & 4) << 1) | ((kk & 8) >> 1), col = (sub & 3) * 32 + ((within & 63) >> 1);
    voff[i] = (unsigned)(k * ldk * 2 + col * 2); }
#define KROW(t) ((t) * KVBLK + (((t) >= nfirst) ? skip : 0))
#define DK_ISSUE(t, slot) do { const char* kb_ = (const char*)K + (size_t)KROW(t) * 2 * ldk; \
    _Pragma("unroll") for (int i = 0; i < 2; ++i) dma16(kb_ + koff[i], K_lds + (slot) * 16384 + (wid * 2 + i) * 1024); } while (0)
#define DV_ISSUE(t, slot) do { const char* vb_ = (const char*)V + (size_t)KROW(t) * 2 * ldk; \
    _Pragma("unroll") for (int i = 0; i < 2; ++i) dma16(vb_ + voff[i], V_lds + (slot) * 16384 + (wid * 2 + i) * 1024); } while (0)
#define RESC(a) do { if (__any((a) < 1.f)) { if (hi == 0) al_l[r32] = (a); asm volatile("s_waitcnt lgkmcnt(0)" ::: "memory"); \
    _Pragma("unroll") for (int d = 0; d < 4; ++d) _Pragma("unroll") for (int r = 0; r < 16; ++r) o[d][r] *= al_l[crow(r, hi)]; } } while (0)
#define MASK(P0, P1, t) do { if ((t) >= nfirst) band_mask(P0, P1, KROW(t) - 512 - qi, hi); } while (0)
#define STEP_SYNC() do { asm volatile("s_waitcnt vmcnt(0) lgkmcnt(0)" ::: "memory"); __builtin_amdgcn_s_barrier(); } while (0)
  DK_ISSUE(0, 0); DV_ISSUE(0, 0); DK_ISSUE(1, 1);
  bf16x8 qr[8];
  { const bf16_t* Qw = Q + (long)(wid * QBLK + r32) * ldq + hi * 8;
#pragma unroll
    for (int d0 = 0; d0 < 8; ++d0) qr[d0] = *reinterpret_cast<const bf16x8*>(Qw + d0 * 16);
    if (qmode) {
      float qf[8][8];
#pragma unroll
      for (int d0 = 0; d0 < 8; ++d0)
#pragma unroll
        for (int j = 0; j < 8; ++j) qf[d0][j] = __uint_as_float(((unsigned)(unsigned short)qr[d0][j]) << 16);
      if (qmode & 1) { float ss = 0.f;
#pragma unroll
        for (int d0 = 0; d0 < 8; ++d0)
#pragma unroll
          for (int j = 0; j < 8; ++j) ss += qf[d0][j] * qf[d0][j];
        ss += __shfl_xor(ss, 32);
        const float rstd = 1.0f / sqrtf(ss * (1.0f / 128.0f) + 1e-6f);
#pragma unroll
        for (int d0 = 0; d0 < 8; ++d0) { const float* gp = gq + d0 * 16 + hi * 8; const float4 g0 = *reinterpret_cast<const float4*>(gp), g1 = *reinterpret_cast<const float4*>(gp + 4);
          qf[d0][0] *= rstd * g0.x; qf[d0][1] *= rstd * g0.y; qf[d0][2] *= rstd * g0.z; qf[d0][3] *= rstd * g0.w; qf[d0][4] *= rstd * g1.x; qf[d0][5] *= rstd * g1.y; qf[d0][6] *= rstd * g1.z; qf[d0][7] *= rstd * g1.w; } }
      if (qmode & 2) { const int t = qi;
#pragma unroll
        for (int hf = 0; hf < 2; ++hf) { const int p = hf ? (t & 63) : (t >> 6);
#pragma unroll
          for (int dd = 0; dd < 2; ++dd) { const int d0 = hf * 4 + dd, i0 = dd * 16 + hi * 8;
            const float4 c0 = *reinterpret_cast<const float4*>(ropeC + p * 32 + i0), c1 = *reinterpret_cast<const float4*>(ropeC + p * 32 + i0 + 4);
            const float4 s0 = *reinterpret_cast<const float4*>(ropeS + p * 32 + i0), s1 = *reinterpret_cast<const float4*>(ropeS + p * 32 + i0 + 4);
            const float cs[8] = {c0.x, c0.y, c0.z, c0.w, c1.x, c1.y, c1.z, c1.w}, sn[8] = {s0.x, s0.y, s0.z, s0.w, s1.x, s1.y, s1.z, s1.w};
#pragma unroll
            for (int j = 0; j < 8; ++j) { const float x1 = qf[d0][j], x2 = qf[d0 + 2][j]; qf[d0][j] = x1 * cs[j] - x2 * sn[j]; qf[d0 + 2][j] = x1 * sn[j] + x2 * cs[j]; } } } }
#pragma unroll
      for (int d0 = 0; d0 < 8; ++d0) { u32x4 w = {cvtpk(qf[d0][0], qf[d0][1]), cvtpk(qf[d0][2], qf[d0][3]), cvtpk(qf[d0][4], qf[d0][5]), cvtpk(qf[d0][6], qf[d0][7])}; qr[d0] = *reinterpret_cast<bf16x8*>(&w); }
    } }
  float m_reg = -1e30f, l_reg = 0.f; f32x16 o[4] = {};
  const int vb0 = (int)(uintptr_t)V_lds + v_rd_base(lane);
  f32x16 pA0, pA1, pB0, pB1; float mnA, mnB, alA, alB; bf16x8 pa0, pa1, pa2, pa3;
  STEP_SYNC();
  qkt(pA0, pA1, K_lds, qr, r32, hi); MASK(pA0, pA1, 0); partialSM(pA0, pA1, m_reg, mnA, alA);
  STEP_SYNC();
  int j = 0;
  for (; j + 2 < nt; j += 2) {
    DK_ISSUE(j + 2, 0); DV_ISSUE(j + 1, 1);
    SBAR(); qkt(pB0, pB1, K_lds + 16384, qr, r32, hi);
    finishSM(pA0, pA1, alA, l_reg, pa0, pa1, pa2, pa3); SBAR();
    MASK(pB0, pB1, j + 1); pv_sm(o, vb0, pa0, pa1, pa2, pa3, pB0, pB1, m_reg, mnB, alB);
    STEP_SYNC();
    RESC(alB);
    if (j + 3 < nt) DK_ISSUE(j + 3, 1);
    DV_ISSUE(j + 2, 0);
    SBAR(); qkt(pA0, pA1, K_lds, qr, r32, hi);
    finishSM(pB0, pB1, alB, l_reg, pa0, pa1, pa2, pa3); SBAR();
    MASK(pA0, pA1, j + 2); pv_sm(o, vb0 + 16384, pa0, pa1, pa2, pa3, pA0, pA1, m_reg, mnA, alA);
    STEP_SYNC();
    RESC(alA);
  }
  DV_ISSUE(j + 1, 1);
  SBAR(); qkt(pB0, pB1, K_lds + 16384, qr, r32, hi);
  finishSM(pA0, pA1, alA, l_reg, pa0, pa1, pa2, pa3); SBAR();
  MASK(pB0, pB1, j + 1); pv_sm(o, vb0, pa0, pa1, pa2, pa3, pB0, pB1, m_reg, mnB, alB);
  STEP_SYNC();
  RESC(alB);
  finishSM(pB0, pB1, alB, l_reg, pa0, pa1, pa2, pa3); SBAR();
  pv_d0(o, vb0 + 16384, pa0, pa1, pa2, pa3);
  STEP_SYNC();
#undef DK_ISSUE
#undef DV_ISSUE
#undef KROW
#undef RESC
#undef MASK
#undef STEP_SYNC
  l_reg += __builtin_amdgcn_exp2f(sinkl2 - m_reg * (SCALE * 1.4426950408889634f));
  if (hi == 0) li_l[r32] = l_reg; asm volatile("s_waitcnt lgkmcnt(0)" ::: "memory");
  float rli[16];
#pragma unroll
  for (int r = 0; r < 16; ++r) rli[r] = __builtin_amdgcn_rcpf(li_l[crow(r, hi)]);
  { ALAS char* og = lds + wid * 8192; bf16_t* Og = O + (long)(wid * QBLK) * ldo;
#pragma unroll
    for (int r = 0; r < 16; ++r) { const int row = crow(r, hi);
#pragma unroll
      for (int d = 0; d < 4; ++d) { const unsigned w = cvtpk(o[d][r] * rli[r], 0.f); *(ALAS unsigned short*)(og + row * 256 + (d * 32 + r32) * 2) = (unsigned short)(w & 0xffffu); } }
#pragma unroll
    for (int k = 0; k < 8; ++k) { const int p = lane + 64 * k; const u32x4 v = *(const ALAS u32x4*)(og + p * 16);
      *reinterpret_cast<u32x4*>(Og + (long)(p >> 4) * ldo + (p & 15) * 8) = v; }
  }
}

__device__ __forceinline__ void attn_unit_pp(const bf16_t* __restrict__ Q, const bf16_t* __restrict__ K, const bf16_t* __restrict__ V, bf16_t* __restrict__ O,
                                               int ldq, int ldk, int ldo, int nt, int nfirst, int skip, int qpos0, float sinkl2, ALAS char* lds, ALAS float* scr,
                                               int qmode, const float* __restrict__ gq, const float* __restrict__ ropeC, const float* __restrict__ ropeS) {
  int tid_l = tid_now(); asm volatile("" : "+v"(tid_l));
  const int tid = tid_l, wid = __builtin_amdgcn_readfirstlane(tid >> 6), lane = tid & 63, r32 = lane & 31, hi = lane >> 5;
  ALAS char* K_lds = lds; ALAS char* V_lds = lds + 32768;
  ALAS float* li_l = scr; ALAS float* al_l = scr + 32;
  const int qi = qpos0 + wid * QBLK + r32;
  unsigned koff[2], voff[2];
#pragma unroll
  for (int i = 0; i < 2; ++i) { const int L = (wid * 2 + i) * 1024 + lane * 16, row = L >> 8, cb = (L & 255) ^ ((row & 7) << 4); koff[i] = (unsigned)(row * ldk * 2 + cb); }
#pragma unroll
  for (int i = 0; i < 2; ++i) { const int L = (wid * 2 + i) * 1024 + lane * 16, sub = L >> 9, within = L & 511;
    const int kk = (sub >> 2) * 8 + (within >> 6), k = (kk & ~0xC) | ((kk & 4) << 1) | ((kk & 8) >> 1), col = (sub & 3) * 32 + ((within & 63) >> 1);
    voff[i] = (unsigned)(k * ldk * 2 + col * 2); }
#define KROW(t) ((t) * KVBLK + (((t) >= nfirst) ? skip : 0))
#define DK_ISSUE(t, slot) do { const char* kb_ = (const char*)K + (size_t)KROW(t) * 2 * ldk; \
    _Pragma("unroll") for (int i = 0; i < 2; ++i) dma16(kb_ + koff[i], K_lds + (slot) * 16384 + (wid * 2 + i) * 1024); } while (0)
#define DV_ISSUE(t, slot) do { const char* vb_ = (const char*)V + (size_t)KROW(t) * 2 * ldk; \
    _Pragma("unroll") for (int i = 0; i < 2; ++i) dma16(vb_ + voff[i], V_lds + (slot) * 16384 + (wid * 2 + i) * 1024); } while (0)
#define RESC(a) do { if (__any((a) < 1.f)) { if (hi == 0) al_l[r32] = (a); asm volatile("s_waitcnt lgkmcnt(0)" ::: "memory"); \
    _Pragma("unroll") for (int d = 0; d < 5; ++d) _Pragma("unroll") for (int r = 0; r < 16; ++r) o[d][r] *= al_l[crow(r, hi)]; } } while (0)
#define MASK(P0, P1, t) do { if ((t) >= nfirst) band_mask(P0, P1, KROW(t) - 512 - qi, hi); } while (0)
#define STEP_SYNC() do { asm volatile("s_waitcnt vmcnt(0) lgkmcnt(0)" ::: "memory"); __builtin_amdgcn_s_barrier(); } while (0)
  DK_ISSUE(0, 0);
  bf16x8 qr[8];
  { const bf16_t* Qw = Q + (long)(wid * QBLK + r32) * ldq + hi * 8;
#pragma unroll
    for (int d0 = 0; d0 < 8; ++d0) qr[d0] = *reinterpret_cast<const bf16x8*>(Qw + d0 * 16);
    {
      constexpr float CQ = SCALE * 1.4426950408889634f;
      float qf[8][8];
#pragma unroll
      for (int d0 = 0; d0 < 8; ++d0)
#pragma unroll
        for (int j = 0; j < 8; ++j) qf[d0][j] = __uint_as_float(((unsigned)(unsigned short)qr[d0][j]) << 16);
      if (qmode & 1) { float ss = 0.f;
#pragma unroll
        for (int d0 = 0; d0 < 8; ++d0)
#pragma unroll
          for (int j = 0; j < 8; ++j) ss += qf[d0][j] * qf[d0][j];
        ss += __shfl_xor(ss, 32);
        const float rstd = 1.0f / sqrtf(ss * (1.0f / 128.0f) + 1e-6f);
#pragma unroll
        for (int d0 = 0; d0 < 8; ++d0) { const float* gp = gq + d0 * 16 + hi * 8; const float4 g0 = *reinterpret_cast<const float4*>(gp), g1 = *reinterpret_cast<const float4*>(gp + 4);
          qf[d0][0] *= rstd * g0.x; qf[d0][1] *= rstd * g0.y; qf[d0][2] *= rstd * g0.z; qf[d0][3] *= rstd * g0.w; qf[d0][4] *= rstd * g1.x; qf[d0][5] *= rstd * g1.y; qf[d0][6] *= rstd * g1.z; qf[d0][7] *= rstd * g1.w; } }
      if (qmode & 2) { const int t = qi;
#pragma unroll
        for (int hf = 0; hf < 2; ++hf) { const int p = hf ? (t & 63) : (t >> 6);
#pragma unroll
          for (int dd = 0; dd < 2; ++dd) { const int d0 = hf * 4 + dd, i0 = dd * 16 + hi * 8;
            const float4 c0 = *reinterpret_cast<const float4*>(ropeC + p * 32 + i0), c1 = *reinterpret_cast<const float4*>(ropeC + p * 32 + i0 + 4);
            const float4 s0 = *reinterpret_cast<const float4*>(ropeS + p * 32 + i0), s1 = *reinterpret_cast<const float4*>(ropeS + p * 32 + i0 + 4);
            const float cs[8] = {c0.x, c0.y, c0.z, c0.w, c1.x, c1.y, c1.z, c1.w}, sn[8] = {s0.x, s0.y, s0.z, s0.w, s1.x, s1.y, s1.z, s1.w};
#pragma unroll
            for (int j = 0; j < 8; ++j) { const float x1 = qf[d0][j], x2 = qf[d0 + 2][j]; qf[d0][j] = x1 * cs[j] - x2 * sn[j]; qf[d0 + 2][j] = x1 * sn[j] + x2 * cs[j]; } } } }
#pragma unroll
      for (int d0 = 0; d0 < 8; ++d0) { u32x4 w = {cvtpk(qf[d0][0] * CQ, qf[d0][1] * CQ), cvtpk(qf[d0][2] * CQ, qf[d0][3] * CQ), cvtpk(qf[d0][4] * CQ, qf[d0][5] * CQ), cvtpk(qf[d0][6] * CQ, qf[d0][7] * CQ)}; qr[d0] = *reinterpret_cast<bf16x8*>(&w); }
    } }
  float m_reg = 0.f; f32x16 o[5] = {}; f32x16 negm = {};
  const ALAS char* vbp = V_lds + v_rd_base(lane);
  f32x16 p0 = {}, p1 = {}; float al = 1.f; bf16x8 pa0 = {}, pa1 = {}, pa2 = {}, pa3 = {};
  const int grp = wid >> 2;
#define SEG_END() do { SBAR(); __builtin_amdgcn_s_barrier(); SBAR(); } while (0)
#define PSEG(t) do { MASK(p0, p1, t); psm_n(p0, p1, m_reg, al, negm, (t) == 0); RESC(al); } while (0)
  STEP_SYNC();
#define SEG_END_V() do { SBAR(); asm volatile("s_waitcnt vmcnt(0)" ::: "memory"); __builtin_amdgcn_s_barrier(); SBAR(); } while (0)
  if (grp == 0) {
    for (int j = 0; j < nt; ++j) {
      const int sc = (j & 1) * 16384, sn = 16384 - sc;
      if (j + 1 < nt) DK_ISSUE(j + 1, (j + 1) & 1);
      DV_ISSUE(j, j & 1);
      if (j > 0) { pv_seg(o, vbp + sn, pa0, pa1, pa2, pa3); SBAR(); }
      qk_seg(p0, p1, K_lds + sc, qr, negm, r32, hi);
      SEG_END();
      PSEG(j);
      fsm_n(p0, p1, pa0, pa1, pa2, pa3);
      SEG_END_V();
    }
    pv_seg(o, vbp + ((nt - 1) & 1) * 16384, pa0, pa1, pa2, pa3);
    SEG_END();
  } else {
    DK_ISSUE(1, 1);
    DV_ISSUE(0, 0);
    SEG_END();
    for (int j = 0; j < nt; ++j) {
      const int sc = (j & 1) * 16384, sn = 16384 - sc;
      if (j > 0) { pv_seg(o, vbp + sn, pa0, pa1, pa2, pa3); SBAR(); }
      qk_seg(p0, p1, K_lds + sc, qr, negm, r32, hi);
      SEG_END_V();
      if (j + 2 < nt) DK_ISSUE(j + 2, j & 1);
      if (j + 1 < nt) DV_ISSUE(j + 1, (j + 1) & 1);
      PSEG(j);
      fsm_n(p0, p1, pa0, pa1, pa2, pa3);
      SEG_END();
    }
    pv_seg(o, vbp + ((nt - 1) & 1) * 16384, pa0, pa1, pa2, pa3);
  }
  STEP_SYNC();
#undef SEG_END_V
#undef PSEG
#undef SEG_END
#undef DK_ISSUE
#undef DV_ISSUE
#undef KROW
#undef RESC
#undef MASK
#undef STEP_SYNC
  if (hi == 0) li_l[r32] = m_reg; asm volatile("s_waitcnt lgkmcnt(0)" ::: "memory");
  float rli[16];
#pragma unroll
  for (int r = 0; r < 16; ++r) rli[r] = __builtin_amdgcn_rcpf(o[4][r] + __builtin_amdgcn_exp2f(sinkl2 - li_l[crow(r, hi)]));
  { ALAS char* og = lds + wid * 8192; bf16_t* Og = O + (long)(wid * QBLK) * ldo;
#pragma unroll
    for (int r = 0; r < 16; ++r) { const int row = crow(r, hi);
#pragma unroll
      for (int d = 0; d < 4; ++d) { const unsigned w = cvtpk(o[d][r] * rli[r], 0.f); *(ALAS unsigned short*)(og + row * 256 + (d * 32 + r32) * 2) = (unsigned short)(w & 0xffffu); } }
#pragma unroll
    for (int k = 0; k < 8; ++k) { const int p = lane + 64 * k; const u32x4 v = *(const ALAS u32x4*)(og + p * 16);
      *reinterpret_cast<u32x4*>(Og + (long)(p >> 4) * ldo + (p & 15) * 8) = v; }
  }
}

#define G_CVT4(P, BASE) do { t0 = cvtpk(P[BASE + 0], P[BASE + 1]); t1 = cvtpk(P[BASE + 2], P[BASE + 3]); t2 = cvtpk(P[BASE + 4], P[BASE + 5]); t3 = cvtpk(P[BASE + 6], P[BASE + 7]); } while (0)
#define G_SWP4(OUT) do { auto r0_ = __builtin_amdgcn_permlane32_swap(t0, t2, false, false); auto r1_ = __builtin_amdgcn_permlane32_swap(t1, t3, false, false); \
    u32x4 w_ = {r0_[0], r1_[0], r0_[1], r1_[1]}; OUT = *reinterpret_cast<bf16x8*>(&w_); } while (0)
__device__ __forceinline__ void blk_qk_fin(f32x16& n0, f32x16& n1, const ALAS char* Ks, const bf16x8* qr, const f32x16& negm, int r32, int hi,
                                           const f32x16& c0, f32x16& c1, bf16x8& pa0, bf16x8& pa1, bf16x8& pa2, float alpha_c, float& l_reg) {
  int sw = ((r32 & 7) << 4) ^ (hi * 16); asm volatile("" : "+v"(sw));
  const int r0 = (int)(uintptr_t)Ks + r32 * 256;
#define KRD(DST0, DST1, d0) do { const int ad_ = r0 + (((d0) * 32) ^ sw); asm volatile("ds_read_b128 %0, %2\n\tds_read_b128 %1, %2 offset:8192" : "=&v"(DST0), "=&v"(DST1) : "v"(ad_) : "memory"); } while (0)
  bf16x8 a[2], b[2]; unsigned t0 = 0, t1 = 0, t2 = 0, t3 = 0; float psA = 0.f, psB = 0.f;
  KRD(a[0], b[0], 0); KRD(a[1], b[1], 1);
  SBAR();
#pragma unroll
  for (int d0 = 0; d0 < 8; ++d0) {
    if (d0 < 7) PP_WAIT2(2, a[d0 & 1], b[d0 & 1]); else PP_WAIT2(0, a[d0 & 1], b[d0 & 1]);
    n0 = __builtin_amdgcn_mfma_f32_32x32x16_bf16(a[d0 & 1], qr[d0], d0 == 0 ? negm : n0, 0, 0, 0);
    n1 = __builtin_amdgcn_mfma_f32_32x32x16_bf16(b[d0 & 1], qr[d0], d0 == 0 ? negm : n1, 0, 0, 0);
    SBAR();
    if (d0 + 2 < 8) { KRD(a[d0 & 1], b[d0 & 1], d0 + 2); SBAR(); }
    c1[2 * d0] = __builtin_amdgcn_exp2f(c1[2 * d0]); c1[2 * d0 + 1] = __builtin_amdgcn_exp2f(c1[2 * d0 + 1]);
    psA += c0[2 * d0] + c0[2 * d0 + 1]; if (d0 > 0) psB += c1[2 * d0 - 2] + c1[2 * d0 - 1];
    if (d0 == 0) G_CVT4(c0, 0); if (d0 == 1) G_SWP4(pa0); if (d0 == 2) G_CVT4(c0, 8); if (d0 == 3) G_SWP4(pa1); if (d0 == 4) G_CVT4(c1, 0); if (d0 == 5) G_SWP4(pa2);
    SBAR();
  }
  { float ps = (psA + psB) + (c1[14] + c1[15]); auto rr = __builtin_amdgcn_permlane32_swap(__float_as_uint(ps), __float_as_uint(ps), false, false);
    l_reg = l_reg * alpha_c + (__uint_as_float(rr[0]) + __uint_as_float(rr[1])); }
#undef KRD
}
__device__ __forceinline__ void blk_pv_par(f32x16* o, const ALAS char* vbp, bf16x8 pa0, bf16x8 pa1, bf16x8 pa2, const f32x16& c1,
                                           f32x16& n0, f32x16& n1, float& m_reg, float& alpha, f32x16& negm, bool domask, int dj, int hi) {
  const int vb = (int)(uintptr_t)vbp;
#define PK(L, H) (bf16x8){L[0], L[1], L[2], L[3], H[0], H[1], H[2], H[3]}
  s16x4 lo[3], hh[3]; bf16x8 pa3 = {}; unsigned t0 = 0, t1 = 0, t2 = 0, t3 = 0; float mA = 0.f, mB = 0.f, pmax = 0.f;
  lo[0] = tr_read<v_rd_off(0, 0, 0)>(vb); hh[0] = tr_read<v_rd_off(0, 0, 1)>(vb); lo[1] = tr_read<v_rd_off(0, 1, 0)>(vb); hh[1] = tr_read<v_rd_off(0, 1, 1)>(vb);
  lo[2] = tr_read<v_rd_off(0, 2, 0)>(vb); hh[2] = tr_read<v_rd_off(0, 2, 1)>(vb);
  if (domask) band_mask(n0, n1, dj, hi);
  SBAR();
#define PVSTEP(d, ks, PA, WN, NEXT) do { constexpr int i_ = (d) * 4 + (ks), s_ = i_ % 3, n_ = i_ + 3; PP_WAIT2(WN, lo[s_], hh[s_]); o[d] = __builtin_amdgcn_mfma_f32_32x32x16_bf16(PA, PK(lo[s_], hh[s_]), o[d], 0, 0, 0); SBAR(); \
    if (NEXT) { lo[s_] = tr_read<v_rd_off((n_ >> 2) & 3, n_ & 3, 0)>(vb); hh[s_] = tr_read<v_rd_off((n_ >> 2) & 3, n_ & 3, 1)>(vb); SBAR(); } } while (0)
#define MX3(M, P, i) M = fmaxf(fmaxf(M, P[i]), P[(i) + 1])
  PVSTEP(0, 0, pa0, 4, 1); G_CVT4(c1, 8); SBAR();
  PVSTEP(0, 1, pa1, 4, 1); G_SWP4(pa3); SBAR();
  PVSTEP(0, 2, pa2, 4, 1); mA = fmaxf(fmaxf(n0[0], n0[1]), n0[2]); mB = fmaxf(fmaxf(n1[0], n1[1]), n1[2]); SBAR();
  PVSTEP(0, 3, pa3, 4, 1); MX3(mA, n0, 3); MX3(mB, n1, 3); SBAR();
  PVSTEP(1, 0, pa0, 4, 1); MX3(mA, n0, 5); MX3(mB, n1, 5); SBAR();
  PVSTEP(1, 1, pa1, 4, 1); MX3(mA, n0, 7); MX3(mB, n1, 7); SBAR();
  PVSTEP(1, 2, pa2, 4, 1); MX3(mA, n0, 9); MX3(mB, n1, 9); SBAR();
  PVSTEP(1, 3, pa3, 4, 1); MX3(mA, n0, 11); MX3(mB, n1, 11); SBAR();
  PVSTEP(2, 0, pa0, 4, 1); MX3(mA, n0, 13); MX3(mB, n1, 13); SBAR();
  PVSTEP(2, 1, pa1, 4, 1); pmax = fmaxf(fmaxf(mA, n0[15]), fmaxf(mB, n1[15]));
  { auto rr = __builtin_amdgcn_permlane32_swap(__float_as_uint(pmax), __float_as_uint(pmax), false, false); pmax = fmaxf(__uint_as_float(rr[0]), __uint_as_float(rr[1])); } SBAR();
  PVSTEP(2, 2, pa2, 4, 1);
  alpha = 1.f;
  if (__builtin_expect(!__all(pmax <= THRL2), 0)) { const float delta = fmaxf(pmax, 0.f); alpha = __builtin_amdgcn_exp2f(-delta); m_reg += delta;
#pragma unroll
    for (int r = 0; r < 16; ++r) { n0[r] -= delta; n1[r] -= delta; negm[r] = -m_reg; } }
  SBAR();
  PVSTEP(2, 3, pa3, 4, 1); n0[0] = __builtin_amdgcn_exp2f(n0[0]); n0[1] = __builtin_amdgcn_exp2f(n0[1]); SBAR();
  PVSTEP(3, 0, pa0, 4, 1); n0[2] = __builtin_amdgcn_exp2f(n0[2]); n0[3] = __builtin_amdgcn_exp2f(n0[3]); SBAR();
  PVSTEP(3, 1, pa1, 4, 0); n0[4] = __builtin_amdgcn_exp2f(n0[4]); n0[5] = __builtin_amdgcn_exp2f(n0[5]); SBAR();
  PVSTEP(3, 2, pa2, 2, 0); n0[6] = __builtin_amdgcn_exp2f(n0[6]); n0[7] = __builtin_amdgcn_exp2f(n0[7]); SBAR();
  PVSTEP(3, 3, pa3, 0, 0); n0[8] = __builtin_amdgcn_exp2f(n0[8]); n0[9] = __builtin_amdgcn_exp2f(n0[9]); SBAR();
  n0[10] = __builtin_amdgcn_exp2f(n0[10]); n0[11] = __builtin_amdgcn_exp2f(n0[11]); n0[12] = __builtin_amdgcn_exp2f(n0[12]); n0[13] = __builtin_amdgcn_exp2f(n0[13]);
  n0[14] = __builtin_amdgcn_exp2f(n0[14]); n0[15] = __builtin_amdgcn_exp2f(n0[15]); SBAR();
#undef MX3
#undef PVSTEP
#undef PK
}
__device__ __forceinline__ void attn_unit_g(const bf16_t* __restrict__ Q, const bf16_t* __restrict__ K, const bf16_t* __restrict__ V, bf16_t* __restrict__ O,
                                               int ldq, int ldk, int ldo, int nt, int nfirst, int skip, int qpos0, float sinkl2, ALAS char* lds, ALAS float* scr,
                                               int qmode  , float sinkB, const float* __restrict__ gq, const float* __restrict__ ropeC, const float* __restrict__ ropeS) {
  int tid_l = tid_now(); asm volatile("" : "+v"(tid_l));
  const int tid = tid_l, wid = __builtin_amdgcn_readfirstlane(tid >> 6), lane = tid & 63, r32 = lane & 31, hi = lane >> 5;
  ALAS char* K_lds = lds; ALAS char* V_lds = lds + 32768;
  ALAS float* li_l = scr; ALAS float* al_l = scr + 32;
  const int wrow = (qmode & 4) ? (wid & 3) : wid, hoff = (qmode & 4) ? (wid >> 2) * 128 : 0;
  const int qi = qpos0 + wrow * QBLK + r32;
  unsigned koff[2], voff[2];
#pragma unroll
  for (int i = 0; i < 2; ++i) { const int L = (wid * 2 + i) * 1024 + lane * 16, row = L >> 8, cb = (L & 255) ^ ((row & 7) << 4); koff[i] = (unsigned)(row * ldk * 2 + cb); }
#pragma unroll
  for (int i = 0; i < 2; ++i) { const int L = (wid * 2 + i) * 1024 + lane * 16, sub = L >> 9, within = L & 511;
    const int kk = (sub >> 2) * 8 + (within >> 6), k = (kk & ~0xC) | ((kk & 4) << 1) | ((kk & 8) >> 1), col = (sub & 3) * 32 + ((within & 63) >> 1);
    voff[i] = (unsigned)(k * ldk * 2 + col * 2); }
#define KROW(t) ((t) * KVBLK + (((t) >= nfirst) ? skip : 0))
  ALAS char* const offs = lds + 65536 + wid * 1024 + lane * 16;
  { u32x4 ov = {koff[0], koff[1], voff[0], voff[1]}; *(ALAS u32x4*)offs = ov; asm volatile("s_waitcnt lgkmcnt(0)" ::: "memory"); }
#define DK_ISSUE(t, slot) do { const char* kb_ = (const char*)K + (size_t)KROW(t) * 2 * ldk; const u32x4 ov_ = *(const ALAS u32x4*)offs; \
    dma16(kb_ + ov_[0], K_lds + (slot) * 16384 + (wid * 2 + 0) * 1024); dma16(kb_ + ov_[1], K_lds + (slot) * 16384 + (wid * 2 + 1) * 1024); } while (0)
#define DV_ISSUE(t, slot) do { const char* vb_ = (const char*)V + (size_t)KROW(t) * 2 * ldk; const u32x4 ov_ = *(const ALAS u32x4*)offs; \
    dma16(vb_ + ov_[2], V_lds + (slot) * 16384 + (wid * 2 + 0) * 1024); dma16(vb_ + ov_[3], V_lds + (slot) * 16384 + (wid * 2 + 1) * 1024); } while (0)
#define RESC(a) do { if (__any((a) < 1.f)) { if (hi == 0) al_l[r32] = (a); asm volatile("s_waitcnt lgkmcnt(0)" ::: "memory"); \
    _Pragma("unroll") for (int d = 0; d < 4; ++d) _Pragma("unroll") for (int r = 0; r < 16; ++r) o[d][r] *= al_l[crow(r, hi)]; } } while (0)
#define MASK(P0, P1, t) do { if ((t) >= nfirst) band_mask(P0, P1, KROW(t) - 512 - qi, hi); } while (0)
#define STEP_SYNC() do { asm volatile("s_waitcnt vmcnt(0) lgkmcnt(0)" ::: "memory"); __builtin_amdgcn_s_barrier(); } while (0)
  DK_ISSUE(0, 0); DV_ISSUE(0, 0); DK_ISSUE(1, 1);
  bf16x8 qr[8];
  { const bf16_t* Qw = Q + hoff + (long)(wrow * QBLK + r32) * ldq + hi * 8;
#pragma unroll
    for (int d0 = 0; d0 < 8; ++d0) qr[d0] = *reinterpret_cast<const bf16x8*>(Qw + d0 * 16);
    {
      constexpr float CQ = SCALE * 1.4426950408889634f;
      float qf[8][8];
#pragma unroll
      for (int d0 = 0; d0 < 8; ++d0)
#pragma unroll
        for (int j = 0; j < 8; ++j) qf[d0][j] = __uint_as_float(((unsigned)(unsigned short)qr[d0][j]) << 16);
      if (qmode & 1) { float ss = 0.f;
#pragma unroll
        for (int d0 = 0; d0 < 8; ++d0)
#pragma unroll
          for (int j = 0; j < 8; ++j) ss += qf[d0][j] * qf[d0][j];
        ss += __shfl_xor(ss, 32);
        const float rstd = 1.0f / sqrtf(ss * (1.0f / 128.0f) + 1e-6f);
#pragma unroll
        for (int d0 = 0; d0 < 8; ++d0) { const float* gp = gq + d0 * 16 + hi * 8; const float4 g0 = *reinterpret_cast<const float4*>(gp), g1 = *reinterpret_cast<const float4*>(gp + 4);
          qf[d0][0] *= rstd * g0.x; qf[d0][1] *= rstd * g0.y; qf[d0][2] *= rstd * g0.z; qf[d0][3] *= rstd * g0.w; qf[d0][4] *= rstd * g1.x; qf[d0][5] *= rstd * g1.y; qf[d0][6] *= rstd * g1.z; qf[d0][7] *= rstd * g1.w; } }
      if (qmode & 2) { const int t = qi;
#pragma unroll
        for (int hf = 0; hf < 2; ++hf) { const int p = hf ? (t & 63) : (t >> 6);
#pragma unroll
          for (int dd = 0; dd < 2; ++dd) { const int d0 = hf * 4 + dd, i0 = dd * 16 + hi * 8;
            const float4 c0 = *reinterpret_cast<const float4*>(ropeC + p * 32 + i0), c1 = *reinterpret_cast<const float4*>(ropeC + p * 32 + i0 + 4);
            const float4 s0 = *reinterpret_cast<const float4*>(ropeS + p * 32 + i0), s1 = *reinterpret_cast<const float4*>(ropeS + p * 32 + i0 + 4);
            const float cs[8] = {c0.x, c0.y, c0.z, c0.w, c1.x, c1.y, c1.z, c1.w}, sn[8] = {s0.x, s0.y, s0.z, s0.w, s1.x, s1.y, s1.z, s1.w};
#pragma unroll
            for (int j = 0; j < 8; ++j) { const float x1 = qf[d0][j], x2 = qf[d0 + 2][j]; qf[d0][j] = x1 * cs[j] - x2 * sn[j]; qf[d0 + 2][j] = x1 * sn[j] + x2 * cs[j]; } } } }
#pragma unroll
      for (int d0 = 0; d0 < 8; ++d0) { u32x4 w = {cvtpk(qf[d0][0] * CQ, qf[d0][1] * CQ), cvtpk(qf[d0][2] * CQ, qf[d0][3] * CQ), cvtpk(qf[d0][4] * CQ, qf[d0][5] * CQ), cvtpk(qf[d0][6] * CQ, qf[d0][7] * CQ)}; qr[d0] = *reinterpret_cast<bf16x8*>(&w); }
    } }
  float m_reg = 0.f, l_reg = 0.f; f32x16 o[4] = {}; f32x16 negm = {};
  const ALAS char* vbp = V_lds + v_rd_base(lane);
  f32x16 pA0, pA1, pB0, pB1; float alA = 1.f, alB = 1.f; bf16x8 pa0, pa1, pa2, pa3;
  STEP_SYNC();
  qk_seg(pA0, pA1, K_lds, qr, negm, r32, hi); MASK(pA0, pA1, 0); psm_n(pA0, pA1, m_reg, alA, negm, true);
  STEP_SYNC();
  int j = 0;
  for (; j + 2 < nt; j += 2) {
    DK_ISSUE(j + 2, 0); DV_ISSUE(j + 1, 1);
    SBAR(); blk_qk_fin(pB0, pB1, K_lds + 16384, qr, negm, r32, hi, pA0, pA1, pa0, pa1, pa2, alA, l_reg);
    blk_pv_par(o, vbp, pa0, pa1, pa2, pA1, pB0, pB1, m_reg, alB, negm, (j + 1) >= nfirst, KROW(j + 1) - 512 - qi, hi);
    STEP_SYNC();
    RESC(alB);
    if (j + 3 < nt) DK_ISSUE(j + 3, 1);
    DV_ISSUE(j + 2, 0);
    SBAR(); blk_qk_fin(pA0, pA1, K_lds, qr, negm, r32, hi, pB0, pB1, pa0, pa1, pa2, alB, l_reg);
    blk_pv_par(o, vbp + 16384, pa0, pa1, pa2, pB1, pA0, pA1, m_reg, alA, negm, (j + 2) >= nfirst, KROW(j + 2) - 512 - qi, hi);
    STEP_SYNC();
    RESC(alA);
  }
  DV_ISSUE(j + 1, 1);
  SBAR(); blk_qk_fin(pB0, pB1, K_lds + 16384, qr, negm, r32, hi, pA0, pA1, pa0, pa1, pa2, alA, l_reg);
  blk_pv_par(o, vbp, pa0, pa1, pa2, pA1, pB0, pB1, m_reg, alB, negm, (j + 1) >= nfirst, KROW(j + 1) - 512 - qi, hi);
  STEP_SYNC();
  RESC(alB);
  finishSM(pB0, pB1, alB, l_reg, pa0, pa1, pa2, pa3); SBAR();
  pv_d0(o, (int)(uintptr_t)(vbp + 16384), pa0, pa1, pa2, pa3);
  STEP_SYNC();
#undef DK_ISSUE
#undef DV_ISSUE
#undef KROW
#undef RESC
#undef MASK
#undef STEP_SYNC
  l_reg += __builtin_amdgcn_exp2f(((qmode & 4) && wid >= 4 ? sinkB : sinkl2) - m_reg);
  if (hi == 0) li_l[r32] = l_reg; asm volatile("s_waitcnt lgkmcnt(0)" ::: "memory");
  float rli[16];
#pragma unroll
  for (int r = 0; r < 16; ++r) rli[r] = __builtin_amdgcn_rcpf(li_l[crow(r, hi)]);
  { ALAS char* og = lds + wid * 8192; bf16_t* Og = O + hoff + (long)(wrow * QBLK) * ldo;
#pragma unroll
    for (int r = 0; r < 16; ++r) { const int row = crow(r, hi);
#pragma unroll
      for (int d = 0; d < 4; ++d) { const unsigned w = cvtpk(o[d][r] * rli[r], 0.f); *(ALAS unsigned short*)(og + row * 256 + (d * 32 + r32) * 2) = (unsigned short)(w & 0xffffu); } }
#pragma unroll
    for (int k = 0; k < 8; ++k) { const int p = lane + 64 * k; const u32x4 v = *(const ALAS u32x4*)(og + p * 16);
      *reinterpret_cast<u32x4*>(Og + (long)(p >> 4) * ldo + (p & 15) * 8) = v; }
  }
}

__device__ __forceinline__ void pv8_sm(f32x16* o, int vb, bf16x8 pa0, bf16x8 pa1, bf16x8 pa2, bf16x8 pa3, f32x16& p0, f32x16& p1, float& m_reg, float& mn, float& alpha) {
  constexpr float C = SCALE * 1.4426950408889634f;
  pv_one<0>(o[0], vb, pa0, pa1, pa2, pa3); pv_one<1>(o[1], vb, pa0, pa1, pa2, pa3);
  float pmax = p0[0];
#pragma unroll
  for (int r = 1; r < 16; ++r) pmax = fmaxf(pmax, p0[r]);
#pragma unroll
  for (int r = 0; r < 16; ++r) pmax = fmaxf(pmax, p1[r]);
  { auto rr = __builtin_amdgcn_permlane32_swap(__float_as_uint(pmax), __float_as_uint(pmax), false, false);
    pmax = fmaxf(__uint_as_float(rr[0]), __uint_as_float(rr[1])); }
  pv_one<2>(o[2], vb, pa0, pa1, pa2, pa3); pv_one<3>(o[3], vb, pa0, pa1, pa2, pa3);
  if (__builtin_expect(__all(pmax - m_reg <= THR / SCALE), 1)) { mn = m_reg; alpha = 1.f; }
  else { mn = fmaxf(m_reg, pmax); alpha = __builtin_amdgcn_exp2f((m_reg - mn) * C); m_reg = mn; }
  const float mnC = -mn * C;
#pragma unroll
  for (int r = 0; r < 16; ++r) p0[r] = fmaf(p0[r], C, mnC);
  pv_one<0>(o[4], vb + 16384, pa0, pa1, pa2, pa3); pv_one<1>(o[5], vb + 16384, pa0, pa1, pa2, pa3);
#pragma unroll
  for (int r = 0; r < 16; ++r) p1[r] = fmaf(p1[r], C, mnC);
#pragma unroll
  for (int r = 0; r < 8; ++r) p0[r] = __builtin_amdgcn_exp2f(p0[r]);
  pv_one<2>(o[6], vb + 16384, pa0, pa1, pa2, pa3); pv_one<3>(o[7], vb + 16384, pa0, pa1, pa2, pa3);
#pragma unroll
  for (int r = 8; r < 16; ++r) p0[r] = __builtin_amdgcn_exp2f(p0[r]);
}
__device__ __forceinline__ void qkt_ldsq(f32x16& p0, f32x16& p1, const ALAS char* Ks, const ALAS char* Qs, int lane, int r32, int hi) {
  p0 = f32x16{}; p1 = f32x16{};
#pragma unroll
  for (int d0 = 0; d0 < 8; ++d0) { const int cb = (d0 * 16 + hi * 8) * 2;
    const bf16x8 qd = *(const ALAS bf16x8*)(Qs + (d0 * 64 + lane) * 16);
    const bf16x8 b0 = *reinterpret_cast<const ALAS bf16x8*>(Ks + KSWZ(r32, cb));
    const bf16x8 b1 = *reinterpret_cast<const ALAS bf16x8*>(Ks + KSWZ(32 + r32, cb));
    p0 = __builtin_amdgcn_mfma_f32_32x32x16_bf16(b0, qd, p0, 0, 0, 0);
    p1 = __builtin_amdgcn_mfma_f32_32x32x16_bf16(b1, qd, p1, 0, 0, 0); }
}
__device__ __forceinline__ void attn_unit_diff2(const bf16_t* __restrict__ Q, const bf16_t* __restrict__ K, const bf16_t* __restrict__ V, bf16_t* __restrict__ O,
                                                int ldq, int ldk, int ldo, int nt, int qpos0, ALAS char* lds, ALAS float* scr,
                                                int qmode, const float* __restrict__ ropeC, const float* __restrict__ ropeS) {
  int tid_l = tid_now(); asm volatile("" : "+v"(tid_l));
  const int tid = tid_l, wid = __builtin_amdgcn_readfirstlane(tid >> 6), lane = tid & 63, r32 = lane & 31, hi = lane >> 5;
  ALAS char* K_lds = lds; ALAS char* V_lds = lds + 32768; ALAS char* Qs = lds + 65536 + wid * 8192;
  ALAS float* li_l = scr; ALAS float* al_l = scr + 32;
#define DK_ISSUE(t, slot) do { const char* kb_ = (const char*)K + (size_t)(t) * (KVBLK * 2) * ldk; int ln_ = lane; asm volatile("" : "+v"(ln_)); \
    _Pragma("unroll") for (int i = 0; i < 2; ++i) { const int L = (wid * 2 + i) * 1024 + ln_ * 16, row = L >> 8, cb = (L & 255) ^ ((row & 7) << 4); \
        dma16(kb_ + (unsigned)(row * ldk * 2 + cb), K_lds + (slot) * 16384 + (wid * 2 + i) * 1024); } } while (0)
#define DV_ISSUE(t) do { const char* vb_ = (const char*)V + (size_t)(t) * (KVBLK * 2) * ldk; int ln_ = lane; asm volatile("" : "+v"(ln_)); \
    _Pragma("unroll") for (int i = 0; i < 4; ++i) { const int L = (wid * 4 + i) * 1024 + ln_ * 16, half = L >> 14, Lh = L & 16383, sub = Lh >> 9, within = Lh & 511; \
        const int kk = (sub >> 2) * 8 + (within >> 6), k = (kk & ~0xC) | ((kk & 4) << 1) | ((kk & 8) >> 1), col = half * 128 + (sub & 3) * 32 + ((within & 63) >> 1); \
        dma16(vb_ + (unsigned)(k * ldk * 2 + col * 2), V_lds + (wid * 4 + i) * 1024); } } while (0)
#define RESC8(a) do { if (__any((a) < 1.f)) { if (hi == 0) al_l[r32] = (a); asm volatile("s_waitcnt lgkmcnt(0)" ::: "memory"); \
    _Pragma("unroll") for (int d = 0; d < 8; ++d) _Pragma("unroll") for (int r = 0; r < 16; ++r) o[d][r] *= al_l[crow(r, hi)]; } } while (0)
#define STEP_SYNC() do { asm volatile("s_waitcnt vmcnt(0) lgkmcnt(0)" ::: "memory"); __builtin_amdgcn_s_barrier(); } while (0)
  DK_ISSUE(0, 0); DK_ISSUE(1, 1);
  { bf16x8 qr[8];
    const bf16_t* Qw = Q + (long)(wid * QBLK + r32) * ldq + hi * 8;
#pragma unroll
    for (int d0 = 0; d0 < 8; ++d0) qr[d0] = *reinterpret_cast<const bf16x8*>(Qw + d0 * 16);
    if (qmode & 2) {
      float qf[8][8];
#pragma unroll
      for (int d0 = 0; d0 < 8; ++d0)
#pragma unroll
        for (int j = 0; j < 8; ++j) qf[d0][j] = __uint_as_float(((unsigned)(unsigned short)qr[d0][j]) << 16);
      const int t = qpos0 + wid * QBLK + r32;
#pragma unroll
      for (int hf = 0; hf < 2; ++hf) { const int p = hf ? (t & 63) : (t >> 6);
#pragma unroll
        for (int dd = 0; dd < 2; ++dd) { const int d0 = hf * 4 + dd, i0 = dd * 16 + hi * 8;
          const float4 c0 = *reinterpret_cast<const float4*>(ropeC + p * 32 + i0), c1 = *reinterpret_cast<const float4*>(ropeC + p * 32 + i0 + 4);
          const float4 s0 = *reinterpret_cast<const float4*>(ropeS + p * 32 + i0), s1 = *reinterpret_cast<const float4*>(ropeS + p * 32 + i0 + 4);
          const float cs[8] = {c0.x, c0.y, c0.z, c0.w, c1.x, c1.y, c1.z, c1.w}, sn[8] = {s0.x, s0.y, s0.z, s0.w, s1.x, s1.y, s1.z, s1.w};
#pragma unroll
          for (int j = 0; j < 8; ++j) { const float x1 = qf[d0][j], x2 = qf[d0 + 2][j]; qf[d0][j] = x1 * cs[j] - x2 * sn[j]; qf[d0 + 2][j] = x1 * sn[j] + x2 * cs[j]; } } }
#pragma unroll
      for (int d0 = 0; d0 < 8; ++d0) { u32x4 w = {cvtpk(qf[d0][0], qf[d0][1]), cvtpk(qf[d0][2], qf[d0][3]), cvtpk(qf[d0][4], qf[d0][5]), cvtpk(qf[d0][6], qf[d0][7])}; qr[d0] = *reinterpret_cast<bf16x8*>(&w); }
    }
#pragma unroll
    for (int d0 = 0; d0 < 8; ++d0) *(ALAS bf16x8*)(Qs + (d0 * 64 + lane) * 16) = qr[d0];
  }
  float m_reg = -1e30f, l_reg = 0.f; f32x16 o[8] = {};
  const int vb0 = (int)(uintptr_t)V_lds + v_rd_base(lane);
  f32x16 pA0, pA1, pB0, pB1; float mnA, mnB, alA, alB; bf16x8 pa0, pa1, pa2, pa3;
  STEP_SYNC();
  qkt_ldsq(pA0, pA1, K_lds, Qs, lane, r32, hi); partialSM(pA0, pA1, m_reg, mnA, alA);
  STEP_SYNC();
  int j = 0;
  for (; j + 2 < nt; j += 2) {
    DV_ISSUE(j); DK_ISSUE(j + 2, 0);
    SBAR(); qkt_ldsq(pB0, pB1, K_lds + 16384, Qs, lane, r32, hi);
    finishSM(pA0, pA1, alA, l_reg, pa0, pa1, pa2, pa3); SBAR();
    STEP_SYNC();
    pv8_sm(o, vb0, pa0, pa1, pa2, pa3, pB0, pB1, m_reg, mnB, alB);
    STEP_SYNC();
    RESC8(alB);
    DV_ISSUE(j + 1); if (j + 3 < nt) DK_ISSUE(j + 3, 1);
    SBAR(); qkt_ldsq(pA0, pA1, K_lds, Qs, lane, r32, hi);
    finishSM(pB0, pB1, alB, l_reg, pa0, pa1, pa2, pa3); SBAR();
    STEP_SYNC();
    pv8_sm(o, vb0, pa0, pa1, pa2, pa3, pA0, pA1, m_reg, mnA, alA);
    STEP_SYNC();
    RESC8(alA);
  }
  DV_ISSUE(j);
  SBAR(); qkt_ldsq(pB0, pB1, K_lds + 16384, Qs, lane, r32, hi);
  finishSM(pA0, pA1, alA, l_reg, pa0, pa1, pa2, pa3); SBAR();
  STEP_SYNC();
  pv8_sm(o, vb0, pa0, pa1, pa2, pa3, pB0, pB1, m_reg, mnB, alB);
  STEP_SYNC();
  RESC8(alB);
  DV_ISSUE(j + 1);
  finishSM(pB0, pB1, alB, l_reg, pa0, pa1, pa2, pa3); SBAR();
  STEP_SYNC();
  pv_one<0>(o[0], vb0, pa0, pa1, pa2, pa3); pv_one<1>(o[1], vb0, pa0, pa1, pa2, pa3); pv_one<2>(o[2], vb0, pa0, pa1, pa2, pa3); pv_one<3>(o[3], vb0, pa0, pa1, pa2, pa3);
  pv_one<0>(o[4], vb0 + 16384, pa0, pa1, pa2, pa3); pv_one<1>(o[5], vb0 + 16384, pa0, pa1, pa2, pa3); pv_one<2>(o[6], vb0 + 16384, pa0, pa1, pa2, pa3); pv_one<3>(o[7], vb0 + 16384, pa0, pa1, pa2, pa3);
#undef DK_ISSUE
#undef DV_ISSUE
#undef RESC8
#undef STEP_SYNC
  if (hi == 0) li_l[r32] = l_reg; asm volatile("s_waitcnt lgkmcnt(0)" ::: "memory");
  float rli[16];
#pragma unroll
  for (int r = 0; r < 16; ++r) rli[r] = __builtin_amdgcn_rcpf(li_l[crow(r, hi)]);
  { ALAS char* og = Qs; bf16_t* Og = O + (long)(wid * QBLK) * ldo;
#pragma unroll
    for (int hf = 0; hf < 2; ++hf) {
#pragma unroll
      for (int rr = 0; rr < 8; ++rr) { const int r = hf * 8 + rr, lrow = crow(r, hi) - 16 * hf;
#pragma unroll
        for (int d = 0; d < 8; ++d) { const unsigned w = cvtpk(o[d][r] * rli[r], 0.f); *(ALAS unsigned short*)(og + lrow * 512 + (d * 32 + r32) * 2) = (unsigned short)(w & 0xffffu); } }
#pragma unroll
      for (int k = 0; k < 8; ++k) { const int p = lane + 64 * k; const u32x4 v = *(const ALAS u32x4*)(og + p * 16);
        *reinterpret_cast<u32x4*>(Og + (long)(16 * hf + (p >> 5)) * ldo + (p & 31) * 8) = v; }
    } }
}
}
#define GAS __attribute__((address_space(1)))
#define LAS __attribute__((address_space(3)))
typedef unsigned short bf16;
typedef unsigned v4u __attribute__((ext_vector_type(4)));
typedef float f32x4 __attribute__((ext_vector_type(4)));
typedef short bf16x8 __attribute__((ext_vector_type(8)));
typedef GAS unsigned gu32;
typedef GAS unsigned long long gu64;
#define RLX_AGENT __ATOMIC_RELAXED, __HIP_MEMORY_SCOPE_AGENT
#define LDS_WAIT() asm volatile("s_waitcnt lgkmcnt(0)" ::: "memory")
#define VM_WAIT() asm volatile("s_waitcnt vmcnt(0)" ::: "memory")
__device__ __forceinline__ unsigned long long rt() { return __builtin_amdgcn_s_memrealtime(); }
__device__ __forceinline__ unsigned f2bf(float f) { unsigned u = __builtin_bit_cast(unsigned, f); return (u + 0x7fffu + ((u >> 16) & 1u)) >> 16; }
__device__ __forceinline__ unsigned pk2(float lo, float hi) { return f2bf(lo) | (f2bf(hi) << 16); }

#define XB_TMO      128
#define XB_XCNT(j)  (256  + 64 * (j))
#define XB_XSUB(j)  (1280 + 64 * (j))
#define XB_XGEN(j)  (2304 + 64 * (j))
#define XB_TOP      3328
#define XB_TOPGEN   3392
#define XCD_BAR_WORDS 3456
#define XB_SPIN_CAP (1u << 18)

__device__ __forceinline__ unsigned xb_ld(unsigned* p)              { return __hip_atomic_load(p, __ATOMIC_RELAXED, __HIP_MEMORY_SCOPE_AGENT); }
__device__ __forceinline__ unsigned xb_add(unsigned* p, unsigned v) { return __hip_atomic_fetch_add(p, v, __ATOMIC_RELAXED, __HIP_MEMORY_SCOPE_AGENT); }
__device__ __forceinline__ unsigned xb_xcc_id() { return (unsigned)__builtin_amdgcn_s_getreg((3 << 11) | 20) & 0xFu; }
#define XB_SPIN(cond, bar) do { unsigned _sp = 0; while (cond) { __builtin_amdgcn_s_sleep(1); \
    if ((++_sp & 255u) == 0u) { if (xb_ld(&(bar)[XB_TMO])) break; if (_sp > XB_SPIN_CAP) { atomicAdd(&(bar)[XB_TMO], 1u); break; } } } } while (0)

struct XcdBarrier {
    unsigned* bar; unsigned x;
    volatile LAS unsigned* st;
};

__device__ __forceinline__ XcdBarrier xcd_barrier_post(unsigned* bar, volatile LAS unsigned* st) {
    XcdBarrier b; b.bar = bar; b.x = xb_xcc_id(); b.st = st;
    if (tid_now() == 0) (void)xb_add(&bar[XB_XCNT(b.x)], 1u);
    return b;
}
__device__ __forceinline__ void xcd_barrier_complete(unsigned* bar, unsigned x, unsigned& nloc, unsigned& nx) {
    const unsigned G = gridDim.x * gridDim.y * gridDim.z;
    asm volatile("" : "+s"(x));
    unsigned sum, cnt, mine, sp = 0u;
    for (;;) {
        sum = 0u; cnt = 0u; mine = 0u;
#pragma unroll
        for (unsigned j = 0; j < 16; ++j) { const unsigned c = xb_ld(&bar[XB_XCNT(j)]); sum += c; cnt += (c > 0u) ? 1u : 0u; mine = (j == x) ? c : mine; }
        if (sum == G) break;
        __builtin_amdgcn_s_sleep(1);
        if ((++sp & 255u) == 0u) { if (xb_ld(&bar[XB_TMO])) break; if (sp > XB_SPIN_CAP) { atomicAdd(&bar[XB_TMO], 1u); break; } }
    }
    nloc = mine > 0u ? mine : 1u; nx = cnt > 0u ? cnt : 1u;
}

__device__ __forceinline__ void xcd_barrier(const XcdBarrier& b) {
    asm volatile("s_waitcnt vmcnt(0)" ::: "memory");
    __syncthreads();
    if (tid_now() == 0) {
        unsigned* bar = b.bar; unsigned bx_ = b.x;
        asm volatile("" : "+s"(bar), "+s"(bx_));
        __builtin_amdgcn_s_waitcnt(0);
        unsigned nloc = b.st[0], nx = b.st[1];
        if (nloc == 0u) { xcd_barrier_complete(bar, bx_, nloc, nx); b.st[0] = nloc; b.st[1] = nx; }
        const unsigned old = xb_add(&bar[XB_XSUB(bx_)], 1u);
        const unsigned gen = old / nloc;
        if (old + 1u == (gen + 1u) * nloc) {
            __builtin_amdgcn_fence(__ATOMIC_RELEASE, "agent");
            asm volatile("s_waitcnt vmcnt(0)" ::: "memory");
            const unsigned og = xb_add(&bar[XB_TOP], 1u);
            const unsigned tg = og / nx;
            if (og + 1u == (tg + 1u) * nx) xb_add(&bar[XB_TOPGEN], 1u);
            else XB_SPIN(xb_ld(&bar[XB_TOPGEN]) == tg, bar);
            __builtin_amdgcn_fence(__ATOMIC_ACQUIRE, "agent");
            xb_add(&bar[XB_XGEN(bx_)], 1u);
            asm volatile("s_waitcnt vmcnt(0)" ::: "memory");
        } else {
            XB_SPIN(xb_ld(&bar[XB_XGEN(bx_)]) == gen, bar);
            __builtin_amdgcn_fence(__ATOMIC_ACQUIRE, "agent");
            asm volatile("s_waitcnt vmcnt(0)" ::: "memory");
        }
    }
    __syncthreads();
}

#ifndef ATT_DMA_ALL
#define ATT_DMA_ALL 6
#endif
#ifndef ATT_DIFF_PIPE
#define ATT_DIFF_PIPE 1
#endif
constexpr int NWAVES = 8;
constexpr int DM = 2048, TP = 8192, TS = 16384, TT = TP + TS;
constexpr int SP = 256, SS = 2048, PAST = 512, SKV = PAST + SS;
constexpr int NQKV = 3072, KVW = 512, FF = 5632, NGU = 2 * FF;
constexpr float EPS = 1e-6f;
constexpr float LAM_INIT2 = 0.47071301834358414f;
enum { I_XP = 0, I_XS, I_C, I_CKF, I_CVF, I_CKW, I_CVW, I_CKD, I_CVD, I_CCTX, I_WADA, I_BADA, I_GNORM, I_WQKVF, I_WOF, I_GQF, I_GKF, I_WQKVW, I_WOW, I_SINKW,
       I_WQKVD, I_WOD, I_LQ1, I_LK1, I_LQ2, I_LK2, I_GSUB, I_WG, I_WU, I_WD, N_IN };
constexpr size_t O_YP = 0, O_YS = (size_t)TP * DM, O_KF = (size_t)TT * DM, O_VF = O_KF + (size_t)32 * 2 * SP * KVW, O_KW = O_VF + (size_t)32 * 2 * SP * KVW,
                 O_VW = O_KW + (size_t)32 * SP * KVW, O_KD = O_VW + (size_t)32 * SP * KVW, O_VD = O_KD + (size_t)32 * SP * KVW, O_END = O_VD + (size_t)32 * SP * KVW;
static_assert(O_END == 83886080, "output size");
constexpr size_t MiB = 1u << 20;
constexpr size_t WS_CTL = 0, CTL_ZERO_BYTES = 1 * MiB;
constexpr size_t WS_ROPE = 1 * MiB;
constexpr size_t WS_VEC = 2 * MiB;
constexpr size_t WS_PART = 4 * MiB;
constexpr size_t WS_W = 20 * MiB, W_LAYER = 86 * MiB, W_QKV = 0, W_O = 12 * MiB, W_GU = 20 * MiB, W_D = 64 * MiB;
constexpr size_t WS_KC = 364 * MiB, WS_VC = 384 * MiB, WS_KP = 404 * MiB, WS_VP = 412 * MiB;
constexpr size_t WS_H = 420 * MiB, WS_MF = 516 * MiB;
constexpr size_t WS_ACT = 612 * MiB;
constexpr size_t WS_RAW = WS_ACT, WS_ATT = WS_ACT + 144 * MiB, WS_X16 = 876 * MiB, WS_END = 972 * MiB;
static_assert(WS_W + 4 * W_LAYER == WS_KC && WS_ATT + (size_t)TT * DM * 2 <= WS_X16 && WS_ACT + (size_t)TT * FF * 2 <= WS_X16 && WS_X16 + (size_t)TT * DM * 2 <= WS_END && WS_MF + (size_t)TT * DM * 2 == WS_ACT, "ws map");
constexpr int CW_BAR = 4096;
constexpr int RING_BYTES = 131072, LDSCTL_OFF = RING_BYTES, MISC_OFF = LDSCTL_OFF + 320, LDS_BYTES = 147456;

typedef unsigned v2u __attribute__((ext_vector_type(2)));

__device__ __forceinline__ float wave_sum(float v) {
#pragma unroll
    for (int o = 1; o < 64; o <<= 1) v += __shfl_xor(v, o);
    return v;
}
__device__ __forceinline__ float bf2f(unsigned h) { return __uint_as_float(h << 16); }
__device__ __forceinline__ unsigned pkbf(float lo, float hi) { unsigned r; asm volatile("v_cvt_pk_bf16_f32 %0, %1, %2" : "=v"(r) : "v"(lo), "v"(hi)); return r; }

__device__ __forceinline__ void transpose_item(const float* __restrict__ W, int K, int N, bf16* __restrict__ WT, int k0, int n0, int drow0, LAS float* scr, int lane) {
    { const int kr = lane >> 3, c4 = (lane & 7) * 4;
      f32x4 v[8];
#pragma unroll
      for (int i = 0; i < 8; ++i) v[i] = *(const f32x4*)(W + (size_t)(k0 + 8 * i + kr) * N + n0 + c4);
#pragma unroll
      for (int i = 0; i < 8; ++i) { LAS float* d = scr + (8 * i + kr) * 33 + c4; d[0] = v[i].x; d[1] = v[i].y; d[2] = v[i].z; d[3] = v[i].w; } }
    LDS_WAIT(); asm volatile("" ::: "memory");
    const int c = lane & 7;
#pragma unroll
    for (int j = 0; j < 4; ++j) { const int n = (lane >> 3) + 8 * j; const LAS float* s = scr + (8 * c) * 33 + n;
        v4u o; o.x = pkbf(s[0 * 33], s[1 * 33]); o.y = pkbf(s[2 * 33], s[3 * 33]); o.z = pkbf(s[4 * 33], s[5 * 33]); o.w = pkbf(s[6 * 33], s[7 * 33]);
        *(v4u*)(WT + (size_t)(drow0 + n) * K + k0 + 8 * c) = o; }
    LDS_WAIT(); asm volatile("" ::: "memory");
}

struct Args { const float* in[N_IN]; float* out; unsigned char* ws; };

typedef const float* cfp;
#define KAS __attribute__((address_space(4)))
__device__ __forceinline__ const KAS cfp* kargs() { const KAS cfp* p = (const KAS cfp*)__builtin_amdgcn_kernarg_segment_ptr(); asm volatile("" : "+s"(p)); return p; }
#define PHASE_ENV \
    const KAS cfp* const ka = kargs(); unsigned char* const ws = (unsigned char*)ka[N_IN + 1]; float* const out = (float*)ka[N_IN]; (void)out; \
    int tid_ = tid_now(); asm volatile("" : "+v"(tid_)); const int tid = tid_, lane = tid & 63, wave = __builtin_amdgcn_readfirstlane(tid >> 6); \
    const int G = gridDim.x, bx = blockIdx.x, vcu = (G % 8 == 0) ? (bx % 8) * (G / 8) + bx / 8 : bx, gw = vcu * NWAVES + wave, NGW = G * NWAVES; \
    (void)tid; (void)lane; (void)wave; (void)gw; (void)NGW; (void)vcu; \
    float* const ropeC = (float*)(ws + WS_ROPE); float* const ropeS = ropeC + 64 * 32; float* const VEC = (float*)(ws + WS_VEC); float* const PART = (float*)(ws + WS_PART); \
    bf16* const KC = (bf16*)(ws + WS_KC); bf16* const VC = (bf16*)(ws + WS_VC); bf16* const KP = (bf16*)(ws + WS_KP); bf16* const VP = (bf16*)(ws + WS_VP); \
    bf16* const H = (bf16*)(ws + WS_H); bf16* const MF = (bf16*)(ws + WS_MF); bf16* const ACT = (bf16*)(ws + WS_ACT); \
    bf16* const RAW = (bf16*)(ws + WS_RAW); bf16* const ATT = (bf16*)(ws + WS_ATT); bf16* const ADIF = (bf16*)(ws + WS_H); bf16* const X16 = (bf16*)(ws + WS_X16); (void)X16; \
    (void)ropeC; (void)ropeS; (void)VEC; (void)PART; (void)KC; (void)VC; (void)KP; (void)VP; (void)H; (void)MF; (void)ACT; (void)RAW; (void)ATT; (void)ADIF;
#define IN(i) (ka[i])

__global__ void __launch_bounds__(NWAVES * 64, 2) trunk_fwd(Args args) {
    extern __shared__ __attribute__((aligned(16))) unsigned char lds_raw[];
    LAS unsigned char* const lds = (LAS unsigned char*)lds_raw;
    XcdBarrier bar;
    {
        volatile LAS unsigned* MISC = (volatile LAS unsigned*)(lds + MISC_OFF);
        for (int u = threadIdx.x; u < (LDS_BYTES - LDSCTL_OFF) / 4; u += NWAVES * 64) ((LAS unsigned*)(lds + LDSCTL_OFF))[u] = 0u;
        __syncthreads();
        { const unsigned slot_ = (unsigned)__builtin_amdgcn_s_getreg((5 << 11) | 4) & 63u;
          if ((threadIdx.x & 63) == 0) *(volatile LAS unsigned*)(lds + (TIDTAB_LDS_ADDR - 0) + slot_ * 4) = threadIdx.x >> 6; }
        __syncthreads();
        bar = xcd_barrier_post((unsigned*)(args.ws + WS_CTL) + CW_BAR, MISC + 8);
    }

    {
        PHASE_ENV
        LAS float* sl = (LAS float*)lds;
        for (int i = tid; i < 9 * DM; i += NWAVES * 64) { const int r = i >> 11, k = i & (DM - 1);
            const float cv = (r == 0) ? IN(I_CCTX)[k] : IN(I_C)[(r - 1) * DM + k]; sl[i] = cv / (1.0f + expf(-cv)); }
        __syncthreads();
        for (int t = gw; t < 2048; t += NGW) {
            const int l = t >> 9, cc = (t >> 3) & 63, kc = t & 7;
            if (lane < 48) {
                const float* Wp = IN(I_WADA) + ((size_t)l * DM + kc * 256) * (6 * DM) + cc * 192 + lane * 4;
                const LAS float* sp = sl + kc * 256;
                f32x4 acc[9];
#pragma unroll
                for (int r = 0; r < 9; ++r) acc[r] = (f32x4){0.f, 0.f, 0.f, 0.f};
#pragma unroll 16
                for (int k = 0; k < 256; ++k) { const f32x4 w = *(const f32x4*)(Wp + (size_t)k * (6 * DM));
#pragma unroll
                    for (int r = 0; r < 9; ++r) acc[r] += w * sp[r * DM + k]; }
#pragma unroll
                for (int r = 0; r < 9; ++r) *(f32x4*)(PART + ((size_t)((kc * 4 + l) * 9 + r)) * (6 * DM) + cc * 192 + lane * 4) = acc[r];
            }
        }
        __syncthreads();
        LAS float* scr = (LAS float*)(lds + wave * 16384);
        constexpr int IT_QKV = 32 * 96, IT_O = 32 * 64, IT_G = 32 * 176, IT_D = 88 * 64, IT_LAYER = IT_QKV + IT_O + 2 * IT_G + IT_D;
        for (int it = gw; it < 4 * IT_LAYER; it += NGW) {
            const int l = it / IT_LAYER; int r = it - l * IT_LAYER; const int kind = l % 3, slot = l / 3;
            unsigned char* wl = ws + WS_W + (size_t)l * W_LAYER;
            if (r < IT_QKV) { const float* W = (kind == 0 ? IN(I_WQKVF) + (size_t)slot * DM * NQKV : kind == 1 ? IN(I_WQKVW) : IN(I_WQKVD));
                const int kb = r / 96, nb = r % 96; transpose_item(W, DM, NQKV, (bf16*)(wl + W_QKV), 64 * kb, 32 * nb, 32 * nb, scr, lane); continue; } r -= IT_QKV;
            if (r < IT_O) { const float* W = (kind == 0 ? IN(I_WOF) + (size_t)slot * DM * DM : kind == 1 ? IN(I_WOW) : IN(I_WOD));
                const int kb = r / 64, nb = r % 64; transpose_item(W, DM, DM, (bf16*)(wl + W_O), 64 * kb, 32 * nb, 32 * nb, scr, lane); continue; } r -= IT_O;
            if (r < 2 * IT_G) { const int up = r >= IT_G; if (up) r -= IT_G; const float* W = IN(up ? I_WU : I_WG) + (size_t)l * DM * FF;
                const int kb = r / 176, nb = r % 176, n0 = 32 * nb; transpose_item(W, DM, FF, (bf16*)(wl + W_GU), 64 * kb, n0, (n0 >> 5) * 64 + up * 32, scr, lane); continue; } r -= 2 * IT_G;
            { const float* W = IN(I_WD) + (size_t)l * FF * DM; const int kb = r / 64, nb = r % 64; transpose_item(W, FF, DM, (bf16*)(wl + W_D), 64 * kb, 32 * nb, 32 * nb, scr, lane); }
        }
        { const int gt = bx * (NWAVES * 64) + tid;
          if (gt < 64 * 32) { const int p = gt >> 5, i = gt & 31; double inv = 1.0; for (int q = 0; q < i; ++q) inv *= 0.7498942093324559;
            const float ang = (float)p * (float)inv; const double a = (double)ang; const double n = __builtin_rint(a * 0.6366197723675814);
            double rr = __builtin_fma(-n, 1.5707963267948966, a); rr = __builtin_fma(-n, 6.123233995736766e-17, rr);
            const double r2 = rr * rr;
            const double sn = rr * (1.0 + r2 * (-1.0 / 6 + r2 * (1.0 / 120 + r2 * (-1.0 / 5040 + r2 * (1.0 / 362880 + r2 * (-1.0 / 39916800 + r2 * (1.0 / 6227020800.0)))))));
            const double cs = 1.0 + r2 * (-0.5 + r2 * (1.0 / 24 + r2 * (-1.0 / 720 + r2 * (1.0 / 40320 + r2 * (-1.0 / 3628800 + r2 * (1.0 / 479001600.0))))));
            const int q4 = ((int)n) & 3; const double s_ = (q4 == 0) ? sn : (q4 == 1) ? cs : (q4 == 2) ? -sn : -cs, c_ = (q4 == 0) ? cs : (q4 == 1) ? -sn : (q4 == 2) ? -cs : sn;
            ropeC[gt] = (float)c_; ropeS[gt] = (float)s_; } }
    }
    xcd_barrier(bar);
    {
    PHASE_ENV
    for (int e = bx * (NWAVES * 64) + tid; e < 4 * 9 * DM; e += G * NWAVES * 64) {
        const int l = e / (9 * DM), r = (e / DM) % 9, c = e & (DM - 1);
        float mod[6];
#pragma unroll
        for (int j = 0; j < 6; ++j) { float s = IN(I_BADA)[(size_t)l * 6 * DM + j * DM + c];
#pragma unroll
            for (int kc = 0; kc < 8; ++kc) s += PART[((size_t)((kc * 4 + l) * 9 + r)) * (6 * DM) + j * DM + c];
            mod[j] = s; }
        const float* gn = IN(I_GNORM) + (size_t)l * 4 * DM;
        float* vb = VEC + (size_t)l * 6 * 9 * DM + (size_t)r * DM + c;
        vb[0 * 9 * DM] = gn[0 * DM + c] * (1.0f + mod[1]); vb[1 * 9 * DM] = mod[0]; vb[2 * 9 * DM] = mod[2] * gn[1 * DM + c];
        vb[3 * 9 * DM] = gn[2 * DM + c] * (1.0f + mod[4]); vb[4 * 9 * DM] = mod[3]; vb[5 * 9 * DM] = mod[5] * gn[3 * DM + c];
    }
    }
    xcd_barrier(bar);

#define BF8_TO_F(W, LO, HI) do { LO = (f32x4){bf2f(W.x & 0xffffu), bf2f(W.x >> 16), bf2f(W.y & 0xffffu), bf2f(W.y >> 16)}; HI = (f32x4){bf2f(W.z & 0xffffu), bf2f(W.z >> 16), bf2f(W.w & 0xffffu), bf2f(W.w >> 16)}; } while (0)
#define THIN_LOADX(ROW, XV, XW, MW, XP, XS, XIN16, RES) do { const int r_ = (ROW); \
        if (XIN16) { _Pragma("unroll") for (int c = 0; c < 4; ++c) XW[c] = __builtin_nontemporal_load(&((const v4u*)(X16 + (size_t)r_ * DM))[64 * c + lane]); } \
        else { const float* xb_ = (XP), * xs_m = (XS) - (size_t)TP * DM; const float* xr_ = (r_ < TP ? xb_ : xs_m) + (size_t)r_ * DM; \
            _Pragma("unroll") for (int c = 0; c < 4; ++c) { XV[2 * c] = __builtin_nontemporal_load(&((const f32x4*)xr_)[128 * c + 2 * lane]); XV[2 * c + 1] = __builtin_nontemporal_load(&((const f32x4*)xr_)[128 * c + 2 * lane + 1]); } } \
        if (RES) { _Pragma("unroll") for (int c = 0; c < 4; ++c) MW[c] = __builtin_nontemporal_load(&((const v4u*)(MF + (size_t)r_ * DM))[64 * c + lane]); } } while (0)
#define THIN_ROW(ROW, XV, XW, MW, XIN16, XOUT16, RES, HOUT) do { const int r_ = (ROW); \
        if (XIN16) { _Pragma("unroll") for (int c = 0; c < 4; ++c) BF8_TO_F(XW[c], XV[2 * c], XV[2 * c + 1]); } \
        if (RES) { \
            f32x4 mv[8]; float ss = 0.f; \
            _Pragma("unroll") for (int c = 0; c < 4; ++c) BF8_TO_F(MW[c], mv[2 * c], mv[2 * c + 1]); \
            _Pragma("unroll") for (int j = 0; j < 8; ++j) ss += (mv[j].x * mv[j].x + mv[j].y * mv[j].y) + (mv[j].z * mv[j].z + mv[j].w * mv[j].w); \
            const float rstd = 1.0f / sqrtf(wave_sum(ss) * (1.0f / DM) + EPS); \
            _Pragma("unroll") for (int j = 0; j < 8; ++j) XV[j] += gv[j] * (mv[j] * rstd); \
            if (XOUT16) { _Pragma("unroll") for (int c = 0; c < 4; ++c) { v4u w; w.x = pkbf(XV[2 * c].x, XV[2 * c].y); w.y = pkbf(XV[2 * c].z, XV[2 * c].w); w.z = pkbf(XV[2 * c + 1].x, XV[2 * c + 1].y); w.w = pkbf(XV[2 * c + 1].z, XV[2 * c + 1].w); \
                    __builtin_nontemporal_store(w, &((v4u*)(X16 + (size_t)r_ * DM))[64 * c + lane]); } } \
            else { _Pragma("unroll") for (int c = 0; c < 4; ++c) { __builtin_nontemporal_store(XV[2 * c], &((f32x4*)(out + (size_t)r_ * DM))[128 * c + 2 * lane]); __builtin_nontemporal_store(XV[2 * c + 1], &((f32x4*)(out + (size_t)r_ * DM))[128 * c + 2 * lane + 1]); } } \
        } \
        if (HOUT) { \
            float s2 = 0.f; \
            _Pragma("unroll") for (int j = 0; j < 8; ++j) s2 += (XV[j].x * XV[j].x + XV[j].y * XV[j].y) + (XV[j].z * XV[j].z + XV[j].w * XV[j].w); \
            const float r2 = 1.0f / sqrtf(wave_sum(s2) * (1.0f / DM) + EPS); \
            _Pragma("unroll") for (int c = 0; c < 4; ++c) { const f32x4 h0 = XV[2 * c] * r2 * av[2 * c] + bv[2 * c], h1 = XV[2 * c + 1] * r2 * av[2 * c + 1] + bv[2 * c + 1]; \
                v4u w; w.x = pkbf(h0.x, h0.y); w.y = pkbf(h0.z, h0.w); w.z = pkbf(h1.x, h1.y); w.w = pkbf(h1.z, h1.w); ((v4u*)(H + (size_t)r_ * DM))[64 * c + lane] = w; } \
        } } while (0)
#define THIN_PHASE(XP, XS, XIN16, XOUT16, RES, GV, HOUT, AV, BV) do { \
    for (int row = 2 * gw; row < TT; row += 2 * NGW) { \
        const int cls = row < TP ? 0 : 1 + ((row - TP) >> 11); \
        f32x4 xa[8], xb[8], gv[8], av[8], bv[8]; v4u xwa[4], xwb[4], mwa[4], mwb[4]; \
        THIN_LOADX(row, xa, xwa, mwa, XP, XS, XIN16, RES); THIN_LOADX(row + 1, xb, xwb, mwb, XP, XS, XIN16, RES); \
        if (RES) { _Pragma("unroll") for (int c = 0; c < 4; ++c) { gv[2 * c] = ((const f32x4*)((GV) + (size_t)cls * DM))[128 * c + 2 * lane]; gv[2 * c + 1] = ((const f32x4*)((GV) + (size_t)cls * DM))[128 * c + 2 * lane + 1]; } } \
        { _Pragma("unroll") for (int c = 0; c < 4; ++c) { av[2 * c] = ((const f32x4*)((AV) + (size_t)cls * DM))[128 * c + 2 * lane]; av[2 * c + 1] = ((const f32x4*)((AV) + (size_t)cls * DM))[128 * c + 2 * lane + 1]; \
                bv[2 * c] = ((const f32x4*)((BV) + (size_t)cls * DM))[128 * c + 2 * lane]; bv[2 * c + 1] = ((const f32x4*)((BV) + (size_t)cls * DM))[128 * c + 2 * lane + 1]; } } \
        THIN_ROW(row, xa, xwa, mwa, XIN16, XOUT16, RES, HOUT); \
        THIN_ROW(row + 1, xb, xwb, mwb, XIN16, XOUT16, RES, HOUT); \
    } } while (0)
#define THIN_DMA_ISSUE(PAIR) do { const size_t r0_ = (size_t)(PAIR) * 2; \
        _Pragma("unroll") for (int q = 0; q < 2; ++q) _Pragma("unroll") for (int c = 0; c < 4; ++c) { \
            __builtin_amdgcn_global_load_lds((const unsigned*)(X16 + (r0_ + q) * DM + c * 512 + lane * 8), (LAS unsigned*)(wl_ + q * 4096 + c * 1024), 16, 0, 2); \
            __builtin_amdgcn_global_load_lds((const unsigned*)(MF + (r0_ + q) * DM + c * 512 + lane * 8), (LAS unsigned*)(wl_ + 8192 + q * 4096 + c * 1024), 16, 0, 2); } } while (0)
#define THIN_PHASE_DMA(XOUT16, GV, HOUT, AV, BV) do { \
    LAS unsigned char* const wl_ = lds + wave * 16384; \
    const int npair_ = TT / 2; \
    if (gw < npair_) THIN_DMA_ISSUE(gw); \
    for (int pr = gw; pr < npair_; pr += NGW) { \
        const int row = 2 * pr; const int cls = row < TP ? 0 : 1 + ((row - TP) >> 11); \
        f32x4 xa[8], xb[8], gv[8], av[8], bv[8]; v4u xwa[4], xwb[4], mwa[4], mwb[4]; \
        asm volatile("s_waitcnt vmcnt(0)" ::: "memory");     \
        _Pragma("unroll") for (int c = 0; c < 4; ++c) { xwa[c] = *(const LAS v4u*)(wl_ + c * 1024 + lane * 16); xwb[c] = *(const LAS v4u*)(wl_ + 4096 + c * 1024 + lane * 16); \
            mwa[c] = *(const LAS v4u*)(wl_ + 8192 + c * 1024 + lane * 16); mwb[c] = *(const LAS v4u*)(wl_ + 12288 + c * 1024 + lane * 16); } \
        asm volatile("s_waitcnt lgkmcnt(0)" ::: "memory");     \
        if (pr + NGW < npair_) THIN_DMA_ISSUE(pr + NGW); \
        { _Pragma("unroll") for (int c = 0; c < 4; ++c) { gv[2 * c] = ((const f32x4*)((GV) + (size_t)cls * DM))[128 * c + 2 * lane]; gv[2 * c + 1] = ((const f32x4*)((GV) + (size_t)cls * DM))[128 * c + 2 * lane + 1]; } } \
        { _Pragma("unroll") for (int c = 0; c < 4; ++c) { av[2 * c] = ((const f32x4*)((AV) + (size_t)cls * DM))[128 * c + 2 * lane]; av[2 * c + 1] = ((const f32x4*)((AV) + (size_t)cls * DM))[128 * c + 2 * lane + 1]; \
                bv[2 * c] = ((const f32x4*)((BV) + (size_t)cls * DM))[128 * c + 2 * lane]; bv[2 * c + 1] = ((const f32x4*)((BV) + (size_t)cls * DM))[128 * c + 2 * lane + 1]; } } \
        THIN_ROW(row, xa, xwa, mwa, true, XOUT16, true, HOUT); \
        THIN_ROW(row + 1, xb, xwb, mwb, true, XOUT16, true, HOUT); \
    } } while (0)
#define X_IS_BF16 1

    { PHASE_ENV
      THIN_PHASE(IN(I_XP), IN(I_XS), false, false, false, VEC, true, VEC + 0 * 9 * DM, VEC + 1 * 9 * DM); }
    xcd_barrier(bar);

    for (int L = 0; L < 4; ++L) {
        const int kind = L % 3, slot = L / 3, nslot = (kind == 0) ? 2 : 1;
#define LAYER_ENV PHASE_ENV unsigned char* const wl = ws + WS_W + (size_t)L * W_LAYER; const float* const vecL = VEC + (size_t)L * 6 * 9 * DM; (void)wl; (void)vecL;
        { LAYER_ENV pg8::Gemm g{H, (const bf16*)(wl + W_QKV), TT, NQKV, DM}; pg8::StaticOrder S; S.init(TT, NQKV, G, bx);
          pg8::EpiStore E{RAW, NQKV};
          pg8::gemm_phase<pg8::EpiStore, pg8::StaticOrder, true, true>(lds, g, S, E); }
        { LAYER_ENV
          { const int first = ((TT / 256) * (NQKV / 256)) % (int)gridDim.x, bxc = blockIdx.x;
            if (bxc >= first) {
                const float* ck = (kind == 0) ? IN(I_CKF) : (kind == 1) ? IN(I_CKW) : IN(I_CKD);
                const float* cv = (kind == 0) ? IN(I_CVF) : (kind == 1) ? IN(I_CVW) : IN(I_CVD);
                for (int it = (bxc - first) * NWAVES + wave; it < 2 * 8 * 128; it += ((int)gridDim.x - first) * NWAVES) {
                    const int p0 = (it & 127) * 4, b = (it >> 7) & 7, isv = it >> 10;
                    const float* src = (isv ? cv : ck) + ((size_t)(b * nslot + slot) * PAST + p0) * KVW + lane * 8;
                    bf16* dst = (isv ? VC : KC) + ((size_t)b * SKV + p0) * KVW + lane * 8;
                    f32x4 a[8];
#pragma unroll
                    for (int q = 0; q < 4; ++q) { a[2 * q] = *(const f32x4*)(src + q * KVW); a[2 * q + 1] = *(const f32x4*)(src + q * KVW + 4); }
#pragma unroll
                    for (int q = 0; q < 4; ++q) { v4u o; o.x = pkbf(a[2 * q].x, a[2 * q].y); o.y = pkbf(a[2 * q].z, a[2 * q].w); o.z = pkbf(a[2 * q + 1].x, a[2 * q + 1].y); o.w = pkbf(a[2 * q + 1].z, a[2 * q + 1].w); *(v4u*)(dst + q * KVW) = o; }
                } } } }
        xcd_barrier(bar);
        {
            LAYER_ENV
            const float* ck = (kind == 0) ? IN(I_CKF) : (kind == 1) ? IN(I_CKW) : IN(I_CKD);
            const float* cv = (kind == 0) ? IN(I_CVF) : (kind == 1) ? IN(I_CVW) : IN(I_CVD);
            float* const ok = out + ((kind == 0) ? O_KF : (kind == 1) ? O_KW : O_KD);
            float* const ov = out + ((kind == 0) ? O_VF : (kind == 1) ? O_VW : O_VD);
            const int l16 = lane & 15;
            f32x4 gq0, gq1, gk0, gk1;
            { const float* gqp = IN(I_GQF) + slot * 128 + l16 * 8; const float* gkp = IN(I_GKF) + slot * 128 + l16 * 8;
              gq0 = *(const f32x4*)gqp; gq1 = *(const f32x4*)(gqp + 4); gk0 = *(const f32x4*)gkp; gk1 = *(const f32x4*)(gkp + 4); }
            constexpr int LIM = TT;
#define POST_LOAD(ROW, W, CS) do { const int r_ = (ROW); \
        if (r_ < TT) { const bf16* rp_ = RAW + (size_t)r_ * NQKV + lane * 8; _Pragma("unroll") for (int q_ = 0; q_ < 2; ++q_) W[q_] = *(const v4u*)(rp_ + 2048 + q_ * 512); \
            if (r_ >= TP) { const int s_ = (r_ - TP) & (SS - 1); const int p_ = (lane & 8) ? (s_ & 63) : (s_ >> 6); const int i0_ = (lane & 3) * 8; \
                CS[0] = *(const f32x4*)(ropeC + p_ * 32 + i0_); CS[1] = *(const f32x4*)(ropeC + p_ * 32 + i0_ + 4); CS[2] = *(const f32x4*)(ropeS + p_ * 32 + i0_); CS[3] = *(const f32x4*)(ropeS + p_ * 32 + i0_ + 4); } } \
        else { const int ct_ = r_ - TT, isv_ = ct_ >> 12, rr_ = ct_ & 4095, b_ = rr_ >> 9, p_ = rr_ & 511; \
            const float* src_ = (isv_ ? cv : ck) + ((size_t)(b_ * nslot + slot) * PAST + p_) * KVW + lane * 8; W[0] = *(const v4u*)src_; W[1] = *(const v4u*)(src_ + 4); } } while (0)
#define POST_ROW(ROW, W, CS) do { const int row = (ROW); \
                if (row < TT) { \
                    const bool is_s = row >= TP; const int b = is_s ? (row - TP) >> 11 : row >> 8, s = is_s ? (row - TP) & (SS - 1) : row & (SP - 1); \
                    const float cs[8] = {CS[0].x, CS[0].y, CS[0].z, CS[0].w, CS[1].x, CS[1].y, CS[1].z, CS[1].w}; \
                    const float sn[8] = {CS[2].x, CS[2].y, CS[2].z, CS[2].w, CS[3].x, CS[3].y, CS[3].z, CS[3].w}; \
                    const size_t kvrow = is_s ? ((size_t)b * SKV + PAST + s) : (size_t)row; \
                    bf16* const kdst = (is_s ? KC : KP) + kvrow * KVW + lane * 8; \
                    bf16* const vdst = (is_s ? VC : VP) + kvrow * KVW + lane * 8; \
                    const size_t orow = ((size_t)(b * nslot + slot) * SP + s) * KVW + lane * 8; \
                    _Pragma("unroll") for (int step = 4; step < 6; ++step) {     \
                        const v4u w = W[step - 4]; \
                        float f[8] = {bf2f(w.x & 0xffffu), bf2f(w.x >> 16), bf2f(w.y & 0xffffu), bf2f(w.y >> 16), bf2f(w.z & 0xffffu), bf2f(w.z >> 16), bf2f(w.w & 0xffffu), bf2f(w.w >> 16)}; \
                        if (step < 5) { \
                            if (kind == 0) { float ss = 0.f; \
                                _Pragma("unroll") for (int j = 0; j < 8; ++j) ss += f[j] * f[j]; \
                                ss += __shfl_xor(ss, 1); ss += __shfl_xor(ss, 2); ss += __shfl_xor(ss, 4); ss += __shfl_xor(ss, 8); \
                                const float rstd = 1.0f / sqrtf(ss * (1.0f / 128.0f) + EPS); \
                                f[0] *= rstd * gk0.x; f[1] *= rstd * gk0.y; f[2] *= rstd * gk0.z; f[3] *= rstd * gk0.w; f[4] *= rstd * gk1.x; f[5] *= rstd * gk1.y; f[6] *= rstd * gk1.z; f[7] *= rstd * gk1.w; } \
                            if (is_s) { \
                                _Pragma("unroll") for (int j = 0; j < 8; ++j) { const float pf = __shfl_xor(f[j], 4); f[j] = (lane & 4) ? (pf * sn[j] + f[j] * cs[j]) : (f[j] * cs[j] - pf * sn[j]); } } \
                        } \
                        v4u o; o.x = pkbf(f[0], f[1]); o.y = pkbf(f[2], f[3]); o.z = pkbf(f[4], f[5]); o.w = pkbf(f[6], f[7]); \
                        *(v4u*)(step == 4 ? kdst : vdst) = o; \
                        if (!is_s) { float* op = (step == 4 ? ok : ov) + orow; *(f32x4*)op = (f32x4){f[0], f[1], f[2], f[3]}; *(f32x4*)(op + 4) = (f32x4){f[4], f[5], f[6], f[7]}; } \
                    } \
                } else { \
                    const int ct = row - TT, isv = ct >> 12, rr = ct & 4095, b = rr >> 9, p = rr & 511; \
                    const f32x4 a0 = __builtin_bit_cast(f32x4, W[0]), a1 = __builtin_bit_cast(f32x4, W[1]); \
                    v4u o; o.x = pkbf(a0.x, a0.y); o.y = pkbf(a0.z, a0.w); o.z = pkbf(a1.x, a1.y); o.w = pkbf(a1.z, a1.w); \
                    *(v4u*)((isv ? VC : KC) + ((size_t)b * SKV + p) * KVW + lane * 8) = o; \
                } } while (0)
            for (int q4 = gw; q4 < LIM / 4; q4 += NGW) {
                const int row0 = 4 * q4;
                v4u w0[2], w1[2], w2[2], w3[2]; f32x4 c0[4], c1[4], c2[4], c3[4];
#pragma unroll
                for (int q = 0; q < 4; ++q) { c0[q] = (f32x4){0.f, 0.f, 0.f, 0.f}; c1[q] = c0[q]; c2[q] = c0[q]; c3[q] = c0[q]; }
                POST_LOAD(row0, w0, c0); POST_LOAD(row0 + 1, w1, c1); POST_LOAD(row0 + 2, w2, c2); POST_LOAD(row0 + 3, w3, c3);
                POST_ROW(row0, w0, c0); POST_ROW(row0 + 1, w1, c1); POST_ROW(row0 + 2, w2, c2); POST_ROW(row0 + 3, w3, c3);
            }
#undef POST_ROW
#undef POST_LOAD
        }
        xcd_barrier(bar);
        {
            LAYER_ENV
            if (kind != 2) {
                const int nsamp = 1024, nprm = 512;
                for (int u = vcu; u < nsamp + nprm; u += G) {
                    const bf16 *Qp, *Kp_, *Vp_; bf16* Op; int nt, nfirst, skip = 0, qpos0 = 0; float sinkl2 = -1e30f; int b, h, qb;
                    bool hpair = false; float sinkB = -1e30f;
                    if (u < nsamp && kind == 1) {
                        hpair = true; qb = u & 15; const int hp = (u >> 4) & 7; h = 2 * hp; b = u >> 7; const size_t r0 = (size_t)TP + (size_t)b * SS + qb * 128;
                        Qp = RAW + r0 * NQKV + h * 128; Kp_ = KC + (size_t)b * SKV * KVW + (h >> 2) * 128; Vp_ = VC + (size_t)b * SKV * KVW + (h >> 2) * 128; Op = ATT + r0 * DM + h * 128;
                        qpos0 = qb * 128; const int bs = (qpos0 - 128) < 0 ? 0 : qpos0 - 128, be = (qpos0 + 256) > SS ? SS : qpos0 + 256; nfirst = PAST / 64; nt = nfirst + (be - bs) / 64; skip = bs;
                        sinkB = IN(I_SINKW)[h + 1] * 1.4426950408889634f; }
                    else
                    if (u < nsamp) { qb = u & 7; h = (u >> 3) & 15; b = u >> 7; const size_t r0 = (size_t)TP + (size_t)b * SS + qb * 256;
                        Qp = RAW + r0 * NQKV + h * 128; Kp_ = KC + (size_t)b * SKV * KVW + (h >> 2) * 128; Vp_ = VC + (size_t)b * SKV * KVW + (h >> 2) * 128; Op = ATT + r0 * DM + h * 128;
                        nt = SKV / 64; nfirst = nt; qpos0 = qb * 256; }
                    else { const int v = u - nsamp; h = v & 15; b = v >> 4; const size_t r0 = (size_t)b * SP;
                        Qp = RAW + r0 * NQKV + h * 128; Kp_ = KP + r0 * KVW + (h >> 2) * 128; Vp_ = VP + r0 * KVW + (h >> 2) * 128; Op = ATT + r0 * DM + h * 128; nt = SP / 64; nfirst = nt; }
                    if (kind == 1) sinkl2 = IN(I_SINKW)[h] * 1.4426950408889634f;
                    __syncthreads();
#if ATT_DMA_ALL == 6
                    att::attn_unit_g(Qp, Kp_, Vp_, Op, NQKV, KVW, DM, nt, nfirst, skip, qpos0, sinkl2, (LAS char*)lds, (LAS float*)(lds + LDSCTL_OFF + 1024) + wave * 64,
                                        (kind == 0 ? 1 : 0) | (u < nsamp ? 2 : 0) | (hpair ? 4 : 0), sinkB, IN(I_GQF) + slot * 128, ropeC, ropeS);
#elif ATT_DMA_ALL == 5
                    att::attn_unit_pp(Qp, Kp_, Vp_, Op, NQKV, KVW, DM, nt, nfirst, skip, qpos0, sinkl2, (LAS char*)lds, (LAS float*)(lds + LDSCTL_OFF + 1024) + wave * 64,
                                        (kind == 0 ? 1 : 0) | (u < nsamp ? 2 : 0), IN(I_GQF) + slot * 128, ropeC, ropeS);
#elif ATT_DMA_ALL == 2
                    att::attn_unit_dma2(Qp, Kp_, Vp_, Op, NQKV, KVW, DM, nt, nfirst, skip, qpos0, sinkl2, (LAS char*)lds, (LAS float*)(lds + LDSCTL_OFF + 1024) + wave * 64,
                                        (kind == 0 ? 1 : 0) | (u < nsamp ? 2 : 0), IN(I_GQF) + slot * 128, ropeC, ropeS);
#elif ATT_DMA_ALL
                    att::attn_unit_dma<4>(Qp, Kp_, Vp_, Op, NQKV, KVW, DM, nt, nfirst, skip, qpos0, sinkl2, (LAS char*)lds, (LAS float*)(lds + LDSCTL_OFF + 1024) + wave * 64,
                                          (kind == 0 ? 1 : 0) | (u < nsamp ? 2 : 0), IN(I_GQF) + slot * 128, ropeC, ropeS);
#else
                    att::attn_unit(Qp, Kp_, Vp_, Op, NQKV, KVW, DM, nt, nfirst, skip, qpos0, sinkl2, (LAS char*)lds, (kind == 0 ? 1 : 0) | (u < nsamp ? 2 : 0), IN(I_GQF) + slot * 128, ropeC, ropeS);
#endif
                }
            } else {
                const int nsamp = 1024, nprm = 512;
                for (int u = vcu; u < nsamp + nprm; u += G) {
                    int b, g, kvv, nt, qpos0 = 0; size_t r0; const bf16 *kbase, *vbase;
                    if (u < nsamp) { const int qb = u & 7; g = (u >> 3) & 3; kvv = (u >> 5) & 3; b = u >> 7; r0 = (size_t)TP + (size_t)b * SS + qb * 256; kbase = KC + (size_t)b * SKV * KVW; vbase = VC + (size_t)b * SKV * KVW; nt = SKV / 64; qpos0 = qb * 256; }
                    else { const int v = u - nsamp; g = v & 3; kvv = (v >> 2) & 3; b = v >> 4; r0 = (size_t)b * SP; kbase = KP + r0 * KVW; vbase = VP + r0 * KVW; nt = SP / 64; }
                    const int kv = kvv >> 1, m = kvv & 1, hv = ((kv * 4 + g) << 1) | m;
                    __syncthreads();
#if ATT_DIFF_PIPE
                    att::attn_unit_diff2(RAW + r0 * NQKV + hv * 128, kbase + kvv * 128, vbase + kv * 256, ADIF + r0 * 4096 + hv * 256, NQKV, KVW, 4096, nt, qpos0,
                                         (LAS char*)lds, (LAS float*)(lds + LDSCTL_OFF + 1024) + wave * 64, (u < nsamp ? 2 : 0), ropeC, ropeS);
#else
                    att::attn_unit_dma<8>(RAW + r0 * NQKV + hv * 128, kbase + kvv * 128, vbase + kv * 256, ADIF + r0 * 4096 + hv * 256, NQKV, KVW, 4096, nt, nt, 0, qpos0, -1e30f,
                                          (LAS char*)lds, (LAS float*)(lds + LDSCTL_OFF + 1024) + wave * 64, (u < nsamp ? 2 : 0), IN(I_GQF), ropeC, ropeS);
#endif
                }
            }
        }
        xcd_barrier(bar);
        if (kind == 2) { LAYER_ENV
            float d1 = IN(I_LQ1)[lane] * IN(I_LK1)[lane] + IN(I_LQ1)[lane + 64] * IN(I_LK1)[lane + 64];
            float d2 = IN(I_LQ2)[lane] * IN(I_LK2)[lane] + IN(I_LQ2)[lane + 64] * IN(I_LK2)[lane + 64];
            const float lam = expf(wave_sum(d1)) - expf(wave_sum(d2)) + LAM_INIT2;
            const f32x4 gs = *(const f32x4*)(IN(I_GSUB) + lane * 4) * (1.0f - LAM_INIT2);
            for (int row0 = 2 * gw; row0 < TT; row0 += 2 * NGW) {
                v2u la0[8], lc0[8], la1[8], lc1[8];
#pragma unroll
                for (int h = 0; h < 8; ++h) {
                    la0[h] = __builtin_nontemporal_load((const v2u*)(ADIF + (size_t)row0 * 4096 + (2 * h) * 256 + lane * 4)); lc0[h] = __builtin_nontemporal_load((const v2u*)(ADIF + (size_t)row0 * 4096 + (2 * h + 1) * 256 + lane * 4));
                    la1[h] = __builtin_nontemporal_load((const v2u*)(ADIF + (size_t)(row0 + 1) * 4096 + (2 * h) * 256 + lane * 4)); lc1[h] = __builtin_nontemporal_load((const v2u*)(ADIF + (size_t)(row0 + 1) * 4096 + (2 * h + 1) * 256 + lane * 4));
                }
#pragma unroll
                for (int rr = 0; rr < 2; ++rr)
#pragma unroll
                for (int h = 0; h < 8; ++h) {
                    const int row = row0 + rr;
                    const v2u a = rr ? la1[h] : la0[h], c = rr ? lc1[h] : lc0[h];
                    f32x4 o = (f32x4){bf2f(a.x & 0xffffu), bf2f(a.x >> 16), bf2f(a.y & 0xffffu), bf2f(a.y >> 16)} - lam * (f32x4){bf2f(c.x & 0xffffu), bf2f(c.x >> 16), bf2f(c.y & 0xffffu), bf2f(c.y >> 16)};
                    const float ss = wave_sum((o.x * o.x + o.y * o.y) + (o.z * o.z + o.w * o.w));
                    o = o * (1.0f / sqrtf(ss * (1.0f / 256.0f) + EPS)) * gs;
                    v2u w; w.x = pkbf(o.x, o.y); w.y = pkbf(o.z, o.w); *(v2u*)(ATT + (size_t)row * DM + h * 256 + lane * 4) = w;
                }
            }
            xcd_barrier(bar);
        }
        { LAYER_ENV pg8::Gemm g{ATT, (const bf16*)(wl + W_O), TT, DM, DM}; pg8::StaticOrder S; S.init(TT, DM, G, bx);
          pg8::EpiStore E{MF, DM};
          pg8::gemm_phase<pg8::EpiStore, pg8::StaticOrder, true, true>(lds, g, S, E); }
        xcd_barrier(bar);
        { LAYER_ENV const float* const xp_ = (L == 0) ? IN(I_XP) : (const float*)out; const float* const xs_ = (L == 0) ? IN(I_XS) : (const float*)(out + O_YS);
          if (X_IS_BF16 && L != 0) THIN_PHASE_DMA(true, vecL + 2 * 9 * DM, true, vecL + 3 * 9 * DM, vecL + 4 * 9 * DM);
          else THIN_PHASE(xp_, xs_, false, (X_IS_BF16 != 0), true, vecL + 2 * 9 * DM, true, vecL + 3 * 9 * DM, vecL + 4 * 9 * DM); }
        xcd_barrier(bar);
        { LAYER_ENV pg8::Gemm g{H, (const bf16*)(wl + W_GU), TT, NGU, DM}; pg8::StaticOrder S; S.init(TT, NGU, G, bx);
          pg8::EpiSwiglu E{ACT, FF};
          pg8::gemm_phase<pg8::EpiSwiglu, pg8::StaticOrder, true, true>(lds, g, S, E); }
        xcd_barrier(bar);
        { LAYER_ENV pg8::Gemm g{ACT, (const bf16*)(wl + W_D), TT, DM, FF}; pg8::StaticOrder S; S.init(TT, DM, G, bx); S.rev = 1;
          pg8::EpiStore E{MF, DM};
          pg8::gemm_phase<pg8::EpiStore, pg8::StaticOrder, true, true>(lds, g, S, E); }
        xcd_barrier(bar);
        { LAYER_ENV const float* vecN = VEC + (size_t)(L < 3 ? L + 1 : L) * 6 * 9 * DM; const bool hout = L < 3;
          if (X_IS_BF16 && hout) THIN_PHASE_DMA(true, vecL + 5 * 9 * DM, true, vecN + 0 * 9 * DM, vecN + 1 * 9 * DM);
          else THIN_PHASE(out, out + O_YS, (X_IS_BF16 != 0), false, true, vecL + 5 * 9 * DM, hout, vecN + 0 * 9 * DM, vecN + 1 * 9 * DM); }
        if (L < 3) xcd_barrier(bar);
    }
#undef THIN_PHASE
#undef THIN_LOADX
#undef THIN_ROW
#undef THIN_PHASE_DMA
#undef THIN_DMA_ISSUE
#undef BF8_TO_F
#undef LAYER_ENV
}

extern "C" void kernel_launch(void* const* d_in, const int* in_sizes, int n_in, void* d_out, int out_size, void* d_ws, size_t ws_size, hipStream_t stream) {
    static int grid = 0;
    if (grid == 0) {
        if (n_in != N_IN || (size_t)out_size != O_END || ws_size < WS_END) { fprintf(stderr, "kernel_launch: shape mismatch: n_in %d out %d ws %zu\n", n_in, out_size, ws_size); grid = -1; return; }
        int dev = 0, cus = 0, per_cu = 0;
        if (hipGetDevice(&dev) != hipSuccess || hipDeviceGetAttribute(&cus, hipDeviceAttributeMultiprocessorCount, dev) != hipSuccess) { grid = -1; return; }
        if (hipFuncSetAttribute((const void*)trunk_fwd, hipFuncAttributeMaxDynamicSharedMemorySize, LDS_BYTES) != hipSuccess) { fprintf(stderr, "kernel_launch: hipFuncSetAttribute failed\n"); grid = -1; return; }
        if (hipOccupancyMaxActiveBlocksPerMultiprocessor(&per_cu, (const void*)trunk_fwd, NWAVES * 64, LDS_BYTES) != hipSuccess || per_cu < 1)
            fprintf(stderr, "kernel_launch: note: occupancy query reports %d workgroups per CU\n", per_cu);
        (void)hipGetLastError();
        grid = cus;
    }
    if (grid < 0) return;
    if (hipMemsetAsync((char*)d_ws + WS_CTL, 0, CTL_ZERO_BYTES, stream) != hipSuccess) { fprintf(stderr, "kernel_launch: memset failed\n"); return; }
    Args a{};
    for (int i = 0; i < N_IN; ++i) a.in[i] = (const float*)d_in[i];
    a.out = (float*)d_out; a.ws = (unsigned char*)d_ws;
    hipLaunchKernelGGL(trunk_fwd, dim3(grid), dim3(NWAVES * 64), LDS_BYTES, stream, a);
    const hipError_t le = hipPeekAtLastError();
    if (le != hipSuccess) fprintf(stderr, "kernel_launch: launch failed: %s\n", hipGetErrorName(le));
}
```

```cpp
#include <hip/hip_runtime.h>
#include <cstdio>
#include <cstdint>
#define TIDTAB_LDS_ADDR (131072 + 3072)
__device__ __forceinline__ int tid_now() {
    const unsigned slot = (unsigned)__builtin_amdgcn_s_getreg((5 << 11) | 4) & 63u;
    const unsigned w = *(const volatile __attribute__((address_space(3))) unsigned*)(unsigned long)(TIDTAB_LDS_ADDR + slot * 4);
    unsigned ln; asm volatile("v_mbcnt_lo_u32_b32 %0, -1, 0\n\tv_mbcnt_hi_u32_b32 %0, -1, %0" : "=v"(ln));
    return (int)(__builtin_amdgcn_readfirstlane(w) * 64u + ln);
}
namespace pg8 {
#define PG8_LAS __attribute__((address_space(3)))
typedef unsigned short bf16_t;
typedef short bf16x8 __attribute__((ext_vector_type(8)));
typedef float f32x4 __attribute__((ext_vector_type(4)));
typedef unsigned u32x4 __attribute__((ext_vector_type(4)));
constexpr int BM = 256, BK = 64, HALF = 128, HTB = HALF * BK * 2  , STAGE_BYTES = 8 * HTB, NXCD = 8, WGM = 8;

__host__ __device__ __forceinline__ int lds_byte(int r, int c) { const int st = (r >> 4) * 2 + (c >> 5), rr = r & 15, cc = c & 31, ob = rr * 64 + cc * 2; return st * 1024 + (ob ^ (((ob >> 9) & 1) << 5)); }
__host__ __device__ __forceinline__ void stage_rc(int b, int& R, int& C) { const int st = b / 1024, sb = b % 1024, swz = sb ^ (((sb >> 9) & 1) << 5); R = (st >> 1) * 16 + swz / 64; C = (st & 1) * 32 + (swz % 64) / 2; }
__host__ __device__ __forceinline__ int perm32(int rho) { const int n = rho >> 4, i = rho & 15; return 8 * (i >> 2) + 4 * n + (i & 3); }

struct Unit { int pm, pn; };
struct Gemm { const bf16_t* A; const bf16_t* Bt; int M, N, K; };

struct StaticOrder {
    int nM, nN, nwg, G, c, rev;
    __host__ __device__ void init(int M, int N, int G_, int c_) { nM = M / BM; nN = N / BM; nwg = nM * nN; G = G_; c = c_; rev = 0; }
    __host__ __device__ bool next(int i, Unit& u) const {
        const long L = (long)i * G + c; if (L >= nwg) return false;
        int wgid = (int)L; { const int q = nwg / NXCD, r = nwg % NXCD, xcd = wgid % NXCD, off = wgid / NXCD; wgid = (xcd < r ? xcd * (q + 1) : r * (q + 1) + (xcd - r) * q) + (rev ? (xcd < r ? q : q - 1) - off : off); }
        const int nig = WGM * nN, gid = wgid / nig, fm = gid * WGM, gsz = (nM - fm) < WGM ? (nM - fm) : WGM;
        u.pm = fm + ((wgid % nig) % gsz); u.pn = (wgid % nig) / gsz; return true;
    }
    __device__ __forceinline__ void a_ready(const Unit&) const {}
    __device__ __forceinline__ void done(const Unit&) const {}
};

__device__ __forceinline__ unsigned cvt_pk_bf16(float lo, float hi) { unsigned r; asm volatile("v_cvt_pk_bf16_f32 %0, %1, %2" : "=v"(r) : "v"(lo), "v"(hi)); return r; }

struct EpiStore {
    static constexpr bool PERM = true, AFTER_DRAIN = false;
    bf16_t* O; int ldc;
    __device__ __forceinline__ static unsigned ror8(unsigned v) { return (unsigned)__builtin_amdgcn_update_dpp(0, (int)v, 0x128, 0xf, 0xf, false); }
    __device__ __forceinline__ void operator()(const f32x4 (&acc)[2][2][4][2], const Unit& u, int wr, int wc, int fr, int fq) const {
        const bool lo = fr < 8;
        const int row0 = u.pm * BM + wr * 64 + (fr & 7), col0 = u.pn * BM + wc * 64 + 8 * fq + (lo ? 0 : 32);
#pragma unroll
        for (int ai = 0; ai < 2; ++ai)
#pragma unroll
            for (int m = 0; m < 4; ++m) { bf16_t* rowp = O + (size_t)(row0 + ai * HALF + m * 16) * ldc + col0;
                u32x4 A, B;
                { const f32x4 v0 = acc[ai][0][m][0], v1 = acc[ai][0][m][1]; A.x = cvt_pk_bf16(v0[0], v0[1]); A.y = cvt_pk_bf16(v0[2], v0[3]); A.z = cvt_pk_bf16(v1[0], v1[1]); A.w = cvt_pk_bf16(v1[2], v1[3]); }
                { const f32x4 v0 = acc[ai][1][m][0], v1 = acc[ai][1][m][1]; B.x = cvt_pk_bf16(v0[0], v0[1]); B.y = cvt_pk_bf16(v0[2], v0[3]); B.z = cvt_pk_bf16(v1[0], v1[1]); B.w = cvt_pk_bf16(v1[2], v1[3]); }
                u32x4 R; R.x = ror8(lo ? B.x : A.x); R.y = ror8(lo ? B.y : A.y); R.z = ror8(lo ? B.z : A.z); R.w = ror8(lo ? B.w : A.w);
                u32x4 w1, w2; w1.x = lo ? A.x : R.x; w1.y = lo ? A.y : R.y; w1.z = lo ? A.z : R.z; w1.w = lo ? A.w : R.w;
                w2.x = lo ? R.x : B.x; w2.y = lo ? R.y : B.y; w2.z = lo ? R.z : B.z; w2.w = lo ? R.w : B.w;
                *(u32x4*)rowp = w1; *(u32x4*)(rowp + (size_t)8 * ldc) = w2; }
    }
};
struct EpiSwiglu {
    static constexpr bool PERM = true, AFTER_DRAIN = false;
    bf16_t* O; int ldc;
    __device__ __forceinline__ static float swi(float g, float u) { const float e = __builtin_amdgcn_exp2f(g * -1.4426950408889634f); return g * u * __builtin_amdgcn_rcpf(1.0f + e); }
    __device__ __forceinline__ void operator()(const f32x4 (&acc)[2][2][4][2], const Unit& u, int wr, int wc, int fr, int fq) const {
        const int row0 = u.pm * BM + wr * 64 + fr, col0 = u.pn * HALF + wc * 32 + 8 * fq;
#pragma unroll
        for (int ai = 0; ai < 2; ++ai)
#pragma unroll
            for (int m = 0; m < 4; ++m) { bf16_t* rowp = O + (size_t)(row0 + ai * HALF + m * 16) * ldc + col0;
                const f32x4 g0 = acc[ai][0][m][0], g1 = acc[ai][0][m][1], u0 = acc[ai][1][m][0], u1 = acc[ai][1][m][1];
                u32x4 w; w.x = cvt_pk_bf16(swi(g0[0], u0[0]), swi(g0[1], u0[1])); w.y = cvt_pk_bf16(swi(g0[2], u0[2]), swi(g0[3], u0[3]));
                w.z = cvt_pk_bf16(swi(g1[0], u1[0]), swi(g1[1], u1[1])); w.w = cvt_pk_bf16(swi(g1[2], u1[2]), swi(g1[3], u1[3]));
                *(u32x4*)rowp = w; }
    }
};

template <class Epi, class Sched, bool ALIGN_EPI = false, bool SP2 = false>
__device__ __forceinline__ void gemm_phase(PG8_LAS unsigned char* lds, const Gemm g, const Sched& S, const Epi& E) {
    int tid_l = tid_now(); asm volatile("" : "+v"(tid_l));
    const int tid = tid_l, wid = __builtin_amdgcn_readfirstlane(tid >> 6), lane = tid & 63, wr = wid >> 2, wc = wid & 3, fr = lane & 15, fq = lane >> 4;
    const int K = g.K, nt = K / BK;
    unsigned voffA[2], voffB[2];
#pragma unroll
    for (int i = 0; i < 2; ++i) { int R, C; stage_rc(tid * 16 + i * 8192, R, C); const int Rb = Epi::PERM ? (64 * (R >> 5) + perm32(R & 31)) : R;
        voffA[i] = (unsigned)(R * K + C) * 2u; voffB[i] = (unsigned)(Rb * K + C) * 2u; }
    const size_t kstep = (size_t)(BK * 2);
    const size_t hstep = (size_t)HALF * K * 2;
    const size_t tstep = 2 * hstep;
    const size_t hstepB = Epi::PERM ? (size_t)32 * K * 2 : hstep;
    const unsigned ldsw = (unsigned)wid * 1024u;
    const int aoff = lds_byte(wr * 64 + fr, fq * 8), boff = lds_byte(wc * 32 + fr, fq * 8);
#define PG8_SA(b, h) (((b) * 2 + (h)) * HTB)
#define PG8_SB(b, h) ((4 + (b) * 2 + (h)) * HTB)
    const __amdgpu_buffer_rsrc_t rs_voffA = __builtin_amdgcn_make_buffer_rsrc((void*)g.A, 0, 0x7ffffffe, 0x00020000), rs_voffB = __builtin_amdgcn_make_buffer_rsrc((void*)g.Bt, 0, 0x7ffffffe, 0x00020000);
    const char* const base_voffA = (const char*)g.A; const char* const base_voffB = (const char*)g.Bt;
#define PG8_STAGE(bufoff, gbase, voff) do { const int so_ = (int)((const char*)(gbase) - base_##voff); _Pragma("unroll") for (int _i = 0; _i < 2; ++_i) \
        __builtin_amdgcn_raw_ptr_buffer_load_lds(rs_##voff, (PG8_LAS void*)(lds + (bufoff) + ldsw + _i * 8192), 16, (int)(voff)[_i], so_, 0, 0); } while (0)
#define PG8_LDA(dst, b, h) do { _Pragma("unroll") for (int m = 0; m < 4; ++m) _Pragma("unroll") for (int k = 0; k < 2; ++k) dst[m][k] = *(const PG8_LAS bf16x8*)(lds + PG8_SA(b, h) + aoff + m * 2048 + k * 1024); } while (0)
#define PG8_LDB(dst, b, h) do { _Pragma("unroll") for (int n = 0; n < 2; ++n) _Pragma("unroll") for (int k = 0; k < 2; ++k) dst[n][k] = *(const PG8_LAS bf16x8*)(lds + PG8_SB(b, h) + boff + n * 2048 + k * 1024); } while (0)
#define PG8_MMA(ai, bj, At, Bt) do { __builtin_amdgcn_s_setprio(1); _Pragma("unroll") for (int m = 0; m < 4; ++m) _Pragma("unroll") for (int n = 0; n < 2; ++n) _Pragma("unroll") for (int k = 0; k < 2; ++k) \
        acc[ai][bj][m][n] = __builtin_amdgcn_mfma_f32_16x16x32_bf16(Bt[n][k], At[m][k], acc[ai][bj][m][n], 0, 0, 0); __builtin_amdgcn_s_setprio(0); } while (0)
#define PG8_WAIT_V(n) asm volatile("s_waitcnt vmcnt(" #n ")" ::: "memory")
#define PG8_WAIT_L(n) asm volatile("s_waitcnt lgkmcnt(" #n ")" ::: "memory")
#define PG8_BAR __builtin_amdgcn_s_barrier()
#define PG8_SCHED __builtin_amdgcn_sched_barrier(0)
    Unit cur, nxt; int ui = 0;
    if (!S.next(0, cur)) return;
    f32x4 acc[2][2][4][2];
#pragma unroll
    for (int a = 0; a < 2; ++a)
#pragma unroll
        for (int b = 0; b < 2; ++b)
#pragma unroll
            for (int m = 0; m < 4; ++m)
#pragma unroll
                for (int n = 0; n < 2; ++n) acc[a][b][m][n] = (f32x4){0.f, 0.f, 0.f, 0.f};
    bf16x8 At[4][2], B0[2][2], B1[2][2];
    const char* cA = (const char*)g.A + (size_t)cur.pm * tstep; const char* cB = (const char*)g.Bt + (size_t)cur.pn * tstep;
    S.a_ready(cur);
    if constexpr (SP2) {
        PG8_STAGE(PG8_SB(0, 0), cB, voffB); PG8_STAGE(PG8_SB(0, 1), cB + hstepB, voffB); PG8_STAGE(PG8_SA(0, 0), cA, voffA); PG8_STAGE(PG8_SA(0, 1), cA + hstep, voffA);
        if (wr == 1) PG8_BAR;
        PG8_WAIT_V(2); PG8_BAR;
        PG8_STAGE(PG8_SB(1, 0), cB + kstep, voffB); PG8_STAGE(PG8_SA(1, 0), cA + kstep, voffA); PG8_STAGE(PG8_SB(1, 1), cB + hstepB + kstep, voffB);
        PG8_WAIT_V(6); PG8_BAR;
    } else {
        PG8_STAGE(PG8_SB(0, 0), cB, voffB); PG8_STAGE(PG8_SA(0, 0), cA, voffA); PG8_STAGE(PG8_SB(0, 1), cB + hstepB, voffB); PG8_STAGE(PG8_SA(0, 1), cA + hstep, voffA);
        if (wr == 1) PG8_BAR;
        PG8_WAIT_V(4); PG8_BAR;
        PG8_STAGE(PG8_SB(1, 0), cB + kstep, voffB); PG8_STAGE(PG8_SA(1, 0), cA + kstep, voffA); PG8_STAGE(PG8_SB(1, 1), cB + hstepB + kstep, voffB);
        PG8_WAIT_V(6); PG8_BAR;
    }
    for (;;) {
        const bool has_next = S.next(ui + 1, nxt);
        const char* nA = has_next ? (const char*)g.A + (size_t)nxt.pm * tstep : cA; const char* nB = has_next ? (const char*)g.Bt + (size_t)nxt.pn * tstep : cB;
        for (int t = 0; t < nt; t += 2) {
            const bool last = (t == nt - 2);
            const char* a1 = cA + (size_t)(t + 1) * kstep;
            const char* a2 = last ? nA : cA + (size_t)(t + 2) * kstep; const char* b2 = last ? nB : cB + (size_t)(t + 2) * kstep;
            const char* a3 = a2 + kstep; const char* b3 = b2 + kstep;
            if (last && has_next) S.a_ready(nxt);
            if constexpr (SP2) {
            PG8_LDB(B0, 0, 0); PG8_LDB(B1, 0, 1); PG8_SCHED; PG8_LDA(At, 0, 0); PG8_STAGE(PG8_SA(1, 1), a1 + hstep, voffA);
            PG8_WAIT_V(8); PG8_WAIT_L(0); PG8_BAR; PG8_MMA(0, 0, At, B0); PG8_MMA(0, 1, At, B1); PG8_BAR; PG8_SCHED;
            PG8_LDA(At, 0, 1); PG8_STAGE(PG8_SB(0, 0), b2, voffB); PG8_STAGE(PG8_SB(0, 1), b2 + hstepB, voffB); PG8_STAGE(PG8_SA(0, 0), a2, voffA);
            PG8_WAIT_V(8); PG8_WAIT_L(0); PG8_BAR; PG8_MMA(1, 0, At, B0); PG8_MMA(1, 1, At, B1); PG8_BAR; PG8_SCHED;
            PG8_LDB(B0, 1, 0); PG8_LDB(B1, 1, 1); PG8_SCHED; PG8_LDA(At, 1, 0); PG8_STAGE(PG8_SA(0, 1), a2 + hstep, voffA);
            PG8_WAIT_V(8); PG8_WAIT_L(0); PG8_BAR; PG8_MMA(0, 0, At, B0); PG8_MMA(0, 1, At, B1); PG8_BAR; PG8_SCHED;
            PG8_LDA(At, 1, 1); PG8_STAGE(PG8_SB(1, 0), b3, voffB); PG8_STAGE(PG8_SB(1, 1), b3 + hstepB, voffB); PG8_STAGE(PG8_SA(1, 0), a3, voffA);
            PG8_WAIT_V(8); PG8_WAIT_L(0); PG8_BAR; PG8_MMA(1, 0, At, B0); PG8_MMA(1, 1, At, B1); PG8_BAR; PG8_SCHED;
            } else {
            PG8_LDB(B0, 0, 0); PG8_SCHED; PG8_LDA(At, 0, 0); PG8_STAGE(PG8_SA(1, 1), a1 + hstep, voffA);
            PG8_WAIT_L(8); PG8_BAR; PG8_WAIT_L(0); PG8_MMA(0, 0, At, B0); PG8_BAR; PG8_SCHED;
            PG8_LDB(B1, 0, 1); PG8_STAGE(PG8_SB(0, 0), b2, voffB);
            PG8_BAR; PG8_WAIT_L(0); PG8_MMA(0, 1, At, B1); PG8_BAR;
            PG8_LDA(At, 0, 1); PG8_STAGE(PG8_SA(0, 0), a2, voffA);
            PG8_BAR; PG8_WAIT_L(0); PG8_MMA(1, 0, At, B0); PG8_BAR; PG8_SCHED;
            PG8_STAGE(PG8_SB(0, 1), b2 + hstepB, voffB);
            PG8_WAIT_V(6); PG8_BAR; PG8_MMA(1, 1, At, B1); PG8_BAR;
            PG8_LDB(B0, 1, 0); PG8_SCHED; PG8_LDA(At, 1, 0); PG8_STAGE(PG8_SA(0, 1), a2 + hstep, voffA);
            PG8_WAIT_L(8); PG8_BAR; PG8_WAIT_L(0); PG8_MMA(0, 0, At, B0); PG8_BAR; PG8_SCHED;
            PG8_LDB(B1, 1, 1); PG8_STAGE(PG8_SB(1, 0), b3, voffB);
            PG8_BAR; PG8_WAIT_L(0); PG8_MMA(0, 1, At, B1); PG8_BAR;
            PG8_LDA(At, 1, 1); PG8_STAGE(PG8_SA(1, 0), a3, voffA);
            PG8_BAR; PG8_WAIT_L(0); PG8_MMA(1, 0, At, B0); PG8_BAR; PG8_SCHED;
            PG8_STAGE(PG8_SB(1, 1), b3 + hstepB, voffB);
            PG8_WAIT_V(6); PG8_BAR; PG8_MMA(1, 1, At, B1); PG8_BAR;
            }
        }
        if constexpr (ALIGN_EPI) { if (wr == 0) PG8_BAR; }
        if constexpr (!Epi::AFTER_DRAIN) { E(acc, cur, wr, wc, fr, fq); S.done(cur); }
        if (!has_next) break;
#pragma unroll
        for (int a = 0; a < 2; ++a)
#pragma unroll
            for (int b = 0; b < 2; ++b)
#pragma unroll
                for (int m = 0; m < 4; ++m)
#pragma unroll
                    for (int n = 0; n < 2; ++n) acc[a][b][m][n] = (f32x4){0.f, 0.f, 0.f, 0.f};
        cur = nxt; cA = nA; cB = nB; ++ui;
        if constexpr (ALIGN_EPI) { if (wr == 1) PG8_BAR; }
    }
    PG8_WAIT_V(0);
    if constexpr (!ALIGN_EPI) { if (wr == 0) PG8_BAR; }
    PG8_BAR;
    if constexpr (Epi::AFTER_DRAIN) { E.fused(acc, cur, wr, wc, fr, fq, lds, wid, lane); S.done(cur); }
#undef PG8_SA
#undef PG8_SB
#undef PG8_STAGE
#undef PG8_LDA
#undef PG8_LDB
#undef PG8_MMA
#undef PG8_WAIT_V
#undef PG8_WAIT_L
#undef PG8_BAR
#undef PG8_SCHED
}
}

namespace att {
#define ALAS __attribute__((address_space(3)))
typedef unsigned short bf16_t;
using bf16x8 = __attribute__((ext_vector_type(8))) short;
using s16x4  = __attribute__((ext_vector_type(4))) short;
using f32x16 = __attribute__((ext_vector_type(16))) float;
using u32x4  = __attribute__((ext_vector_type(4))) unsigned;
constexpr int   D = 128, NW = 8, QBLK = 32, KVBLK = 64;
constexpr float SCALE = 0.088388347648318440f;
constexpr float THR = 8.f;
constexpr int SHM_V = KVBLK * D * 2, SHM_K = KVBLK * D * 2, SHM_ATTN = 2 * SHM_V + 2 * SHM_K + NW * 64 * 4;
#define KSWZ(row, colB) ((row) * 256 + ((colB) ^ (((row) & 7) << 4)))
#define SBAR() __builtin_amdgcn_sched_barrier(0)
__device__ __forceinline__ int crow(int r, int hi) { return (r & 3) + 8 * (r >> 2) + 4 * hi; }
__device__ __forceinline__ unsigned cvtpk(float lo, float hi) { unsigned r; asm volatile("v_cvt_pk_bf16_f32 %0, %1, %2" : "=v"(r) : "v"(lo), "v"(hi)); return r; }

__device__ __forceinline__ void partialSM(f32x16& p0, f32x16& p1, float& m_reg, float& mn, float& alpha) {
  constexpr float C = SCALE * 1.4426950408889634f;
  float pmax = p0[0];
#pragma unroll
  for (int r = 1; r < 16; ++r) pmax = fmaxf(pmax, p0[r]);
#pragma unroll
  for (int r = 0; r < 16; ++r) pmax = fmaxf(pmax, p1[r]);
  { auto rr = __builtin_amdgcn_permlane32_swap(__float_as_uint(pmax), __float_as_uint(pmax), false, false);
    pmax = fmaxf(__uint_as_float(rr[0]), __uint_as_float(rr[1])); }
  if (__builtin_expect(__all(pmax - m_reg <= THR / SCALE), 1)) { mn = m_reg; alpha = 1.f; }
  else { mn = fmaxf(m_reg, pmax); alpha = __builtin_amdgcn_exp2f((m_reg - mn) * C); m_reg = mn; }
  float mnC = -mn * C;
#pragma unroll
  for (int r = 0; r < 16; ++r) p0[r] = fmaf(p0[r], C, mnC);
#pragma unroll
  for (int r = 0; r < 16; ++r) p1[r] = fmaf(p1[r], C, mnC);
#pragma unroll
  for (int r = 0; r < 16; ++r) p0[r] = __builtin_amdgcn_exp2f(p0[r]);
}
__device__ __forceinline__ void finishSM(f32x16& p0, f32x16& p1, float alpha, float& l_reg, bf16x8& pa0, bf16x8& pa1, bf16x8& pa2, bf16x8& pa3) {
#pragma unroll
  for (int r = 0; r < 16; ++r) p1[r] = __builtin_amdgcn_exp2f(p1[r]);
  float ps = 0;
#pragma unroll
  for (int r = 0; r < 16; ++r) ps += p0[r];
#pragma unroll
  for (int r = 0; r < 16; ++r) ps += p1[r];
  { auto rr = __builtin_amdgcn_permlane32_swap(__float_as_uint(ps), __float_as_uint(ps), false, false);
    ps = __uint_as_float(rr[0]) + __uint_as_float(rr[1]); }
  l_reg = l_reg * alpha + ps;
#define PK4(P, BASE, OUT) do { unsigned a0 = cvtpk(P[BASE + 0], P[BASE + 1]), a1 = cvtpk(P[BASE + 2], P[BASE + 3]);   \
    unsigned b0 = cvtpk(P[BASE + 4], P[BASE + 5]), b1 = cvtpk(P[BASE + 6], P[BASE + 7]);                              \
    auto r0 = __builtin_amdgcn_permlane32_swap(a0, b0, false, false); auto r1 = __builtin_amdgcn_permlane32_swap(a1, b1, false, false); \
    u32x4 w = {r0[0], r1[0], r0[1], r1[1]}; OUT = *reinterpret_cast<bf16x8*>(&w); } while (0)
  PK4(p0, 0, pa0); PK4(p0, 8, pa1); PK4(p1, 0, pa2); PK4(p1, 8, pa3);
#undef PK4
}
__device__ __forceinline__ void qkt(f32x16& p0, f32x16& p1, const ALAS char* Ks, const bf16x8* qr, int r32, int hi) {
  p0 = f32x16{}; p1 = f32x16{};
#pragma unroll
  for (int d0 = 0; d0 < 8; ++d0) { int cb = (d0 * 16 + hi * 8) * 2;
    bf16x8 b0 = *reinterpret_cast<const ALAS bf16x8*>(Ks + KSWZ(r32, cb));
    bf16x8 b1 = *reinterpret_cast<const ALAS bf16x8*>(Ks + KSWZ(32 + r32, cb));
    p0 = __builtin_amdgcn_mfma_f32_32x32x16_bf16(b0, qr[d0], p0, 0, 0, 0);
    p1 = __builtin_amdgcn_mfma_f32_32x32x16_bf16(b1, qr[d0], p1, 0, 0, 0); }
}
__device__ __forceinline__ void band_mask(f32x16& p0, f32x16& p1, int dj, int hi) {
#pragma unroll
  for (int r = 0; r < 16; ++r) { const int d = dj + crow(r, hi);
    if ((unsigned)(d + 128) > 256u) p0[r] = -1e30f;
    if ((unsigned)(d + 160) > 256u) p1[r] = -1e30f; }
}
__device__ __forceinline__ int v_st(int k, int c) { const int kk = (k & ~0xC) | ((k & 4) << 1) | ((k & 8) >> 1); return ((kk >> 3) * 4 + (c >> 5)) * 512 + ((kk & 7) * 32 + (c & 31)) * 2; }
__device__ __forceinline__ int v_rd_base(int lane) { return ((lane & 3) << 3) | (((lane >> 2) & 3) << 6) | (((lane >> 4) & 1) << 5) | (((lane >> 5) & 1) << 8); }
constexpr int v_rd_off(int d0, int ks, int half) { return d0 * 512 + ks * 4096 + half * 2048; }
template <int OFF> __device__ __forceinline__ s16x4 tr_read(int vb) {
  s16x4 r; asm volatile("ds_read_b64_tr_b16 %0, %1 offset:%2" : "=&v"(r) : "v"(vb), "i"(OFF) : "memory"); return r;
}
template <int D0> __device__ __forceinline__ void pv_one(f32x16& od, int vb, bf16x8 pa0, bf16x8 pa1, bf16x8 pa2, bf16x8 pa3) {
  s16x4 l0 = tr_read<v_rd_off(D0, 0, 0)>(vb), h0 = tr_read<v_rd_off(D0, 0, 1)>(vb), l1 = tr_read<v_rd_off(D0, 1, 0)>(vb), h1 = tr_read<v_rd_off(D0, 1, 1)>(vb);
  s16x4 l2 = tr_read<v_rd_off(D0, 2, 0)>(vb), h2 = tr_read<v_rd_off(D0, 2, 1)>(vb), l3 = tr_read<v_rd_off(D0, 3, 0)>(vb), h3 = tr_read<v_rd_off(D0, 3, 1)>(vb);
  asm volatile("s_waitcnt lgkmcnt(0)" : "+v"(l0), "+v"(h0), "+v"(l1), "+v"(h1), "+v"(l2), "+v"(h2), "+v"(l3), "+v"(h3) :: "memory");
#define PK(L, H) (bf16x8){L[0], L[1], L[2], L[3], H[0], H[1], H[2], H[3]}
  od = __builtin_amdgcn_mfma_f32_32x32x16_bf16(pa0, PK(l0, h0), od, 0, 0, 0);
  od = __builtin_amdgcn_mfma_f32_32x32x16_bf16(pa1, PK(l1, h1), od, 0, 0, 0);
  od = __builtin_amdgcn_mfma_f32_32x32x16_bf16(pa2, PK(l2, h2), od, 0, 0, 0);
  od = __builtin_amdgcn_mfma_f32_32x32x16_bf16(pa3, PK(l3, h3), od, 0, 0, 0);
#undef PK
}
__device__ __forceinline__ void pv_d0(f32x16* o, int vb, bf16x8 pa0, bf16x8 pa1, bf16x8 pa2, bf16x8 pa3) {
  pv_one<0>(o[0], vb, pa0, pa1, pa2, pa3); pv_one<1>(o[1], vb, pa0, pa1, pa2, pa3); pv_one<2>(o[2], vb, pa0, pa1, pa2, pa3); pv_one<3>(o[3], vb, pa0, pa1, pa2, pa3);
}
__device__ __forceinline__ void pv_sm(f32x16* o, int vb, bf16x8 pa0, bf16x8 pa1, bf16x8 pa2, bf16x8 pa3, f32x16& p0, f32x16& p1, float& m_reg, float& mn, float& alpha) {
  constexpr float C = SCALE * 1.4426950408889634f;
  pv_one<0>(o[0], vb, pa0, pa1, pa2, pa3);
  float pmax = p0[0];
#pragma unroll
  for (int r = 1; r < 16; ++r) pmax = fmaxf(pmax, p0[r]);
#pragma unroll
  for (int r = 0; r < 16; ++r) pmax = fmaxf(pmax, p1[r]);
  { auto rr = __builtin_amdgcn_permlane32_swap(__float_as_uint(pmax), __float_as_uint(pmax), false, false);
    pmax = fmaxf(__uint_as_float(rr[0]), __uint_as_float(rr[1])); }
  pv_one<1>(o[1], vb, pa0, pa1, pa2, pa3);
  if (__builtin_expect(__all(pmax - m_reg <= THR / SCALE), 1)) { mn = m_reg; alpha = 1.f; }
  else { mn = fmaxf(m_reg, pmax); alpha = __builtin_amdgcn_exp2f((m_reg - mn) * C); m_reg = mn; }
  const float mnC = -mn * C;
#pragma unroll
  for (int r = 0; r < 16; ++r) p0[r] = fmaf(p0[r], C, mnC);
  pv_one<2>(o[2], vb, pa0, pa1, pa2, pa3);
#pragma unroll
  for (int r = 0; r < 16; ++r) p1[r] = fmaf(p1[r], C, mnC);
#pragma unroll
  for (int r = 0; r < 8; ++r) p0[r] = __builtin_amdgcn_exp2f(p0[r]);
  pv_one<3>(o[3], vb, pa0, pa1, pa2, pa3);
#pragma unroll
  for (int r = 8; r < 16; ++r) p0[r] = __builtin_amdgcn_exp2f(p0[r]);
}

__device__ __forceinline__ void attn_unit(const bf16_t* __restrict__ Q, const bf16_t* __restrict__ K, const bf16_t* __restrict__ V, bf16_t* __restrict__ O,
                                          int ldq, int ldk, int ldo, int nt, int nfirst, int skip, int qpos0, float sinkl2, ALAS char* lds,
                                          int qmode, const float* __restrict__ gq, const float* __restrict__ ropeC, const float* __restrict__ ropeS) {
  int tid_l = tid_now(); asm volatile("" : "+v"(tid_l));
  const int tid = tid_l, wid = tid >> 6, lane = tid & 63, r32 = lane & 31, hi = lane >> 5;
  ALAS char* V_lds = lds; ALAS char* K_lds = lds + 2 * SHM_V;
  ALAS float* ws = (ALAS float*)(lds + 2 * SHM_V + 2 * SHM_K) + wid * 64; ALAS float* li_l = ws; ALAS float* al_l = ws + 32;
  float m_reg = -1e30f, l_reg = 0; f32x16 o[4] = {}; bf16x8 qr[8];
  const bf16_t* Qw = Q + (long)(wid * QBLK + r32) * ldq + hi * 8;
#pragma unroll
  for (int d0 = 0; d0 < 8; ++d0) qr[d0] = *reinterpret_cast<const bf16x8*>(Qw + d0 * 16);
  if (qmode) {
    float qf[8][8];
#pragma unroll
    for (int d0 = 0; d0 < 8; ++d0)
#pragma unroll
      for (int j = 0; j < 8; ++j) qf[d0][j] = __uint_as_float(((unsigned)(unsigned short)qr[d0][j]) << 16);
    if (qmode & 1) { float ss = 0.f;
#pragma unroll
      for (int d0 = 0; d0 < 8; ++d0)
#pragma unroll
        for (int j = 0; j < 8; ++j) ss += qf[d0][j] * qf[d0][j];
      ss += __shfl_xor(ss, 32);
      const float rstd = 1.0f / sqrtf(ss * (1.0f / 128.0f) + 1e-6f);
#pragma unroll
      for (int d0 = 0; d0 < 8; ++d0) { const float* gp = gq + d0 * 16 + hi * 8; const float4 g0 = *reinterpret_cast<const float4*>(gp), g1 = *reinterpret_cast<const float4*>(gp + 4);
        qf[d0][0] *= rstd * g0.x; qf[d0][1] *= rstd * g0.y; qf[d0][2] *= rstd * g0.z; qf[d0][3] *= rstd * g0.w; qf[d0][4] *= rstd * g1.x; qf[d0][5] *= rstd * g1.y; qf[d0][6] *= rstd * g1.z; qf[d0][7] *= rstd * g1.w; } }
    if (qmode & 2) { const int t = qpos0 + wid * QBLK + r32;
#pragma unroll
      for (int hf = 0; hf < 2; ++hf) { const int p = hf ? (t & 63) : (t >> 6);
#pragma unroll
        for (int dd = 0; dd < 2; ++dd) { const int d0 = hf * 4 + dd, i0 = dd * 16 + hi * 8;
          const float4 c0 = *reinterpret_cast<const float4*>(ropeC + p * 32 + i0), c1 = *reinterpret_cast<const float4*>(ropeC + p * 32 + i0 + 4);
          const float4 s0 = *reinterpret_cast<const float4*>(ropeS + p * 32 + i0), s1 = *reinterpret_cast<const float4*>(ropeS + p * 32 + i0 + 4);
          const float cs[8] = {c0.x, c0.y, c0.z, c0.w, c1.x, c1.y, c1.z, c1.w}, sn[8] = {s0.x, s0.y, s0.z, s0.w, s1.x, s1.y, s1.z, s1.w};
#pragma unroll
          for (int j = 0; j < 8; ++j) { const float x1 = qf[d0][j], x2 = qf[d0 + 2][j]; qf[d0][j] = x1 * cs[j] - x2 * sn[j]; qf[d0 + 2][j] = x1 * sn[j] + x2 * cs[j]; } } } }
#pragma unroll
    for (int d0 = 0; d0 < 8; ++d0) { u32x4 w = {cvtpk(qf[d0][0], qf[d0][1]), cvtpk(qf[d0][2], qf[d0][3]), cvtpk(qf[d0][4], qf[d0][5]), cvtpk(qf[d0][6], qf[d0][7])}; qr[d0] = *reinterpret_cast<bf16x8*>(&w); }
  }
  const int sr = tid >> 4, sc = (tid & 15) * 8, vst0 = v_st(sr, sc), vst1 = v_st(32 + sr, sc);
  const int vb0 = (int)(uintptr_t)V_lds + v_rd_base(lane);
  const long ko0 = (long)sr * ldk + sc, ko1 = ko0 + 32L * ldk;
  const int qi = qpos0 + wid * QBLK + r32;
  struct { bf16x8 vs0, vs1, ks0, ks1; } sr_[2];
#define KROW(t) ((t) * KVBLK + (((t) >= nfirst) ? skip : 0))
#define SLOAD(i, t) do { const long ro_ = (long)KROW(t) * ldk; sr_[i].vs0 = *reinterpret_cast<const bf16x8*>(V + ro_ + ko0); sr_[i].vs1 = *reinterpret_cast<const bf16x8*>(V + ro_ + ko1); \
    sr_[i].ks0 = *reinterpret_cast<const bf16x8*>(K + ro_ + ko0); sr_[i].ks1 = *reinterpret_cast<const bf16x8*>(K + ro_ + ko1); } while (0)
#define SWRITE(b, i) do { *(ALAS bf16x8*)(V_lds + (b) * SHM_V + vst0) = sr_[i].vs0;          \
    *(ALAS bf16x8*)(V_lds + (b) * SHM_V + vst1) = sr_[i].vs1; const int kc_ = sc * 2;               \
    *(ALAS bf16x8*)(K_lds + (b) * SHM_K + KSWZ(sr, kc_)) = sr_[i].ks0;                       \
    *(ALAS bf16x8*)(K_lds + (b) * SHM_K + KSWZ(32 + sr, kc_)) = sr_[i].ks1; } while (0)
#define SWAIT() asm volatile("s_waitcnt vmcnt(4)" ::: "memory")
#define RESC(a) do { if (__any((a) < 1.f)) { if (hi == 0) al_l[r32] = (a); asm volatile("s_waitcnt lgkmcnt(0)" ::: "memory"); \
    _Pragma("unroll") for (int d = 0; d < 4; ++d) _Pragma("unroll") for (int r = 0; r < 16; ++r) o[d][r] *= al_l[crow(r, hi)]; } } while (0)
#define MASK(P0, P1, t) do { if ((t) >= nfirst) band_mask(P0, P1, KROW(t) - 512 - qi, hi); } while (0)
  f32x16 pA0, pA1, pB0, pB1; float mnA, mnB, alA, alB; bf16x8 pa0, pa1, pa2, pa3; const int NT = nt;
  constexpr int SE = 0, SO = 1;
  SLOAD(SE, 0); asm volatile("s_waitcnt vmcnt(0)" ::: "memory"); SWRITE(0, SE); __syncthreads();
  qkt(pA0, pA1, K_lds, qr, r32, hi); MASK(pA0, pA1, 0); partialSM(pA0, pA1, m_reg, mnA, alA);
  SLOAD(SO, 1); if (2 < NT) SLOAD(SE, 2);
  SWAIT(); SWRITE(1, SO); __syncthreads();
  for (int j = 1; j + 1 < NT; j += 2) {
    SBAR(); qkt(pB0, pB1, K_lds + SHM_K, qr, r32, hi);
    finishSM(pA0, pA1, alA, l_reg, pa0, pa1, pa2, pa3); SBAR();
    SLOAD(SO, j + 2); SBAR();
    MASK(pB0, pB1, j); pv_sm(o, vb0, pa0, pa1, pa2, pa3, pB0, pB1, m_reg, mnB, alB);
    __syncthreads(); SWAIT(); SWRITE(0, SE);
    RESC(alB); __syncthreads();
    SBAR(); qkt(pA0, pA1, K_lds, qr, r32, hi);
    finishSM(pB0, pB1, alB, l_reg, pa0, pa1, pa2, pa3); SBAR();
    if (j + 3 < NT) SLOAD(SE, j + 3); SBAR();
    MASK(pA0, pA1, j + 1); pv_sm(o, vb0 + (int)SHM_V, pa0, pa1, pa2, pa3, pA0, pA1, m_reg, mnA, alA);
    __syncthreads(); SWAIT(); SWRITE(1, SO);
    RESC(alA); __syncthreads();
  }
  SBAR(); qkt(pB0, pB1, K_lds + SHM_K, qr, r32, hi);
  finishSM(pA0, pA1, alA, l_reg, pa0, pa1, pa2, pa3); SBAR();
  MASK(pB0, pB1, NT - 1); pv_sm(o, vb0, pa0, pa1, pa2, pa3, pB0, pB1, m_reg, mnB, alB);
  __syncthreads(); RESC(alB);
  finishSM(pB0, pB1, alB, l_reg, pa0, pa1, pa2, pa3); SBAR();
  pv_d0(o, vb0 + (int)SHM_V, pa0, pa1, pa2, pa3);
  l_reg += __builtin_amdgcn_exp2f(sinkl2 - m_reg * (SCALE * 1.4426950408889634f));
  if (hi == 0) li_l[r32] = l_reg; asm volatile("s_waitcnt lgkmcnt(0)" ::: "memory");
  float rli[16];
#pragma unroll
  for (int r = 0; r < 16; ++r) rli[r] = __builtin_amdgcn_rcpf(li_l[crow(r, hi)]);
  bf16_t* Ow = O + (long)(wid * QBLK) * ldo + r32;
#pragma unroll
  for (int r = 0; r < 16; ++r) { const int orow = crow(r, hi);
#pragma unroll
    for (int d0 = 0; d0 < 4; ++d0) { const unsigned w = cvtpk(o[d0][r] * rli[r], 0.f); Ow[(long)orow * ldo + d0 * 32] = (bf16_t)(w & 0xffffu); } }
#undef KROW
#undef SLOAD
#undef SWRITE
#undef SWAIT
#undef RESC
#undef MASK
}

__device__ __forceinline__ void dma16(const void* gsrc, ALAS void* lds_dst_uniform) { __builtin_amdgcn_global_load_lds((const unsigned*)gsrc, (ALAS unsigned*)lds_dst_uniform, 16, 0, 0); }
template <int NVB>
__device__ __forceinline__ void attn_unit_dma(const bf16_t* __restrict__ Q, const bf16_t* __restrict__ K, const bf16_t* __restrict__ V, bf16_t* __restrict__ O,
                                              int ldq, int ldk, int ldo, int nt, int nfirst, int skip, int qpos0, float sinkl2, ALAS char* lds, ALAS float* scr,
                                              int qmode, const float* __restrict__ gq, const float* __restrict__ ropeC, const float* __restrict__ ropeS) {
  constexpr int NVP = NVB / 2;
  int tid_l = tid_now(); asm volatile("" : "+v"(tid_l));
  const int tid = tid_l, wid = __builtin_amdgcn_readfirstlane(tid >> 6), lane = tid & 63, r32 = lane & 31, hi = lane >> 5;
  ALAS char* K_lds = lds; ALAS char* V_lds = lds + 32768; ALAS char* Qs = lds + 65536 + wid * 8192;
  ALAS float* li_l = scr; ALAS float* al_l = scr + 32;
  const int qi = qpos0 + wid * QBLK + r32;
  unsigned koff[2], voff[NVP];
#pragma unroll
  for (int i = 0; i < 2; ++i) { const int L = (wid * 2 + i) * 1024 + lane * 16, row = L >> 8, cb = (L & 255) ^ ((row & 7) << 4); koff[i] = (unsigned)(row * ldk * 2 + cb); }
#pragma unroll
  for (int i = 0; i < NVP; ++i) { const int L = (wid * NVP + i) * 1024 + lane * 16, half = L >> 14, Lh = L & 16383, sub = Lh >> 9, within = Lh & 511;
    const int kk = (sub >> 2) * 8 + (within >> 6), k = (kk & ~0xC) | ((kk & 4) << 1) | ((kk & 8) >> 1), col = half * 128 + (sub & 3) * 32 + ((within & 63) >> 1);
    voff[i] = (unsigned)(k * ldk * 2 + col * 2); }
#define KROW(t) ((t) * KVBLK + (((t) >= nfirst) ? skip : 0))
#define DK_ISSUE(t, slot) do { const char* kb_ = (const char*)K + (size_t)KROW(t) * 2 * ldk; \
    _Pragma("unroll") for (int i = 0; i < 2; ++i) dma16(kb_ + koff[i], K_lds + (slot) * 16384 + (wid * 2 + i) * 1024); } while (0)
#define DV_ISSUE(t) do { const char* vb_ = (const char*)V + (size_t)KROW(t) * 2 * ldk; \
    _Pragma("unroll") for (int i = 0; i < NVP; ++i) dma16(vb_ + voff[i], V_lds + (wid * NVP + i) * 1024); } while (0)
  DK_ISSUE(0, 0); DV_ISSUE(0); DK_ISSUE(1, 1);
  { bf16x8 qr[8];
    const bf16_t* Qw = Q + (long)(wid * QBLK + r32) * ldq + hi * 8;
#pragma unroll
    for (int d0 = 0; d0 < 8; ++d0) qr[d0] = *reinterpret_cast<const bf16x8*>(Qw + d0 * 16);
    if (qmode) {
      float qf[8][8];
#pragma unroll
      for (int d0 = 0; d0 < 8; ++d0)
#pragma unroll
        for (int j = 0; j < 8; ++j) qf[d0][j] = __uint_as_float(((unsigned)(unsigned short)qr[d0][j]) << 16);
      if (qmode & 1) { float ss = 0.f;
#pragma unroll
        for (int d0 = 0; d0 < 8; ++d0)
#pragma unroll
          for (int j = 0; j < 8; ++j) ss += qf[d0][j] * qf[d0][j];
        ss += __shfl_xor(ss, 32);
        const float rstd = 1.0f / sqrtf(ss * (1.0f / 128.0f) + 1e-6f);
#pragma unroll
        for (int d0 = 0; d0 < 8; ++d0) { const float* gp = gq + d0 * 16 + hi * 8; const float4 g0 = *reinterpret_cast<const float4*>(gp), g1 = *reinterpret_cast<const float4*>(gp + 4);
          qf[d0][0] *= rstd * g0.x; qf[d0][1] *= rstd * g0.y; qf[d0][2] *= rstd * g0.z; qf[d0][3] *= rstd * g0.w; qf[d0][4] *= rstd * g1.x; qf[d0][5] *= rstd * g1.y; qf[d0][6] *= rstd * g1.z; qf[d0][7] *= rstd * g1.w; } }
      if (qmode & 2) { const int t = qi;
#pragma unroll
        for (int hf = 0; hf < 2; ++hf) { const int p = hf ? (t & 63) : (t >> 6);
#pragma unroll
          for (int dd = 0; dd < 2; ++dd) { const int d0 = hf * 4 + dd, i0 = dd * 16 + hi * 8;
            const float4 c0 = *reinterpret_cast<const float4*>(ropeC + p * 32 + i0), c1 = *reinterpret_cast<const float4*>(ropeC + p * 32 + i0 + 4);
            const float4 s0 = *reinterpret_cast<const float4*>(ropeS + p * 32 + i0), s1 = *reinterpret_cast<const float4*>(ropeS + p * 32 + i0 + 4);
            const float cs[8] = {c0.x, c0.y, c0.z, c0.w, c1.x, c1.y, c1.z, c1.w}, sn[8] = {s0.x, s0.y, s0.z, s0.w, s1.x, s1.y, s1.z, s1.w};
#pragma unroll
            for (int j = 0; j < 8; ++j) { const float x1 = qf[d0][j], x2 = qf[d0 + 2][j]; qf[d0][j] = x1 * cs[j] - x2 * sn[j]; qf[d0 + 2][j] = x1 * sn[j] + x2 * cs[j]; } } } }
#pragma unroll
      for (int d0 = 0; d0 < 8; ++d0) { u32x4 w = {cvtpk(qf[d0][0], qf[d0][1]), cvtpk(qf[d0][2], qf[d0][3]), cvtpk(qf[d0][4], qf[d0][5]), cvtpk(qf[d0][6], qf[d0][7])}; qr[d0] = *reinterpret_cast<bf16x8*>(&w); }
    }
#pragma unroll
    for (int d0 = 0; d0 < 8; ++d0) *(ALAS bf16x8*)(Qs + (d0 * 64 + lane) * 16) = qr[d0];
  }
  float m_reg = -1e30f, l_reg = 0.f; f32x16 o[NVB] = {};
  const int vb0 = (int)(uintptr_t)V_lds + v_rd_base(lane);
  if (NVP == 4) asm volatile("s_waitcnt vmcnt(6)" ::: "memory"); else asm volatile("s_waitcnt vmcnt(4)" ::: "memory");
  asm volatile("s_waitcnt lgkmcnt(0)" ::: "memory"); __builtin_amdgcn_s_barrier();
  for (int j = 0; j < nt; ++j) {
    f32x16 p0 = f32x16{}, p1 = f32x16{}; float mn, alpha; bf16x8 pa0, pa1, pa2, pa3;
    { const ALAS char* Ks = K_lds + (j & 1) * 16384;
#pragma unroll
      for (int d0 = 0; d0 < 8; ++d0) { const int cb = (d0 * 16 + hi * 8) * 2;
        const bf16x8 qd = *(const ALAS bf16x8*)(Qs + (d0 * 64 + lane) * 16);
        const bf16x8 b0 = *reinterpret_cast<const ALAS bf16x8*>(Ks + KSWZ(r32, cb));
        const bf16x8 b1 = *reinterpret_cast<const ALAS bf16x8*>(Ks + KSWZ(32 + r32, cb));
        p0 = __builtin_amdgcn_mfma_f32_32x32x16_bf16(b0, qd, p0, 0, 0, 0);
        p1 = __builtin_amdgcn_mfma_f32_32x32x16_bf16(b1, qd, p1, 0, 0, 0); } }
    if (j >= nfirst) band_mask(p0, p1, KROW(j) - 512 - qi, hi);
    partialSM(p0, p1, m_reg, mn, alpha);
    if (__any(alpha < 1.f)) { if (hi == 0) al_l[r32] = alpha; asm volatile("s_waitcnt lgkmcnt(0)" ::: "memory");
#pragma unroll
      for (int d = 0; d < NVB; ++d)
#pragma unroll
        for (int r = 0; r < 16; ++r) o[d][r] *= al_l[crow(r, hi)]; }
    finishSM(p0, p1, alpha, l_reg, pa0, pa1, pa2, pa3);
    asm volatile("s_waitcnt vmcnt(0) lgkmcnt(0)" ::: "memory"); __builtin_amdgcn_s_barrier();
    pv_one<0>(o[0], vb0, pa0, pa1, pa2, pa3); pv_one<1>(o[1], vb0, pa0, pa1, pa2, pa3); pv_one<2>(o[2], vb0, pa0, pa1, pa2, pa3); pv_one<3>(o[3], vb0, pa0, pa1, pa2, pa3);
    if constexpr (NVB == 8) { pv_one<0>(o[4], vb0 + 16384, pa0, pa1, pa2, pa3); pv_one<1>(o[5], vb0 + 16384, pa0, pa1, pa2, pa3); pv_one<2>(o[6], vb0 + 16384, pa0, pa1, pa2, pa3); pv_one<3>(o[7], vb0 + 16384, pa0, pa1, pa2, pa3); }
    asm volatile("s_waitcnt lgkmcnt(0)" ::: "memory"); __builtin_amdgcn_s_barrier();
    if (j + 1 < nt) DV_ISSUE(j + 1);
    if (j + 2 < nt) DK_ISSUE(j + 2, j & 1);
  }
#undef DK_ISSUE
#undef DV_ISSUE
#undef KROW
  l_reg += __builtin_amdgcn_exp2f(sinkl2 - m_reg * (SCALE * 1.4426950408889634f));
  if (hi == 0) li_l[r32] = l_reg; asm volatile("s_waitcnt lgkmcnt(0)" ::: "memory");
  float rli[16];
#pragma unroll
  for (int r = 0; r < 16; ++r) rli[r] = __builtin_amdgcn_rcpf(li_l[crow(r, hi)]);
  { constexpr int RB = NVB * 64, NPASS = RB / 256, RPP = 32 / NPASS, PPR = RB / 16;
    ALAS char* og = Qs; bf16_t* Og = O + (long)(wid * QBLK) * ldo;
#pragma unroll
    for (int ps = 0; ps < NPASS; ++ps) {
#pragma unroll
      for (int r = 0; r < 16; ++r) { const int row = crow(r, hi); if (row / RPP != ps) continue; const int lrow = row - RPP * ps;
#pragma unroll
        for (int d = 0; d < NVB; ++d) { const unsigned w = cvtpk(o[d][r] * rli[r], 0.f); *(ALAS unsigned short*)(og + lrow * RB + (d * 32 + r32) * 2) = (unsigned short)(w & 0xffffu); } }
#pragma unroll
      for (int k = 0; k < 8; ++k) { const int p = lane + 64 * k; const u32x4 v = *(const ALAS u32x4*)(og + p * 16);
        *reinterpret_cast<u32x4*>(Og + (long)(RPP * ps + p / PPR) * ldo + (p % PPR) * 8) = v; }
    } }
}

#define PP_WAIT2(N, A, B) asm volatile("s_waitcnt lgkmcnt(" #N ")" : "+v"(A), "+v"(B) :: "memory")
__device__ __forceinline__ void qk_seg(f32x16& p0, f32x16& p1, const ALAS char* Ks, const bf16x8* qr, const f32x16& negm, int r32, int hi) {
  int sw = ((r32 & 7) << 4) ^ (hi * 16); asm volatile("" : "+v"(sw));
  const int r0 = (int)(uintptr_t)Ks + r32 * 256;
#define KRD(DST0, DST1, d0) do { const int ad_ = r0 + (((d0) * 32) ^ sw); asm volatile("ds_read_b128 %0, %2\n\tds_read_b128 %1, %2 offset:8192" : "=&v"(DST0), "=&v"(DST1) : "v"(ad_) : "memory"); } while (0)
  bf16x8 a[3], b[3];
  KRD(a[0], b[0], 0); KRD(a[1], b[1], 1); KRD(a[2], b[2], 2);
  SBAR(); __builtin_amdgcn_s_setprio(1);
#pragma unroll
  for (int d0 = 0; d0 < 8; ++d0) {
    if (d0 < 6) PP_WAIT2(4, a[d0 % 3], b[d0 % 3]); else if (d0 == 6) PP_WAIT2(2, a[d0 % 3], b[d0 % 3]); else PP_WAIT2(0, a[d0 % 3], b[d0 % 3]);
    p0 = __builtin_amdgcn_mfma_f32_32x32x16_bf16(a[d0 % 3], qr[d0], d0 == 0 ? negm : p0, 0, 0, 0);
    p1 = __builtin_amdgcn_mfma_f32_32x32x16_bf16(b[d0 % 3], qr[d0], d0 == 0 ? negm : p1, 0, 0, 0);
    SBAR();
    if (d0 + 3 < 8) { KRD(a[d0 % 3], b[d0 % 3], d0 + 3); SBAR(); }
  }
  __builtin_amdgcn_s_setprio(0);
#undef KRD
}
__device__ __forceinline__ void pv_seg(f32x16* o, const ALAS char* vbp, bf16x8 pa0, bf16x8 pa1, bf16x8 pa2, bf16x8 pa3) {
  const int vb = (int)(uintptr_t)vbp;
#define PK(L, H) (bf16x8){L[0], L[1], L[2], L[3], H[0], H[1], H[2], H[3]}
  s16x4 lo[4], hh[4];
  lo[0] = tr_read<v_rd_off(0, 0, 0)>(vb); hh[0] = tr_read<v_rd_off(0, 0, 1)>(vb); lo[1] = tr_read<v_rd_off(0, 1, 0)>(vb); hh[1] = tr_read<v_rd_off(0, 1, 1)>(vb);
  lo[2] = tr_read<v_rd_off(0, 2, 0)>(vb); hh[2] = tr_read<v_rd_off(0, 2, 1)>(vb); lo[3] = tr_read<v_rd_off(0, 3, 0)>(vb); hh[3] = tr_read<v_rd_off(0, 3, 1)>(vb);
  SBAR(); __builtin_amdgcn_s_setprio(1);
#define PVSTEP(d, ks, PA, WN, NEXT) do { PP_WAIT2(WN, lo[ks], hh[ks]); o[d] = __builtin_amdgcn_mfma_f32_32x32x16_bf16(PA, PK(lo[ks], hh[ks]), o[d], 0, 0, 0); SBAR(); \
    if (NEXT) { lo[ks] = tr_read<v_rd_off(((d) + 1) & 3, ks, 0)>(vb); hh[ks] = tr_read<v_rd_off(((d) + 1) & 3, ks, 1)>(vb); SBAR(); } } while (0)
  PVSTEP(0, 0, pa0, 6, 1); PVSTEP(0, 1, pa1, 6, 1); PVSTEP(0, 2, pa2, 6, 1); PVSTEP(0, 3, pa3, 6, 1);
  PVSTEP(1, 0, pa0, 6, 1); PVSTEP(1, 1, pa1, 6, 1); PVSTEP(1, 2, pa2, 6, 1); PVSTEP(1, 3, pa3, 6, 1);
  PVSTEP(2, 0, pa0, 6, 1); PVSTEP(2, 1, pa1, 6, 1); PVSTEP(2, 2, pa2, 6, 1); PVSTEP(2, 3, pa3, 6, 1);
  PVSTEP(3, 0, pa0, 6, 0); PVSTEP(3, 1, pa1, 4, 0); PVSTEP(3, 2, pa2, 2, 0); PVSTEP(3, 3, pa3, 0, 0);
  { const bf16x8 ones = {0x3F80, 0x3F80, 0x3F80, 0x3F80, 0x3F80, 0x3F80, 0x3F80, 0x3F80};
    o[4] = __builtin_amdgcn_mfma_f32_32x32x16_bf16(pa0, ones, o[4], 0, 0, 0); o[4] = __builtin_amdgcn_mfma_f32_32x32x16_bf16(pa1, ones, o[4], 0, 0, 0);
    o[4] = __builtin_amdgcn_mfma_f32_32x32x16_bf16(pa2, ones, o[4], 0, 0, 0); o[4] = __builtin_amdgcn_mfma_f32_32x32x16_bf16(pa3, ones, o[4], 0, 0, 0); SBAR(); }
  __builtin_amdgcn_s_setprio(0);
#undef PVSTEP
#undef PK
}
constexpr float THRL2 = THR * 1.4426950408889634f;
__device__ __forceinline__ void psm_n(f32x16& p0, f32x16& p1, float& m_reg, float& alpha, f32x16& negm, bool first) {
  float pmax = fmaxf(p0[0], p1[0]);
#pragma unroll
  for (int r = 1; r < 16; ++r) pmax = fmaxf(pmax, fmaxf(p0[r], p1[r]));
  { auto rr = __builtin_amdgcn_permlane32_swap(__float_as_uint(pmax), __float_as_uint(pmax), false, false); pmax = fmaxf(__uint_as_float(rr[0]), __uint_as_float(rr[1])); }
  alpha = 1.f;
  if (first || !__all(pmax <= THRL2)) { const float delta = first ? pmax : fmaxf(pmax, 0.f); if (!first) alpha = __builtin_amdgcn_exp2f(-delta); m_reg += delta;
#pragma unroll
    for (int r = 0; r < 16; ++r) { p0[r] -= delta; p1[r] -= delta; negm[r] = -m_reg; } }
#pragma unroll
  for (int r = 0; r < 16; ++r) p0[r] = __builtin_amdgcn_exp2f(p0[r]);
}
__device__ __forceinline__ void fsm_n(f32x16& p0, f32x16& p1, bf16x8& pa0, bf16x8& pa1, bf16x8& pa2, bf16x8& pa3) {
#pragma unroll
  for (int r = 0; r < 16; ++r) p1[r] = __builtin_amdgcn_exp2f(p1[r]);
#define PK4(P, BASE, OUT) do { unsigned a0 = cvtpk(P[BASE + 0], P[BASE + 1]), a1 = cvtpk(P[BASE + 2], P[BASE + 3]);   \
    unsigned b0 = cvtpk(P[BASE + 4], P[BASE + 5]), b1 = cvtpk(P[BASE + 6], P[BASE + 7]);                              \
    auto r0 = __builtin_amdgcn_permlane32_swap(a0, b0, false, false); auto r1 = __builtin_amdgcn_permlane32_swap(a1, b1, false, false); \
    u32x4 w = {r0[0], r1[0], r0[1], r1[1]}; OUT = *reinterpret_cast<bf16x8*>(&w); } while (0)
  PK4(p0, 0, pa0); PK4(p0, 8, pa1); PK4(p1, 0, pa2); PK4(p1, 8, pa3);
#undef PK4
}
__device__ __forceinline__ void attn_unit_dma2(const bf16_t* __restrict__ Q, const bf16_t* __restrict__ K, const bf16_t* __restrict__ V, bf16_t* __restrict__ O,
                                               int ldq, int ldk, int ldo, int nt, int nfirst, int skip, int qpos0, float sinkl2, ALAS char* lds, ALAS float* scr,
                                               int qmode, const float* __restrict__ gq, const float* __restrict__ ropeC, const float* __restrict__ ropeS) {
  int tid_l = tid_now(); asm volatile("" : "+v"(tid_l));
  const int tid = tid_l, wid = __builtin_amdgcn_readfirstlane(tid >> 6), lane = tid & 63, r32 = lane & 31, hi = lane >> 5;
  ALAS char* K_lds = lds; ALAS char* V_lds = lds + 32768;
  ALAS float* li_l = scr; ALAS float* al_l = scr + 32;
  const int qi = qpos0 + wid * QBLK + r32;
  unsigned koff[2], voff[2];
#pragma unroll
  for (int i = 0; i < 2; ++i) { const int L = (wid * 2 + i) * 1024 + lane * 16, row = L >> 8, cb = (L & 255) ^ ((row & 7) << 4); koff[i] = (unsigned)(row * ldk * 2 + cb); }
#pragma unroll
  for (int i = 0; i < 2; ++i) { const int L = (wid * 2 + i) * 1024 + lane * 16, sub = L >> 9, within = L & 511;
    const int kk = (sub >> 2) * 8 + (within >> 6), k = (kk & ~0xC) | ((kk & 4) << 1) | ((kk & 8) >> 1), col = (sub & 3) * 32 + ((within & 63) >> 1);
    voff[i] = (unsigned)(k * ldk * 2 + col * 2); }
#define KROW(t) ((t) * KVBLK + (((t) >= nfirst) ? skip : 0))
#define DK_ISSUE(t, slot) do { const char* kb_ = (const char*)K + (size_t)KROW(t) * 2 * ldk; \
    _Pragma("unroll") for (int i = 0; i < 2; ++i) dma16(kb_ + koff[i], K_lds + (slot) * 16384 + (wid * 2 + i) * 1024); } while (0)
#define DV_ISSUE(t, slot) do { const char* vb_ = (const char*)V + (size_t)KROW(t) * 2 * ldk; \
    _Pragma("unroll") for (int i = 0; i < 2; ++i) dma16(vb_ + voff[i], V_lds + (slot) * 16384 + (wid * 2 + i) * 1024); } while (0)
#define RESC(a) do { if (__any((a) < 1.f)) { if (hi == 0) al_l[r32] = (a); asm volatile("s_waitcnt lgkmcnt(0)" ::: "memory"); \
    _Pragma("unroll") for (int d = 0; d < 4; ++d) _Pragma("unroll") for (int r = 0; r < 16; ++r) o[d][r] *= al_l[crow(r, hi)]; } } while (0)
#define MASK(P0, P1, t) do { if ((t) >= nfirst) band_mask(P0, P1, KROW(t) - 512 - qi, hi); } while (0)
#define STEP_SYNC() do { asm volatile("s_waitcnt vmcnt(0) lgkmcnt(0)" ::: "memory"); __builtin_amdgcn_s_barrier(); } while (0)
  DK_ISSUE(0, 0); DV_ISSUE(0, 0); DK_ISSUE(1, 1);
  bf16x8 qr[8];
  { const bf16_t* Qw = Q + (long)(wid * QBLK + r32) * ldq + hi * 8;
#pragma unroll
    for (int d0 = 0; d0 < 8; ++d0) qr[d0] = *reinterpret_cast<const bf16x8*>(Qw + d0 * 16);
    if (qmode) {
      float qf[8][8];
#pragma unroll
      for (int d0 = 0; d0 < 8; ++d0)
#pragma unroll
        for (int j = 0; j < 8; ++j) qf[d0][j] = __uint_as_float(((unsigned)(unsigned short)qr[d0][j]) << 16);
      if (qmode & 1) { float ss = 0.f;
#pragma unroll
        for (int d0 = 0; d0 < 8; ++d0)
#pragma unroll
          for (int j = 0; j < 8; ++j) ss += qf[d0][j] * qf[d0][j];
        ss += __shfl_xor(ss, 32);
        const float rstd = 1.0f / sqrtf(ss * (1.0f / 128.0f) + 1e-6f);
#pragma unroll
        for (int d0 = 0; d0 < 8; ++d0) { const float* gp = gq + d0 * 16 + hi * 8; const float4 g0 = *reinterpret_cast<const float4*>(gp), g1 = *reinterpret_cast<const float4*>(gp + 4);
          qf[d0][0] *= rstd * g0.x; qf[d0][1] *= rstd * g0.y; qf[d0][2] *= rstd * g0.z; qf[d0][3] *= rstd * g0.w; qf[d0][4] *= rstd * g1.x; qf[d0][5] *= rstd * g1.y; qf[d0][6] *= rstd * g1.z; qf[d0][7] *= rstd * g1.w; } }
      if (qmode & 2) { const int t = qi;
#pragma unroll
        for (int hf = 0; hf < 2; ++hf) { const int p = hf ? (t & 63) : (t >> 6);
#pragma unroll
          for (int dd = 0; dd < 2; ++dd) { const int d0 = hf * 4 + dd, i0 = dd * 16 + hi * 8;
            const float4 c0 = *reinterpret_cast<const float4*>(ropeC + p * 32 + i0), c1 = *reinterpret_cast<const float4*>(ropeC + p * 32 + i0 + 4);
            const float4 s0 = *reinterpret_cast<const float4*>(ropeS + p * 32 + i0), s1 = *reinterpret_cast<const float4*>(ropeS + p * 32 + i0 + 4);
            const float cs[8] = {c0.x, c0.y, c0.z, c0.w, c1.x, c1.y, c1.z, c1.w}, sn[8] = {s0.x, s0.y, s0.z, s0.w, s1.x, s1.y, s1.z, s1.w};
#pragma unroll
            for (int j = 0; j < 8; ++j) { const float x1 = qf[d0][j], x2 = qf[d0 + 2][j]; qf[d0][j] = x1 * cs[j] - x2 * sn[j]; qf[d0 + 2][j] = x1 * sn[j] + x2 * cs[j]; } } } }
#pragma unroll
      for (int d0 = 0; d0 < 8; ++d0) { u32x4 w = {cvtpk(qf[d0][0], qf[d0][1]), cvtpk(qf[d0][2], qf[d0][3]), cvtpk(qf[d0][4], qf[d0][5]), cvtpk(qf[d0][6], qf[d0][7])}; qr[d0] = *reinterpret_cast<bf16x8*>(&w); }
    } }
  float m_reg = -1e30f, l_reg = 0.f; f32x16 o[4] = {};
  const int vb0 = (int)(uintptr_t)V_lds + v_rd_base(lane);
  f32x16 pA0, pA1, pB0, pB1; float mnA, mnB, alA, alB; bf16x8 pa0, pa1, pa2, pa3;
  STEP_SYNC();
  qkt(pA0, pA1, K_lds, qr, r32, hi); MASK(pA0, pA1, 0); partialSM(pA0, pA1, m_reg, mnA, alA);
  STEP_SYNC();
  int j = 0;
  for (; j + 2 < nt; j += 2) {
    DK_ISSUE(j + 2, 0); DV_ISSUE(j + 1, 1);
    SBAR(); qkt(pB0, pB1, K_lds + 16384, qr, r32, hi);
    finishSM(pA0, pA1, alA, l_reg, pa0, pa1, pa2, pa3); SBAR();
    MASK(pB0, pB1, j + 1); pv_sm(o, vb0, pa0, pa1, pa2, pa3, pB0, pB1, m_reg, mnB, alB);
    STEP_SYNC();
    RESC(alB);
    if (j + 3 < nt) DK_ISSUE(j + 3, 1);
    DV_ISSUE(j + 2, 0);
    SBAR(); qkt(pA0, pA1, K_lds, qr, r32, hi);
    finishSM(pB0, pB1, alB, l_reg, pa0, pa1, pa2, pa3); SBAR();
    MASK(pA0, pA1, j + 2); pv_sm(o, vb0 + 16384, pa0, pa1, pa2, pa3, pA0, pA1, m_reg, mnA, alA);
    STEP_SYNC();
    RESC(alA);
  }
  DV_ISSUE(j + 1, 1);
  SBAR(); qkt(pB0, pB1, K_lds + 16384, qr, r32, hi);
  finishSM(pA0, pA1, alA, l_reg, pa0, pa1, pa2, pa3); SBAR();
  MASK(pB0, pB1, j + 1); pv_sm(o, vb0, pa0, pa1, pa2, pa3, pB0, pB1, m_reg, mnB, alB);
  STEP_SYNC();
  RESC(alB);
  finishSM(pB0, pB1, alB, l_reg, pa0, pa1, pa2, pa3); SBAR();
  pv_d0(o, vb0 + 16384, pa0, pa1, pa2, pa3);
  STEP_SYNC();
#undef DK_ISSUE
#undef DV_ISSUE
#undef KROW
#undef RESC
#undef MASK
#undef STEP_SYNC
  l_reg += __builtin_amdgcn_exp2f(sinkl2 - m_reg * (SCALE * 1.4426950408889634f));
  if (hi == 0) li_l[r32] = l_reg; asm volatile("s_waitcnt lgkmcnt(0)" ::: "memory");
  float rli[16];
#pragma unroll
  for (int r = 0; r < 16; ++r) rli[r] = __builtin_amdgcn_rcpf(li_l[crow(r, hi)]);
  { ALAS char* og = lds + wid * 8192; bf16_t* Og = O + (long)(wid * QBLK) * ldo;
#pragma unroll
    for (int r = 0; r < 16; ++r) { const int row = crow(r, hi);
#pragma unroll
      for (int d = 0; d < 4; ++d) { const unsigned w = cvtpk(o[d][r] * rli[r], 0.f); *(ALAS unsigned short*)(og + row * 256 + (d * 32 + r32) * 2) = (unsigned short)(w & 0xffffu); } }
#pragma unroll
    for (int k = 0; k < 8; ++k) { const int p = lane + 64 * k; const u32x4 v = *(const ALAS u32x4*)(og + p * 16);
      *reinterpret_cast<u32x4*>(Og + (long)(p >> 4) * ldo + (p & 15) * 8) = v; }
  }
}

__device__ __forceinline__ void attn_unit_pp(const bf16_t* __restrict__ Q, const bf16_t* __restrict__ K, const bf16_t* __restrict__ V, bf16_t* __restrict__ O,
                                               int ldq, int ldk, int ldo, int nt, int nfirst, int skip, int qpos0, float sinkl2, ALAS char* lds, ALAS float* scr,
                                               int qmode, const float* __restrict__ gq, const float* __restrict__ ropeC, const float* __restrict__ ropeS) {
  int tid_l = tid_now(); asm volatile("" : "+v"(tid_l));
  const int tid = tid_l, wid = __builtin_amdgcn_readfirstlane(tid >> 6), lane = tid & 63, r32 = lane & 31, hi = lane >> 5;
  ALAS char* K_lds = lds; ALAS char* V_lds = lds + 32768;
  ALAS float* li_l = scr; ALAS float* al_l = scr + 32;
  const int qi = qpos0 + wid * QBLK + r32;
  unsigned koff[2], voff[2];
#pragma unroll
  for (int i = 0; i < 2; ++i) { const int L = (wid * 2 + i) * 1024 + lane * 16, row = L >> 8, cb = (L & 255) ^ ((row & 7) << 4); koff[i] = (unsigned)(row * ldk * 2 + cb); }
#pragma unroll
  for (int i = 0; i < 2; ++i) { const int L = (wid * 2 + i) * 1024 + lane * 16, sub = L >> 9, within = L & 511;
    const int kk = (sub >> 2) * 8 + (within >> 6), k = (kk & ~0xC) | ((kk & 4) << 1) | ((kk & 8) >> 1), col = (sub & 3) * 32 + ((within & 63) >> 1);
    voff[i] = (unsigned)(k * ldk * 2 + col * 2); }
#define KROW(t) ((t) * KVBLK + (((t) >= nfirst) ? skip : 0))
#define DK_ISSUE(t, slot) do { const char* kb_ = (const char*)K + (size_t)KROW(t) * 2 * ldk; \
    _Pragma("unroll") for (int i = 0; i < 2; ++i) dma16(kb_ + koff[i], K_lds + (slot) * 16384 + (wid * 2 + i) * 1024); } while (0)
#define DV_ISSUE(t, slot) do { const char* vb_ = (const char*)V + (size_t)KROW(t) * 2 * ldk; \
    _Pragma("unroll") for (int i = 0; i < 2; ++i) dma16(vb_ + voff[i], V_lds + (slot) * 16384 + (wid * 2 + i) * 1024); } while (0)
#define RESC(a) do { if (__any((a) < 1.f)) { if (hi == 0) al_l[r32] = (a); asm volatile("s_waitcnt lgkmcnt(0)" ::: "memory"); \
    _Pragma("unroll") for (int d = 0; d < 5; ++d) _Pragma("unroll") for (int r = 0; r < 16; ++r) o[d][r] *= al_l[crow(r, hi)]; } } while (0)
#define MASK(P0, P1, t) do { if ((t) >= nfirst) band_mask(P0, P1, KROW(t) - 512 - qi, hi); } while (0)
#define STEP_SYNC() do { asm volatile("s_waitcnt vmcnt(0) lgkmcnt(0)" ::: "memory"); __builtin_amdgcn_s_barrier(); } while (0)
  DK_ISSUE(0, 0);
  bf16x8 qr[8];
  { const bf16_t* Qw = Q + (long)(wid * QBLK + r32) * ldq + hi * 8;
#pragma unroll
    for (int d0 = 0; d0 < 8; ++d0) qr[d0] = *reinterpret_cast<const bf16x8*>(Qw + d0 * 16);
    {
      constexpr float CQ = SCALE * 1.4426950408889634f;
      float qf[8][8];
#pragma unroll
      for (int d0 = 0; d0 < 8; ++d0)
#pragma unroll
        for (int j = 0; j < 8; ++j) qf[d0][j] = __uint_as_float(((unsigned)(unsigned short)qr[d0][j]) << 16);
      if (qmode & 1) { float ss = 0.f;
#pragma unroll
        for (int d0 = 0; d0 < 8; ++d0)
#pragma unroll
          for (int j = 0; j < 8; ++j) ss += qf[d0][j] * qf[d0][j];
        ss += __shfl_xor(ss, 32);
        const float rstd = 1.0f / sqrtf(ss * (1.0f / 128.0f) + 1e-6f);
#pragma unroll
        for (int d0 = 0; d0 < 8; ++d0) { const float* gp = gq + d0 * 16 + hi * 8; const float4 g0 = *reinterpret_cast<const float4*>(gp), g1 = *reinterpret_cast<const float4*>(gp + 4);
          qf[d0][0] *= rstd * g0.x; qf[d0][1] *= rstd * g0.y; qf[d0][2] *= rstd * g0.z; qf[d0][3] *= rstd * g0.w; qf[d0][4] *= rstd * g1.x; qf[d0][5] *= rstd * g1.y; qf[d0][6] *= rstd * g1.z; qf[d0][7] *= rstd * g1.w; } }
      if (qmode & 2) { const int t = qi;
#pragma unroll
        for (int hf = 0; hf < 2; ++hf) { const int p = hf ? (t & 63) : (t >> 6);
#pragma unroll
          for (int dd = 0; dd < 2; ++dd) { const int d0 = hf * 4 + dd, i0 = dd * 16 + hi * 8;
            const float4 c0 = *reinterpret_cast<const float4*>(ropeC + p * 32 + i0), c1 = *reinterpret_cast<const float4*>(ropeC + p * 32 + i0 + 4);
            const float4 s0 = *reinterpret_cast<const float4*>(ropeS + p * 32 + i0), s1 = *reinterpret_cast<const float4*>(ropeS + p * 32 + i0 + 4);
            const float cs[8] = {c0.x, c0.y, c0.z, c0.w, c1.x, c1.y, c1.z, c1.w}, sn[8] = {s0.x, s0.y, s0.z, s0.w, s1.x, s1.y, s1.z, s1.w};
#pragma unroll
            for (int j = 0; j < 8; ++j) { const float x1 = qf[d0][j], x2 = qf[d0 + 2][j]; qf[d0][j] = x1 * cs[j] - x2 * sn[j]; qf[d0 + 2][j] = x1 * sn[j] + x2 * cs[j]; } } } }
#pragma unroll
      for (int d0 = 0; d0 < 8; ++d0) { u32x4 w = {cvtpk(qf[d0][0] * CQ, qf[d0][1] * CQ), cvtpk(qf[d0][2] * CQ, qf[d0][3] * CQ), cvtpk(qf[d0][4] * CQ, qf[d0][5] * CQ), cvtpk(qf[d0][6] * CQ, qf[d0][7] * CQ)}; qr[d0] = *reinterpret_cast<bf16x8*>(&w); }
    } }
  float m_reg = 0.f; f32x16 o[5] = {}; f32x16 negm = {};
  const ALAS char* vbp = V_lds + v_rd_base(lane);
  f32x16 p0 = {}, p1 = {}; float al = 1.f; bf16x8 pa0 = {}, pa1 = {}, pa2 = {}, pa3 = {};
  const int grp = wid >> 2;
#define SEG_END() do { SBAR(); __builtin_amdgcn_s_barrier(); SBAR(); } while (0)
#define PSEG(t) do { MASK(p0, p1, t); psm_n(p0, p1, m_reg, al, negm, (t) == 0); RESC(al); } while (0)
  STEP_SYNC();
#define SEG_END_V() do { SBAR(); asm volatile("s_waitcnt vmcnt(0)" ::: "memory"); __builtin_amdgcn_s_barrier(); SBAR(); } while (0)
  if (grp == 0) {
    for (int j = 0; j < nt; ++j) {
      const int sc = (j & 1) * 16384, sn = 16384 - sc;
      if (j + 1 < nt) DK_ISSUE(j + 1, (j + 1) & 1);
      DV_ISSUE(j, j & 1);
      if (j > 0) { pv_seg(o, vbp + sn, pa0, pa1, pa2, pa3); SBAR(); }
      qk_seg(p0, p1, K_lds + sc, qr, negm, r32, hi);
      SEG_END();
      PSEG(j);
      fsm_n(p0, p1, pa0, pa1, pa2, pa3);
      SEG_END_V();
    }
    pv_seg(o, vbp + ((nt - 1) & 1) * 16384, pa0, pa1, pa2, pa3);
    SEG_END();
  } else {
    DK_ISSUE(1, 1);
    DV_ISSUE(0, 0);
    SEG_END();
    for (int j = 0; j < nt; ++j) {
      const int sc = (j & 1) * 16384, sn = 16384 - sc;
      if (j > 0) { pv_seg(o, vbp + sn, pa0, pa1, pa2, pa3); SBAR(); }
      qk_seg(p0, p1, K_lds + sc, qr, negm, r32, hi);
      SEG_END_V();
      if (j + 2 < nt) DK_ISSUE(j + 2, j & 1);
      if (j + 1 < nt) DV_ISSUE(j + 1, (j + 1) & 1);
      PSEG(j);
      fsm_n(p0, p1, pa0, pa1, pa2, pa3);
      SEG_END();
    }
    pv_seg(o, vbp + ((nt - 1) & 1) * 16384, pa0, pa1, pa2, pa3);
  }
  STEP_SYNC();
#undef SEG_END_V
#undef PSEG
#undef SEG_END
#undef DK_ISSUE
#undef DV_ISSUE
#undef KROW
#undef RESC
#undef MASK
#undef STEP_SYNC
  if (hi == 0) li_l[r32] = m_reg; asm volatile("s_waitcnt lgkmcnt(0)" ::: "memory");
  float rli[16];
#pragma unroll
  for (int r = 0; r < 16; ++r) rli[r] = __builtin_amdgcn_rcpf(o[4][r] + __builtin_amdgcn_exp2f(sinkl2 - li_l[crow(r, hi)]));
  { ALAS char* og = lds + wid * 8192; bf16_t* Og = O + (long)(wid * QBLK) * ldo;
#pragma unroll
    for (int r = 0; r < 16; ++r) { const int row = crow(r, hi);
#pragma unroll
      for (int d = 0; d < 4; ++d) { const unsigned w = cvtpk(o[d][r] * rli[r], 0.f); *(ALAS unsigned short*)(og + row * 256 + (d * 32 + r32) * 2) = (unsigned short)(w & 0xffffu); } }
#pragma unroll
    for (int k = 0; k < 8; ++k) { const int p = lane + 64 * k; const u32x4 v = *(const ALAS u32x4*)(og + p * 16);
      *reinterpret_cast<u32x4*>(Og + (long)(p >> 4) * ldo + (p & 15) * 8) = v; }
  }
}

#define G_CVT4(P, BASE) do { t0 = cvtpk(P[BASE + 0], P[BASE + 1]); t1 = cvtpk(P[BASE + 2], P[BASE + 3]); t2 = cvtpk(P[BASE + 4], P[BASE + 5]); t3 = cvtpk(P[BASE + 6], P[BASE + 7]); } while (0)
#define G_SWP4(OUT) do { auto r0_ = __builtin_amdgcn_permlane32_swap(t0, t2, false, false); auto r1_ = __builtin_amdgcn_permlane32_swap(t1, t3, false, false); \
    u32x4 w_ = {r0_[0], r1_[0], r0_[1], r1_[1]}; OUT = *reinterpret_cast<bf16x8*>(&w_); } while (0)
__device__ __forceinline__ void blk_qk_fin(f32x16& n0, f32x16& n1, const ALAS char* Ks, const bf16x8* qr, const f32x16& negm, int r32, int hi,
                                           const f32x16& c0, f32x16& c1, bf16x8& pa0, bf16x8& pa1, bf16x8& pa2, float alpha_c, float& l_reg) {
  int sw = ((r32 & 7) << 4) ^ (hi * 16); asm volatile("" : "+v"(sw));
  const int r0 = (int)(uintptr_t)Ks + r32 * 256;
#define KRD(DST0, DST1, d0) do { const int ad_ = r0 + (((d0) * 32) ^ sw); asm volatile("ds_read_b128 %0, %2\n\tds_read_b128 %1, %2 offset:8192" : "=&v"(DST0), "=&v"(DST1) : "v"(ad_) : "memory"); } while (0)
  bf16x8 a[2], b[2]; unsigned t0 = 0, t1 = 0, t2 = 0, t3 = 0; float psA = 0.f, psB = 0.f;
  KRD(a[0], b[0], 0); KRD(a[1], b[1], 1);
  SBAR();
#pragma unroll
  for (int d0 = 0; d0 < 8; ++d0) {
    if (d0 < 7) PP_WAIT2(2, a[d0 & 1], b[d0 & 1]); else PP_WAIT2(0, a[d0 & 1], b[d0 & 1]);
    n0 = __builtin_amdgcn_mfma_f32_32x32x16_bf16(a[d0 & 1], qr[d0], d0 == 0 ? negm : n0, 0, 0, 0);
    n1 = __builtin_amdgcn_mfma_f32_32x32x16_bf16(b[d0 & 1], qr[d0], d0 == 0 ? negm : n1, 0, 0, 0);
    SBAR();
    if (d0 + 2 < 8) { KRD(a[d0 & 1], b[d0 & 1], d0 + 2); SBAR(); }
    c1[2 * d0] = __builtin_amdgcn_exp2f(c1[2 * d0]); c1[2 * d0 + 1] = __builtin_amdgcn_exp2f(c1[2 * d0 + 1]);
    psA += c0[2 * d0] + c0[2 * d0 + 1]; if (d0 > 0) psB += c1[2 * d0 - 2] + c1[2 * d0 - 1];
    if (d0 == 0) G_CVT4(c0, 0); if (d0 == 1) G_SWP4(pa0); if (d0 == 2) G_CVT4(c0, 8); if (d0 == 3) G_SWP4(pa1); if (d0 == 4) G_CVT4(c1, 0); if (d0 == 5) G_SWP4(pa2);
    SBAR();
  }
  { float ps = (psA + psB) + (c1[14] + c1[15]); auto rr = __builtin_amdgcn_permlane32_swap(__float_as_uint(ps), __float_as_uint(ps), false, false);
    l_reg = l_reg * alpha_c + (__uint_as_float(rr[0]) + __uint_as_float(rr[1])); }
#undef KRD
}
__device__ __forceinline__ void blk_pv_par(f32x16* o, const ALAS char* vbp, bf16x8 pa0, bf16x8 pa1, bf16x8 pa2, const f32x16& c1,
                                           f32x16& n0, f32x16& n1, float& m_reg, float& alpha, f32x16& negm, bool domask, int dj, int hi) {
  const int vb = (int)(uintptr_t)vbp;
#define PK(L, H) (bf16x8){L[0], L[1], L[2], L[3], H[0], H[1], H[2], H[3]}
  s16x4 lo[3], hh[3]; bf16x8 pa3 = {}; unsigned t0 = 0, t1 = 0, t2 = 0, t3 = 0; float mA = 0.f, mB = 0.f, pmax = 0.f;
  lo[0] = tr_read<v_rd_off(0, 0, 0)>(vb); hh[0] = tr_read<v_rd_off(0, 0, 1)>(vb); lo[1] = tr_read<v_rd_off(0, 1, 0)>(vb); hh[1] = tr_read<v_rd_off(0, 1, 1)>(vb);
  lo[2] = tr_read<v_rd_off(0, 2, 0)>(vb); hh[2] = tr_read<v_rd_off(0, 2, 1)>(vb);
  if (domask) band_mask(n0, n1, dj, hi);
  SBAR();
#define PVSTEP(d, ks, PA, WN, NEXT) do { constexpr int i_ = (d) * 4 + (ks), s_ = i_ % 3, n_ = i_ + 3; PP_WAIT2(WN, lo[s_], hh[s_]); o[d] = __builtin_amdgcn_mfma_f32_32x32x16_bf16(PA, PK(lo[s_], hh[s_]), o[d], 0, 0, 0); SBAR(); \
    if (NEXT) { lo[s_] = tr_read<v_rd_off((n_ >> 2) & 3, n_ & 3, 0)>(vb); hh[s_] = tr_read<v_rd_off((n_ >> 2) & 3, n_ & 3, 1)>(vb); SBAR(); } } while (0)
#define MX3(M, P, i) M = fmaxf(fmaxf(M, P[i]), P[(i) + 1])
  PVSTEP(0, 0, pa0, 4, 1); G_CVT4(c1, 8); SBAR();
  PVSTEP(0, 1, pa1, 4, 1); G_SWP4(pa3); SBAR();
  PVSTEP(0, 2, pa2, 4, 1); mA = fmaxf(fmaxf(n0[0], n0[1]), n0[2]); mB = fmaxf(fmaxf(n1[0], n1[1]), n1[2]); SBAR();
  PVSTEP(0, 3, pa3, 4, 1); MX3(mA, n0, 3); MX3(mB, n1, 3); SBAR();
  PVSTEP(1, 0, pa0, 4, 1); MX3(mA, n0, 5); MX3(mB, n1, 5); SBAR();
  PVSTEP(1, 1, pa1, 4, 1); MX3(mA, n0, 7); MX3(mB, n1, 7); SBAR();
  PVSTEP(1, 2, pa2, 4, 1); MX3(mA, n0, 9); MX3(mB, n1, 9); SBAR();
  PVSTEP(1, 3, pa3, 4, 1); MX3(mA, n0, 11); MX3(mB, n1, 11); SBAR();
  PVSTEP(2, 0, pa0, 4, 1); MX3(mA, n0, 13); MX3(mB, n1, 13); SBAR();
  PVSTEP(2, 1, pa1, 4, 1); pmax = fmaxf(fmaxf(mA, n0[15]), fmaxf(mB, n1[15]));
  { auto rr = __builtin_amdgcn_permlane32_swap(__float_as_uint(pmax), __float_as_uint(pmax), false, false); pmax = fmaxf(__uint_as_float(rr[0]), __uint_as_float(rr[1])); } SBAR();
  PVSTEP(2, 2, pa2, 4, 1);
  alpha = 1.f;
  if (__builtin_expect(!__all(pmax <= THRL2), 0)) { const float delta = fmaxf(pmax, 0.f); alpha = __builtin_amdgcn_exp2f(-delta); m_reg += delta;
#pragma unroll
    for (int r = 0; r < 16; ++r) { n0[r] -= delta; n1[r] -= delta; negm[r] = -m_reg; } }
  SBAR();
  PVSTEP(2, 3, pa3, 4, 1); n0[0] = __builtin_amdgcn_exp2f(n0[0]); n0[1] = __builtin_amdgcn_exp2f(n0[1]); SBAR();
  PVSTEP(3, 0, pa0, 4, 1); n0[2] = __builtin_amdgcn_exp2f(n0[2]); n0[3] = __builtin_amdgcn_exp2f(n0[3]); SBAR();
  PVSTEP(3, 1, pa1, 4, 0); n0[4] = __builtin_amdgcn_exp2f(n0[4]); n0[5] = __builtin_amdgcn_exp2f(n0[5]); SBAR();
  PVSTEP(3, 2, pa2, 2, 0); n0[6] = __builtin_amdgcn_exp2f(n0[6]); n0[7] = __builtin_amdgcn_exp2f(n0[7]); SBAR();
  PVSTEP(3, 3, pa3, 0, 0); n0[8] = __builtin_amdgcn_exp2f(n0[8]); n0[9] = __builtin_amdgcn_exp2f(n0[9]); SBAR();
  n0[10] = __builtin_amdgcn_exp2f(n0[10]); n0[11] = __builtin_amdgcn_exp2f(n0[11]); n0[12] = __builtin_amdgcn_exp2f(n0[12]); n0[13] = __builtin_amdgcn_exp2f(n0[13]);
  n0[14] = __builtin_amdgcn_exp2f(n0[14]); n0[15] = __builtin_amdgcn_exp2f(n0[15]); SBAR();
#undef MX3
#undef PVSTEP
#undef PK
}
__device__ __forceinline__ void attn_unit_g(const bf16_t* __restrict__ Q, const bf16_t* __restrict__ K, const bf16_t* __restrict__ V, bf16_t* __restrict__ O,
                                               int ldq, int ldk, int ldo, int nt, int nfirst, int skip, int qpos0, float sinkl2, ALAS char* lds, ALAS float* scr,
                                               int qmode  , float sinkB, const float* __restrict__ gq, const float* __restrict__ ropeC, const float* __restrict__ ropeS) {
  int tid_l = tid_now(); asm volatile("" : "+v"(tid_l));
  const int tid = tid_l, wid = __builtin_amdgcn_readfirstlane(tid >> 6), lane = tid & 63, r32 = lane & 31, hi = lane >> 5;
  ALAS char* K_lds = lds; ALAS char* V_lds = lds + 32768;
  ALAS float* li_l = scr; ALAS float* al_l = scr + 32;
  const int wrow = (qmode & 4) ? (wid & 3) : wid, hoff = (qmode & 4) ? (wid >> 2) * 128 : 0;
  const int qi = qpos0 + wrow * QBLK + r32;
  unsigned koff[2], voff[2];
#pragma unroll
  for (int i = 0; i < 2; ++i) { const int L = (wid * 2 + i) * 1024 + lane * 16, row = L >> 8, cb = (L & 255) ^ ((row & 7) << 4); koff[i] = (unsigned)(row * ldk * 2 + cb); }
#pragma unroll
  for (int i = 0; i < 2; ++i) { const int L = (wid * 2 + i) * 1024 + lane * 16, sub = L >> 9, within = L & 511;
    const int kk = (sub >> 2) * 8 + (within >> 6), k = (kk & ~0xC) | ((kk & 4) << 1) | ((kk & 8) >> 1), col = (sub & 3) * 32 + ((within & 63) >> 1);
    voff[i] = (unsigned)(k * ldk * 2 + col * 2); }
#define KROW(t) ((t) * KVBLK + (((t) >= nfirst) ? skip : 0))
  ALAS char* const offs = lds + 65536 + wid * 1024 + lane * 16;
  { u32x4 ov = {koff[0], koff[1], voff[0], voff[1]}; *(ALAS u32x4*)offs = ov; asm volatile("s_waitcnt lgkmcnt(0)" ::: "memory"); }
#define DK_ISSUE(t, slot) do { const char* kb_ = (const char*)K + (size_t)KROW(t) * 2 * ldk; const u32x4 ov_ = *(const ALAS u32x4*)offs; \
    dma16(kb_ + ov_[0], K_lds + (slot) * 16384 + (wid * 2 + 0) * 1024); dma16(kb_ + ov_[1], K_lds + (slot) * 16384 + (wid * 2 + 1) * 1024); } while (0)
#define DV_ISSUE(t, slot) do { const char* vb_ = (const char*)V + (size_t)KROW(t) * 2 * ldk; const u32x4 ov_ = *(const ALAS u32x4*)offs; \
    dma16(vb_ + ov_[2], V_lds + (slot) * 16384 + (wid * 2 + 0) * 1024); dma16(vb_ + ov_[3], V_lds + (slot) * 16384 + (wid * 2 + 1) * 1024); } while (0)
#define RESC(a) do { if (__any((a) < 1.f)) { if (hi == 0) al_l[r32] = (a); asm volatile("s_waitcnt lgkmcnt(0)" ::: "memory"); \
    _Pragma("unroll") for (int d = 0; d < 4; ++d) _Pragma("unroll") for (int r = 0; r < 16; ++r) o[d][r] *= al_l[crow(r, hi)]; } } while (0)
#define MASK(P0, P1, t) do { if ((t) >= nfirst) band_mask(P0, P1, KROW(t) - 512 - qi, hi); } while (0)
#define STEP_SYNC() do { asm volatile("s_waitcnt vmcnt(0) lgkmcnt(0)" ::: "memory"); __builtin_amdgcn_s_barrier(); } while (0)
  DK_ISSUE(0, 0); DV_ISSUE(0, 0); DK_ISSUE(1, 1);
  bf16x8 qr[8];
  { const bf16_t* Qw = Q + hoff + (long)(wrow * QBLK + r32) * ldq + hi * 8;
#pragma unroll
    for (int d0 = 0; d0 < 8; ++d0) qr[d0] = *reinterpret_cast<const bf16x8*>(Qw + d0 * 16);
    {
      constexpr float CQ = SCALE * 1.4426950408889634f;
      float qf[8][8];
#pragma unroll
      for (int d0 = 0; d0 < 8; ++d0)
#pragma unroll
        for (int j = 0; j < 8; ++j) qf[d0][j] = __uint_as_float(((unsigned)(unsigned short)qr[d0][j]) << 16);
      if (qmode & 1) { float ss = 0.f;
#pragma unroll
        for (int d0 = 0; d0 < 8; ++d0)
#pragma unroll
          for (int j = 0; j < 8; ++j) ss += qf[d0][j] * qf[d0][j];
        ss += __shfl_xor(ss, 32);
        const float rstd = 1.0f / sqrtf(ss * (1.0f / 128.0f) + 1e-6f);
#pragma unroll
        for (int d0 = 0; d0 < 8; ++d0) { const float* gp = gq + d0 * 16 + hi * 8; const float4 g0 = *reinterpret_cast<const float4*>(gp), g1 = *reinterpret_cast<const float4*>(gp + 4);
          qf[d0][0] *= rstd * g0.x; qf[d0][1] *= rstd * g0.y; qf[d0][2] *= rstd * g0.z; qf[d0][3] *= rstd * g0.w; qf[d0][4] *= rstd * g1.x; qf[d0][5] *= rstd * g1.y; qf[d0][6] *= rstd * g1.z; qf[d0][7] *= rstd * g1.w; } }
      if (qmode & 2) { const int t = qi;
#pragma unroll
        for (int hf = 0; hf < 2; ++hf) { const int p = hf ? (t & 63) : (t >> 6);
#pragma unroll
          for (int dd = 0; dd < 2; ++dd) { const int d0 = hf * 4 + dd, i0 = dd * 16 + hi * 8;
            const float4 c0 = *reinterpret_cast<const float4*>(ropeC + p * 32 + i0), c1 = *reinterpret_cast<const float4*>(ropeC + p * 32 + i0 + 4);
            const float4 s0 = *reinterpret_cast<const float4*>(ropeS + p * 32 + i0), s1 = *reinterpret_cast<const float4*>(ropeS + p * 32 + i0 + 4);
            const float cs[8] = {c0.x, c0.y, c0.z, c0.w, c1.x, c1.y, c1.z, c1.w}, sn[8] = {s0.x, s0.y, s0.z, s0.w, s1.x, s1.y, s1.z, s1.w};
#pragma unroll
            for (int j = 0; j < 8; ++j) { const float x1 = qf[d0][j], x2 = qf[d0 + 2][j]; qf[d0][j] = x1 * cs[j] - x2 * sn[j]; qf[d0 + 2][j] = x1 * sn[j] + x2 * cs[j]; } } } }
#pragma unroll
      for (int d0 = 0; d0 < 8; ++d0) { u32x4 w = {cvtpk(qf[d0][0] * CQ, qf[d0][1] * CQ), cvtpk(qf[d0][2] * CQ, qf[d0][3] * CQ), cvtpk(qf[d0][4] * CQ, qf[d0][5] * CQ), cvtpk(qf[d0][6] * CQ, qf[d0][7] * CQ)}; qr[d0] = *reinterpret_cast<bf16x8*>(&w); }
    } }
  float m_reg = 0.f, l_reg = 0.f; f32x16 o[4] = {}; f32x16 negm = {};
  const ALAS char* vbp = V_lds + v_rd_base(lane);
  f32x16 pA0, pA1, pB0, pB1; float alA = 1.f, alB = 1.f; bf16x8 pa0, pa1, pa2, pa3;
  STEP_SYNC();
  qk_seg(pA0, pA1, K_lds, qr, negm, r32, hi); MASK(pA0, pA1, 0); psm_n(pA0, pA1, m_reg, alA, negm, true);
  STEP_SYNC();
  int j = 0;
  for (; j + 2 < nt; j += 2) {
    DK_ISSUE(j + 2, 0); DV_ISSUE(j + 1, 1);
    SBAR(); blk_qk_fin(pB0, pB1, K_lds + 16384, qr, negm, r32, hi, pA0, pA1, pa0, pa1, pa2, alA, l_reg);
    blk_pv_par(o, vbp, pa0, pa1, pa2, pA1, pB0, pB1, m_reg, alB, negm, (j + 1) >= nfirst, KROW(j + 1) - 512 - qi, hi);
    STEP_SYNC();
    RESC(alB);
    if (j + 3 < nt) DK_ISSUE(j + 3, 1);
    DV_ISSUE(j + 2, 0);
    SBAR(); blk_qk_fin(pA0, pA1, K_lds, qr, negm, r32, hi, pB0, pB1, pa0, pa1, pa2, alB, l_reg);
    blk_pv_par(o, vbp + 16384, pa0, pa1, pa2, pB1, pA0, pA1, m_reg, alA, negm, (j + 2) >= nfirst, KROW(j + 2) - 512 - qi, hi);
    STEP_SYNC();
    RESC(alA);
  }
  DV_ISSUE(j + 1, 1);
  SBAR(); blk_qk_fin(pB0, pB1, K_lds + 16384, qr, negm, r32, hi, pA0, pA1, pa0, pa1, pa2, alA, l_reg);
  blk_pv_par(o, vbp, pa0, pa1, pa2, pA1, pB0, pB1, m_reg, alB, negm, (j + 1) >= nfirst, KROW(j + 1) - 512 - qi, hi);
  STEP_SYNC();
  RESC(alB);
  finishSM(pB0, pB1, alB, l_reg, pa0, pa1, pa2, pa3); SBAR();
  pv_d0(o, (int)(uintptr_t)(vbp + 16384), pa0, pa1, pa2, pa3);
  STEP_SYNC();
#undef DK_ISSUE
#undef DV_ISSUE
#undef KROW
#undef RESC
#undef MASK
#undef STEP_SYNC
  l_reg += __builtin_amdgcn_exp2f(((qmode & 4) && wid >= 4 ? sinkB : sinkl2) - m_reg);
  if (hi == 0) li_l[r32] = l_reg; asm volatile("s_waitcnt lgkmcnt(0)" ::: "memory");
  float rli[16];
#pragma unroll
  for (int r = 0; r < 16; ++r) rli[r] = __builtin_amdgcn_rcpf(li_l[crow(r, hi)]);
  { ALAS char* og = lds + wid * 8192; bf16_t* Og = O + hoff + (long)(wrow * QBLK) * ldo;
#pragma unroll
    for (int r = 0; r < 16; ++r) { const int row = crow(r, hi);
#pragma unroll
      for (int d = 0; d < 4; ++d) { const unsigned w = cvtpk(o[d][r] * rli[r], 0.f); *(ALAS unsigned short*)(og + row * 256 + (d * 32 + r32) * 2) = (unsigned short)(w & 0xffffu); } }
#pragma unroll
    for (int k = 0; k < 8; ++k) { const int p = lane + 64 * k; const u32x4 v = *(const ALAS u32x4*)(og + p * 16);
      *reinterpret_cast<u32x4*>(Og + (long)(p >> 4) * ldo + (p & 15) * 8) = v; }
  }
}

__device__ __forceinline__ void pv8_sm(f32x16* o, int vb, bf16x8 pa0, bf16x8 pa1, bf16x8 pa2, bf16x8 pa3, f32x16& p0, f32x16& p1, float& m_reg, float& mn, float& alpha) {
  constexpr float C = SCALE * 1.4426950408889634f;
  pv_one<0>(o[0], vb, pa0, pa1, pa2, pa3); pv_one<1>(o[1], vb, pa0, pa1, pa2, pa3);
  float pmax = p0[0];
#pragma unroll
  for (int r = 1; r < 16; ++r) pmax = fmaxf(pmax, p0[r]);
#pragma unroll
  for (int r = 0; r < 16; ++r) pmax = fmaxf(pmax, p1[r]);
  { auto rr = __builtin_amdgcn_permlane32_swap(__float_as_uint(pmax), __float_as_uint(pmax), false, false);
    pmax = fmaxf(__uint_as_float(rr[0]), __uint_as_float(rr[1])); }
  pv_one<2>(o[2], vb, pa0, pa1, pa2, pa3); pv_one<3>(o[3], vb, pa0, pa1, pa2, pa3);
  if (__builtin_expect(__all(pmax - m_reg <= THR / SCALE), 1)) { mn = m_reg; alpha = 1.f; }
  else { mn = fmaxf(m_reg, pmax); alpha = __builtin_amdgcn_exp2f((m_reg - mn) * C); m_reg = mn; }
  const float mnC = -mn * C;
#pragma unroll
  for (int r = 0; r < 16; ++r) p0[r] = fmaf(p0[r], C, mnC);
  pv_one<0>(o[4], vb + 16384, pa0, pa1, pa2, pa3); pv_one<1>(o[5], vb + 16384, pa0, pa1, pa2, pa3);
#pragma unroll
  for (int r = 0; r < 16; ++r) p1[r] = fmaf(p1[r], C, mnC);
#pragma unroll
  for (int r = 0; r < 8; ++r) p0[r] = __builtin_amdgcn_exp2f(p0[r]);
  pv_one<2>(o[6], vb + 16384, pa0, pa1, pa2, pa3); pv_one<3>(o[7], vb + 16384, pa0, pa1, pa2, pa3);
#pragma unroll
  for (int r = 8; r < 16; ++r) p0[r] = __builtin_amdgcn_exp2f(p0[r]);
}
__device__ __forceinline__ void qkt_ldsq(f32x16& p0, f32x16& p1, const ALAS char* Ks, const ALAS char* Qs, int lane, int r32, int hi) {
  p0 = f32x16{}; p1 = f32x16{};
#pragma unroll
  for (int d0 = 0; d0 < 8; ++d0) { const int cb = (d0 * 16 + hi * 8) * 2;
    const bf16x8 qd = *(const ALAS bf16x8*)(Qs + (d0 * 64 + lane) * 16);
    const bf16x8 b0 = *reinterpret_cast<const ALAS bf16x8*>(Ks + KSWZ(r32, cb));
    const bf16x8 b1 = *reinterpret_cast<const ALAS bf16x8*>(Ks + KSWZ(32 + r32, cb));
    p0 = __builtin_amdgcn_mfma_f32_32x32x16_bf16(b0, qd, p0, 0, 0, 0);
    p1 = __builtin_amdgcn_mfma_f32_32x32x16_bf16(b1, qd, p1, 0, 0, 0); }
}
__device__ __forceinline__ void attn_unit_diff2(const bf16_t* __restrict__ Q, const bf16_t* __restrict__ K, const bf16_t* __restrict__ V, bf16_t* __restrict__ O,
                                                int ldq, int ldk, int ldo, int nt, int qpos0, ALAS char* lds, ALAS float* scr,
                                                int qmode, const float* __restrict__ ropeC, const float* __restrict__ ropeS) {
  int tid_l = tid_now(); asm volatile("" : "+v"(tid_l));
  const int tid = tid_l, wid = __builtin_amdgcn_readfirstlane(tid >> 6), lane = tid & 63, r32 = lane & 31, hi = lane >> 5;
  ALAS char* K_lds = lds; ALAS char* V_lds = lds + 32768; ALAS char* Qs = lds + 65536 + wid * 8192;
  ALAS float* li_l = scr; ALAS float* al_l = scr + 32;
#define DK_ISSUE(t, slot) do { const char* kb_ = (const char*)K + (size_t)(t) * (KVBLK * 2) * ldk; int ln_ = lane; asm volatile("" : "+v"(ln_)); \
    _Pragma("unroll") for (int i = 0; i < 2; ++i) { const int L = (wid * 2 + i) * 1024 + ln_ * 16, row = L >> 8, cb = (L & 255) ^ ((row & 7) << 4); \
        dma16(kb_ + (unsigned)(row * ldk * 2 + cb), K_lds + (slot) * 16384 + (wid * 2 + i) * 1024); } } while (0)
#define DV_ISSUE(t) do { const char* vb_ = (const char*)V + (size_t)(t) * (KVBLK * 2) * ldk; int ln_ = lane; asm volatile("" : "+v"(ln_)); \
    _Pragma("unroll") for (int i = 0; i < 4; ++i) { const int L = (wid * 4 + i) * 1024 + ln_ * 16, half = L >> 14, Lh = L & 16383, sub = Lh >> 9, within = Lh & 511; \
        const int kk = (sub >> 2) * 8 + (within >> 6), k = (kk & ~0xC) | ((kk & 4) << 1) | ((kk & 8) >> 1), col = half * 128 + (sub & 3) * 32 + ((within & 63) >> 1); \
        dma16(vb_ + (unsigned)(k * ldk * 2 + col * 2), V_lds + (wid * 4 + i) * 1024); } } while (0)
#define RESC8(a) do { if (__any((a) < 1.f)) { if (hi == 0) al_l[r32] = (a); asm volatile("s_waitcnt lgkmcnt(0)" ::: "memory"); \
    _Pragma("unroll") for (int d = 0; d < 8; ++d) _Pragma("unroll") for (int r = 0; r < 16; ++r) o[d][r] *= al_l[crow(r, hi)]; } } while (0)
#define STEP_SYNC() do { asm volatile("s_waitcnt vmcnt(0) lgkmcnt(0)" ::: "memory"); __builtin_amdgcn_s_barrier(); } while (0)
  DK_ISSUE(0, 0); DK_ISSUE(1, 1);
  { bf16x8 qr[8];
    const bf16_t* Qw = Q + (long)(wid * QBLK + r32) * ldq + hi * 8;
#pragma unroll
    for (int d0 = 0; d0 < 8; ++d0) qr[d0] = *reinterpret_cast<const bf16x8*>(Qw + d0 * 16);
    if (qmode & 2) {
      float qf[8][8];
#pragma unroll
      for (int d0 = 0; d0 < 8; ++d0)
#pragma unroll
        for (int j = 0; j < 8; ++j) qf[d0][j] = __uint_as_float(((unsigned)(unsigned short)qr[d0][j]) << 16);
      const int t = qpos0 + wid * QBLK + r32;
#pragma unroll
      for (int hf = 0; hf < 2; ++hf) { const int p = hf ? (t & 63) : (t >> 6);
#pragma unroll
        for (int dd = 0; dd < 2; ++dd) { const int d0 = hf * 4 + dd, i0 = dd * 16 + hi * 8;
          const float4 c0 = *reinterpret_cast<const float4*>(ropeC + p * 32 + i0), c1 = *reinterpret_cast<const float4*>(ropeC + p * 32 + i0 + 4);
          const float4 s0 = *reinterpret_cast<const float4*>(ropeS + p * 32 + i0), s1 = *reinterpret_cast<const float4*>(ropeS + p * 32 + i0 + 4);
          const float cs[8] = {c0.x, c0.y, c0.z, c0.w, c1.x, c1.y, c1.z, c1.w}, sn[8] = {s0.x, s0.y, s0.z, s0.w, s1.x, s1.y, s1.z, s1.w};
#pragma unroll
          for (int j = 0; j < 8; ++j) { const float x1 = qf[d0][j], x2 = qf[d0 + 2][j]; qf[d0][j] = x1 * cs[j] - x2 * sn[j]; qf[d0 + 2][j] = x1 * sn[j] + x2 * cs[j]; } } }
#pragma unroll
      for (int d0 = 0; d0 < 8; ++d0) { u32x4 w = {cvtpk(qf[d0][0], qf[d0][1]), cvtpk(qf[d0][2], qf[d0][3]), cvtpk(qf[d0][4], qf[d0][5]), cvtpk(qf[d0][6], qf[d0][7])}; qr[d0] = *reinterpret_cast<bf16x8*>(&w); }
    }
#pragma unroll
    for (int d0 = 0; d0 < 8; ++d0) *(ALAS bf16x8*)(Qs + (d0 * 64 + lane) * 16) = qr[d0];
  }
  float m_reg = -1e30f, l_reg = 0.f; f32x16 o[8] = {};
  const int vb0 = (int)(uintptr_t)V_lds + v_rd_base(lane);
  f32x16 pA0, pA1, pB0, pB1; float mnA, mnB, alA, alB; bf16x8 pa0, pa1, pa2, pa3;
  STEP_SYNC();
  qkt_ldsq(pA0, pA1, K_lds, Qs, lane, r32, hi); partialSM(pA0, pA1, m_reg, mnA, alA);
  STEP_SYNC();
  int j = 0;
  for (; j + 2 < nt; j += 2) {
    DV_ISSUE(j); DK_ISSUE(j + 2, 0);
    SBAR(); qkt_ldsq(pB0, pB1, K_lds + 16384, Qs, lane, r32, hi);
    finishSM(pA0, pA1, alA, l_reg, pa0, pa1, pa2, pa3); SBAR();
    STEP_SYNC();
    pv8_sm(o, vb0, pa0, pa1, pa2, pa3, pB0, pB1, m_reg, mnB, alB);
    STEP_SYNC();
    RESC8(alB);
    DV_ISSUE(j + 1); if (j + 3 < nt) DK_ISSUE(j + 3, 1);
    SBAR(); qkt_ldsq(pA0, pA1, K_lds, Qs, lane, r32, hi);
    finishSM(pB0, pB1, alB, l_reg, pa0, pa1, pa2, pa3); SBAR();
    STEP_SYNC();
    pv8_sm(o, vb0, pa0, pa1, pa2, pa3, pA0, pA1, m_reg, mnA, alA);
    STEP_SYNC();
    RESC8(alA);
  }
  DV_ISSUE(j);
  SBAR(); qkt_ldsq(pB0, pB1, K_lds + 16384, Qs, lane, r32, hi);
  finishSM(pA0, pA1, alA, l_reg, pa0, pa1, pa2, pa3); SBAR();
  STEP_SYNC();
  pv8_sm(o, vb0, pa0, pa1, pa2, pa3, pB0, pB1, m_reg, mnB, alB);
  STEP_SYNC();
  RESC8(alB);
  DV_ISSUE(j + 1);
  finishSM(pB0, pB1, alB, l_reg, pa0, pa1, pa2, pa3); SBAR();
  STEP_SYNC();
  pv_one<0>(o[0], vb0, pa0, pa1, pa2, pa3); pv_one<1>(o[1], vb0, pa0, pa1, pa2, pa3); pv_one<2>(o[2], vb0, pa0, pa1, pa2, pa3); pv_one<3>(o[3], vb0, pa0, pa1, pa2, pa3);
  pv_one<0>(o[4], vb0 + 16384, pa0, pa1, pa2, pa3); pv_one<1>(o[5], vb0 + 16384, pa0, pa1, pa2, pa3); pv_one<2>(o[6], vb0 + 16384, pa0, pa1, pa2, pa3); pv_one<3>(o[7], vb0 + 16384, pa0, pa1, pa2, pa3);
#undef DK_ISSUE
#undef DV_ISSUE
#undef RESC8
#undef STEP_SYNC
  if (hi == 0) li_l[r32] = l_reg; asm volatile("s_waitcnt lgkmcnt(0)" ::: "memory");
  float rli[16];
#pragma unroll
  for (int r = 0; r < 16; ++r) rli[r] = __builtin_amdgcn_rcpf(li_l[crow(r, hi)]);
  { ALAS char* og = Qs; bf16_t* Og = O + (long)(wid * QBLK) * ldo;
#pragma unroll
    for (int hf = 0; hf < 2; ++hf) {
#pragma unroll
      for (int rr = 0; rr < 8; ++rr) { const int r = hf * 8 + rr, lrow = crow(r, hi) - 16 * hf;
#pragma unroll
        for (int d = 0; d < 8; ++d) { const unsigned w = cvtpk(o[d][r] * rli[r], 0.f); *(ALAS unsigned short*)(og + lrow * 512 + (d * 32 + r32) * 2) = (unsigned short)(w & 0xffffu); } }
#pragma unroll
      for (int k = 0; k < 8; ++k) { const int p = lane + 64 * k; const u32x4 v = *(const ALAS u32x4*)(og + p * 16);
        *reinterpret_cast<u32x4*>(Og + (long)(16 * hf + (p >> 5)) * ldo + (p & 31) * 8) = v; }
    } }
}
}
#define GAS __attribute__((address_space(1)))
#define LAS __attribute__((address_space(3)))
typedef unsigned short bf16;
typedef unsigned v4u __attribute__((ext_vector_type(4)));
typedef float f32x4 __attribute__((ext_vector_type(4)));
typedef short bf16x8 __attribute__((ext_vector_type(8)));
typedef GAS unsigned gu32;
typedef GAS unsigned long long gu64;
#define RLX_AGENT __ATOMIC_RELAXED, __HIP_MEMORY_SCOPE_AGENT
#define LDS_WAIT() asm volatile("s_waitcnt lgkmcnt(0)" ::: "memory")
#define VM_WAIT() asm volatile("s_waitcnt vmcnt(0)" ::: "memory")
__device__ __forceinline__ unsigned long long rt() { return __builtin_amdgcn_s_memrealtime(); }
__device__ __forceinline__ unsigned f2bf(float f) { unsigned u = __builtin_bit_cast(unsigned, f); return (u + 0x7fffu + ((u >> 16) & 1u)) >> 16; }
__device__ __forceinline__ unsigned pk2(float lo, float hi) { return f2bf(lo) | (f2bf(hi) << 16); }

#define XB_TMO      128
#define XB_XCNT(j)  (256  + 64 * (j))
#define XB_XSUB(j)  (1280 + 64 * (j))
#define XB_XGEN(j)  (2304 + 64 * (j))
#define XB_TOP      3328
#define XB_TOPGEN   3392
#define XCD_BAR_WORDS 3456
#define XB_SPIN_CAP (1u << 18)

__device__ __forceinline__ unsigned xb_ld(unsigned* p)              { return __hip_atomic_load(p, __ATOMIC_RELAXED, __HIP_MEMORY_SCOPE_AGENT); }
__device__ __forceinline__ unsigned xb_add(unsigned* p, unsigned v) { return __hip_atomic_fetch_add(p, v, __ATOMIC_RELAXED, __HIP_MEMORY_SCOPE_AGENT); }
__device__ __forceinline__ unsigned xb_xcc_id() { return (unsigned)__builtin_amdgcn_s_getreg((3 << 11) | 20) & 0xFu; }
#define XB_SPIN(cond, bar) do { unsigned _sp = 0; while (cond) { __builtin_amdgcn_s_sleep(1); \
    if ((++_sp & 255u) == 0u) { if (xb_ld(&(bar)[XB_TMO])) break; if (_sp > XB_SPIN_CAP) { atomicAdd(&(bar)[XB_TMO], 1u); break; } } } } while (0)

struct XcdBarrier {
    unsigned* bar; unsigned x;
    volatile LAS unsigned* st;
};

__device__ __forceinline__ XcdBarrier xcd_barrier_post(unsigned* bar, volatile LAS unsigned* st) {
    XcdBarrier b; b.bar = bar; b.x = xb_xcc_id(); b.st = st;
    if (tid_now() == 0) (void)xb_add(&bar[XB_XCNT(b.x)], 1u);
    return b;
}
__device__ __forceinline__ void xcd_barrier_complete(unsigned* bar, unsigned x, unsigned& nloc, unsigned& nx) {
    const unsigned G = gridDim.x * gridDim.y * gridDim.z;
    asm volatile("" : "+s"(x));
    unsigned sum, cnt, mine, sp = 0u;
    for (;;) {
        sum = 0u; cnt = 0u; mine = 0u;
#pragma unroll
        for (unsigned j = 0; j < 16; ++j) { const unsigned c = xb_ld(&bar[XB_XCNT(j)]); sum += c; cnt += (c > 0u) ? 1u : 0u; mine = (j == x) ? c : mine; }
        if (sum == G) break;
        __builtin_amdgcn_s_sleep(1);
        if ((++sp & 255u) == 0u) { if (xb_ld(&bar[XB_TMO])) break; if (sp > XB_SPIN_CAP) { atomicAdd(&bar[XB_TMO], 1u); break; } }
    }
    nloc = mine > 0u ? mine : 1u; nx = cnt > 0u ? cnt : 1u;
}

__device__ __forceinline__ void xcd_barrier(const XcdBarrier& b) {
    asm volatile("s_waitcnt vmcnt(0)" ::: "memory");
    __syncthreads();
    if (tid_now() == 0) {
        unsigned* bar = b.bar; unsigned bx_ = b.x;
        asm volatile("" : "+s"(bar), "+s"(bx_));
        __builtin_amdgcn_s_waitcnt(0);
        unsigned nloc = b.st[0], nx = b.st[1];
        if (nloc == 0u) { xcd_barrier_complete(bar, bx_, nloc, nx); b.st[0] = nloc; b.st[1] = nx; }
        const unsigned old = xb_add(&bar[XB_XSUB(bx_)], 1u);
        const unsigned gen = old / nloc;
        if (old + 1u == (gen + 1u) * nloc) {
            __builtin_amdgcn_fence(__ATOMIC_RELEASE, "agent");
            asm volatile("s_waitcnt vmcnt(0)" ::: "memory");
            const unsigned og = xb_add(&bar[XB_TOP], 1u);
            const unsigned tg = og / nx;
            if (og + 1u == (tg + 1u) * nx) xb_add(&bar[XB_TOPGEN], 1u);
            else XB_SPIN(xb_ld(&bar[XB_TOPGEN]) == tg, bar);
            __builtin_amdgcn_fence(__ATOMIC_ACQUIRE, "agent");
            xb_add(&bar[XB_XGEN(bx_)], 1u);
            asm volatile("s_waitcnt vmcnt(0)" ::: "memory");
        } else {
            XB_SPIN(xb_ld(&bar[XB_XGEN(bx_)]) == gen, bar);
            __builtin_amdgcn_fence(__ATOMIC_ACQUIRE, "agent");
            asm volatile("s_waitcnt vmcnt(0)" ::: "memory");
        }
    }
    __syncthreads();
}

#ifndef ATT_DMA_ALL
#define ATT_DMA_ALL 6
#endif
#ifndef ATT_DIFF_PIPE
#define ATT_DIFF_PIPE 1
#endif
constexpr int NWAVES = 8;
constexpr int DM = 2048, TP = 8192, TS = 16384, TT = TP + TS;
constexpr int SP = 256, SS = 2048, PAST = 512, SKV = PAST + SS;
constexpr int NQKV = 3072, KVW = 512, FF = 5632, NGU = 2 * FF;
constexpr float EPS = 1e-6f;
constexpr float LAM_INIT2 = 0.47071301834358414f;
enum { I_XP = 0, I_XS, I_C, I_CKF, I_CVF, I_CKW, I_CVW, I_CKD, I_CVD, I_CCTX, I_WADA, I_BADA, I_GNORM, I_WQKVF, I_WOF, I_GQF, I_GKF, I_WQKVW, I_WOW, I_SINKW,
       I_WQKVD, I_WOD, I_LQ1, I_LK1, I_LQ2, I_LK2, I_GSUB, I_WG, I_WU, I_WD, N_IN };
constexpr size_t O_YP = 0, O_YS = (size_t)TP * DM, O_KF = (size_t)TT * DM, O_VF = O_KF + (size_t)32 * 2 * SP * KVW, O_KW = O_VF + (size_t)32 * 2 * SP * KVW,
                 O_VW = O_KW + (size_t)32 * SP * KVW, O_KD = O_VW + (size_t)32 * SP * KVW, O_VD = O_KD + (size_t)32 * SP * KVW, O_END = O_VD + (size_t)32 * SP * KVW;
static_assert(O_END == 83886080, "output size");
constexpr size_t MiB = 1u << 20;
constexpr size_t WS_CTL = 0, CTL_ZERO_BYTES = 1 * MiB;
constexpr size_t WS_ROPE = 1 * MiB;
constexpr size_t WS_VEC = 2 * MiB;
constexpr size_t WS_PART = 4 * MiB;
constexpr size_t WS_W = 20 * MiB, W_LAYER = 86 * MiB, W_QKV = 0, W_O = 12 * MiB, W_GU = 20 * MiB, W_D = 64 * MiB;
constexpr size_t WS_KC = 364 * MiB, WS_VC = 384 * MiB, WS_KP = 404 * MiB, WS_VP = 412 * MiB;
constexpr size_t WS_H = 420 * MiB, WS_MF = 516 * MiB;
constexpr size_t WS_ACT = 612 * MiB;
constexpr size_t WS_RAW = WS_ACT, WS_ATT = WS_ACT + 144 * MiB, WS_X16 = 876 * MiB, WS_END = 972 * MiB;
static_assert(WS_W + 4 * W_LAYER == WS_KC && WS_ATT + (size_t)TT * DM * 2 <= WS_X16 && WS_ACT + (size_t)TT * FF * 2 <= WS_X16 && WS_X16 + (size_t)TT * DM * 2 <= WS_END && WS_MF + (size_t)TT * DM * 2 == WS_ACT, "ws map");
constexpr int CW_BAR = 4096;
constexpr int RING_BYTES = 131072, LDSCTL_OFF = RING_BYTES, MISC_OFF = LDSCTL_OFF + 320, LDS_BYTES = 147456;

typedef unsigned v2u __attribute__((ext_vector_type(2)));

__device__ __forceinline__ float wave_sum(float v) {
#pragma unroll
    for (int o = 1; o < 64; o <<= 1) v += __shfl_xor(v, o);
    return v;
}
__device__ __forceinline__ float bf2f(unsigned h) { return __uint_as_float(h << 16); }
__device__ __forceinline__ unsigned pkbf(float lo, float hi) { unsigned r; asm volatile("v_cvt_pk_bf16_f32 %0, %1, %2" : "=v"(r) : "v"(lo), "v"(hi)); return r; }

__device__ __forceinline__ void transpose_item(const float* __restrict__ W, int K, int N, bf16* __restrict__ WT, int k0, int n0, int drow0, LAS float* scr, int lane) {
    { const int kr = lane >> 3, c4 = (lane & 7) * 4;
      f32x4 v[8];
#pragma unroll
      for (int i = 0; i < 8; ++i) v[i] = *(const f32x4*)(W + (size_t)(k0 + 8 * i + kr) * N + n0 + c4);
#pragma unroll
      for (int i = 0; i < 8; ++i) { LAS float* d = scr + (8 * i + kr) * 33 + c4; d[0] = v[i].x; d[1] = v[i].y; d[2] = v[i].z; d[3] = v[i].w; } }
    LDS_WAIT(); asm volatile("" ::: "memory");
    const int c = lane & 7;
#pragma unroll
    for (int j = 0; j < 4; ++j) { const int n = (lane >> 3) + 8 * j; const LAS float* s = scr + (8 * c) * 33 + n;
        v4u o; o.x = pkbf(s[0 * 33], s[1 * 33]); o.y = pkbf(s[2 * 33], s[3 * 33]); o.z = pkbf(s[4 * 33], s[5 * 33]); o.w = pkbf(s[6 * 33], s[7 * 33]);
        *(v4u*)(WT + (size_t)(drow0 + n) * K + k0 + 8 * c) = o; }
    LDS_WAIT(); asm volatile("" ::: "memory");
}

struct Args { const float* in[N_IN]; float* out; unsigned char* ws; };

typedef const float* cfp;
#define KAS __attribute__((address_space(4)))
__device__ __forceinline__ const KAS cfp* kargs() { const KAS cfp* p = (const KAS cfp*)__builtin_amdgcn_kernarg_segment_ptr(); asm volatile("" : "+s"(p)); return p; }
#define PHASE_ENV \
    const KAS cfp* const ka = kargs(); unsigned char* const ws = (unsigned char*)ka[N_IN + 1]; float* const out = (float*)ka[N_IN]; (void)out; \
    int tid_ = tid_now(); asm volatile("" : "+v"(tid_)); const int tid = tid_, lane = tid & 63, wave = __builtin_amdgcn_readfirstlane(tid >> 6); \
    const int G = gridDim.x, bx = blockIdx.x, vcu = (G % 8 == 0) ? (bx % 8) * (G / 8) + bx / 8 : bx, gw = vcu * NWAVES + wave, NGW = G * NWAVES; \
    (void)tid; (void)lane; (void)wave; (void)gw; (void)NGW; (void)vcu; \
    float* const ropeC = (float*)(ws + WS_ROPE); float* const ropeS = ropeC + 64 * 32; float* const VEC = (float*)(ws + WS_VEC); float* const PART = (float*)(ws + WS_PART); \
    bf16* const KC = (bf16*)(ws + WS_KC); bf16* const VC = (bf16*)(ws + WS_VC); bf16* const KP = (bf16*)(ws + WS_KP); bf16* const VP = (bf16*)(ws + WS_VP); \
    bf16* const H = (bf16*)(ws + WS_H); bf16* const MF = (bf16*)(ws + WS_MF); bf16* const ACT = (bf16*)(ws + WS_ACT); \
    bf16* const RAW = (bf16*)(ws + WS_RAW); bf16* const ATT = (bf16*)(ws + WS_ATT); bf16* const ADIF = (bf16*)(ws + WS_H); bf16* const X16 = (bf16*)(ws + WS_X16); (void)X16; \
    (void)ropeC; (void)ropeS; (void)VEC; (void)PART; (void)KC; (void)VC; (void)KP; (void)VP; (void)H; (void)MF; (void)ACT; (void)RAW; (void)ATT; (void)ADIF;
#define IN(i) (ka[i])

__global__ void __launch_bounds__(NWAVES * 64, 2) trunk_fwd(Args args) {
    extern __shared__ __attribute__((aligned(16))) unsigned char lds_raw[];
    LAS unsigned char* const lds = (LAS unsigned char*)lds_raw;
    XcdBarrier bar;
    {
        volatile LAS unsigned* MISC = (volatile LAS unsigned*)(lds + MISC_OFF);
        for (int u = threadIdx.x; u < (LDS_BYTES - LDSCTL_OFF) / 4; u += NWAVES * 64) ((LAS unsigned*)(lds + LDSCTL_OFF))[u] = 0u;
        __syncthreads();
        { const unsigned slot_ = (unsigned)__builtin_amdgcn_s_getreg((5 << 11) | 4) & 63u;
          if ((threadIdx.x & 63) == 0) *(volatile LAS unsigned*)(lds + (TIDTAB_LDS_ADDR - 0) + slot_ * 4) = threadIdx.x >> 6; }
        __syncthreads();
        bar = xcd_barrier_post((unsigned*)(args.ws + WS_CTL) + CW_BAR, MISC + 8);
    }

    {
        PHASE_ENV
        LAS float* sl = (LAS float*)lds;
        for (int i = tid; i < 9 * DM; i += NWAVES * 64) { const int r = i >> 11, k = i & (DM - 1);
            const float cv = (r == 0) ? IN(I_CCTX)[k] : IN(I_C)[(r - 1) * DM + k]; sl[i] = cv / (1.0f + expf(-cv)); }
        __syncthreads();
        for (int t = gw; t < 2048; t += NGW) {
            const int l = t >> 9, cc = (t >> 3) & 63, kc = t & 7;
            if (lane < 48) {
                const float* Wp = IN(I_WADA) + ((size_t)l * DM + kc * 256) * (6 * DM) + cc * 192 + lane * 4;
                const LAS float* sp = sl + kc * 256;
                f32x4 acc[9];
#pragma unroll
                for (int r = 0; r < 9; ++r) acc[r] = (f32x4){0.f, 0.f, 0.f, 0.f};
#pragma unroll 16
                for (int k = 0; k < 256; ++k) { const f32x4 w = *(const f32x4*)(Wp + (size_t)k * (6 * DM));
#pragma unroll
                    for (int r = 0; r < 9; ++r) acc[r] += w * sp[r * DM + k]; }
#pragma unroll
                for (int r = 0; r < 9; ++r) *(f32x4*)(PART + ((size_t)((kc * 4 + l) * 9 + r)) * (6 * DM) + cc * 192 + lane * 4) = acc[r];
            }
        }
        __syncthreads();
        LAS float* scr = (LAS float*)(lds + wave * 16384);
        constexpr int IT_QKV = 32 * 96, IT_O = 32 * 64, IT_G = 32 * 176, IT_D = 88 * 64, IT_LAYER = IT_QKV + IT_O + 2 * IT_G + IT_D;
        for (int it = gw; it < 4 * IT_LAYER; it += NGW) {
            const int l = it / IT_LAYER; int r = it - l * IT_LAYER; const int kind = l % 3, slot = l / 3;
            unsigned char* wl = ws + WS_W + (size_t)l * W_LAYER;
            if (r < IT_QKV) { const float* W = (kind == 0 ? IN(I_WQKVF) + (size_t)slot * DM * NQKV : kind == 1 ? IN(I_WQKVW) : IN(I_WQKVD));
                const int kb = r / 96, nb = r % 96; transpose_item(W, DM, NQKV, (bf16*)(wl + W_QKV), 64 * kb, 32 * nb, 32 * nb, scr, lane); continue; } r -= IT_QKV;
            if (r < IT_O) { const float* W = (kind == 0 ? IN(I_WOF) + (size_t)slot * DM * DM : kind == 1 ? IN(I_WOW) : IN(I_WOD));
                const int kb = r / 64, nb = r % 64; transpose_item(W, DM, DM, (bf16*)(wl + W_O), 64 * kb, 32 * nb, 32 * nb, scr, lane); continue; } r -= IT_O;
            if (r < 2 * IT_G) { const int up = r >= IT_G; if (up) r -= IT_G; const float* W = IN(up ? I_WU : I_WG) + (size_t)l * DM * FF;
                const int kb = r / 176, nb = r % 176, n0 = 32 * nb; transpose_item(W, DM, FF, (bf16*)(wl + W_GU), 64 * kb, n0, (n0 >> 5) * 64 + up * 32, scr, lane); continue; } r -= 2 * IT_G;
            { const float* W = IN(I_WD) + (size_t)l * FF * DM; const int kb = r / 64, nb = r % 64; transpose_item(W, FF, DM, (bf16*)(wl + W_D), 64 * kb, 32 * nb, 32 * nb, scr, lane); }
        }
        { const int gt = bx * (NWAVES * 64) + tid;
          if (gt < 64 * 32) { const int p = gt >> 5, i = gt & 31; double inv = 1.0; for (int q = 0; q < i; ++q) inv *= 0.7498942093324559;
            const float ang = (float)p * (float)inv; const double a = (double)ang; const double n = __builtin_rint(a * 0.6366197723675814);
            double rr = __builtin_fma(-n, 1.5707963267948966, a); rr = __builtin_fma(-n, 6.123233995736766e-17, rr);
            const double r2 = rr * rr;
            const double sn = rr * (1.0 + r2 * (-1.0 / 6 + r2 * (1.0 / 120 + r2 * (-1.0 / 5040 + r2 * (1.0 / 362880 + r2 * (-1.0 / 39916800 + r2 * (1.0 / 6227020800.0)))))));
            const double cs = 1.0 + r2 * (-0.5 + r2 * (1.0 / 24 + r2 * (-1.0 / 720 + r2 * (1.0 / 40320 + r2 * (-1.0 / 3628800 + r2 * (1.0 / 479001600.0))))));
            const int q4 = ((int)n) & 3; const double s_ = (q4 == 0) ? sn : (q4 == 1) ? cs : (q4 == 2) ? -sn : -cs, c_ = (q4 == 0) ? cs : (q4 == 1) ? -sn : (q4 == 2) ? -cs : sn;
            ropeC[gt] = (float)c_; ropeS[gt] = (float)s_; } }
    }
    xcd_barrier(bar);
    {
    PHASE_ENV
    for (int e = bx * (NWAVES * 64) + tid; e < 4 * 9 * DM; e += G * NWAVES * 64) {
        const int l = e / (9 * DM), r = (e / DM) % 9, c = e & (DM - 1);
        float mod[6];
#pragma unroll
        for (int j = 0; j < 6; ++j) { float s = IN(I_BADA)[(size_t)l * 6 * DM + j * DM + c];
#pragma unroll
            for (int kc = 0; kc < 8; ++kc) s += PART[((size_t)((kc * 4 + l) * 9 + r)) * (6 * DM) + j * DM + c];
            mod[j] = s; }
        const float* gn = IN(I_GNORM) + (size_t)l * 4 * DM;
        float* vb = VEC + (size_t)l * 6 * 9 * DM + (size_t)r * DM + c;
        vb[0 * 9 * DM] = gn[0 * DM + c] * (1.0f + mod[1]); vb[1 * 9 * DM] = mod[0]; vb[2 * 9 * DM] = mod[2] * gn[1 * DM + c];
        vb[3 * 9 * DM] = gn[2 * DM + c] * (1.0f + mod[4]); vb[4 * 9 * DM] = mod[3]; vb[5 * 9 * DM] = mod[5] * gn[3 * DM + c];
    }
    }
    xcd_barrier(bar);

#define BF8_TO_F(W, LO, HI) do { LO = (f32x4){bf2f(W.x & 0xffffu), bf2f(W.x >> 16), bf2f(W.y & 0xffffu), bf2f(W.y >> 16)}; HI = (f32x4){bf2f(W.z & 0xffffu), bf2f(W.z >> 16), bf2f(W.w & 0xffffu), bf2f(W.w >> 16)}; } while (0)
#define THIN_LOADX(ROW, XV, XW, MW, XP, XS, XIN16, RES) do { const int r_ = (ROW); \
        if (XIN16) { _Pragma("unroll") for (int c = 0; c < 4; ++c) XW[c] = __builtin_nontemporal_load(&((const v4u*)(X16 + (size_t)r_ * DM))[64 * c + lane]); } \
        else { const float* xb_ = (XP), * xs_m = (XS) - (size_t)TP * DM; const float* xr_ = (r_ < TP ? xb_ : xs_m) + (size_t)r_ * DM; \
            _Pragma("unroll") for (int c = 0; c < 4; ++c) { XV[2 * c] = __builtin_nontemporal_load(&((const f32x4*)xr_)[128 * c + 2 * lane]); XV[2 * c + 1] = __builtin_nontemporal_load(&((const f32x4*)xr_)[128 * c + 2 * lane + 1]); } } \
        if (RES) { _Pragma("unroll") for (int c = 0; c < 4; ++c) MW[c] = __builtin_nontemporal_load(&((const v4u*)(MF + (size_t)r_ * DM))[64 * c + lane]); } } while (0)
#define THIN_ROW(ROW, XV, XW, MW, XIN16, XOUT16, RES, HOUT) do { const int r_ = (ROW); \
        if (XIN16) { _Pragma("unroll") for (int c = 0; c < 4; ++c) BF8_TO_F(XW[c], XV[2 * c], XV[2 * c + 1]); } \
        if (RES) { \
            f32x4 mv[8]; float ss = 0.f; \
            _Pragma("unroll") for (int c = 0; c < 4; ++c) BF8_TO_F(MW[c], mv[2 * c], mv[2 * c + 1]); \
            _Pragma("unroll") for (int j = 0; j < 8; ++j) ss += (mv[j].x * mv[j].x + mv[j].y * mv[j].y) + (mv[j].z * mv[j].z + mv[j].w * mv[j].w); \
            const float rstd = 1.0f / sqrtf(wave_sum(ss) * (1.0f / DM) + EPS); \
            _Pragma("unroll") for (int j = 0; j < 8; ++j) XV[j] += gv[j] * (mv[j] * rstd); \
            if (XOUT16) { _Pragma("unroll") for (int c = 0; c < 4; ++c) { v4u w; w.x = pkbf(XV[2 * c].x, XV[2 * c].y); w.y = pkbf(XV[2 * c].z, XV[2 * c].w); w.z = pkbf(XV[2 * c + 1].x, XV[2 * c + 1].y); w.w = pkbf(XV[2 * c + 1].z, XV[2 * c + 1].w); \
                    __builtin_nontemporal_store(w, &((v4u*)(X16 + (size_t)r_ * DM))[64 * c + lane]); } } \
            else { _Pragma("unroll") for (int c = 0; c < 4; ++c) { __builtin_nontemporal_store(XV[2 * c], &((f32x4*)(out + (size_t)r_ * DM))[128 * c + 2 * lane]); __builtin_nontemporal_store(XV[2 * c + 1], &((f32x4*)(out + (size_t)r_ * DM))[128 * c + 2 * lane + 1]); } } \
        } \
        if (HOUT) { \
            float s2 = 0.f; \
            _Pragma("unroll") for (int j = 0; j < 8; ++j) s2 += (XV[j].x * XV[j].x + XV[j].y * XV[j].y) + (XV[j].z * XV[j].z + XV[j].w * XV[j].w); \
            const float r2 = 1.0f / sqrtf(wave_sum(s2) * (1.0f / DM) + EPS); \
            _Pragma("unroll") for (int c = 0; c < 4; ++c) { const f32x4 h0 = XV[2 * c] * r2 * av[2 * c] + bv[2 * c], h1 = XV[2 * c + 1] * r2 * av[2 * c + 1] + bv[2 * c + 1]; \
                v4u w; w.x = pkbf(h0.x, h0.y); w.y = pkbf(h0.z, h0.w); w.z = pkbf(h1.x, h1.y); w.w = pkbf(h1.z, h1.w); ((v4u*)(H + (size_t)r_ * DM))[64 * c + lane] = w; } \
        } } while (0)
#define THIN_PHASE(XP, XS, XIN16, XOUT16, RES, GV, HOUT, AV, BV) do { \
    for (int row = 2 * gw; row < TT; row += 2 * NGW) { \
        const int cls = row < TP ? 0 : 1 + ((row - TP) >> 11); \
        f32x4 xa[8], xb[8], gv[8], av[8], bv[8]; v4u xwa[4], xwb[4], mwa[4], mwb[4]; \
        THIN_LOADX(row, xa, xwa, mwa, XP, XS, XIN16, RES); THIN_LOADX(row + 1, xb, xwb, mwb, XP, XS, XIN16, RES); \
        if (RES) { _Pragma("unroll") for (int c = 0; c < 4; ++c) { gv[2 * c] = ((const f32x4*)((GV) + (size_t)cls * DM))[128 * c + 2 * lane]; gv[2 * c + 1] = ((const f32x4*)((GV) + (size_t)cls * DM))[128 * c + 2 * lane + 1]; } } \
        { _Pragma("unroll") for (int c = 0; c < 4; ++c) { av[2 * c] = ((const f32x4*)((AV) + (size_t)cls * DM))[128 * c + 2 * lane]; av[2 * c + 1] = ((const f32x4*)((AV) + (size_t)cls * DM))[128 * c + 2 * lane + 1]; \
                bv[2 * c] = ((const f32x4*)((BV) + (size_t)cls * DM))[128 * c + 2 * lane]; bv[2 * c + 1] = ((const f32x4*)((BV) + (size_t)cls * DM))[128 * c + 2 * lane + 1]; } } \
        THIN_ROW(row, xa, xwa, mwa, XIN16, XOUT16, RES, HOUT); \
        THIN_ROW(row + 1, xb, xwb, mwb, XIN16, XOUT16, RES, HOUT); \
    } } while (0)
#define THIN_DMA_ISSUE(PAIR) do { const size_t r0_ = (size_t)(PAIR) * 2; \
        _Pragma("unroll") for (int q = 0; q < 2; ++q) _Pragma("unroll") for (int c = 0; c < 4; ++c) { \
            __builtin_amdgcn_global_load_lds((const unsigned*)(X16 + (r0_ + q) * DM + c * 512 + lane * 8), (LAS unsigned*)(wl_ + q * 4096 + c * 1024), 16, 0, 2); \
            __builtin_amdgcn_global_load_lds((const unsigned*)(MF + (r0_ + q) * DM + c * 512 + lane * 8), (LAS unsigned*)(wl_ + 8192 + q * 4096 + c * 1024), 16, 0, 2); } } while (0)
#define THIN_PHASE_DMA(XOUT16, GV, HOUT, AV, BV) do { \
    LAS unsigned char* const wl_ = lds + wave * 16384; \
    const int npair_ = TT / 2; \
    if (gw < npair_) THIN_DMA_ISSUE(gw); \
    for (int pr = gw; pr < npair_; pr += NGW) { \
        const int row = 2 * pr; const int cls = row < TP ? 0 : 1 + ((row - TP) >> 11); \
        f32x4 xa[8], xb[8], gv[8], av[8], bv[8]; v4u xwa[4], xwb[4], mwa[4], mwb[4]; \
        { _Pragma("unroll") for (int c = 0; c < 4; ++c) { gv[2 * c] = ((const f32x4*)((GV) + (size_t)cls * DM))[128 * c + 2 * lane]; gv[2 * c + 1] = ((const f32x4*)((GV) + (size_t)cls * DM))[128 * c + 2 * lane + 1]; } } \
        { _Pragma("unroll") for (int c = 0; c < 4; ++c) { av[2 * c] = ((const f32x4*)((AV) + (size_t)cls * DM))[128 * c + 2 * lane]; av[2 * c + 1] = ((const f32x4*)((AV) + (size_t)cls * DM))[128 * c + 2 * lane + 1]; \
                bv[2 * c] = ((const f32x4*)((BV) + (size_t)cls * DM))[128 * c + 2 * lane]; bv[2 * c + 1] = ((const f32x4*)((BV) + (size_t)cls * DM))[128 * c + 2 * lane + 1]; } } \
        asm volatile("" ::: "memory"); __builtin_amdgcn_s_waitcnt(0x0F70); asm volatile("" ::: "memory");     \
        _Pragma("unroll") for (int c = 0; c < 4; ++c) { xwa[c] = *(const LAS v4u*)(wl_ + c * 1024 + lane * 16); xwb[c] = *(const LAS v4u*)(wl_ + 4096 + c * 1024 + lane * 16); \
            mwa[c] = *(const LAS v4u*)(wl_ + 8192 + c * 1024 + lane * 16); mwb[c] = *(const LAS v4u*)(wl_ + 12288 + c * 1024 + lane * 16); } \
        asm volatile("s_waitcnt lgkmcnt(0)" ::: "memory");     \
        if (pr + NGW < npair_) THIN_DMA_ISSUE(pr + NGW); \
        THIN_ROW(row, xa, xwa, mwa, true, XOUT16, true, HOUT); \
        THIN_ROW(row + 1, xb, xwb, mwb, true, XOUT16, true, HOUT); \
    } } while (0)
#define X_IS_BF16 1

    { PHASE_ENV
      THIN_PHASE(IN(I_XP), IN(I_XS), false, false, false, VEC, true, VEC + 0 * 9 * DM, VEC + 1 * 9 * DM); }
    xcd_barrier(bar);

    for (int L = 0; L < 4; ++L) {
        const int kind = L % 3, slot = L / 3, nslot = (kind == 0) ? 2 : 1;
#define LAYER_ENV PHASE_ENV unsigned char* const wl = ws + WS_W + (size_t)L * W_LAYER; const float* const vecL = VEC + (size_t)L * 6 * 9 * DM; (void)wl; (void)vecL;
        { LAYER_ENV pg8::Gemm g{H, (const bf16*)(wl + W_QKV), TT, NQKV, DM}; pg8::StaticOrder S; S.init(TT, NQKV, G, bx);
          pg8::EpiStore E{RAW, NQKV};
          pg8::gemm_phase<pg8::EpiStore, pg8::StaticOrder, true, true>(lds, g, S, E); }
        { LAYER_ENV
          { const int first = ((TT / 256) * (NQKV / 256)) % (int)gridDim.x, bxc = blockIdx.x;
            if (bxc >= first) {
                const float* ck = (kind == 0) ? IN(I_CKF) : (kind == 1) ? IN(I_CKW) : IN(I_CKD);
                const float* cv = (kind == 0) ? IN(I_CVF) : (kind == 1) ? IN(I_CVW) : IN(I_CVD);
                for (int it = (bxc - first) * NWAVES + wave; it < 2 * 8 * 128; it += ((int)gridDim.x - first) * NWAVES) {
                    const int p0 = (it & 127) * 4, b = (it >> 7) & 7, isv = it >> 10;
                    const float* src = (isv ? cv : ck) + ((size_t)(b * nslot + slot) * PAST + p0) * KVW + lane * 8;
                    bf16* dst = (isv ? VC : KC) + ((size_t)b * SKV + p0) * KVW + lane * 8;
                    f32x4 a[8];
#pragma unroll
                    for (int q = 0; q < 4; ++q) { a[2 * q] = *(const f32x4*)(src + q * KVW); a[2 * q + 1] = *(const f32x4*)(src + q * KVW + 4); }
#pragma unroll
                    for (int q = 0; q < 4; ++q) { v4u o; o.x = pkbf(a[2 * q].x, a[2 * q].y); o.y = pkbf(a[2 * q].z, a[2 * q].w); o.z = pkbf(a[2 * q + 1].x, a[2 * q + 1].y); o.w = pkbf(a[2 * q + 1].z, a[2 * q + 1].w); *(v4u*)(dst + q * KVW) = o; }
                } } } }
        xcd_barrier(bar);
        {
            LAYER_ENV
            const float* ck = (kind == 0) ? IN(I_CKF) : (kind == 1) ? IN(I_CKW) : IN(I_CKD);
            const float* cv = (kind == 0) ? IN(I_CVF) : (kind == 1) ? IN(I_CVW) : IN(I_CVD);
            float* const ok = out + ((kind == 0) ? O_KF : (kind == 1) ? O_KW : O_KD);
            float* const ov = out + ((kind == 0) ? O_VF : (kind == 1) ? O_VW : O_VD);
            const int l16 = lane & 15;
            f32x4 gq0, gq1, gk0, gk1;
            { const float* gqp = IN(I_GQF) + slot * 128 + l16 * 8; const float* gkp = IN(I_GKF) + slot * 128 + l16 * 8;
              gq0 = *(const f32x4*)gqp; gq1 = *(const f32x4*)(gqp + 4); gk0 = *(const f32x4*)gkp; gk1 = *(const f32x4*)(gkp + 4); }
            constexpr int LIM = TT;
#define POST_LOAD(ROW, W, CS) do { const int r_ = (ROW); \
        if (r_ < TT) { const bf16* rp_ = RAW + (size_t)r_ * NQKV + lane * 8; _Pragma("unroll") for (int q_ = 0; q_ < 2; ++q_) W[q_] = *(const v4u*)(rp_ + 2048 + q_ * 512); \
            if (r_ >= TP) { const int s_ = (r_ - TP) & (SS - 1); const int p_ = (lane & 8) ? (s_ & 63) : (s_ >> 6); const int i0_ = (lane & 3) * 8; \
                CS[0] = *(const f32x4*)(ropeC + p_ * 32 + i0_); CS[1] = *(const f32x4*)(ropeC + p_ * 32 + i0_ + 4); CS[2] = *(const f32x4*)(ropeS + p_ * 32 + i0_); CS[3] = *(const f32x4*)(ropeS + p_ * 32 + i0_ + 4); } } \
        else { const int ct_ = r_ - TT, isv_ = ct_ >> 12, rr_ = ct_ & 4095, b_ = rr_ >> 9, p_ = rr_ & 511; \
            const float* src_ = (isv_ ? cv : ck) + ((size_t)(b_ * nslot + slot) * PAST + p_) * KVW + lane * 8; W[0] = *(const v4u*)src_; W[1] = *(const v4u*)(src_ + 4); } } while (0)
#define POST_ROW(ROW, W, CS) do { const int row = (ROW); \
                if (row < TT) { \
                    const bool is_s = row >= TP; const int b = is_s ? (row - TP) >> 11 : row >> 8, s = is_s ? (row - TP) & (SS - 1) : row & (SP - 1); \
                    const float cs[8] = {CS[0].x, CS[0].y, CS[0].z, CS[0].w, CS[1].x, CS[1].y, CS[1].z, CS[1].w}; \
                    const float sn[8] = {CS[2].x, CS[2].y, CS[2].z, CS[2].w, CS[3].x, CS[3].y, CS[3].z, CS[3].w}; \
                    const size_t kvrow = is_s ? ((size_t)b * SKV + PAST + s) : (size_t)row; \
                    bf16* const kdst = (is_s ? KC : KP) + kvrow * KVW + lane * 8; \
                    bf16* const vdst = (is_s ? VC : VP) + kvrow * KVW + lane * 8; \
                    const size_t orow = ((size_t)(b * nslot + slot) * SP + s) * KVW + lane * 8; \
                    _Pragma("unroll") for (int step = 4; step < 6; ++step) {     \
                        const v4u w = W[step - 4]; \
                        float f[8] = {bf2f(w.x & 0xffffu), bf2f(w.x >> 16), bf2f(w.y & 0xffffu), bf2f(w.y >> 16), bf2f(w.z & 0xffffu), bf2f(w.z >> 16), bf2f(w.w & 0xffffu), bf2f(w.w >> 16)}; \
                        if (step < 5) { \
                            if (kind == 0) { float ss = 0.f; \
                                _Pragma("unroll") for (int j = 0; j < 8; ++j) ss += f[j] * f[j]; \
                                ss += __shfl_xor(ss, 1); ss += __shfl_xor(ss, 2); ss += __shfl_xor(ss, 4); ss += __shfl_xor(ss, 8); \
                                const float rstd = 1.0f / sqrtf(ss * (1.0f / 128.0f) + EPS); \
                                f[0] *= rstd * gk0.x; f[1] *= rstd * gk0.y; f[2] *= rstd * gk0.z; f[3] *= rstd * gk0.w; f[4] *= rstd * gk1.x; f[5] *= rstd * gk1.y; f[6] *= rstd * gk1.z; f[7] *= rstd * gk1.w; } \
                            if (is_s) { \
                                _Pragma("unroll") for (int j = 0; j < 8; ++j) { const float pf = __shfl_xor(f[j], 4); f[j] = (lane & 4) ? (pf * sn[j] + f[j] * cs[j]) : (f[j] * cs[j] - pf * sn[j]); } } \
                        } \
                        v4u o; o.x = pkbf(f[0], f[1]); o.y = pkbf(f[2], f[3]); o.z = pkbf(f[4], f[5]); o.w = pkbf(f[6], f[7]); \
                        *(v4u*)(step == 4 ? kdst : vdst) = o; \
                        if (!is_s) { float* op = (step == 4 ? ok : ov) + orow; *(f32x4*)op = (f32x4){f[0], f[1], f[2], f[3]}; *(f32x4*)(op + 4) = (f32x4){f[4], f[5], f[6], f[7]}; } \
                    } \
                } else { \
                    const int ct = row - TT, isv = ct >> 12, rr = ct & 4095, b = rr >> 9, p = rr & 511; \
                    const f32x4 a0 = __builtin_bit_cast(f32x4, W[0]), a1 = __builtin_bit_cast(f32x4, W[1]); \
                    v4u o; o.x = pkbf(a0.x, a0.y); o.y = pkbf(a0.z, a0.w); o.z = pkbf(a1.x, a1.y); o.w = pkbf(a1.z, a1.w); \
                    *(v4u*)((isv ? VC : KC) + ((size_t)b * SKV + p) * KVW + lane * 8) = o; \
                } } while (0)
            for (int q4 = gw; q4 < LIM / 4; q4 += NGW) {
                const int row0 = 4 * q4;
                v4u w0[2], w1[2], w2[2], w3[2]; f32x4 c0[4], c1[4], c2[4], c3[4];
#pragma unroll
                for (int q = 0; q < 4; ++q) { c0[q] = (f32x4){0.f, 0.f, 0.f, 0.f}; c1[q] = c0[q]; c2[q] = c0[q]; c3[q] = c0[q]; }
                POST_LOAD(row0, w0, c0); POST_LOAD(row0 + 1, w1, c1); POST_LOAD(row0 + 2, w2, c2); POST_LOAD(row0 + 3, w3, c3);
                POST_ROW(row0, w0, c0); POST_ROW(row0 + 1, w1, c1); POST_ROW(row0 + 2, w2, c2); POST_ROW(row0 + 3, w3, c3);
            }
#undef POST_ROW
#undef POST_LOAD
        }
        xcd_barrier(bar);
        {
            LAYER_ENV
            if (kind != 2) {
                const int nsamp = 1024, nprm = 512;
                for (int u = vcu; u < nsamp + nprm; u += G) {
                    const bf16 *Qp, *Kp_, *Vp_; bf16* Op; int nt, nfirst, skip = 0, qpos0 = 0; float sinkl2 = -1e30f; int b, h, qb;
                    bool hpair = false; float sinkB = -1e30f;
                    if (u < nsamp && kind == 1) {
                        hpair = true; qb = u & 15; const int hp = (u >> 4) & 7; h = 2 * hp; b = u >> 7; const size_t r0 = (size_t)TP + (size_t)b * SS + qb * 128;
                        Qp = RAW + r0 * NQKV + h * 128; Kp_ = KC + (size_t)b * SKV * KVW + (h >> 2) * 128; Vp_ = VC + (size_t)b * SKV * KVW + (h >> 2) * 128; Op = ATT + r0 * DM + h * 128;
                        qpos0 = qb * 128; const int bs = (qpos0 - 128) < 0 ? 0 : qpos0 - 128, be = (qpos0 + 256) > SS ? SS : qpos0 + 256; nfirst = PAST / 64; nt = nfirst + (be - bs) / 64; skip = bs;
                        sinkB = IN(I_SINKW)[h + 1] * 1.4426950408889634f; }
                    else
                    if (u < nsamp) { qb = u & 7; h = (u >> 3) & 15; b = u >> 7; const size_t r0 = (size_t)TP + (size_t)b * SS + qb * 256;
                        Qp = RAW + r0 * NQKV + h * 128; Kp_ = KC + (size_t)b * SKV * KVW + (h >> 2) * 128; Vp_ = VC + (size_t)b * SKV * KVW + (h >> 2) * 128; Op = ATT + r0 * DM + h * 128;
                        nt = SKV / 64; nfirst = nt; qpos0 = qb * 256; }
                    else { const int v = u - nsamp; h = v & 15; b = v >> 4; const size_t r0 = (size_t)b * SP;
                        Qp = RAW + r0 * NQKV + h * 128; Kp_ = KP + r0 * KVW + (h >> 2) * 128; Vp_ = VP + r0 * KVW + (h >> 2) * 128; Op = ATT + r0 * DM + h * 128; nt = SP / 64; nfirst = nt; }
                    if (kind == 1) sinkl2 = IN(I_SINKW)[h] * 1.4426950408889634f;
                    __syncthreads();
#if ATT_DMA_ALL == 6
                    att::attn_unit_g(Qp, Kp_, Vp_, Op, NQKV, KVW, DM, nt, nfirst, skip, qpos0, sinkl2, (LAS char*)lds, (LAS float*)(lds + LDSCTL_OFF + 1024) + wave * 64,
                                        (kind == 0 ? 1 : 0) | (u < nsamp ? 2 : 0) | (hpair ? 4 : 0), sinkB, IN(I_GQF) + slot * 128, ropeC, ropeS);
#elif ATT_DMA_ALL == 5
                    att::attn_unit_pp(Qp, Kp_, Vp_, Op, NQKV, KVW, DM, nt, nfirst, skip, qpos0, sinkl2, (LAS char*)lds, (LAS float*)(lds + LDSCTL_OFF + 1024) + wave * 64,
                                        (kind == 0 ? 1 : 0) | (u < nsamp ? 2 : 0), IN(I_GQF) + slot * 128, ropeC, ropeS);
#elif ATT_DMA_ALL == 2
                    att::attn_unit_dma2(Qp, Kp_, Vp_, Op, NQKV, KVW, DM, nt, nfirst, skip, qpos0, sinkl2, (LAS char*)lds, (LAS float*)(lds + LDSCTL_OFF + 1024) + wave * 64,
                                        (kind == 0 ? 1 : 0) | (u < nsamp ? 2 : 0), IN(I_GQF) + slot * 128, ropeC, ropeS);
#elif ATT_DMA_ALL
                    att::attn_unit_dma<4>(Qp, Kp_, Vp_, Op, NQKV, KVW, DM, nt, nfirst, skip, qpos0, sinkl2, (LAS char*)lds, (LAS float*)(lds + LDSCTL_OFF + 1024) + wave * 64,
                                          (kind == 0 ? 1 : 0) | (u < nsamp ? 2 : 0), IN(I_GQF) + slot * 128, ropeC, ropeS);
#else
                    att::attn_unit(Qp, Kp_, Vp_, Op, NQKV, KVW, DM, nt, nfirst, skip, qpos0, sinkl2, (LAS char*)lds, (kind == 0 ? 1 : 0) | (u < nsamp ? 2 : 0), IN(I_GQF) + slot * 128, ropeC, ropeS);
#endif
                }
            } else {
                const int nsamp = 1024, nprm = 512;
                for (int u = vcu; u < nsamp + nprm; u += G) {
                    int b, g, kvv, nt, qpos0 = 0; size_t r0; const bf16 *kbase, *vbase;
                    if (u < nsamp) { const int qb = u & 7; g = (u >> 3) & 3; kvv = (u >> 5) & 3; b = u >> 7; r0 = (size_t)TP + (size_t)b * SS + qb * 256; kbase = KC + (size_t)b * SKV * KVW; vbase = VC + (size_t)b * SKV * KVW; nt = SKV / 64; qpos0 = qb * 256; }
                    else { const int v = u - nsamp; g = v & 3; kvv = (v >> 2) & 3; b = v >> 4; r0 = (size_t)b * SP; kbase = KP + r0 * KVW; vbase = VP + r0 * KVW; nt = SP / 64; }
                    const int kv = kvv >> 1, m = kvv & 1, hv = ((kv * 4 + g) << 1) | m;
                    __syncthreads();
#if ATT_DIFF_PIPE
                    att::attn_unit_diff2(RAW + r0 * NQKV + hv * 128, kbase + kvv * 128, vbase + kv * 256, ADIF + r0 * 4096 + hv * 256, NQKV, KVW, 4096, nt, qpos0,
                                         (LAS char*)lds, (LAS float*)(lds + LDSCTL_OFF + 1024) + wave * 64, (u < nsamp ? 2 : 0), ropeC, ropeS);
#else
                    att::attn_unit_dma<8>(RAW + r0 * NQKV + hv * 128, kbase + kvv * 128, vbase + kv * 256, ADIF + r0 * 4096 + hv * 256, NQKV, KVW, 4096, nt, nt, 0, qpos0, -1e30f,
                                          (LAS char*)lds, (LAS float*)(lds + LDSCTL_OFF + 1024) + wave * 64, (u < nsamp ? 2 : 0), IN(I_GQF), ropeC, ropeS);
#endif
                }
            }
        }
        xcd_barrier(bar);
        if (kind == 2) { LAYER_ENV
            float d1 = IN(I_LQ1)[lane] * IN(I_LK1)[lane] + IN(I_LQ1)[lane + 64] * IN(I_LK1)[lane + 64];
            float d2 = IN(I_LQ2)[lane] * IN(I_LK2)[lane] + IN(I_LQ2)[lane + 64] * IN(I_LK2)[lane + 64];
            const float lam = expf(wave_sum(d1)) - expf(wave_sum(d2)) + LAM_INIT2;
            const f32x4 gs = *(const f32x4*)(IN(I_GSUB) + lane * 4) * (1.0f - LAM_INIT2);
            for (int row0 = 2 * gw; row0 < TT; row0 += 2 * NGW) {
                v2u la0[8], lc0[8], la1[8], lc1[8];
#pragma unroll
                for (int h = 0; h < 8; ++h) {
                    la0[h] = __builtin_nontemporal_load((const v2u*)(ADIF + (size_t)row0 * 4096 + (2 * h) * 256 + lane * 4)); lc0[h] = __builtin_nontemporal_load((const v2u*)(ADIF + (size_t)row0 * 4096 + (2 * h + 1) * 256 + lane * 4));
                    la1[h] = __builtin_nontemporal_load((const v2u*)(ADIF + (size_t)(row0 + 1) * 4096 + (2 * h) * 256 + lane * 4)); lc1[h] = __builtin_nontemporal_load((const v2u*)(ADIF + (size_t)(row0 + 1) * 4096 + (2 * h + 1) * 256 + lane * 4));
                }
#pragma unroll
                for (int rr = 0; rr < 2; ++rr)
#pragma unroll
                for (int h = 0; h < 8; ++h) {
                    const int row = row0 + rr;
                    const v2u a = rr ? la1[h] : la0[h], c = rr ? lc1[h] : lc0[h];
                    f32x4 o = (f32x4){bf2f(a.x & 0xffffu), bf2f(a.x >> 16), bf2f(a.y & 0xffffu), bf2f(a.y >> 16)} - lam * (f32x4){bf2f(c.x & 0xffffu), bf2f(c.x >> 16), bf2f(c.y & 0xffffu), bf2f(c.y >> 16)};
                    const float ss = wave_sum((o.x * o.x + o.y * o.y) + (o.z * o.z + o.w * o.w));
                    o = o * (1.0f / sqrtf(ss * (1.0f / 256.0f) + EPS)) * gs;
                    v2u w; w.x = pkbf(o.x, o.y); w.y = pkbf(o.z, o.w); *(v2u*)(ATT + (size_t)row * DM + h * 256 + lane * 4) = w;
                }
            }
            xcd_barrier(bar);
        }
        { LAYER_ENV pg8::Gemm g{ATT, (const bf16*)(wl + W_O), TT, DM, DM}; pg8::StaticOrder S; S.init(TT, DM, G, bx);
          pg8::EpiStore E{MF, DM};
          pg8::gemm_phase<pg8::EpiStore, pg8::StaticOrder, true, true>(lds, g, S, E); }
        xcd_barrier(bar);
        { LAYER_ENV const float* const xp_ = (L == 0) ? IN(I_XP) : (const float*)out; const float* const xs_ = (L == 0) ? IN(I_XS) : (const float*)(out + O_YS);
          if (X_IS_BF16 && L != 0) THIN_PHASE_DMA(true, vecL + 2 * 9 * DM, true, vecL + 3 * 9 * DM, vecL + 4 * 9 * DM);
          else THIN_PHASE(xp_, xs_, false, (X_IS_BF16 != 0), true, vecL + 2 * 9 * DM, true, vecL + 3 * 9 * DM, vecL + 4 * 9 * DM); }
        xcd_barrier(bar);
        { LAYER_ENV pg8::Gemm g{H, (const bf16*)(wl + W_GU), TT, NGU, DM}; pg8::StaticOrder S; S.init(TT, NGU, G, bx);
          pg8::EpiSwiglu E{ACT, FF};
          pg8::gemm_phase<pg8::EpiSwiglu, pg8::StaticOrder, true, true>(lds, g, S, E); }
        xcd_barrier(bar);
        { LAYER_ENV pg8::Gemm g{ACT, (const bf16*)(wl + W_D), TT, DM, FF}; pg8::StaticOrder S; S.init(TT, DM, G, bx); S.rev = 1;
          pg8::EpiStore E{MF, DM};
          pg8::gemm_phase<pg8::EpiStore, pg8::StaticOrder, true, true>(lds, g, S, E); }
        xcd_barrier(bar);
        { LAYER_ENV const float* vecN = VEC + (size_t)(L < 3 ? L + 1 : L) * 6 * 9 * DM; const bool hout = L < 3;
          if (X_IS_BF16 && hout) THIN_PHASE_DMA(true, vecL + 5 * 9 * DM, true, vecN + 0 * 9 * DM, vecN + 1 * 9 * DM);
          else THIN_PHASE(out, out + O_YS, (X_IS_BF16 != 0), false, true, vecL + 5 * 9 * DM, hout, vecN + 0 * 9 * DM, vecN + 1 * 9 * DM); }
        if (L < 3) xcd_barrier(bar);
    }
#undef THIN_PHASE
#undef THIN_LOADX
#undef THIN_ROW
#undef THIN_PHASE_DMA
#undef THIN_DMA_ISSUE
#undef BF8_TO_F
#undef LAYER_ENV
}

extern "C" void kernel_launch(void* const* d_in, const int* in_sizes, int n_in, void* d_out, int out_size, void* d_ws, size_t ws_size, hipStream_t stream) {
    static int grid = 0;
    if (grid == 0) {
        if (n_in != N_IN || (size_t)out_size != O_END || ws_size < WS_END) { fprintf(stderr, "kernel_launch: shape mismatch: n_in %d out %d ws %zu\n", n_in, out_size, ws_size); grid = -1; return; }
        int dev = 0, cus = 0, per_cu = 0;
        if (hipGetDevice(&dev) != hipSuccess || hipDeviceGetAttribute(&cus, hipDeviceAttributeMultiprocessorCount, dev) != hipSuccess) { grid = -1; return; }
        if (hipFuncSetAttribute((const void*)trunk_fwd, hipFuncAttributeMaxDynamicSharedMemorySize, LDS_BYTES) != hipSuccess) { fprintf(stderr, "kernel_launch: hipFuncSetAttribute failed\n"); grid = -1; return; }
        if (hipOccupancyMaxActiveBlocksPerMultiprocessor(&per_cu, (const void*)trunk_fwd, NWAVES * 64, LDS_BYTES) != hipSuccess || per_cu < 1)
            fprintf(stderr, "kernel_launch: note: occupancy query reports %d workgroups per CU\n", per_cu);
        (void)hipGetLastError();
        grid = cus;
    }
    if (grid < 0) return;
    if (hipMemsetAsync((char*)d_ws + WS_CTL, 0, CTL_ZERO_BYTES, stream) != hipSuccess) { fprintf(stderr, "kernel_launch: memset failed\n"); return; }
    Args a{};
    for (int i = 0; i < N_IN; ++i) a.in[i] = (const float*)d_in[i];
    a.out = (float*)d_out; a.ws = (unsigned char*)d_ws;
    hipLaunchKernelGGL(trunk_fwd, dim3(grid), dim3(NWAVES * 64), LDS_BYTES, stream, a);
    const hipError_t le = hipPeekAtLastError();
    if (le != hipSuccess) fprintf(stderr, "kernel_launch: launch failed: %s\n", hipGetErrorName(le));
}
```

```cpp
#include <hip/hip_runtime.h>
#include <cstdio>
#include <cstdint>
#define TIDTAB_LDS_ADDR (131072 + 3072)
__device__ __forceinline__ int tid_now() {
    const unsigned slot = (unsigned)__builtin_amdgcn_s_getreg((5 << 11) | 4) & 63u;
    const unsigned w = *(const volatile __attribute__((address_space(3))) unsigned*)(unsigned long)(TIDTAB_LDS_ADDR + slot * 4);
    unsigned ln; asm volatile("v_mbcnt_lo_u32_b32 %0, -1, 0\n\tv_mbcnt_hi_u32_b32 %0, -1, %0" : "=v"(ln));
    return (int)(__builtin_amdgcn_readfirstlane(w) * 64u + ln);
}
namespace pg8 {
#define PG8_LAS __attribute__((address_space(3)))
typedef unsigned short bf16_t;
typedef short bf16x8 __attribute__((ext_vector_type(8)));
typedef float f32x4 __attribute__((ext_vector_type(4)));
typedef unsigned u32x4 __attribute__((ext_vector_type(4)));
constexpr int BM = 256, BK = 64, HALF = 128, HTB = HALF * BK * 2  , STAGE_BYTES = 8 * HTB, NXCD = 8, WGM = 8;

__host__ __device__ __forceinline__ int lds_byte(int r, int c) { const int st = (r >> 4) * 2 + (c >> 5), rr = r & 15, cc = c & 31, ob = rr * 64 + cc * 2; return st * 1024 + (ob ^ (((ob >> 9) & 1) << 5)); }
__host__ __device__ __forceinline__ void stage_rc(int b, int& R, int& C) { const int st = b / 1024, sb = b % 1024, swz = sb ^ (((sb >> 9) & 1) << 5); R = (st >> 1) * 16 + swz / 64; C = (st & 1) * 32 + (swz % 64) / 2; }
__host__ __device__ __forceinline__ int perm32(int rho) { const int n = rho >> 4, i = rho & 15; return 8 * (i >> 2) + 4 * n + (i & 3); }

struct Unit { int pm, pn; };
struct Gemm { const bf16_t* A; const bf16_t* Bt; int M, N, K; };

struct StaticOrder {
    int nM, nN, nwg, G, c, rev;
    __host__ __device__ void init(int M, int N, int G_, int c_) { nM = M / BM; nN = N / BM; nwg = nM * nN; G = G_; c = c_; rev = 0; }
    __host__ __device__ bool next(int i, Unit& u) const {
        const long L = (long)i * G + c; if (L >= nwg) return false;
        int wgid = (int)L; { const int q = nwg / NXCD, r = nwg % NXCD, xcd = wgid % NXCD, off = wgid / NXCD; wgid = (xcd < r ? xcd * (q + 1) : r * (q + 1) + (xcd - r) * q) + (rev ? (xcd < r ? q : q - 1) - off : off); }
        const int nig = WGM * nN, gid = wgid / nig, fm = gid * WGM, gsz = (nM - fm) < WGM ? (nM - fm) : WGM;
        u.pm = fm + ((wgid % nig) % gsz); u.pn = (wgid % nig) / gsz; return true;
    }
    __device__ __forceinline__ void a_ready(const Unit&) const {}
    __device__ __forceinline__ void done(const Unit&) const {}
};

__device__ __forceinline__ unsigned cvt_pk_bf16(float lo, float hi) { unsigned r; asm volatile("v_cvt_pk_bf16_f32 %0, %1, %2" : "=v"(r) : "v"(lo), "v"(hi)); return r; }

struct EpiStore {
    static constexpr bool PERM = true, AFTER_DRAIN = false;
    bf16_t* O; int ldc;
    __device__ __forceinline__ static unsigned ror8(unsigned v) { return (unsigned)__builtin_amdgcn_update_dpp(0, (int)v, 0x128, 0xf, 0xf, false); }
    __device__ __forceinline__ void operator()(const f32x4 (&acc)[2][2][4][2], const Unit& u, int wr, int wc, int fr, int fq) const {
        const bool lo = fr < 8;
        const int row0 = u.pm * BM + wr * 64 + (fr & 7), col0 = u.pn * BM + wc * 64 + 8 * fq + (lo ? 0 : 32);
#pragma unroll
        for (int ai = 0; ai < 2; ++ai)
#pragma unroll
            for (int m = 0; m < 4; ++m) { bf16_t* rowp = O + (size_t)(row0 + ai * HALF + m * 16) * ldc + col0;
                u32x4 A, B;
                { const f32x4 v0 = acc[ai][0][m][0], v1 = acc[ai][0][m][1]; A.x = cvt_pk_bf16(v0[0], v0[1]); A.y = cvt_pk_bf16(v0[2], v0[3]); A.z = cvt_pk_bf16(v1[0], v1[1]); A.w = cvt_pk_bf16(v1[2], v1[3]); }
                { const f32x4 v0 = acc[ai][1][m][0], v1 = acc[ai][1][m][1]; B.x = cvt_pk_bf16(v0[0], v0[1]); B.y = cvt_pk_bf16(v0[2], v0[3]); B.z = cvt_pk_bf16(v1[0], v1[1]); B.w = cvt_pk_bf16(v1[2], v1[3]); }
                u32x4 R; R.x = ror8(lo ? B.x : A.x); R.y = ror8(lo ? B.y : A.y); R.z = ror8(lo ? B.z : A.z); R.w = ror8(lo ? B.w : A.w);
                u32x4 w1, w2; w1.x = lo ? A.x : R.x; w1.y = lo ? A.y : R.y; w1.z = lo ? A.z : R.z; w1.w = lo ? A.w : R.w;
                w2.x = lo ? R.x : B.x; w2.y = lo ? R.y : B.y; w2.z = lo ? R.z : B.z; w2.w = lo ? R.w : B.w;
                *(u32x4*)rowp = w1; *(u32x4*)(rowp + (size_t)8 * ldc) = w2; }
    }
};
struct EpiSwiglu {
    static constexpr bool PERM = true, AFTER_DRAIN = false;
    bf16_t* O; int ldc;
    __device__ __forceinline__ static float swi(float g, float u) { const float e = __builtin_amdgcn_exp2f(g * -1.4426950408889634f); return g * u * __builtin_amdgcn_rcpf(1.0f + e); }
    __device__ __forceinline__ void operator()(const f32x4 (&acc)[2][2][4][2], const Unit& u, int wr, int wc, int fr, int fq) const {
        const int row0 = u.pm * BM + wr * 64 + fr, col0 = u.pn * HALF + wc * 32 + 8 * fq;
#pragma unroll
        for (int ai = 0; ai < 2; ++ai)
#pragma unroll
            for (int m = 0; m < 4; ++m) { bf16_t* rowp = O + (size_t)(row0 + ai * HALF + m * 16) * ldc + col0;
                const f32x4 g0 = acc[ai][0][m][0], g1 = acc[ai][0][m][1], u0 = acc[ai][1][m][0], u1 = acc[ai][1][m][1];
                u32x4 w; w.x = cvt_pk_bf16(swi(g0[0], u0[0]), swi(g0[1], u0[1])); w.y = cvt_pk_bf16(swi(g0[2], u0[2]), swi(g0[3], u0[3]));
                w.z = cvt_pk_bf16(swi(g1[0], u1[0]), swi(g1[1], u1[1])); w.w = cvt_pk_bf16(swi(g1[2], u1[2]), swi(g1[3], u1[3]));
                *(u32x4*)rowp = w; }
    }
};

template <class Epi, class Sched, bool ALIGN_EPI = false, bool SP2 = false>
__device__ __forceinline__ void gemm_phase(PG8_LAS unsigned char* lds, const Gemm g, const Sched& S, const Epi& E) {
    int tid_l = tid_now(); asm volatile("" : "+v"(tid_l));
    const int tid = tid_l, wid = __builtin_amdgcn_readfirstlane(tid >> 6), lane = tid & 63, wr = wid >> 2, wc = wid & 3, fr = lane & 15, fq = lane >> 4;
    const int K = g.K, nt = K / BK;
    unsigned voffA[2], voffB[2];
#pragma unroll
    for (int i = 0; i < 2; ++i) { int R, C; stage_rc(tid * 16 + i * 8192, R, C); const int Rb = Epi::PERM ? (64 * (R >> 5) + perm32(R & 31)) : R;
        voffA[i] = (unsigned)(R * K + C) * 2u; voffB[i] = (unsigned)(Rb * K + C) * 2u; }
    const size_t kstep = (size_t)(BK * 2);
    const size_t hstep = (size_t)HALF * K * 2;
    const size_t tstep = 2 * hstep;
    const size_t hstepB = Epi::PERM ? (size_t)32 * K * 2 : hstep;
    const unsigned ldsw = (unsigned)wid * 1024u;
    const int aoff = lds_byte(wr * 64 + fr, fq * 8), boff = lds_byte(wc * 32 + fr, fq * 8);
#define PG8_SA(b, h) (((b) * 2 + (h)) * HTB)
#define PG8_SB(b, h) ((4 + (b) * 2 + (h)) * HTB)
    const __amdgpu_buffer_rsrc_t rs_voffA = __builtin_amdgcn_make_buffer_rsrc((void*)g.A, 0, 0x7ffffffe, 0x00020000), rs_voffB = __builtin_amdgcn_make_buffer_rsrc((void*)g.Bt, 0, 0x7ffffffe, 0x00020000);
    const char* const base_voffA = (const char*)g.A; const char* const base_voffB = (const char*)g.Bt;
#define PG8_STAGE(bufoff, gbase, voff) do { const int so_ = (int)((const char*)(gbase) - base_##voff); _Pragma("unroll") for (int _i = 0; _i < 2; ++_i) \
        __builtin_amdgcn_raw_ptr_buffer_load_lds(rs_##voff, (PG8_LAS void*)(lds + (bufoff) + ldsw + _i * 8192), 16, (int)(voff)[_i], so_, 0, 0); } while (0)
#define PG8_LDA(dst, b, h) do { _Pragma("unroll") for (int m = 0; m < 4; ++m) _Pragma("unroll") for (int k = 0; k < 2; ++k) dst[m][k] = *(const PG8_LAS bf16x8*)(lds + PG8_SA(b, h) + aoff + m * 2048 + k * 1024); } while (0)
#define PG8_LDB(dst, b, h) do { _Pragma("unroll") for (int n = 0; n < 2; ++n) _Pragma("unroll") for (int k = 0; k < 2; ++k) dst[n][k] = *(const PG8_LAS bf16x8*)(lds + PG8_SB(b, h) + boff + n * 2048 + k * 1024); } while (0)
#define PG8_MMA(ai, bj, At, Bt) do { __builtin_amdgcn_s_setprio(1); _Pragma("unroll") for (int m = 0; m < 4; ++m) _Pragma("unroll") for (int n = 0; n < 2; ++n) _Pragma("unroll") for (int k = 0; k < 2; ++k) \
        acc[ai][bj][m][n] = __builtin_amdgcn_mfma_f32_16x16x32_bf16(Bt[n][k], At[m][k], acc[ai][bj][m][n], 0, 0, 0); __builtin_amdgcn_s_setprio(0); } while (0)
#define PG8_WAIT_V(n) asm volatile("s_waitcnt vmcnt(" #n ")" ::: "memory")
#define PG8_WAIT_L(n) asm volatile("s_waitcnt lgkmcnt(" #n ")" ::: "memory")
#define PG8_BAR __builtin_amdgcn_s_barrier()
#define PG8_SCHED __builtin_amdgcn_sched_barrier(0)
    Unit cur, nxt; int ui = 0;
    if (!S.next(0, cur)) return;
    f32x4 acc[2][2][4][2];
#pragma unroll
    for (int a = 0; a < 2; ++a)
#pragma unroll
        for (int b = 0; b < 2; ++b)
#pragma unroll
            for (int m = 0; m < 4; ++m)
#pragma unroll
                for (int n = 0; n < 2; ++n) acc[a][b][m][n] = (f32x4){0.f, 0.f, 0.f, 0.f};
    bf16x8 At[4][2], B0[2][2], B1[2][2];
    const char* cA = (const char*)g.A + (size_t)cur.pm * tstep; const char* cB = (const char*)g.Bt + (size_t)cur.pn * tstep;
    S.a_ready(cur);
    if constexpr (SP2) {
        PG8_STAGE(PG8_SB(0, 0), cB, voffB); PG8_STAGE(PG8_SB(0, 1), cB + hstepB, voffB); PG8_STAGE(PG8_SA(0, 0), cA, voffA); PG8_STAGE(PG8_SA(0, 1), cA + hstep, voffA);
        if (wr == 1) PG8_BAR;
        PG8_WAIT_V(2); PG8_BAR;
        PG8_STAGE(PG8_SB(1, 0), cB + kstep, voffB); PG8_STAGE(PG8_SA(1, 0), cA + kstep, voffA); PG8_STAGE(PG8_SB(1, 1), cB + hstepB + kstep, voffB);
        PG8_WAIT_V(6); PG8_BAR;
    } else {
        PG8_STAGE(PG8_SB(0, 0), cB, voffB); PG8_STAGE(PG8_SA(0, 0), cA, voffA); PG8_STAGE(PG8_SB(0, 1), cB + hstepB, voffB); PG8_STAGE(PG8_SA(0, 1), cA + hstep, voffA);
        if (wr == 1) PG8_BAR;
        PG8_WAIT_V(4); PG8_BAR;
        PG8_STAGE(PG8_SB(1, 0), cB + kstep, voffB); PG8_STAGE(PG8_SA(1, 0), cA + kstep, voffA); PG8_STAGE(PG8_SB(1, 1), cB + hstepB + kstep, voffB);
        PG8_WAIT_V(6); PG8_BAR;
    }
    for (;;) {
        const bool has_next = S.next(ui + 1, nxt);
        const char* nA = has_next ? (const char*)g.A + (size_t)nxt.pm * tstep : cA; const char* nB = has_next ? (const char*)g.Bt + (size_t)nxt.pn * tstep : cB;
        for (int t = 0; t < nt; t += 2) {
            const bool last = (t == nt - 2);
            const char* a1 = cA + (size_t)(t + 1) * kstep;
            const char* a2 = last ? nA : cA + (size_t)(t + 2) * kstep; const char* b2 = last ? nB : cB + (size_t)(t + 2) * kstep;
            const char* a3 = a2 + kstep; const char* b3 = b2 + kstep;
            if (last && has_next) S.a_ready(nxt);
            if constexpr (SP2) {
            PG8_LDB(B0, 0, 0); PG8_LDB(B1, 0, 1); PG8_SCHED; PG8_LDA(At, 0, 0); PG8_STAGE(PG8_SA(1, 1), a1 + hstep, voffA);
            PG8_WAIT_V(8); PG8_WAIT_L(0); PG8_BAR; PG8_MMA(0, 0, At, B0); PG8_MMA(0, 1, At, B1); PG8_BAR; PG8_SCHED;
            PG8_LDA(At, 0, 1); PG8_STAGE(PG8_SB(0, 0), b2, voffB); PG8_STAGE(PG8_SB(0, 1), b2 + hstepB, voffB); PG8_STAGE(PG8_SA(0, 0), a2, voffA);
            PG8_WAIT_V(8); PG8_WAIT_L(0); PG8_BAR; PG8_MMA(1, 0, At, B0); PG8_MMA(1, 1, At, B1); PG8_BAR; PG8_SCHED;
            PG8_LDB(B0, 1, 0); PG8_LDB(B1, 1, 1); PG8_SCHED; PG8_LDA(At, 1, 0); PG8_STAGE(PG8_SA(0, 1), a2 + hstep, voffA);
            PG8_WAIT_V(8); PG8_WAIT_L(0); PG8_BAR; PG8_MMA(0, 0, At, B0); PG8_MMA(0, 1, At, B1); PG8_BAR; PG8_SCHED;
            PG8_LDA(At, 1, 1); PG8_STAGE(PG8_SB(1, 0), b3, voffB); PG8_STAGE(PG8_SB(1, 1), b3 + hstepB, voffB); PG8_STAGE(PG8_SA(1, 0), a3, voffA);
            PG8_WAIT_V(8); PG8_WAIT_L(0); PG8_BAR; PG8_MMA(1, 0, At, B0); PG8_MMA(1, 1, At, B1); PG8_BAR; PG8_SCHED;
            } else {
            PG8_LDB(B0, 0, 0); PG8_SCHED; PG8_LDA(At, 0, 0); PG8_STAGE(PG8_SA(1, 1), a1 + hstep, voffA);
            PG8_WAIT_L(8); PG8_BAR; PG8_WAIT_L(0); PG8_MMA(0, 0, At, B0); PG8_BAR; PG8_SCHED;
            PG8_LDB(B1, 0, 1); PG8_STAGE(PG8_SB(0, 0), b2, voffB);
            PG8_BAR; PG8_WAIT_L(0); PG8_MMA(0, 1, At, B1); PG8_BAR;
            PG8_LDA(At, 0, 1); PG8_STAGE(PG8_SA(0, 0), a2, voffA);
            PG8_BAR; PG8_WAIT_L(0); PG8_MMA(1, 0, At, B0); PG8_BAR; PG8_SCHED;
            PG8_STAGE(PG8_SB(0, 1), b2 + hstepB, voffB);
            PG8_WAIT_V(6); PG8_BAR; PG8_MMA(1, 1, At, B1); PG8_BAR;
            PG8_LDB(B0, 1, 0); PG8_SCHED; PG8_LDA(At, 1, 0); PG8_STAGE(PG8_SA(0, 1), a2 + hstep, voffA);
            PG8_WAIT_L(8); PG8_BAR; PG8_WAIT_L(0); PG8_MMA(0, 0, At, B0); PG8_BAR; PG8_SCHED;
            PG8_LDB(B1, 1, 1); PG8_STAGE(PG8_SB(1, 0), b3, voffB);
            PG8_BAR; PG8_WAIT_L(0); PG8_MMA(0, 1, At, B1); PG8_BAR;
            PG8_LDA(At, 1, 1); PG8_STAGE(PG8_SA(1, 0), a3, voffA);
            PG8_BAR; PG8_WAIT_L(0); PG8_MMA(1, 0, At, B0); PG8_BAR; PG8_SCHED;
            PG8_STAGE(PG8_SB(1, 1), b3 + hstepB, voffB);
            PG8_WAIT_V(6); PG8_BAR; PG8_MMA(1, 1, At, B1); PG8_BAR;
            }
        }
        if constexpr (ALIGN_EPI) { if (wr == 0) PG8_BAR; }
        if constexpr (!Epi::AFTER_DRAIN) { E(acc, cur, wr, wc, fr, fq); S.done(cur); }
        if (!has_next) break;
#pragma unroll
        for (int a = 0; a < 2; ++a)
#pragma unroll
            for (int b = 0; b < 2; ++b)
#pragma unroll
                for (int m = 0; m < 4; ++m)
#pragma unroll
                    for (int n = 0; n < 2; ++n) acc[a][b][m][n] = (f32x4){0.f, 0.f, 0.f, 0.f};
        cur = nxt; cA = nA; cB = nB; ++ui;
        if constexpr (ALIGN_EPI) { if (wr == 1) PG8_BAR; }
    }
    PG8_WAIT_V(0);
    if constexpr (!ALIGN_EPI) { if (wr == 0) PG8_BAR; }
    PG8_BAR;
    if constexpr (Epi::AFTER_DRAIN) { E.fused(acc, cur, wr, wc, fr, fq, lds, wid, lane); S.done(cur); }
#undef PG8_SA
#undef PG8_SB
#undef PG8_STAGE
#undef PG8_LDA
#undef PG8_LDB
#undef PG8_MMA
#undef PG8_WAIT_V
#undef PG8_WAIT_L
#undef PG8_BAR
#undef PG8_SCHED
}
}

namespace att {
#define ALAS __attribute__((address_space(3)))
typedef unsigned short bf16_t;
using bf16x8 = __attribute__((ext_vector_type(8))) short;
using s16x4  = __attribute__((ext_vector_type(4))) short;
using f32x16 = __attribute__((ext_vector_type(16))) float;
using u32x4  = __attribute__((ext_vector_type(4))) unsigned;
constexpr int   D = 128, NW = 8, QBLK = 32, KVBLK = 64;
constexpr float SCALE = 0.088388347648318440f;
constexpr float THR = 8.f;
constexpr int SHM_V = KVBLK * D * 2, SHM_K = KVBLK * D * 2, SHM_ATTN = 2 * SHM_V + 2 * SHM_K + NW * 64 * 4;
#define KSWZ(row, colB) ((row) * 256 + ((colB) ^ (((row) & 7) << 4)))
#define SBAR() __builtin_amdgcn_sched_barrier(0)
__device__ __forceinline__ int crow(int r, int hi) { return (r & 3) + 8 * (r >> 2) + 4 * hi; }
__device__ __forceinline__ unsigned cvtpk(float lo, float hi) { unsigned r; asm volatile("v_cvt_pk_bf16_f32 %0, %1, %2" : "=v"(r) : "v"(lo), "v"(hi)); return r; }

__device__ __forceinline__ void partialSM(f32x16& p0, f32x16& p1, float& m_reg, float& mn, float& alpha) {
  constexpr float C = SCALE * 1.4426950408889634f;
  float pmax = p0[0];
#pragma unroll
  for (int r = 1; r < 16; ++r) pmax = fmaxf(pmax, p0[r]);
#pragma unroll
  for (int r = 0; r < 16; ++r) pmax = fmaxf(pmax, p1[r]);
  { auto rr = __builtin_amdgcn_permlane32_swap(__float_as_uint(pmax), __float_as_uint(pmax), false, false);
    pmax = fmaxf(__uint_as_float(rr[0]), __uint_as_float(rr[1])); }
  if (__builtin_expect(__all(pmax - m_reg <= THR / SCALE), 1)) { mn = m_reg; alpha = 1.f; }
  else { mn = fmaxf(m_reg, pmax); alpha = __builtin_amdgcn_exp2f((m_reg - mn) * C); m_reg = mn; }
  float mnC = -mn * C;
#pragma unroll
  for (int r = 0; r < 16; ++r) p0[r] = fmaf(p0[r], C, mnC);
#pragma unroll
  for (int r = 0; r < 16; ++r) p1[r] = fmaf(p1[r], C, mnC);
#pragma unroll
  for (int r = 0; r < 16; ++r) p0[r] = __builtin_amdgcn_exp2f(p0[r]);
}
__device__ __forceinline__ void finishSM(f32x16& p0, f32x16& p1, float alpha, float& l_reg, bf16x8& pa0, bf16x8& pa1, bf16x8& pa2, bf16x8& pa3) {
#pragma unroll
  for (int r = 0; r < 16; ++r) p1[r] = __builtin_amdgcn_exp2f(p1[r]);
  float ps = 0;
#pragma unroll
  for (int r = 0; r < 16; ++r) ps += p0[r];
#pragma unroll
  for (int r = 0; r < 16; ++r) ps += p1[r];
  { auto rr = __builtin_amdgcn_permlane32_swap(__float_as_uint(ps), __float_as_uint(ps), false, false);
    ps = __uint_as_float(rr[0]) + __uint_as_float(rr[1]); }
  l_reg = l_reg * alpha + ps;
#define PK4(P, BASE, OUT) do { unsigned a0 = cvtpk(P[BASE + 0], P[BASE + 1]), a1 = cvtpk(P[BASE + 2], P[BASE + 3]);   \
    unsigned b0 = cvtpk(P[BASE + 4], P[BASE + 5]), b1 = cvtpk(P[BASE + 6], P[BASE + 7]);                              \
    auto r0 = __builtin_amdgcn_permlane32_swap(a0, b0, false, false); auto r1 = __builtin_amdgcn_permlane32_swap(a1, b1, false, false); \
    u32x4 w = {r0[0], r1[0], r0[1], r1[1]}; OUT = *reinterpret_cast<bf16x8*>(&w); } while (0)
  PK4(p0, 0, pa0); PK4(p0, 8, pa1); PK4(p1, 0, pa2); PK4(p1, 8, pa3);
#undef PK4
}
__device__ __forceinline__ void qkt(f32x16& p0, f32x16& p1, const ALAS char* Ks, const bf16x8* qr, int r32, int hi) {
  p0 = f32x16{}; p1 = f32x16{};
#pragma unroll
  for (int d0 = 0; d0 < 8; ++d0) { int cb = (d0 * 16 + hi * 8) * 2;
    bf16x8 b0 = *reinterpret_cast<const ALAS bf16x8*>(Ks + KSWZ(r32, cb));
    bf16x8 b1 = *reinterpret_cast<const ALAS bf16x8*>(Ks + KSWZ(32 + r32, cb));
    p0 = __builtin_amdgcn_mfma_f32_32x32x16_bf16(b0, qr[d0], p0, 0, 0, 0);
    p1 = __builtin_amdgcn_mfma_f32_32x32x16_bf16(b1, qr[d0], p1, 0, 0, 0); }
}
__device__ __forceinline__ void band_mask(f32x16& p0, f32x16& p1, int dj, int hi) {
#pragma unroll
  for (int r = 0; r < 16; ++r) { const int d = dj + crow(r, hi);
    if ((unsigned)(d + 128) > 256u) p0[r] = -1e30f;
    if ((unsigned)(d + 160) > 256u) p1[r] = -1e30f; }
}
__device__ __forceinline__ int v_st(int k, int c) { const int kk = (k & ~0xC) | ((k & 4) << 1) | ((k & 8) >> 1); return ((kk >> 3) * 4 + (c >> 5)) * 512 + ((kk & 7) * 32 + (c & 31)) * 2; }
__device__ __forceinline__ int v_rd_base(int lane) { return ((lane & 3) << 3) | (((lane >> 2) & 3) << 6) | (((lane >> 4) & 1) << 5) | (((lane >> 5) & 1) << 8); }
constexpr int v_rd_off(int d0, int ks, int half) { return d0 * 512 + ks * 4096 + half * 2048; }
template <int OFF> __device__ __forceinline__ s16x4 tr_read(int vb) {
  s16x4 r; asm volatile("ds_read_b64_tr_b16 %0, %1 offset:%2" : "=&v"(r) : "v"(vb), "i"(OFF) : "memory"); return r;
}
template <int D0> __device__ __forceinline__ void pv_one(f32x16& od, int vb, bf16x8 pa0, bf16x8 pa1, bf16x8 pa2, bf16x8 pa3) {
  s16x4 l0 = tr_read<v_rd_off(D0, 0, 0)>(vb), h0 = tr_read<v_rd_off(D0, 0, 1)>(vb), l1 = tr_read<v_rd_off(D0, 1, 0)>(vb), h1 = tr_read<v_rd_off(D0, 1, 1)>(vb);
  s16x4 l2 = tr_read<v_rd_off(D0, 2, 0)>(vb), h2 = tr_read<v_rd_off(D0, 2, 1)>(vb), l3 = tr_read<v_rd_off(D0, 3, 0)>(vb), h3 = tr_read<v_rd_off(D0, 3, 1)>(vb);
  asm volatile("s_waitcnt lgkmcnt(0)" : "+v"(l0), "+v"(h0), "+v"(l1), "+v"(h1), "+v"(l2), "+v"(h2), "+v"(l3), "+v"(h3) :: "memory");
#define PK(L, H) (bf16x8){L[0], L[1], L[2], L[3], H[0], H[1], H[2], H[3]}
  od = __builtin_amdgcn_mfma_f32_32x32x16_bf16(pa0, PK(l0, h0), od, 0, 0, 0);
  od = __builtin_amdgcn_mfma_f32_32x32x16_bf16(pa1, PK(l1, h1), od, 0, 0, 0);
  od = __builtin_amdgcn_mfma_f32_32x32x16_bf16(pa2, PK(l2, h2), od, 0, 0, 0);
  od = __builtin_amdgcn_mfma_f32_32x32x16_bf16(pa3, PK(l3, h3), od, 0, 0, 0);
#undef PK
}
__device__ __forceinline__ void pv_d0(f32x16* o, int vb, bf16x8 pa0, bf16x8 pa1, bf16x8 pa2, bf16x8 pa3) {
  pv_one<0>(o[0], vb, pa0, pa1, pa2, pa3); pv_one<1>(o[1], vb, pa0, pa1, pa2, pa3); pv_one<2>(o[2], vb, pa0, pa1, pa2, pa3); pv_one<3>(o[3], vb, pa0, pa1, pa2, pa3);
}
__device__ __forceinline__ void pv_sm(f32x16* o, int vb, bf16x8 pa0, bf16x8 pa1, bf16x8 pa2, bf16x8 pa3, f32x16& p0, f32x16& p1, float& m_reg, float& mn, float& alpha) {
  constexpr float C = SCALE * 1.4426950408889634f;
  pv_one<0>(o[0], vb, pa0, pa1, pa2, pa3);
  float pmax = p0[0];
#pragma unroll
  for (int r = 1; r < 16; ++r) pmax = fmaxf(pmax, p0[r]);
#pragma unroll
  for (int r = 0; r < 16; ++r) pmax = fmaxf(pmax, p1[r]);
  { auto rr = __builtin_amdgcn_permlane32_swap(__float_as_uint(pmax), __float_as_uint(pmax), false, false);
    pmax = fmaxf(__uint_as_float(rr[0]), __uint_as_float(rr[1])); }
  pv_one<1>(o[1], vb, pa0, pa1, pa2, pa3);
  if (__builtin_expect(__all(pmax - m_reg <= THR / SCALE), 1)) { mn = m_reg; alpha = 1.f; }
  else { mn = fmaxf(m_reg, pmax); alpha = __builtin_amdgcn_exp2f((m_reg - mn) * C); m_reg = mn; }
  const float mnC = -mn * C;
#pragma unroll
  for (int r = 0; r < 16; ++r) p0[r] = fmaf(p0[r], C, mnC);
  pv_one<2>(o[2], vb, pa0, pa1, pa2, pa3);
#pragma unroll
  for (int r = 0; r < 16; ++r) p1[r] = fmaf(p1[r], C, mnC);
#pragma unroll
  for (int r = 0; r < 8; ++r) p0[r] = __builtin_amdgcn_exp2f(p0[r]);
  pv_one<3>(o[3], vb, pa0, pa1, pa2, pa3);
#pragma unroll
  for (int r = 8; r < 16; ++r) p0[r] = __builtin_amdgcn_exp2f(p0[r]);
}

__device__ __forceinline__ void attn_unit(const bf16_t* __restrict__ Q, const bf16_t* __restrict__ K, const bf16_t* __restrict__ V, bf16_t* __restrict__ O,
                                          int ldq, int ldk, int ldo, int nt, int nfirst, int skip, int qpos0, float sinkl2, ALAS char* lds,
                                          int qmode, const float* __restrict__ gq, const float* __restrict__ ropeC, const float* __restrict__ ropeS) {
  int tid_l = tid_now(); asm volatile("" : "+v"(tid_l));
  const int tid = tid_l, wid = tid >> 6, lane = tid & 63, r32 = lane & 31, hi = lane >> 5;
  ALAS char* V_lds = lds; ALAS char* K_lds = lds + 2 * SHM_V;
  ALAS float* ws = (ALAS float*)(lds + 2 * SHM_V + 2 * SHM_K) + wid * 64; ALAS float* li_l = ws; ALAS float* al_l = ws + 32;
  float m_reg = -1e30f, l_reg = 0; f32x16 o[4] = {}; bf16x8 qr[8];
  const bf16_t* Qw = Q + (long)(wid * QBLK + r32) * ldq + hi * 8;
#pragma unroll
  for (int d0 = 0; d0 < 8; ++d0) qr[d0] = *reinterpret_cast<const bf16x8*>(Qw + d0 * 16);
  if (qmode) {
    float qf[8][8];
#pragma unroll
    for (int d0 = 0; d0 < 8; ++d0)
#pragma unroll
      for (int j = 0; j < 8; ++j) qf[d0][j] = __uint_as_float(((unsigned)(unsigned short)qr[d0][j]) << 16);
    if (qmode & 1) { float ss = 0.f;
#pragma unroll
      for (int d0 = 0; d0 < 8; ++d0)
#pragma unroll
        for (int j = 0; j < 8; ++j) ss += qf[d0][j] * qf[d0][j];
      ss += __shfl_xor(ss, 32);
      const float rstd = 1.0f / sqrtf(ss * (1.0f / 128.0f) + 1e-6f);
#pragma unroll
      for (int d0 = 0; d0 < 8; ++d0) { const float* gp = gq + d0 * 16 + hi * 8; const float4 g0 = *reinterpret_cast<const float4*>(gp), g1 = *reinterpret_cast<const float4*>(gp + 4);
        qf[d0][0] *= rstd * g0.x; qf[d0][1] *= rstd * g0.y; qf[d0][2] *= rstd * g0.z; qf[d0][3] *= rstd * g0.w; qf[d0][4] *= rstd * g1.x; qf[d0][5] *= rstd * g1.y; qf[d0][6] *= rstd * g1.z; qf[d0][7] *= rstd * g1.w; } }
    if (qmode & 2) { const int t = qpos0 + wid * QBLK + r32;
#pragma unroll
      for (int hf = 0; hf < 2; ++hf) { const int p = hf ? (t & 63) : (t >> 6);
#pragma unroll
        for (int dd = 0; dd < 2; ++dd) { const int d0 = hf * 4 + dd, i0 = dd * 16 + hi * 8;
          const float4 c0 = *reinterpret_cast<const float4*>(ropeC + p * 32 + i0), c1 = *reinterpret_cast<const float4*>(ropeC + p * 32 + i0 + 4);
          const float4 s0 = *reinterpret_cast<const float4*>(ropeS + p * 32 + i0), s1 = *reinterpret_cast<const float4*>(ropeS + p * 32 + i0 + 4);
          const float cs[8] = {c0.x, c0.y, c0.z, c0.w, c1.x, c1.y, c1.z, c1.w}, sn[8] = {s0.x, s0.y, s0.z, s0.w, s1.x, s1.y, s1.z, s1.w};
#pragma unroll
          for (int j = 0; j < 8; ++j) { const float x1 = qf[d0][j], x2 = qf[d0 + 2][j]; qf[d0][j] = x1 * cs[j] - x2 * sn[j]; qf[d0 + 2][j] = x1 * sn[j] + x2 * cs[j]; } } } }
#pragma unroll
    for (int d0 = 0; d0 < 8; ++d0) { u32x4 w = {cvtpk(qf[d0][0], qf[d0][1]), cvtpk(qf[d0][2], qf[d0][3]), cvtpk(qf[d0][4], qf[d0][5]), cvtpk(qf[d0][6], qf[d0][7])}; qr[d0] = *reinterpret_cast<bf16x8*>(&w); }
  }
  const int sr = tid >> 4, sc = (tid & 15) * 8, vst0 = v_st(sr, sc), vst1 = v_st(32 + sr, sc);
  const int vb0 = (int)(uintptr_t)V_lds + v_rd_base(lane);
  const long ko0 = (long)sr * ldk + sc, ko1 = ko0 + 32L * ldk;
  const int qi = qpos0 + wid * QBLK + r32;
  struct { bf16x8 vs0, vs1, ks0, ks1; } sr_[2];
#define KROW(t) ((t) * KVBLK + (((t) >= nfirst) ? skip : 0))
#define SLOAD(i, t) do { const long ro_ = (long)KROW(t) * ldk; sr_[i].vs0 = *reinterpret_cast<const bf16x8*>(V + ro_ + ko0); sr_[i].vs1 = *reinterpret_cast<const bf16x8*>(V + ro_ + ko1); \
    sr_[i].ks0 = *reinterpret_cast<const bf16x8*>(K + ro_ + ko0); sr_[i].ks1 = *reinterpret_cast<const bf16x8*>(K + ro_ + ko1); } while (0)
#define SWRITE(b, i) do { *(ALAS bf16x8*)(V_lds + (b) * SHM_V + vst0) = sr_[i].vs0;          \
    *(ALAS bf16x8*)(V_lds + (b) * SHM_V + vst1) = sr_[i].vs1; const int kc_ = sc * 2;               \
    *(ALAS bf16x8*)(K_lds + (b) * SHM_K + KSWZ(sr, kc_)) = sr_[i].ks0;                       \
    *(ALAS bf16x8*)(K_lds + (b) * SHM_K + KSWZ(32 + sr, kc_)) = sr_[i].ks1; } while (0)
#define SWAIT() asm volatile("s_waitcnt vmcnt(4)" ::: "memory")
#define RESC(a) do { if (__any((a) < 1.f)) { if (hi == 0) al_l[r32] = (a); asm volatile("s_waitcnt lgkmcnt(0)" ::: "memory"); \
    _Pragma("unroll") for (int d = 0; d < 4; ++d) _Pragma("unroll") for (int r = 0; r < 16; ++r) o[d][r] *= al_l[crow(r, hi)]; } } while (0)
#define MASK(P0, P1, t) do { if ((t) >= nfirst) band_mask(P0, P1, KROW(t) - 512 - qi, hi); } while (0)
  f32x16 pA0, pA1, pB0, pB1; float mnA, mnB, alA, alB; bf16x8 pa0, pa1, pa2, pa3; const int NT = nt;
  constexpr int SE = 0, SO = 1;
  SLOAD(SE, 0); asm volatile("s_waitcnt vmcnt(0)" ::: "memory"); SWRITE(0, SE); __syncthreads();
  qkt(pA0, pA1, K_lds, qr, r32, hi); MASK(pA0, pA1, 0); partialSM(pA0, pA1, m_reg, mnA, alA);
  SLOAD(SO, 1); if (2 < NT) SLOAD(SE, 2);
  SWAIT(); SWRITE(1, SO); __syncthreads();
  for (int j = 1; j + 1 < NT; j += 2) {
    SBAR(); qkt(pB0, pB1, K_lds + SHM_K, qr, r32, hi);
    finishSM(pA0, pA1, alA, l_reg, pa0, pa1, pa2, pa3); SBAR();
    SLOAD(SO, j + 2); SBAR();
    MASK(pB0, pB1, j); pv_sm(o, vb0, pa0, pa1, pa2, pa3, pB0, pB1, m_reg, mnB, alB);
    __syncthreads(); SWAIT(); SWRITE(0, SE);
    RESC(alB); __syncthreads();
    SBAR(); qkt(pA0, pA1, K_lds, qr, r32, hi);
    finishSM(pB0, pB1, alB, l_reg, pa0, pa1, pa2, pa3); SBAR();
    if (j + 3 < NT) SLOAD(SE, j + 3); SBAR();
    MASK(pA0, pA1, j + 1); pv_sm(o, vb0 + (int)SHM_V, pa0, pa1, pa2, pa3, pA0, pA1, m_reg, mnA, alA);
    __syncthreads(); SWAIT(); SWRITE(1, SO);
    RESC(alA); __syncthreads();
  }
  SBAR(); qkt(pB0, pB1, K_lds + SHM_K, qr, r32, hi);
  finishSM(pA0, pA1, alA, l_reg, pa0, pa1, pa2, pa3); SBAR();
  MASK(pB0, pB1, NT - 1); pv_sm(o, vb0, pa0, pa1, pa2, pa3, pB0, pB1, m_reg, mnB, alB);
  __syncthreads(); RESC(alB);
  finishSM(pB0, pB1, alB, l_reg, pa0, pa1, pa2, pa3); SBAR();
  pv_d0(o, vb0 + (int)SHM_V, pa0, pa1, pa2, pa3);
  l_reg += __builtin_amdgcn_exp2f(sinkl2 - m_reg * (SCALE * 1.4426950408889634f));
  if (hi == 0) li_l[r32] = l_reg; asm volatile("s_waitcnt lgkmcnt(0)" ::: "memory");
  float rli[16];
#pragma unroll
  for (int r = 0; r < 16; ++r) rli[r] = __builtin_amdgcn_rcpf(li_l[crow(r, hi)]);
  bf16_t* Ow = O + (long)(wid * QBLK) * ldo + r32;
#pragma unroll
  for (int r = 0; r < 16; ++r) { const int orow = crow(r, hi);
#pragma unroll
    for (int d0 = 0; d0 < 4; ++d0) { const unsigned w = cvtpk(o[d0][r] * rli[r], 0.f); Ow[(long)orow * ldo + d0 * 32] = (bf16_t)(w & 0xffffu); } }
#undef KROW
#undef SLOAD
#undef SWRITE
#undef SWAIT
#undef RESC
#undef MASK
}

__device__ __forceinline__ void dma16(const void* gsrc, ALAS void* lds_dst_uniform) { __builtin_amdgcn_global_load_lds((const unsigned*)gsrc, (ALAS unsigned*)lds_dst_uniform, 16, 0, 0); }
template <int NVB>
__device__ __forceinline__ void attn_unit_dma(const bf16_t* __restrict__ Q, const bf16_t* __restrict__ K, const bf16_t* __restrict__ V, bf16_t* __restrict__ O,
                                              int ldq, int ldk, int ldo, int nt, int nfirst, int skip, int qpos0, float sinkl2, ALAS char* lds, ALAS float* scr,
                                              int qmode, const float* __restrict__ gq, const float* __restrict__ ropeC, const float* __restrict__ ropeS) {
  constexpr int NVP = NVB / 2;
  int tid_l = tid_now(); asm volatile("" : "+v"(tid_l));
  const int tid = tid_l, wid = __builtin_amdgcn_readfirstlane(tid >> 6), lane = tid & 63, r32 = lane & 31, hi = lane >> 5;
  ALAS char* K_lds = lds; ALAS char* V_lds = lds + 32768; ALAS char* Qs = lds + 65536 + wid * 8192;
  ALAS float* li_l = scr; ALAS float* al_l = scr + 32;
  const int qi = qpos0 + wid * QBLK + r32;
  unsigned koff[2], voff[NVP];
#pragma unroll
  for (int i = 0; i < 2; ++i) { const int L = (wid * 2 + i) * 1024 + lane * 16, row = L >> 8, cb = (L & 255) ^ ((row & 7) << 4); koff[i] = (unsigned)(row * ldk * 2 + cb); }
#pragma unroll
  for (int i = 0; i < NVP; ++i) { const int L = (wid * NVP + i) * 1024 + lane * 16, half = L >> 14, Lh = L & 16383, sub = Lh >> 9, within = Lh & 511;
    const int kk = (sub >> 2) * 8 + (within >> 6), k = (kk & ~0xC) | ((kk & 4) << 1) | ((kk & 8) >> 1), col = half * 128 + (sub & 3) * 32 + ((within & 63) >> 1);
    voff[i] = (unsigned)(k * ldk * 2 + col * 2); }
#define KROW(t) ((t) * KVBLK + (((t) >= nfirst) ? skip : 0))
#define DK_ISSUE(t, slot) do { const char* kb_ = (const char*)K + (size_t)KROW(t) * 2 * ldk; \
    _Pragma("unroll") for (int i = 0; i < 2; ++i) dma16(kb_ + koff[i], K_lds + (slot) * 16384 + (wid * 2 + i) * 1024); } while (0)
#define DV_ISSUE(t) do { const char* vb_ = (const char*)V + (size_t)KROW(t) * 2 * ldk; \
    _Pragma("unroll") for (int i = 0; i < NVP; ++i) dma16(vb_ + voff[i], V_lds + (wid * NVP + i) * 1024); } while (0)
  DK_ISSUE(0, 0); DV_ISSUE(0); DK_ISSUE(1, 1);
  { bf16x8 qr[8];
    const bf16_t* Qw = Q + (long)(wid * QBLK + r32) * ldq + hi * 8;
#pragma unroll
    for (int d0 = 0; d0 < 8; ++d0) qr[d0] = *reinterpret_cast<const bf16x8*>(Qw + d0 * 16);
    if (qmode) {
      float qf[8][8];
#pragma unroll
      for (int d0 = 0; d0 < 8; ++d0)
#pragma unroll
        for (int j = 0; j < 8; ++j) qf[d0][j] = __uint_as_float(((unsigned)(unsigned short)qr[d0][j]) << 16);
      if (qmode & 1) { float ss = 0.f;
#pragma unroll
        for (int d0 = 0; d0 < 8; ++d0)
#pragma unroll
          for (int j = 0; j < 8; ++j) ss += qf[d0][j] * qf[d0][j];
        ss += __shfl_xor(ss, 32);
        const float rstd = 1.0f / sqrtf(ss * (1.0f / 128.0f) + 1e-6f);
#pragma unroll
        for (int d0 = 0; d0 < 8; ++d0) { const float* gp = gq + d0 * 16 + hi * 8; const float4 g0 = *reinterpret_cast<const float4*>(gp), g1 = *reinterpret_cast<const float4*>(gp + 4);
          qf[d0][0] *= rstd * g0.x; qf[d0][1] *= rstd * g0.y; qf[d0][2] *= rstd * g0.z; qf[d0][3] *= rstd * g0.w; qf[d0][4] *= rstd * g1.x; qf[d0][5] *= rstd * g1.y; qf[d0][6] *= rstd * g1.z; qf[d0][7] *= rstd * g1.w; } }
      if (qmode & 2) { const int t = qi;
#pragma unroll
        for (int hf = 0; hf < 2; ++hf) { const int p = hf ? (t & 63) : (t >> 6);
#pragma unroll
          for (int dd = 0; dd < 2; ++dd) { const int d0 = hf * 4 + dd, i0 = dd * 16 + hi * 8;
            const float4 c0 = *reinterpret_cast<const float4*>(ropeC + p * 32 + i0), c1 = *reinterpret_cast<const float4*>(ropeC + p * 32 + i0 + 4);
            const float4 s0 = *reinterpret_cast<const float4*>(ropeS + p * 32 + i0), s1 = *reinterpret_cast<const float4*>(ropeS + p * 32 + i0 + 4);
            const float cs[8] = {c0.x, c0.y, c0.z, c0.w, c1.x, c1.y, c1.z, c1.w}, sn[8] = {s0.x, s0.y, s0.z, s0.w, s1.x, s1.y, s1.z, s1.w};
#pragma unroll
            for (int j = 0; j < 8; ++j) { const float x1 = qf[d0][j], x2 = qf[d0 + 2][j]; qf[d0][j] = x1 * cs[j] - x2 * sn[j]; qf[d0 + 2][j] = x1 * sn[j] + x2 * cs[j]; } } } }
#pragma unroll
      for (int d0 = 0; d0 < 8; ++d0) { u32x4 w = {cvtpk(qf[d0][0], qf[d0][1]), cvtpk(qf[d0][2], qf[d0][3]), cvtpk(qf[d0][4], qf[d0][5]), cvtpk(qf[d0][6], qf[d0][7])}; qr[d0] = *reinterpret_cast<bf16x8*>(&w); }
    }
#pragma unroll
    for (int d0 = 0; d0 < 8; ++d0) *(ALAS bf16x8*)(Qs + (d0 * 64 + lane) * 16) = qr[d0];
  }
  float m_reg = -1e30f, l_reg = 0.f; f32x16 o[NVB] = {};
  const int vb0 = (int)(uintptr_t)V_lds + v_rd_base(lane);
  if (NVP == 4) asm volatile("s_waitcnt vmcnt(6)" ::: "memory"); else asm volatile("s_waitcnt vmcnt(4)" ::: "memory");
  asm volatile("s_waitcnt lgkmcnt(0)" ::: "memory"); __builtin_amdgcn_s_barrier();
  for (int j = 0; j < nt; ++j) {
    f32x16 p0 = f32x16{}, p1 = f32x16{}; float mn, alpha; bf16x8 pa0, pa1, pa2, pa3;
    { const ALAS char* Ks = K_lds + (j & 1) * 16384;
#pragma unroll
      for (int d0 = 0; d0 < 8; ++d0) { const int cb = (d0 * 16 + hi * 8) * 2;
        const bf16x8 qd = *(const ALAS bf16x8*)(Qs + (d0 * 64 + lane) * 16);
        const bf16x8 b0 = *reinterpret_cast<const ALAS bf16x8*>(Ks + KSWZ(r32, cb));
        const bf16x8 b1 = *reinterpret_cast<const ALAS bf16x8*>(Ks + KSWZ(32 + r32, cb));
        p0 = __builtin_amdgcn_mfma_f32_32x32x16_bf16(b0, qd, p0, 0, 0, 0);
        p1 = __builtin_amdgcn_mfma_f32_32x32x16_bf16(b1, qd, p1, 0, 0, 0); } }
    if (j >= nfirst) band_mask(p0, p1, KROW(j) - 512 - qi, hi);
    partialSM(p0, p1, m_reg, mn, alpha);
    if (__any(alpha < 1.f)) { if (hi == 0) al_l[r32] = alpha; asm volatile("s_waitcnt lgkmcnt(0)" ::: "memory");
#pragma unroll
      for (int d = 0; d < NVB; ++d)
#pragma unroll
        for (int r = 0; r < 16; ++r) o[d][r] *= al_l[crow(r, hi)]; }
    finishSM(p0, p1, alpha, l_reg, pa0, pa1, pa2, pa3);
    asm volatile("s_waitcnt vmcnt(0) lgkmcnt(0)" ::: "memory"); __builtin_amdgcn_s_barrier();
    pv_one<0>(o[0], vb0, pa0, pa1, pa2, pa3); pv_one<1>(o[1], vb0, pa0, pa1, pa2, pa3); pv_one<2>(o[2], vb0, pa0, pa1, pa2, pa3); pv_one<3>(o[3], vb0, pa0, pa1, pa2, pa3);
    if constexpr (NVB == 8) { pv_one<0>(o[4], vb0 + 16384, pa0, pa1, pa2, pa3); pv_one<1>(o[5], vb0 + 16384, pa0, pa1, pa2, pa3); pv_one<2>(o[6], vb0 + 16384, pa0, pa1, pa2, pa3); pv_one<3>(o[7], vb0 + 16384, pa0, pa1, pa2, pa3); }
    asm volatile("s_waitcnt lgkmcnt(0)" ::: "memory"); __builtin_amdgcn_s_barrier();
    if (j + 1 < nt) DV_ISSUE(j + 1);
    if (j + 2 < nt) DK_ISSUE(j + 2, j & 1);
  }
#undef DK_ISSUE
#undef DV_ISSUE
#undef KROW
  l_reg += __builtin_amdgcn_exp2f(sinkl2 - m_reg * (SCALE * 1.4426950408889634f));
  if (hi == 0) li_l[r32] = l_reg; asm volatile("s_waitcnt lgkmcnt(0)" ::: "memory");
  float rli[16];
#pragma unroll
  for (int r = 0; r < 16; ++r) rli[r] = __builtin_amdgcn_rcpf(li_l[crow(r, hi)]);
  { constexpr int RB = NVB * 64, NPASS = RB / 256, RPP = 32 / NPASS, PPR = RB / 16;
    ALAS char* og = Qs; bf16_t* Og = O + (long)(wid * QBLK) * ldo;
#pragma unroll
    for (int ps = 0; ps < NPASS; ++ps) {
#pragma unroll
      for (int r = 0; r < 16; ++r) { const int row = crow(r, hi); if (row / RPP != ps) continue; const int lrow = row - RPP * ps;
#pragma unroll
        for (int d = 0; d < NVB; ++d) { const unsigned w = cvtpk(o[d][r] * rli[r], 0.f); *(ALAS unsigned short*)(og + lrow * RB + (d * 32 + r32) * 2) = (unsigned short)(w & 0xffffu); } }
#pragma unroll
      for (int k = 0; k < 8; ++k) { const int p = lane + 64 * k; const u32x4 v = *(const ALAS u32x4*)(og + p * 16);
        *reinterpret_cast<u32x4*>(Og + (long)(RPP * ps + p / PPR) * ldo + (p % PPR) * 8) = v; }
    } }
}

#define PP_WAIT2(N, A, B) asm volatile("s_waitcnt lgkmcnt(" #N ")" : "+v"(A), "+v"(B) :: "memory")
__device__ __forceinline__ void qk_seg(f32x16& p0, f32x16& p1, const ALAS char* Ks, const bf16x8* qr, const f32x16& negm, int r32, int hi) {
  int sw = ((r32 & 7) << 4) ^ (hi * 16); asm volatile("" : "+v"(sw));
  const int r0 = (int)(uintptr_t)Ks + r32 * 256;
#define KRD(DST0, DST1, d0) do { const int ad_ = r0 + (((d0) * 32) ^ sw); asm volatile("ds_read_b128 %0, %2\n\tds_read_b128 %1, %2 offset:8192" : "=&v"(DST0), "=&v"(DST1) : "v"(ad_) : "memory"); } while (0)
  bf16x8 a[3], b[3];
  KRD(a[0], b[0], 0); KRD(a[1], b[1], 1); KRD(a[2], b[2], 2);
  SBAR(); __builtin_amdgcn_s_setprio(1);
#pragma unroll
  for (int d0 = 0; d0 < 8; ++d0) {
    if (d0 < 6) PP_WAIT2(4, a[d0 % 3], b[d0 % 3]); else if (d0 == 6) PP_WAIT2(2, a[d0 % 3], b[d0 % 3]); else PP_WAIT2(0, a[d0 % 3], b[d0 % 3]);
    p0 = __builtin_amdgcn_mfma_f32_32x32x16_bf16(a[d0 % 3], qr[d0], d0 == 0 ? negm : p0, 0, 0, 0);
    p1 = __builtin_amdgcn_mfma_f32_32x32x16_bf16(b[d0 % 3], qr[d0], d0 == 0 ? negm : p1, 0, 0, 0);
    SBAR();
    if (d0 + 3 < 8) { KRD(a[d0 % 3], b[d0 % 3], d0 + 3); SBAR(); }
  }
  __builtin_amdgcn_s_setprio(0);
#undef KRD
}
__device__ __forceinline__ void pv_seg(f32x16* o, const ALAS char* vbp, bf16x8 pa0, bf16x8 pa1, bf16x8 pa2, bf16x8 pa3) {
  const int vb = (int)(uintptr_t)vbp;
#define PK(L, H) (bf16x8){L[0], L[1], L[2], L[3], H[0], H[1], H[2], H[3]}
  s16x4 lo[4], hh[4];
  lo[0] = tr_read<v_rd_off(0, 0, 0)>(vb); hh[0] = tr_read<v_rd_off(0, 0, 1)>(vb); lo[1] = tr_read<v_rd_off(0, 1, 0)>(vb); hh[1] = tr_read<v_rd_off(0, 1, 1)>(vb);
  lo[2] = tr_read<v_rd_off(0, 2, 0)>(vb); hh[2] = tr_read<v_rd_off(0, 2, 1)>(vb); lo[3] = tr_read<v_rd_off(0, 3, 0)>(vb); hh[3] = tr_read<v_rd_off(0, 3, 1)>(vb);
  SBAR(); __builtin_amdgcn_s_setprio(1);
#define PVSTEP(d, ks, PA, WN, NEXT) do { PP_WAIT2(WN, lo[ks], hh[ks]); o[d] = __builtin_amdgcn_mfma_f32_32x32x16_bf16(PA, PK(lo[ks], hh[ks]), o[d], 0, 0, 0); SBAR(); \
    if (NEXT) { lo[ks] = tr_read<v_rd_off(((d) + 1) & 3, ks, 0)>(vb); hh[ks] = tr_read<v_rd_off(((d) + 1) & 3, ks, 1)>(vb); SBAR(); } } while (0)
  PVSTEP(0, 0, pa0, 6, 1); PVSTEP(0, 1, pa1, 6, 1); PVSTEP(0, 2, pa2, 6, 1); PVSTEP(0, 3, pa3, 6, 1);
  PVSTEP(1, 0, pa0, 6, 1); PVSTEP(1, 1, pa1, 6, 1); PVSTEP(1, 2, pa2, 6, 1); PVSTEP(1, 3, pa3, 6, 1);
  PVSTEP(2, 0, pa0, 6, 1); PVSTEP(2, 1, pa1, 6, 1); PVSTEP(2, 2, pa2, 6, 1); PVSTEP(2, 3, pa3, 6, 1);
  PVSTEP(3, 0, pa0, 6, 0); PVSTEP(3, 1, pa1, 4, 0); PVSTEP(3, 2, pa2, 2, 0); PVSTEP(3, 3, pa3, 0, 0);
  { const bf16x8 ones = {0x3F80, 0x3F80, 0x3F80, 0x3F80, 0x3F80, 0x3F80, 0x3F80, 0x3F80};
    o[4] = __builtin_amdgcn_mfma_f32_32x32x16_bf16(pa0, ones, o[4], 0, 0, 0); o[4] = __builtin_amdgcn_mfma_f32_32x32x16_bf16(pa1, ones, o[4], 0, 0, 0);
    o[4] = __builtin_amdgcn_mfma_f32_32x32x16_bf16(pa2, ones, o[4], 0, 0, 0); o[4] = __builtin_amdgcn_mfma_f32_32x32x16_bf16(pa3, ones, o[4], 0, 0, 0); SBAR(); }
  __builtin_amdgcn_s_setprio(0);
#undef PVSTEP
#undef PK
}
constexpr float THRL2 = THR * 1.4426950408889634f;
__device__ __forceinline__ void psm_n(f32x16& p0, f32x16& p1, float& m_reg, float& alpha, f32x16& negm, bool first) {
  float pmax = fmaxf(p0[0], p1[0]);
#pragma unroll
  for (int r = 1; r < 16; ++r) pmax = fmaxf(pmax, fmaxf(p0[r], p1[r]));
  { auto rr = __builtin_amdgcn_permlane32_swap(__float_as_uint(pmax), __float_as_uint(pmax), false, false); pmax = fmaxf(__uint_as_float(rr[0]), __uint_as_float(rr[1])); }
  alpha = 1.f;
  if (first || !__all(pmax <= THRL2)) { const float delta = first ? pmax : fmaxf(pmax, 0.f); if (!first) alpha = __builtin_amdgcn_exp2f(-delta); m_reg += delta;
#pragma unroll
    for (int r = 0; r < 16; ++r) { p0[r] -= delta; p1[r] -= delta; negm[r] = -m_reg; } }
#pragma unroll
  for (int r = 0; r < 16; ++r) p0[r] = __builtin_amdgcn_exp2f(p0[r]);
}
__device__ __forceinline__ void fsm_n(f32x16& p0, f32x16& p1, bf16x8& pa0, bf16x8& pa1, bf16x8& pa2, bf16x8& pa3) {
#pragma unroll
  for (int r = 0; r < 16; ++r) p1[r] = __builtin_amdgcn_exp2f(p1[r]);
#define PK4(P, BASE, OUT) do { unsigned a0 = cvtpk(P[BASE + 0], P[BASE + 1]), a1 = cvtpk(P[BASE + 2], P[BASE + 3]);   \
    unsigned b0 = cvtpk(P[BASE + 4], P[BASE + 5]), b1 = cvtpk(P[BASE + 6], P[BASE + 7]);                              \
    auto r0 = __builtin_amdgcn_permlane32_swap(a0, b0, false, false); auto r1 = __builtin_amdgcn_permlane32_swap(a1, b1, false, false); \
    u32x4 w = {r0[0], r1[0], r0[1], r1[1]}; OUT = *reinterpret_cast<bf16x8*>(&w); } while (0)
  PK4(p0, 0, pa0); PK4(p0, 8, pa1); PK4(p1, 0, pa2); PK4(p1, 8, pa3);
#undef PK4
}
__device__ __forceinline__ void attn_unit_dma2(const bf16_t* __restrict__ Q, const bf16_t* __restrict__ K, const bf16_t* __restrict__ V, bf16_t* __restrict__ O,
                                               int ldq, int ldk, int ldo, int nt, int nfirst, int skip, int qpos0, float sinkl2, ALAS char* lds, ALAS float* scr,
                                               int qmode, const float* __restrict__ gq, const float* __restrict__ ropeC, const float* __restrict__ ropeS) {
  int tid_l = tid_now(); asm volatile("" : "+v"(tid_l));
  const int tid = tid_l, wid = __builtin_amdgcn_readfirstlane(tid >> 6), lane = tid & 63, r32 = lane & 31, hi = lane >> 5;
  ALAS char* K_lds = lds; ALAS char* V_lds = lds + 32768;
  ALAS float* li_l = scr; ALAS float* al_l = scr + 32;
  const int qi = qpos0 + wid * QBLK + r32;
  unsigned koff[2], voff[2];
#pragma unroll
  for (int i = 0; i < 2; ++i) { const int L = (wid * 2 + i) * 1024 + lane * 16, row = L >> 8, cb = (L & 255) ^ ((row & 7) << 4); koff[i] = (unsigned)(row * ldk * 2 + cb); }
#pragma unroll
  for (int i = 0; i < 2; ++i) { const int L = (wid * 2 + i) * 1024 + lane * 16, sub = L >> 9, within = L & 511;
    const int kk = (sub >> 2) * 8 + (within >> 6), k = (kk & ~0xC) | ((kk & 4) << 1) | ((kk & 8) >> 1), col = (sub & 3) * 32 + ((within & 63) >> 1);
    voff[i] = (unsigned)(k * ldk * 2 + col * 2); }
#define KROW(t) ((t) * KVBLK + (((t) >= nfirst) ? skip : 0))
#define DK_ISSUE(t, slot) do { const char* kb_ = (const char*)K + (size_t)KROW(t) * 2 * ldk; \
    _Pragma("unroll") for (int i = 0; i < 2; ++i) dma16(kb_ + koff[i], K_lds + (slot) * 16384 + (wid * 2 + i) * 1024); } while (0)
#define DV_ISSUE(t, slot) do { const char* vb_ = (const char*)V + (size_t)KROW(t) * 2 * ldk; \
    _Pragma("unroll") for (int i = 0; i < 2; ++i) dma16(vb_ + voff[i], V_lds + (slot) * 16384 + (wid * 2 + i) * 1024); } while (0)
#define RESC(a) do { if (__any((a) < 1.f)) { if (hi == 0) al_l[r32] = (a); asm volatile("s_waitcnt lgkmcnt(0)" ::: "memory"); \
    _Pragma("unroll") for (int d = 0; d < 4; ++d) _Pragma("unroll") for (int r = 0; r < 16; ++r) o[d][r] *= al_l[crow(r, hi)]; } } while (0)
#define MASK(P0, P1, t) do { if ((t) >= nfirst) band_mask(P0, P1, KROW(t) - 512 - qi, hi); } while (0)
#define STEP_SYNC() do { asm volatile("s_waitcnt vmcnt(0) lgkmcnt(0)" ::: "memory"); __builtin_amdgcn_s_barrier(); } while (0)
  DK_ISSUE(0, 0); DV_ISSUE(0, 0); DK_ISSUE(1, 1);
  bf16x8 qr[8];
  { const bf16_t* Qw = Q + (long)(wid * QBLK + r32) * ldq + hi * 8;
#pragma unroll
    for (int d0 = 0; d0 < 8; ++d0) qr[d0] = *reinterpret_cast<const bf16x8*>(Qw + d0 * 16);
    if (qmode) {
      float qf[8][8];
#pragma unroll
      for (int d0 = 0; d0 < 8; ++d0)
#pragma unroll
        for (int j = 0; j < 8; ++j) qf[d0][j] = __uint_as_float(((unsigned)(unsigned short)qr[d0][j]) << 16);
      if (qmode & 1) { float ss = 0.f;
#pragma unroll
        for (int d0 = 0; d0 < 8; ++d0)
#pragma unroll
          for (int j = 0; j < 8; ++j) ss += qf[d0][j] * qf[d0][j];
        ss += __shfl_xor(ss, 32);
        const float rstd = 1.0f / sqrtf(ss * (1.0f / 128.0f) + 1e-6f);
#pragma unroll
        for (int d0 = 0; d0 < 8; ++d0) { const float* gp = gq + d0 * 16 + hi * 8; const float4 g0 = *reinterpret_cast<const float4*>(gp), g1 = *reinterpret_cast<const float4*>(gp + 4);
          qf[d0][0] *= rstd * g0.x; qf[d0][1] *= rstd * g0.y; qf[d0][2] *= rstd * g0.z; qf[d0][3] *= rstd * g0.w; qf[d0][4] *= rstd * g1.x; qf[d0][5] *= rstd * g1.y; qf[d0][6] *= rstd * g1.z; qf[d0][7] *= rstd * g1.w; } }
      if (qmode & 2) { const int t = qi;
#pragma unroll
        for (int hf = 0; hf < 2; ++hf) { const int p = hf ? (t & 63) : (t >> 6);
#pragma unroll
          for (int dd = 0; dd < 2; ++dd) { const int d0 = hf * 4 + dd, i0 = dd * 16 + hi * 8;
            const float4 c0 = *reinterpret_cast<const float4*>(ropeC + p * 32 + i0), c1 = *reinterpret_cast<const float4*>(ropeC + p * 32 + i0 + 4);
            const float4 s0 = *reinterpret_cast<const float4*>(ropeS + p * 32 + i0), s1 = *reinterpret_cast<const float4*>(ropeS + p * 32 + i0 + 4);
            const float cs[8] = {c0.x, c0.y, c0.z, c0.w, c1.x, c1.y, c1.z, c1.w}, sn[8] = {s0.x, s0.y, s0.z, s0.w, s1.x, s1.y, s1.z, s1.w};
#pragma unroll
            for (int j = 0; j < 8; ++j) { const float x1 = qf[d0][j], x2 = qf[d0 + 2][j]; qf[d0][j] = x1 * cs[j] - x2 * sn[j]; qf[d0 + 2][j] = x1 * sn[j] + x2 * cs[j]; } } } }
#pragma unroll
      for (int d0 = 0; d0 < 8; ++d0) { u32x4 w = {cvtpk(qf[d0][0], qf[d0][1]), cvtpk(qf[d0][2], qf[d0][3]), cvtpk(qf[d0][4], qf[d0][5]), cvtpk(qf[d0][6], qf[d0][7])}; qr[d0] = *reinterpret_cast<bf16x8*>(&w); }
    } }
  float m_reg = -1e30f, l_reg = 0.f; f32x16 o[4] = {};
  const int vb0 = (int)(uintptr_t)V_lds + v_rd_base(lane);
  f32x16 pA0, pA1, pB0, pB1; float mnA, mnB, alA, alB; bf16x8 pa0, pa1, pa2, pa3;
  STEP_SYNC();
  qkt(pA0, pA1, K_lds, qr, r32, hi); MASK(pA0, pA1, 0); partialSM(pA0, pA1, m_reg, mnA, alA);
  STEP_SYNC();
  int j = 0;
  for (; j + 2 < nt; j += 2) {
    DK_ISSUE(j + 2, 0); DV_ISSUE(j + 1, 1);
    SBAR(); qkt(pB0, pB1, K_lds + 16384, qr, r32, hi);
    finishSM(pA0, pA1, alA, l_reg, pa0, pa1, pa2, pa3); SBAR();
    MASK(pB0, pB1, j + 1); pv_sm(o, vb0, pa0, pa1, pa2, pa3, pB0, pB1, m_reg, mnB, alB);
    STEP_SYNC();
    RESC(alB);
    if (j + 3 < nt) DK_ISSUE(j + 3, 1);
    DV_ISSUE(j + 2, 0);
    SBAR(); qkt(pA0, pA1, K_lds, qr, r32, hi);
    finishSM(pB0, pB1, alB, l_reg, pa0, pa1, pa2, pa3); SBAR();
    MASK(pA0, pA1, j + 2); pv_sm(o, vb0 + 16384, pa0, pa1, pa2, pa3, pA0, pA1, m_reg, mnA, alA);
    STEP_SYNC();
    RESC(alA);
  }
  DV_ISSUE(j + 1, 1);
  SBAR(); qkt(pB0, pB1, K_lds + 16384, qr, r32, hi);
  finishSM(pA0, pA1, alA, l_reg, pa0, pa1, pa2, pa3); SBAR();
  MASK(pB0, pB1, j + 1); pv_sm(o, vb0, pa0, pa1, pa2, pa3, pB0, pB1, m_reg, mnB, alB);
  STEP_SYNC();
  RESC(alB);
  finishSM(pB0, pB1, alB, l_reg, pa0, pa1, pa2, pa3); SBAR();
  pv_d0(o, vb0 + 16384, pa0, pa1, pa2, pa3);
  STEP_SYNC();
#undef DK_ISSUE
#undef DV_ISSUE
#undef KROW
#undef RESC
#undef MASK
#undef STEP_SYNC
  l_reg += __builtin_amdgcn_exp2f(sinkl2 - m_reg * (SCALE * 1.4426950408889634f));
  if (hi == 0) li_l[r32] = l_reg; asm volatile("s_waitcnt lgkmcnt(0)" ::: "memory");
  float rli[16];
#pragma unroll
  for (int r = 0; r < 16; ++r) rli[r] = __builtin_amdgcn_rcpf(li_l[crow(r, hi)]);
  { ALAS char* og = lds + wid * 8192; bf16_t* Og = O + (long)(wid * QBLK) * ldo;
#pragma unroll
    for (int r = 0; r < 16; ++r) { const int row = crow(r, hi);
#pragma unroll
      for (int d = 0; d < 4; ++d) { const unsigned w = cvtpk(o[d][r] * rli[r], 0.f); *(ALAS unsigned short*)(og + row * 256 + (d * 32 + r32) * 2) = (unsigned short)(w & 0xffffu); } }
#pragma unroll
    for (int k = 0; k < 8; ++k) { const int p = lane + 64 * k; const u32x4 v = *(const ALAS u32x4*)(og + p * 16);
      *reinterpret_cast<u32x4*>(Og + (long)(p >> 4) * ldo + (p & 15) * 8) = v; }
  }
}

__device__ __forceinline__ void attn_unit_pp(const bf16_t* __restrict__ Q, const bf16_t* __restrict__ K, const bf16_t* __restrict__ V, bf16_t* __restrict__ O,
                                               int ldq, int ldk, int ldo, int nt, int nfirst, int skip, int qpos0, float sinkl2, ALAS char* lds, ALAS float* scr,
                                               int qmode, const float* __restrict__ gq, const float* __restrict__ ropeC, const float* __restrict__ ropeS) {
  int tid_l = tid_now(); asm volatile("" : "+v"(tid_l));
  const int tid = tid_l, wid = __builtin_amdgcn_readfirstlane(tid >> 6), lane = tid & 63, r32 = lane & 31, hi = lane >> 5;
  ALAS char* K_lds = lds; ALAS char* V_lds = lds + 32768;
  ALAS float* li_l = scr; ALAS float* al_l = scr + 32;
  const int qi = qpos0 + wid * QBLK + r32;
  unsigned koff[2], voff[2];
#pragma unroll
  for (int i = 0; i < 2; ++i) { const int L = (wid * 2 + i) * 1024 + lane * 16, row = L >> 8, cb = (L & 255) ^ ((row & 7) << 4); koff[i] = (unsigned)(row * ldk * 2 + cb); }
#pragma unroll
  for (int i = 0; i < 2; ++i) { const int L = (wid * 2 + i) * 1024 + lane * 16, sub = L >> 9, within = L & 511;
    const int kk = (sub >> 2) * 8 + (within >> 6), k = (kk & ~0xC) | ((kk & 4) << 1) | ((kk & 8) >> 1), col = (sub & 3) * 32 + ((within & 63) >> 1);
    voff[i] = (unsigned)(k * ldk * 2 + col * 2); }
#define KROW(t) ((t) * KVBLK + (((t) >= nfirst) ? skip : 0))
#define DK_ISSUE(t, slot) do { const char* kb_ = (const char*)K + (size_t)KROW(t) * 2 * ldk; \
    _Pragma("unroll") for (int i = 0; i < 2; ++i) dma16(kb_ + koff[i], K_lds + (slot) * 16384 + (wid * 2 + i) * 1024); } while (0)
#define DV_ISSUE(t, slot) do { const char* vb_ = (const char*)V + (size_t)KROW(t) * 2 * ldk; \
    _Pragma("unroll") for (int i = 0; i < 2; ++i) dma16(vb_ + voff[i], V_lds + (slot) * 16384 + (wid * 2 + i) * 1024); } while (0)
#define RESC(a) do { if (__any((a) < 1.f)) { if (hi == 0) al_l[r32] = (a); asm volatile("s_waitcnt lgkmcnt(0)" ::: "memory"); \
    _Pragma("unroll") for (int d = 0; d < 5; ++d) _Pragma("unroll") for (int r = 0; r < 16; ++r) o[d][r] *= al_l[crow(r, hi)]; } } while (0)
#define MASK(P0, P1, t) do { if ((t) >= nfirst) band_mask(P0, P1, KROW(t) - 512 - qi, hi); } while (0)
#define STEP_SYNC() do { asm volatile("s_waitcnt vmcnt(0) lgkmcnt(0)" ::: "memory"); __builtin_amdgcn_s_barrier(); } while (0)
  DK_ISSUE(0, 0);
  bf16x8 qr[8];
  { const bf16_t* Qw = Q + (long)(wid * QBLK + r32) * ldq + hi * 8;
#pragma unroll
    for (int d0 = 0; d0 < 8; ++d0) qr[d0] = *reinterpret_cast<const bf16x8*>(Qw + d0 * 16);
    {
      constexpr float CQ = SCALE * 1.4426950408889634f;
      float qf[8][8];
#pragma unroll
      for (int d0 = 0; d0 < 8; ++d0)
#pragma unroll
        for (int j = 0; j < 8; ++j) qf[d0][j] = __uint_as_float(((unsigned)(unsigned short)qr[d0][j]) << 16);
      if (qmode & 1) { float ss = 0.f;
#pragma unroll
        for (int d0 = 0; d0 < 8; ++d0)
#pragma unroll
          for (int j = 0; j < 8; ++j) ss += qf[d0][j] * qf[d0][j];
        ss += __shfl_xor(ss, 32);
        const float rstd = 1.0f / sqrtf(ss * (1.0f / 128.0f) + 1e-6f);
#pragma unroll
        for (int d0 = 0; d0 < 8; ++d0) { const float* gp = gq + d0 * 16 + hi * 8; const float4 g0 = *reinterpret_cast<const float4*>(gp), g1 = *reinterpret_cast<const float4*>(gp + 4);
          qf[d0][0] *= rstd * g0.x; qf[d0][1] *= rstd * g0.y; qf[d0][2] *= rstd * g0.z; qf[d0][3] *= rstd * g0.w; qf[d0][4] *= rstd * g1.x; qf[d0][5] *= rstd * g1.y; qf[d0][6] *= rstd * g1.z; qf[d0][7] *= rstd * g1.w; } }
      if (qmode & 2) { const int t = qi;
#pragma unroll
        for (int hf = 0; hf < 2; ++hf) { const int p = hf ? (t & 63) : (t >> 6);
#pragma unroll
          for (int dd = 0; dd < 2; ++dd) { const int d0 = hf * 4 + dd, i0 = dd * 16 + hi * 8;
            const float4 c0 = *reinterpret_cast<const float4*>(ropeC + p * 32 + i0), c1 = *reinterpret_cast<const float4*>(ropeC + p * 32 + i0 + 4);
            const float4 s0 = *reinterpret_cast<const float4*>(ropeS + p * 32 + i0), s1 = *reinterpret_cast<const float4*>(ropeS + p * 32 + i0 + 4);
            const float cs[8] = {c0.x, c0.y, c0.z, c0.w, c1.x, c1.y, c1.z, c1.w}, sn[8] = {s0.x, s0.y, s0.z, s0.w, s1.x, s1.y, s1.z, s1.w};
#pragma unroll
            for (int j = 0; j < 8; ++j) { const float x1 = qf[d0][j], x2 = qf[d0 + 2][j]; qf[d0][j] = x1 * cs[j] - x2 * sn[j]; qf[d0 + 2][j] = x1 * sn[j] + x2 * cs[j]; } } } }
#pragma unroll
      for (int d0 = 0; d0 < 8; ++d0) { u32x4 w = {cvtpk(qf[d0][0] * CQ, qf[d0][1] * CQ), cvtpk(qf[d0][2] * CQ, qf[d0][3] * CQ), cvtpk(qf[d0][4] * CQ, qf[d0][5] * CQ), cvtpk(qf[d0][6] * CQ, qf[d0][7] * CQ)}; qr[d0] = *reinterpret_cast<bf16x8*>(&w); }
    } }
  float m_reg = 0.f; f32x16 o[5] = {}; f32x16 negm = {};
  const ALAS char* vbp = V_lds + v_rd_base(lane);
  f32x16 p0 = {}, p1 = {}; float al = 1.f; bf16x8 pa0 = {}, pa1 = {}, pa2 = {}, pa3 = {};
  const int grp = wid >> 2;
#define SEG_END() do { SBAR(); __builtin_amdgcn_s_barrier(); SBAR(); } while (0)
#define PSEG(t) do { MASK(p0, p1, t); psm_n(p0, p1, m_reg, al, negm, (t) == 0); RESC(al); } while (0)
  STEP_SYNC();
#define SEG_END_V() do { SBAR(); asm volatile("s_waitcnt vmcnt(0)" ::: "memory"); __builtin_amdgcn_s_barrier(); SBAR(); } while (0)
  if (grp == 0) {
    for (int j = 0; j < nt; ++j) {
      const int sc = (j & 1) * 16384, sn = 16384 - sc;
      if (j + 1 < nt) DK_ISSUE(j + 1, (j + 1) & 1);
      DV_ISSUE(j, j & 1);
      if (j > 0) { pv_seg(o, vbp + sn, pa0, pa1, pa2, pa3); SBAR(); }
      qk_seg(p0, p1, K_lds + sc, qr, negm, r32, hi);
      SEG_END();
      PSEG(j);
      fsm_n(p0, p1, pa0, pa1, pa2, pa3);
      SEG_END_V();
    }
    pv_seg(o, vbp + ((nt - 1) & 1) * 16384, pa0, pa1, pa2, pa3);
    SEG_END();
  } else {
    DK_ISSUE(1, 1);
    DV_ISSUE(0, 0);
    SEG_END();
    for (int j = 0; j < nt; ++j) {
      const int sc = (j & 1) * 16384, sn = 16384 - sc;
      if (j > 0) { pv_seg(o, vbp + sn, pa0, pa1, pa2, pa3); SBAR(); }
      qk_seg(p0, p1, K_lds + sc, qr, negm, r32, hi);
      SEG_END_V();
      if (j + 2 < nt) DK_ISSUE(j + 2, j & 1);
      if (j + 1 < nt) DV_ISSUE(j + 1, (j + 1) & 1);
      PSEG(j);
      fsm_n(p0, p1, pa0, pa1, pa2, pa3);
      SEG_END();
    }
    pv_seg(o, vbp + ((nt - 1) & 1) * 16384, pa0, pa1, pa2, pa3);
  }
  STEP_SYNC();
#undef SEG_END_V
#undef PSEG
#undef SEG_END
#undef DK_ISSUE
#undef DV_ISSUE
#undef KROW
#undef RESC
#undef MASK
#undef STEP_SYNC
  if (hi == 0) li_l[r32] = m_reg; asm volatile("s_waitcnt lgkmcnt(0)" ::: "memory");
  float rli[16];
#pragma unroll
  for (int r = 0; r < 16; ++r) rli[r] = __builtin_amdgcn_rcpf(o[4][r] + __builtin_amdgcn_exp2f(sinkl2 - li_l[crow(r, hi)]));
  { ALAS char* og = lds + wid * 8192; bf16_t* Og = O + (long)(wid * QBLK) * ldo;
#pragma unroll
    for (int r = 0; r < 16; ++r) { const int row = crow(r, hi);
#pragma unroll
      for (int d = 0; d < 4; ++d) { const unsigned w = cvtpk(o[d][r] * rli[r], 0.f); *(ALAS unsigned short*)(og + row * 256 + (d * 32 + r32) * 2) = (unsigned short)(w & 0xffffu); } }
#pragma unroll
    for (int k = 0; k < 8; ++k) { const int p = lane + 64 * k; const u32x4 v = *(const ALAS u32x4*)(og + p * 16);
      *reinterpret_cast<u32x4*>(Og + (long)(p >> 4) * ldo + (p & 15) * 8) = v; }
  }
}

#define G_CVT4(P, BASE) do { t0 = cvtpk(P[BASE + 0], P[BASE + 1]); t1 = cvtpk(P[BASE + 2], P[BASE + 3]); t2 = cvtpk(P[BASE + 4], P[BASE + 5]); t3 = cvtpk(P[BASE + 6], P[BASE + 7]); } while (0)
#define G_SWP4(OUT) do { auto r0_ = __builtin_amdgcn_permlane32_swap(t0, t2, false, false); auto r1_ = __builtin_amdgcn_permlane32_swap(t1, t3, false, false); \
    u32x4 w_ = {r0_[0], r1_[0], r0_[1], r1_[1]}; OUT = *reinterpret_cast<bf16x8*>(&w_); } while (0)
__device__ __forceinline__ void blk_qk_fin(f32x16& n0, f32x16& n1, const ALAS char* Ks, const bf16x8* qr, const f32x16& negm, int r32, int hi,
                                           const f32x16& c0, f32x16& c1, bf16x8& pa0, bf16x8& pa1, bf16x8& pa2, float alpha_c, float& l_reg) {
  int sw = ((r32 & 7) << 4) ^ (hi * 16); asm volatile("" : "+v"(sw));
  const int r0 = (int)(uintptr_t)Ks + r32 * 256;
#define KRD(DST0, DST1, d0) do { const int ad_ = r0 + (((d0) * 32) ^ sw); asm volatile("ds_read_b128 %0, %2\n\tds_read_b128 %1, %2 offset:8192" : "=&v"(DST0), "=&v"(DST1) : "v"(ad_) : "memory"); } while (0)
  bf16x8 a[2], b[2]; unsigned t0 = 0, t1 = 0, t2 = 0, t3 = 0; float psA = 0.f, psB = 0.f;
  KRD(a[0], b[0], 0); KRD(a[1], b[1], 1);
  SBAR();
#pragma unroll
  for (int d0 = 0; d0 < 8; ++d0) {
    if (d0 < 7) PP_WAIT2(2, a[d0 & 1], b[d0 & 1]); else PP_WAIT2(0, a[d0 & 1], b[d0 & 1]);
    n0 = __builtin_amdgcn_mfma_f32_32x32x16_bf16(a[d0 & 1], qr[d0], d0 == 0 ? negm : n0, 0, 0, 0);
    n1 = __builtin_amdgcn_mfma_f32_32x32x16_bf16(b[d0 & 1], qr[d0], d0 == 0 ? negm : n1, 0, 0, 0);
    SBAR();
    if (d0 + 2 < 8) { KRD(a[d0 & 1], b[d0 & 1], d0 + 2); SBAR(); }
    c1[2 * d0] = __builtin_amdgcn_exp2f(c1[2 * d0]); c1[2 * d0 + 1] = __builtin_amdgcn_exp2f(c1[2 * d0 + 1]);
    psA += c0[2 * d0] + c0[2 * d0 + 1]; if (d0 > 0) psB += c1[2 * d0 - 2] + c1[2 * d0 - 1];
    if (d0 == 0) G_CVT4(c0, 0); if (d0 == 1) G_SWP4(pa0); if (d0 == 2) G_CVT4(c0, 8); if (d0 == 3) G_SWP4(pa1); if (d0 == 4) G_CVT4(c1, 0); if (d0 == 5) G_SWP4(pa2);
    SBAR();
  }
  { float ps = (psA + psB) + (c1[14] + c1[15]); auto rr = __builtin_amdgcn_permlane32_swap(__float_as_uint(ps), __float_as_uint(ps), false, false);
    l_reg = l_reg * alpha_c + (__uint_as_float(rr[0]) + __uint_as_float(rr[1])); }
#undef KRD
}
__device__ __forceinline__ void blk_pv_par(f32x16* o, const ALAS char* vbp, bf16x8 pa0, bf16x8 pa1, bf16x8 pa2, const f32x16& c1,
                                           f32x16& n0, f32x16& n1, float& m_reg, float& alpha, f32x16& negm, bool domask, int dj, int hi) {
  const int vb = (int)(uintptr_t)vbp;
#define PK(L, H) (bf16x8){L[0], L[1], L[2], L[3], H[0], H[1], H[2], H[3]}
  s16x4 lo[3], hh[3]; bf16x8 pa3 = {}; unsigned t0 = 0, t1 = 0, t2 = 0, t3 = 0; float mA = 0.f, mB = 0.f, pmax = 0.f;
  lo[0] = tr_read<v_rd_off(0, 0, 0)>(vb); hh[0] = tr_read<v_rd_off(0, 0, 1)>(vb); lo[1] = tr_read<v_rd_off(0, 1, 0)>(vb); hh[1] = tr_read<v_rd_off(0, 1, 1)>(vb);
  lo[2] = tr_read<v_rd_off(0, 2, 0)>(vb); hh[2] = tr_read<v_rd_off(0, 2, 1)>(vb);
  if (domask) band_mask(n0, n1, dj, hi);
  SBAR();
#define PVSTEP(d, ks, PA, WN, NEXT) do { constexpr int i_ = (d) * 4 + (ks), s_ = i_ % 3, n_ = i_ + 3; PP_WAIT2(WN, lo[s_], hh[s_]); o[d] = __builtin_amdgcn_mfma_f32_32x32x16_bf16(PA, PK(lo[s_], hh[s_]), o[d], 0, 0, 0); SBAR(); \
    if (NEXT) { lo[s_] = tr_read<v_rd_off((n_ >> 2) & 3, n_ & 3, 0)>(vb); hh[s_] = tr_read<v_rd_off((n_ >> 2) & 3, n_ & 3, 1)>(vb); SBAR(); } } while (0)
#define MX3(M, P, i) M = fmaxf(fmaxf(M, P[i]), P[(i) + 1])
  PVSTEP(0, 0, pa0, 4, 1); G_CVT4(c1, 8); SBAR();
  PVSTEP(0, 1, pa1, 4, 1); G_SWP4(pa3); SBAR();
  PVSTEP(0, 2, pa2, 4, 1); mA = fmaxf(fmaxf(n0[0], n0[1]), n0[2]); mB = fmaxf(fmaxf(n1[0], n1[1]), n1[2]); SBAR();
  PVSTEP(0, 3, pa3, 4, 1); MX3(mA, n0, 3); MX3(mB, n1, 3); SBAR();
  PVSTEP(1, 0, pa0, 4, 1); MX3(mA, n0, 5); MX3(mB, n1, 5); SBAR();
  PVSTEP(1, 1, pa1, 4, 1); MX3(mA, n0, 7); MX3(mB, n1, 7); SBAR();
  PVSTEP(1, 2, pa2, 4, 1); MX3(mA, n0, 9); MX3(mB, n1, 9); SBAR();
  PVSTEP(1, 3, pa3, 4, 1); MX3(mA, n0, 11); MX3(mB, n1, 11); SBAR();
  PVSTEP(2, 0, pa0, 4, 1); MX3(mA, n0, 13); MX3(mB, n1, 13); SBAR();
  PVSTEP(2, 1, pa1, 4, 1); pmax = fmaxf(fmaxf(mA, n0[15]), fmaxf(mB, n1[15]));
  { auto rr = __builtin_amdgcn_permlane32_swap(__float_as_uint(pmax), __float_as_uint(pmax), false, false); pmax = fmaxf(__uint_as_float(rr[0]), __uint_as_float(rr[1])); } SBAR();
  PVSTEP(2, 2, pa2, 4, 1);
  alpha = 1.f;
  if (__builtin_expect(!__all(pmax <= THRL2), 0)) { const float delta = fmaxf(pmax, 0.f); alpha = __builtin_amdgcn_exp2f(-delta); m_reg += delta;
#pragma unroll
    for (int r = 0; r < 16; ++r) { n0[r] -= delta; n1[r] -= delta; negm[r] = -m_reg; } }
  SBAR();
  PVSTEP(2, 3, pa3, 4, 1); n0[0] = __builtin_amdgcn_exp2f(n0[0]); n0[1] = __builtin_amdgcn_exp2f(n0[1]); SBAR();
  PVSTEP(3, 0, pa0, 4, 1); n0[2] = __builtin_amdgcn_exp2f(n0[2]); n0[3] = __builtin_amdgcn_exp2f(n0[3]); SBAR();
  PVSTEP(3, 1, pa1, 4, 0); n0[4] = __builtin_amdgcn_exp2f(n0[4]); n0[5] = __builtin_amdgcn_exp2f(n0[5]); SBAR();
  PVSTEP(3, 2, pa2, 2, 0); n0[6] = __builtin_amdgcn_exp2f(n0[6]); n0[7] = __builtin_amdgcn_exp2f(n0[7]); SBAR();
  PVSTEP(3, 3, pa3, 0, 0); n0[8] = __builtin_amdgcn_exp2f(n0[8]); n0[9] = __builtin_amdgcn_exp2f(n0[9]); SBAR();
  n0[10] = __builtin_amdgcn_exp2f(n0[10]); n0[11] = __builtin_amdgcn_exp2f(n0[11]); n0[12] = __builtin_amdgcn_exp2f(n0[12]); n0[13] = __builtin_amdgcn_exp2f(n0[13]);
  n0[14] = __builtin_amdgcn_exp2f(n0[14]); n0[15] = __builtin_amdgcn_exp2f(n0[15]); SBAR();
#undef MX3
#undef PVSTEP
#undef PK
}
__device__ __forceinline__ void attn_unit_g(const bf16_t* __restrict__ Q, const bf16_t* __restrict__ K, const bf16_t* __restrict__ V, bf16_t* __restrict__ O,
                                               int ldq, int ldk, int ldo, int nt, int nfirst, int skip, int qpos0, float sinkl2, ALAS char* lds, ALAS float* scr,
                                               int qmode  , float sinkB, const float* __restrict__ gq, const float* __restrict__ ropeC, const float* __restrict__ ropeS) {
  int tid_l = tid_now(); asm volatile("" : "+v"(tid_l));
  const int tid = tid_l, wid = __builtin_amdgcn_readfirstlane(tid >> 6), lane = tid & 63, r32 = lane & 31, hi = lane >> 5;
  ALAS char* K_lds = lds; ALAS char* V_lds = lds + 32768;
  ALAS float* li_l = scr; ALAS float* al_l = scr + 32;
  const int wrow = (qmode & 4) ? (wid & 3) : wid, hoff = (qmode & 4) ? (wid >> 2) * 128 : 0;
  const int qi = qpos0 + wrow * QBLK + r32;
  unsigned koff[2], voff[2];
#pragma unroll
  for (int i = 0; i < 2; ++i) { const int L = (wid * 2 + i) * 1024 + lane * 16, row = L >> 8, cb = (L & 255) ^ ((row & 7) << 4); koff[i] = (unsigned)(row * ldk * 2 + cb); }
#pragma unroll
  for (int i = 0; i < 2; ++i) { const int L = (wid * 2 + i) * 1024 + lane * 16, sub = L >> 9, within = L & 511;
    const int kk = (sub >> 2) * 8 + (within >> 6), k = (kk & ~0xC) | ((kk & 4) << 1) | ((kk & 8) >> 1), col = (sub & 3) * 32 + ((within & 63) >> 1);
    voff[i] = (unsigned)(k * ldk * 2 + col * 2); }
#define KROW(t) ((t) * KVBLK + (((t) >= nfirst) ? skip : 0))
  ALAS char* const offs = lds + 65536 + wid * 1024 + lane * 16;
  { u32x4 ov = {koff[0], koff[1], voff[0], voff[1]}; *(ALAS u32x4*)offs = ov; asm volatile("s_waitcnt lgkmcnt(0)" ::: "memory"); }
#define DK_ISSUE(t, slot) do { const char* kb_ = (const char*)K + (size_t)KROW(t) * 2 * ldk; const u32x4 ov_ = *(const ALAS u32x4*)offs; \
    dma16(kb_ + ov_[0], K_lds + (slot) * 16384 + (wid * 2 + 0) * 1024); dma16(kb_ + ov_[1], K_lds + (slot) * 16384 + (wid * 2 + 1) * 1024); } while (0)
#define DV_ISSUE(t, slot) do { const char* vb_ = (const char*)V + (size_t)KROW(t) * 2 * ldk; const u32x4 ov_ = *(const ALAS u32x4*)offs; \
    dma16(vb_ + ov_[2], V_lds + (slot) * 16384 + (wid * 2 + 0) * 1024); dma16(vb_ + ov_[3], V_lds + (slot) * 16384 + (wid * 2 + 1) * 1024); } while (0)
#define RESC(a) do { if (__any((a) < 1.f)) { if (hi == 0) al_l[r32] = (a); asm volatile("s_waitcnt lgkmcnt(0)" ::: "memory"); \
    _Pragma("unroll") for (int d = 0; d < 4; ++d) _Pragma("unroll") for (int r = 0; r < 16; ++r) o[d][r] *= al_l[crow(r, hi)]; } } while (0)
#define MASK(P0, P1, t) do { if ((t) >= nfirst) band_mask(P0, P1, KROW(t) - 512 - qi, hi); } while (0)
#define STEP_SYNC() do { asm volatile("s_waitcnt vmcnt(0) lgkmcnt(0)" ::: "memory"); __builtin_amdgcn_s_barrier(); } while (0)
  DK_ISSUE(0, 0); DV_ISSUE(0, 0); DK_ISSUE(1, 1);
  bf16x8 qr[8];
  { const bf16_t* Qw = Q + hoff + (long)(wrow * QBLK + r32) * ldq + hi * 8;
#pragma unroll
    for (int d0 = 0; d0 < 8; ++d0) qr[d0] = *reinterpret_cast<const bf16x8*>(Qw + d0 * 16);
    {
      constexpr float CQ = SCALE * 1.4426950408889634f;
      float qf[8][8];
#pragma unroll
      for (int d0 = 0; d0 < 8; ++d0)
#pragma unroll
        for (int j = 0; j < 8; ++j) qf[d0][j] = __uint_as_float(((unsigned)(unsigned short)qr[d0][j]) << 16);
      if (qmode & 1) { float ss = 0.f;
#pragma unroll
        for (int d0 = 0; d0 < 8; ++d0)
#pragma unroll
          for (int j = 0; j < 8; ++j) ss += qf[d0][j] * qf[d0][j];
        ss += __shfl_xor(ss, 32);
        const float rstd = 1.0f / sqrtf(ss * (1.0f / 128.0f) + 1e-6f);
#pragma unroll
        for (int d0 = 0; d0 < 8; ++d0) { const float* gp = gq + d0 * 16 + hi * 8; const float4 g0 = *reinterpret_cast<const float4*>(gp), g1 = *reinterpret_cast<const float4*>(gp + 4);
          qf[d0][0] *= rstd * g0.x; qf[d0][1] *= rstd * g0.y; qf[d0][2] *= rstd * g0.z; qf[d0][3] *= rstd * g0.w; qf[d0][4] *= rstd * g1.x; qf[d0][5] *= rstd * g1.y; qf[d0][6] *= rstd * g1.z; qf[d0][7] *= rstd * g1.w; } }
      if (qmode & 2) { const int t = qi;
#pragma unroll
        for (int hf = 0; hf < 2; ++hf) { const int p = hf ? (t & 63) : (t >> 6);
#pragma unroll
          for (int dd = 0; dd < 2; ++dd) { const int d0 = hf * 4 + dd, i0 = dd * 16 + hi * 8;
            const float4 c0 = *reinterpret_cast<const float4*>(ropeC + p * 32 + i0), c1 = *reinterpret_cast<const float4*>(ropeC + p * 32 + i0 + 4);
            const float4 s0 = *reinterpret_cast<const float4*>(ropeS + p * 32 + i0), s1 = *reinterpret_cast<const float4*>(ropeS + p * 32 + i0 + 4);
            const float cs[8] = {c0.x, c0.y, c0.z, c0.w, c1.x, c1.y, c1.z, c1.w}, sn[8] = {s0.x, s0.y, s0.z, s0.w, s1.x, s1.y, s1.z, s1.w};
#pragma unroll
            for (int j = 0; j < 8; ++j) { const float x1 = qf[d0][j], x2 = qf[d0 + 2][j]; qf[d0][j] = x1 * cs[j] - x2 * sn[j]; qf[d0 + 2][j] = x1 * sn[j] + x2 * cs[j]; } } } }
#pragma unroll
      for (int d0 = 0; d0 < 8; ++d0) { u32x4 w = {cvtpk(qf[d0][0] * CQ, qf[d0][1] * CQ), cvtpk(qf[d0][2] * CQ, qf[d0][3] * CQ), cvtpk(qf[d0][4] * CQ, qf[d0][5] * CQ), cvtpk(qf[d0][6] * CQ, qf[d0][7] * CQ)}; qr[d0] = *reinterpret_cast<bf16x8*>(&w); }
    } }
  float m_reg = 0.f, l_reg = 0.f; f32x16 o[4] = {}; f32x16 negm = {};
  const ALAS char* vbp = V_lds + v_rd_base(lane);
  f32x16 pA0, pA1, pB0, pB1; float alA = 1.f, alB = 1.f; bf16x8 pa0, pa1, pa2, pa3;
  STEP_SYNC();
  qk_seg(pA0, pA1, K_lds, qr, negm, r32, hi); MASK(pA0, pA1, 0); psm_n(pA0, pA1, m_reg, alA, negm, true);
  STEP_SYNC();
  int j = 0;
  for (; j + 2 < nt; j += 2) {
    DK_ISSUE(j + 2, 0); DV_ISSUE(j + 1, 1);
    SBAR(); blk_qk_fin(pB0, pB1, K_lds + 16384, qr, negm, r32, hi, pA0, pA1, pa0, pa1, pa2, alA, l_reg);
    blk_pv_par(o, vbp, pa0, pa1, pa2, pA1, pB0, pB1, m_reg, alB, negm, (j + 1) >= nfirst, KROW(j + 1) - 512 - qi, hi);
    STEP_SYNC();
    RESC(alB);
    if (j + 3 < nt) DK_ISSUE(j + 3, 1);
    DV_ISSUE(j + 2, 0);
    SBAR(); blk_qk_fin(pA0, pA1, K_lds, qr, negm, r32, hi, pB0, pB1, pa0, pa1, pa2, alB, l_reg);
    blk_pv_par(o, vbp + 16384, pa0, pa1, pa2, pB1, pA0, pA1, m_reg, alA, negm, (j + 2) >= nfirst, KROW(j + 2) - 512 - qi, hi);
    STEP_SYNC();
    RESC(alA);
  }
  DV_ISSUE(j + 1, 1);
  SBAR(); blk_qk_fin(pB0, pB1, K_lds + 16384, qr, negm, r32, hi, pA0, pA1, pa0, pa1, pa2, alA, l_reg);
  blk_pv_par(o, vbp, pa0, pa1, pa2, pA1, pB0, pB1, m_reg, alB, negm, (j + 1) >= nfirst, KROW(j + 1) - 512 - qi, hi);
  STEP_SYNC();
  RESC(alB);
  finishSM(pB0, pB1, alB, l_reg, pa0, pa1, pa2, pa3); SBAR();
  pv_d0(o, (int)(uintptr_t)(vbp + 16384), pa0, pa1, pa2, pa3);
  STEP_SYNC();
#undef DK_ISSUE
#undef DV_ISSUE
#undef KROW
#undef RESC
#undef MASK
#undef STEP_SYNC
  l_reg += __builtin_amdgcn_exp2f(((qmode & 4) && wid >= 4 ? sinkB : sinkl2) - m_reg);
  if (hi == 0) li_l[r32] = l_reg; asm volatile("s_waitcnt lgkmcnt(0)" ::: "memory");
  float rli[16];
#pragma unroll
  for (int r = 0; r < 16; ++r) rli[r] = __builtin_amdgcn_rcpf(li_l[crow(r, hi)]);
  { ALAS char* og = lds + wid * 8192; bf16_t* Og = O + hoff + (long)(wrow * QBLK) * ldo;
#pragma unroll
    for (int r = 0; r < 16; ++r) { const int row = crow(r, hi);
#pragma unroll
      for (int d = 0; d < 4; ++d) { const unsigned w = cvtpk(o[d][r] * rli[r], 0.f); *(ALAS unsigned short*)(og + row * 256 + (d * 32 + r32) * 2) = (unsigned short)(w & 0xffffu); } }
#pragma unroll
    for (int k = 0; k < 8; ++k) { const int p = lane + 64 * k; const u32x4 v = *(const ALAS u32x4*)(og + p * 16);
      *reinterpret_cast<u32x4*>(Og + (long)(p >> 4) * ldo + (p & 15) * 8) = v; }
  }
}

__device__ __forceinline__ void pv8_sm(f32x16* o, int vb, bf16x8 pa0, bf16x8 pa1, bf16x8 pa2, bf16x8 pa3, f32x16& p0, f32x16& p1, float& m_reg, float& mn, float& alpha) {
  constexpr float C = SCALE * 1.4426950408889634f;
  pv_one<0>(o[0], vb, pa0, pa1, pa2, pa3); pv_one<1>(o[1], vb, pa0, pa1, pa2, pa3);
  float pmax = p0[0];
#pragma unroll
  for (int r = 1; r < 16; ++r) pmax = fmaxf(pmax, p0[r]);
#pragma unroll
  for (int r = 0; r < 16; ++r) pmax = fmaxf(pmax, p1[r]);
  { auto rr = __builtin_amdgcn_permlane32_swap(__float_as_uint(pmax), __float_as_uint(pmax), false, false);
    pmax = fmaxf(__uint_as_float(rr[0]), __uint_as_float(rr[1])); }
  pv_one<2>(o[2], vb, pa0, pa1, pa2, pa3); pv_one<3>(o[3], vb, pa0, pa1, pa2, pa3);
  if (__builtin_expect(__all(pmax - m_reg <= THR / SCALE), 1)) { mn = m_reg; alpha = 1.f; }
  else { mn = fmaxf(m_reg, pmax); alpha = __builtin_amdgcn_exp2f((m_reg - mn) * C); m_reg = mn; }
  const float mnC = -mn * C;
#pragma unroll
  for (int r = 0; r < 16; ++r) p0[r] = fmaf(p0[r], C, mnC);
  pv_one<0>(o[4], vb + 16384, pa0, pa1, pa2, pa3); pv_one<1>(o[5], vb + 16384, pa0, pa1, pa2, pa3);
#pragma unroll
  for (int r = 0; r < 16; ++r) p1[r] = fmaf(p1[r], C, mnC);
#pragma unroll
  for (int r = 0; r < 8; ++r) p0[r] = __builtin_amdgcn_exp2f(p0[r]);
  pv_one<2>(o[6], vb + 16384, pa0, pa1, pa2, pa3); pv_one<3>(o[7], vb + 16384, pa0, pa1, pa2, pa3);
#pragma unroll
  for (int r = 8; r < 16; ++r) p0[r] = __builtin_amdgcn_exp2f(p0[r]);
}
__device__ __forceinline__ void qkt_ldsq(f32x16& p0, f32x16& p1, const ALAS char* Ks, const ALAS char* Qs, int lane, int r32, int hi) {
  p0 = f32x16{}; p1 = f32x16{};
#pragma unroll
  for (int d0 = 0; d0 < 8; ++d0) { const int cb = (d0 * 16 + hi * 8) * 2;
    const bf16x8 qd = *(const ALAS bf16x8*)(Qs + (d0 * 64 + lane) * 16);
    const bf16x8 b0 = *reinterpret_cast<const ALAS bf16x8*>(Ks + KSWZ(r32, cb));
    const bf16x8 b1 = *reinterpret_cast<const ALAS bf16x8*>(Ks + KSWZ(32 + r32, cb));
    p0 = __builtin_amdgcn_mfma_f32_32x32x16_bf16(b0, qd, p0, 0, 0, 0);
    p1 = __builtin_amdgcn_mfma_f32_32x32x16_bf16(b1, qd, p1, 0, 0, 0); }
}
__device__ __forceinline__ void attn_unit_diff2(const bf16_t* __restrict__ Q, const bf16_t* __restrict__ K, const bf16_t* __restrict__ V, bf16_t* __restrict__ O,
                                                int ldq, int ldk, int ldo, int nt, int qpos0, ALAS char* lds, ALAS float* scr,
                                                int qmode, const float* __restrict__ ropeC, const float* __restrict__ ropeS) {
  int tid_l = tid_now(); asm volatile("" : "+v"(tid_l));
  const int tid = tid_l, wid = __builtin_amdgcn_readfirstlane(tid >> 6), lane = tid & 63, r32 = lane & 31, hi = lane >> 5;
  ALAS char* K_lds = lds; ALAS char* V_lds = lds + 32768; ALAS char* Qs = lds + 65536 + wid * 8192;
  ALAS float* li_l = scr; ALAS float* al_l = scr + 32;
#define DK_ISSUE(t, slot) do { const char* kb_ = (const char*)K + (size_t)(t) * (KVBLK * 2) * ldk; int ln_ = lane; asm volatile("" : "+v"(ln_)); \
    _Pragma("unroll") for (int i = 0; i < 2; ++i) { const int L = (wid * 2 + i) * 1024 + ln_ * 16, row = L >> 8, cb = (L & 255) ^ ((row & 7) << 4); \
        dma16(kb_ + (unsigned)(row * ldk * 2 + cb), K_lds + (slot) * 16384 + (wid * 2 + i) * 1024); } } while (0)
#define DV_ISSUE(t) do { const char* vb_ = (const char*)V + (size_t)(t) * (KVBLK * 2) * ldk; int ln_ = lane; asm volatile("" : "+v"(ln_)); \
    _Pragma("unroll") for (int i = 0; i < 4; ++i) { const int L = (wid * 4 + i) * 1024 + ln_ * 16, half = L >> 14, Lh = L & 16383, sub = Lh >> 9, within = Lh & 511; \
        const int kk = (sub >> 2) * 8 + (within >> 6), k = (kk & ~0xC) | ((kk & 4) << 1) | ((kk & 8) >> 1), col = half * 128 + (sub & 3) * 32 + ((within & 63) >> 1); \
        dma16(vb_ + (unsigned)(k * ldk * 2 + col * 2), V_lds + (wid * 4 + i) * 1024); } } while (0)
#define RESC8(a) do { if (__any((a) < 1.f)) { if (hi == 0) al_l[r32] = (a); asm volatile("s_waitcnt lgkmcnt(0)" ::: "memory"); \
    _Pragma("unroll") for (int d = 0; d < 8; ++d) _Pragma("unroll") for (int r = 0; r < 16; ++r) o[d][r] *= al_l[crow(r, hi)]; } } while (0)
#define STEP_SYNC() do { asm volatile("s_waitcnt vmcnt(0) lgkmcnt(0)" ::: "memory"); __builtin_amdgcn_s_barrier(); } while (0)
  DK_ISSUE(0, 0); DK_ISSUE(1, 1);
  { bf16x8 qr[8];
    const bf16_t* Qw = Q + (long)(wid * QBLK + r32) * ldq + hi * 8;
#pragma unroll
    for (int d0 = 0; d0 < 8; ++d0) qr[d0] = *reinterpret_cast<const bf16x8*>(Qw + d0 * 16);
    if (qmode & 2) {
      float qf[8][8];
#pragma unroll
      for (int d0 = 0; d0 < 8; ++d0)
#pragma unroll
        for (int j = 0; j < 8; ++j) qf[d0][j] = __uint_as_float(((unsigned)(unsigned short)qr[d0][j]) << 16);
      const int t = qpos0 + wid * QBLK + r32;
#pragma unroll
      for (int hf = 0; hf < 2; ++hf) { const int p = hf ? (t & 63) : (t >> 6);
#pragma unroll
        for (int dd = 0; dd < 2; ++dd) { const int d0 = hf * 4 + dd, i0 = dd * 16 + hi * 8;
          const float4 c0 = *reinterpret_cast<const float4*>(ropeC + p * 32 + i0), c1 = *reinterpret_cast<const float4*>(ropeC + p * 32 + i0 + 4);
          const float4 s0 = *reinterpret_cast<const float4*>(ropeS + p * 32 + i0), s1 = *reinterpret_cast<const float4*>(ropeS + p * 32 + i0 + 4);
          const float cs[8] = {c0.x, c0.y, c0.z, c0.w, c1.x, c1.y, c1.z, c1.w}, sn[8] = {s0.x, s0.y, s0.z, s0.w, s1.x, s1.y, s1.z, s1.w};
#pragma unroll
          for (int j = 0; j < 8; ++j) { const float x1 = qf[d0][j], x2 = qf[d0 + 2][j]; qf[d0][j] = x1 * cs[j] - x2 * sn[j]; qf[d0 + 2][j] = x1 * sn[j] + x2 * cs[j]; } } }
#pragma unroll
      for (int d0 = 0; d0 < 8; ++d0) { u32x4 w = {cvtpk(qf[d0][0], qf[d0][1]), cvtpk(qf[d0][2], qf[d0][3]), cvtpk(qf[d0][4], qf[d0][5]), cvtpk(qf[d0][6], qf[d0][7])}; qr[d0] = *reinterpret_cast<bf16x8*>(&w); }
    }
#pragma unroll
    for (int d0 = 0; d0 < 8; ++d0) *(ALAS bf16x8*)(Qs + (d0 * 64 + lane) * 16) = qr[d0];
  }
  float m_reg = -1e30f, l_reg = 0.f; f32x16 o[8] = {};
  const int vb0 = (int)(uintptr_t)V_lds + v_rd_base(lane);
  f32x16 pA0, pA1, pB0, pB1; float mnA, mnB, alA, alB; bf16x8 pa0, pa1, pa2, pa3;
  STEP_SYNC();
  qkt_ldsq(pA0, pA1, K_lds, Qs, lane, r32, hi); partialSM(pA0, pA1, m_reg, mnA, alA);
  STEP_SYNC();
  int j = 0;
  for (; j + 2 < nt; j += 2) {
    DV_ISSUE(j); DK_ISSUE(j + 2, 0);
    SBAR(); qkt_ldsq(pB0, pB1, K_lds + 16384, Qs, lane, r32, hi);
    finishSM(pA0, pA1, alA, l_reg, pa0, pa1, pa2, pa3); SBAR();
    STEP_SYNC();
    pv8_sm(o, vb0, pa0, pa1, pa2, pa3, pB0, pB1, m_reg, mnB, alB);
    STEP_SYNC();
    RESC8(alB);
    DV_ISSUE(j + 1); if (j + 3 < nt) DK_ISSUE(j + 3, 1);
    SBAR(); qkt_ldsq(pA0, pA1, K_lds, Qs, lane, r32, hi);
    finishSM(pB0, pB1, alB, l_reg, pa0, pa1, pa2, pa3); SBAR();
    STEP_SYNC();
    pv8_sm(o, vb0, pa0, pa1, pa2, pa3, pA0, pA1, m_reg, mnA, alA);
    STEP_SYNC();
    RESC8(alA);
  }
  DV_ISSUE(j);
  SBAR(); qkt_ldsq(pB0, pB1, K_lds + 16384, Qs, lane, r32, hi);
  finishSM(pA0, pA1, alA, l_reg, pa0, pa1, pa2, pa3); SBAR();
  STEP_SYNC();
  pv8_sm(o, vb0, pa0, pa1, pa2, pa3, pB0, pB1, m_reg, mnB, alB);
  STEP_SYNC();
  RESC8(alB);
  DV_ISSUE(j + 1);
  finishSM(pB0, pB1, alB, l_reg, pa0, pa1, pa2, pa3); SBAR();
  STEP_SYNC();
  pv_one<0>(o[0], vb0, pa0, pa1, pa2, pa3); pv_one<1>(o[1], vb0, pa0, pa1, pa2, pa3); pv_one<2>(o[2], vb0, pa0, pa1, pa2, pa3); pv_one<3>(o[3], vb0, pa0, pa1, pa2, pa3);
  pv_one<0>(o[4], vb0 + 16384, pa0, pa1, pa2, pa3); pv_one<1>(o[5], vb0 + 16384, pa0, pa1, pa2, pa3); pv_one<2>(o[6], vb0 + 16384, pa0, pa1, pa2, pa3); pv_one<3>(o[7], vb0 + 16384, pa0, pa1, pa2, pa3);
#undef DK_ISSUE
#undef DV_ISSUE
#undef RESC8
#undef STEP_SYNC
  if (hi == 0) li_l[r32] = l_reg; asm volatile("s_waitcnt lgkmcnt(0)" ::: "memory");
  float rli[16];
#pragma unroll
  for (int r = 0; r < 16; ++r) rli[r] = __builtin_amdgcn_rcpf(li_l[crow(r, hi)]);
  { ALAS char* og = Qs; bf16_t* Og = O + (long)(wid * QBLK) * ldo;
#pragma unroll
    for (int hf = 0; hf < 2; ++hf) {
#pragma unroll
      for (int rr = 0; rr < 8; ++rr) { const int r = hf * 8 + rr, lrow = crow(r, hi) - 16 * hf;
#pragma unroll
        for (int d = 0; d < 8; ++d) { const unsigned w = cvtpk(o[d][r] * rli[r], 0.f); *(ALAS unsigned short*)(og + lrow * 512 + (d * 32 + r32) * 2) = (unsigned short)(w & 0xffffu); } }
#pragma unroll
      for (int k = 0; k < 8; ++k) { const int p = lane + 64 * k; const u32x4 v = *(const ALAS u32x4*)(og + p * 16);
        *reinterpret_cast<u32x4*>(Og + (long)(16 * hf + (p >> 5)) * ldo + (p & 31) * 8) = v; }
    } }
}
}
#define GAS __attribute__((address_space(1)))
#define LAS __attribute__((address_space(3)))
typedef unsigned short bf16;
typedef unsigned v4u __attribute__((ext_vector_type(4)));
typedef float f32x4 __attribute__((ext_vector_type(4)));
typedef short bf16x8 __attribute__((ext_vector_type(8)));
typedef GAS unsigned gu32;
typedef GAS unsigned long long gu64;
#define RLX_AGENT __ATOMIC_RELAXED, __HIP_MEMORY_SCOPE_AGENT
#define LDS_WAIT() asm volatile("s_waitcnt lgkmcnt(0)" ::: "memory")
#define VM_WAIT() asm volatile("s_waitcnt vmcnt(0)" ::: "memory")
__device__ __forceinline__ unsigned long long rt() { return __builtin_amdgcn_s_memrealtime(); }
__device__ __forceinline__ unsigned f2bf(float f) { unsigned u = __builtin_bit_cast(unsigned, f); return (u + 0x7fffu + ((u >> 16) & 1u)) >> 16; }
__device__ __forceinline__ unsigned pk2(float lo, float hi) { return f2bf(lo) | (f2bf(hi) << 16); }

#define XB_TMO      128
#define XB_XCNT(j)  (256  + 64 * (j))
#define XB_XSUB(j)  (1280 + 64 * (j))
#define XB_XGEN(j)  (2304 + 64 * (j))
#define XB_TOP      3328
#define XB_TOPGEN   3392
#define XCD_BAR_WORDS 3456
#define XB_SPIN_CAP (1u << 18)

__device__ __forceinline__ unsigned xb_ld(unsigned* p)              { return __hip_atomic_load(p, __ATOMIC_RELAXED, __HIP_MEMORY_SCOPE_AGENT); }
__device__ __forceinline__ unsigned xb_add(unsigned* p, unsigned v) { return __hip_atomic_fetch_add(p, v, __ATOMIC_RELAXED, __HIP_MEMORY_SCOPE_AGENT); }
__device__ __forceinline__ unsigned xb_xcc_id() { return (unsigned)__builtin_amdgcn_s_getreg((3 << 11) | 20) & 0xFu; }
#define XB_SPIN(cond, bar) do { unsigned _sp = 0; while (cond) { __builtin_amdgcn_s_sleep(1); \
    if ((++_sp & 255u) == 0u) { if (xb_ld(&(bar)[XB_TMO])) break; if (_sp > XB_SPIN_CAP) { atomicAdd(&(bar)[XB_TMO], 1u); break; } } } } while (0)

struct XcdBarrier {
    unsigned* bar; unsigned x;
    volatile LAS unsigned* st;
};

__device__ __forceinline__ XcdBarrier xcd_barrier_post(unsigned* bar, volatile LAS unsigned* st) {
    XcdBarrier b; b.bar = bar; b.x = xb_xcc_id(); b.st = st;
    if (tid_now() == 0) (void)xb_add(&bar[XB_XCNT(b.x)], 1u);
    return b;
}
__device__ __forceinline__ void xcd_barrier_complete(unsigned* bar, unsigned x, unsigned& nloc, unsigned& nx) {
    const unsigned G = gridDim.x * gridDim.y * gridDim.z;
    asm volatile("" : "+s"(x));
    unsigned sum, cnt, mine, sp = 0u;
    for (;;) {
        sum = 0u; cnt = 0u; mine = 0u;
#pragma unroll
        for (unsigned j = 0; j < 16; ++j) { const unsigned c = xb_ld(&bar[XB_XCNT(j)]); sum += c; cnt += (c > 0u) ? 1u : 0u; mine = (j == x) ? c : mine; }
        if (sum == G) break;
        __builtin_amdgcn_s_sleep(1);
        if ((++sp & 255u) == 0u) { if (xb_ld(&bar[XB_TMO])) break; if (sp > XB_SPIN_CAP) { atomicAdd(&bar[XB_TMO], 1u); break; } }
    }
    nloc = mine > 0u ? mine : 1u; nx = cnt > 0u ? cnt : 1u;
}

__device__ __forceinline__ void xcd_barrier(const XcdBarrier& b) {
    asm volatile("s_waitcnt vmcnt(0)" ::: "memory");
    __syncthreads();
    if (tid_now() == 0) {
        unsigned* bar = b.bar; unsigned bx_ = b.x;
        asm volatile("" : "+s"(bar), "+s"(bx_));
        __builtin_amdgcn_s_waitcnt(0);
        unsigned nloc = b.st[0], nx = b.st[1];
        if (nloc == 0u) { xcd_barrier_complete(bar, bx_, nloc, nx); b.st[0] = nloc; b.st[1] = nx; }
        const unsigned old = xb_add(&bar[XB_XSUB(bx_)], 1u);
        const unsigned gen = old / nloc;
        if (old + 1u == (gen + 1u) * nloc) {
            __builtin_amdgcn_fence(__ATOMIC_RELEASE, "agent");
            asm volatile("s_waitcnt vmcnt(0)" ::: "memory");
            const unsigned og = xb_add(&bar[XB_TOP], 1u);
            const unsigned tg = og / nx;
            if (og + 1u == (tg + 1u) * nx) xb_add(&bar[XB_TOPGEN], 1u);
            else XB_SPIN(xb_ld(&bar[XB_TOPGEN]) == tg, bar);
            __builtin_amdgcn_fence(__ATOMIC_ACQUIRE, "agent");
            xb_add(&bar[XB_XGEN(bx_)], 1u);
            asm volatile("s_waitcnt vmcnt(0)" ::: "memory");
        } else {
            XB_SPIN(xb_ld(&bar[XB_XGEN(bx_)]) == gen, bar);
            __builtin_amdgcn_fence(__ATOMIC_ACQUIRE, "agent");
            asm volatile("s_waitcnt vmcnt(0)" ::: "memory");
        }
    }
    __syncthreads();
}

#ifndef ATT_DMA_ALL
#define ATT_DMA_ALL 6
#endif
#ifndef ATT_DIFF_PIPE
#define ATT_DIFF_PIPE 1
#endif
constexpr int NWAVES = 8;
constexpr int DM = 2048, TP = 8192, TS = 16384, TT = TP + TS;
constexpr int SP = 256, SS = 2048, PAST = 512, SKV = PAST + SS;
constexpr int NQKV = 3072, KVW = 512, FF = 5632, NGU = 2 * FF;
constexpr float EPS = 1e-6f;
constexpr float LAM_INIT2 = 0.47071301834358414f;
enum { I_XP = 0, I_XS, I_C, I_CKF, I_CVF, I_CKW, I_CVW, I_CKD, I_CVD, I_CCTX, I_WADA, I_BADA, I_GNORM, I_WQKVF, I_WOF, I_GQF, I_GKF, I_WQKVW, I_WOW, I_SINKW,
       I_WQKVD, I_WOD, I_LQ1, I_LK1, I_LQ2, I_LK2, I_GSUB, I_WG, I_WU, I_WD, N_IN };
constexpr size_t O_YP = 0, O_YS = (size_t)TP * DM, O_KF = (size_t)TT * DM, O_VF = O_KF + (size_t)32 * 2 * SP * KVW, O_KW = O_VF + (size_t)32 * 2 * SP * KVW,
                 O_VW = O_KW + (size_t)32 * SP * KVW, O_KD = O_VW + (size_t)32 * SP * KVW, O_VD = O_KD + (size_t)32 * SP * KVW, O_END = O_VD + (size_t)32 * SP * KVW;
static_assert(O_END == 83886080, "output size");
constexpr size_t MiB = 1u << 20;
constexpr size_t WS_CTL = 0, CTL_ZERO_BYTES = 1 * MiB;
constexpr size_t WS_ROPE = 1 * MiB;
constexpr size_t WS_VEC = 2 * MiB;
constexpr size_t WS_PART = 4 * MiB;
constexpr size_t WS_W = 20 * MiB, W_LAYER = 86 * MiB, W_QKV = 0, W_O = 12 * MiB, W_GU = 20 * MiB, W_D = 64 * MiB;
constexpr size_t WS_KC = 364 * MiB, WS_VC = 384 * MiB, WS_KP = 404 * MiB, WS_VP = 412 * MiB;
constexpr size_t WS_H = 420 * MiB, WS_MF = 516 * MiB;
constexpr size_t WS_ACT = 612 * MiB;
constexpr size_t WS_RAW = WS_ACT, WS_ATT = WS_ACT + 144 * MiB, WS_X16 = 876 * MiB, WS_END = 972 * MiB;
static_assert(WS_W + 4 * W_LAYER == WS_KC && WS_ATT + (size_t)TT * DM * 2 <= WS_X16 && WS_ACT + (size_t)TT * FF * 2 <= WS_X16 && WS_X16 + (size_t)TT * DM * 2 <= WS_END && WS_MF + (size_t)TT * DM * 2 == WS_ACT, "ws map");
constexpr int CW_BAR = 4096;
constexpr int RING_BYTES = 131072, LDSCTL_OFF = RING_BYTES, MISC_OFF = LDSCTL_OFF + 320, LDS_BYTES = 147456;

typedef unsigned v2u __attribute__((ext_vector_type(2)));

__device__ __forceinline__ float wave_sum(float v) {
#pragma unroll
    for (int o = 1; o < 64; o <<= 1) v += __shfl_xor(v, o);
    return v;
}
__device__ __forceinline__ float bf2f(unsigned h) { return __uint_as_float(h << 16); }
__device__ __forceinline__ unsigned pkbf(float lo, float hi) { unsigned r; asm volatile("v_cvt_pk_bf16_f32 %0, %1, %2" : "=v"(r) : "v"(lo), "v"(hi)); return r; }

__device__ __forceinline__ void transpose_item(const float* __restrict__ W, int K, int N, bf16* __restrict__ WT, int k0, int n0, int drow0, LAS float* scr, int lane) {
    { const int kr = lane >> 3, c4 = (lane & 7) * 4;
      f32x4 v[8];
#pragma unroll
      for (int i = 0; i < 8; ++i) v[i] = *(const f32x4*)(W + (size_t)(k0 + 8 * i + kr) * N + n0 + c4);
#pragma unroll
      for (int i = 0; i < 8; ++i) { LAS float* d = scr + (8 * i + kr) * 33 + c4; d[0] = v[i].x; d[1] = v[i].y; d[2] = v[i].z; d[3] = v[i].w; } }
    LDS_WAIT(); asm volatile("" ::: "memory");
    const int c = lane & 7;
#pragma unroll
    for (int j = 0; j < 4; ++j) { const int n = (lane >> 3) + 8 * j; const LAS float* s = scr + (8 * c) * 33 + n;
        v4u o; o.x = pkbf(s[0 * 33], s[1 * 33]); o.y = pkbf(s[2 * 33], s[3 * 33]); o.z = pkbf(s[4 * 33], s[5 * 33]); o.w = pkbf(s[6 * 33], s[7 * 33]);
        *(v4u*)(WT + (size_t)(drow0 + n) * K + k0 + 8 * c) = o; }
    LDS_WAIT(); asm volatile("" ::: "memory");
}

struct Args { const float* in[N_IN]; float* out; unsigned char* ws; };

typedef const float* cfp;
#define KAS __attribute__((address_space(4)))
__device__ __forceinline__ const KAS cfp* kargs() { const KAS cfp* p = (const KAS cfp*)__builtin_amdgcn_kernarg_segment_ptr(); asm volatile("" : "+s"(p)); return p; }
#define PHASE_ENV \
    const KAS cfp* const ka = kargs(); unsigned char* const ws = (unsigned char*)ka[N_IN + 1]; float* const out = (float*)ka[N_IN]; (void)out; \
    int tid_ = tid_now(); asm volatile("" : "+v"(tid_)); const int tid = tid_, lane = tid & 63, wave = __builtin_amdgcn_readfirstlane(tid >> 6); \
    const int G = gridDim.x, bx = blockIdx.x, vcu = (G % 8 == 0) ? (bx % 8) * (G / 8) + bx / 8 : bx, gw = vcu * NWAVES + wave, NGW = G * NWAVES; \
    (void)tid; (void)lane; (void)wave; (void)gw; (void)NGW; (void)vcu; \
    float* const ropeC = (float*)(ws + WS_ROPE); float* const ropeS = ropeC + 64 * 32; float* const VEC = (float*)(ws + WS_VEC); float* const PART = (float*)(ws + WS_PART); \
    bf16* const KC = (bf16*)(ws + WS_KC); bf16* const VC = (bf16*)(ws + WS_VC); bf16* const KP = (bf16*)(ws + WS_KP); bf16* const VP = (bf16*)(ws + WS_VP); \
    bf16* const H = (bf16*)(ws + WS_H); bf16* const MF = (bf16*)(ws + WS_MF); bf16* const ACT = (bf16*)(ws + WS_ACT); \
    bf16* const RAW = (bf16*)(ws + WS_RAW); bf16* const ATT = (bf16*)(ws + WS_ATT); bf16* const ADIF = (bf16*)(ws + WS_H); bf16* const X16 = (bf16*)(ws + WS_X16); (void)X16; \
    (void)ropeC; (void)ropeS; (void)VEC; (void)PART; (void)KC; (void)VC; (void)KP; (void)VP; (void)H; (void)MF; (void)ACT; (void)RAW; (void)ATT; (void)ADIF;
#define IN(i) (ka[i])

__global__ void __launch_bounds__(NWAVES * 64, 2) trunk_fwd(Args args) {
    extern __shared__ __attribute__((aligned(16))) unsigned char lds_raw[];
    LAS unsigned char* const lds = (LAS unsigned char*)lds_raw;
    XcdBarrier bar;
    {
        volatile LAS unsigned* MISC = (volatile LAS unsigned*)(lds + MISC_OFF);
        for (int u = threadIdx.x; u < (LDS_BYTES - LDSCTL_OFF) / 4; u += NWAVES * 64) ((LAS unsigned*)(lds + LDSCTL_OFF))[u] = 0u;
        __syncthreads();
        { const unsigned slot_ = (unsigned)__builtin_amdgcn_s_getreg((5 << 11) | 4) & 63u;
          if ((threadIdx.x & 63) == 0) *(volatile LAS unsigned*)(lds + (TIDTAB_LDS_ADDR - 0) + slot_ * 4) = threadIdx.x >> 6; }
        __syncthreads();
        bar = xcd_barrier_post((unsigned*)(args.ws + WS_CTL) + CW_BAR, MISC + 8);
    }

    {
        PHASE_ENV
        LAS float* sl = (LAS float*)lds;
        for (int i = tid; i < 9 * DM; i += NWAVES * 64) { const int r = i >> 11, k = i & (DM - 1);
            const float cv = (r == 0) ? IN(I_CCTX)[k] : IN(I_C)[(r - 1) * DM + k]; sl[i] = cv / (1.0f + expf(-cv)); }
        __syncthreads();
        for (int t = gw; t < 2048; t += NGW) {
            const int l = t >> 9, cc = (t >> 3) & 63, kc = t & 7;
            if (lane < 48) {
                const float* Wp = IN(I_WADA) + ((size_t)l * DM + kc * 256) * (6 * DM) + cc * 192 + lane * 4;
                const LAS float* sp = sl + kc * 256;
                f32x4 acc[9];
#pragma unroll
                for (int r = 0; r < 9; ++r) acc[r] = (f32x4){0.f, 0.f, 0.f, 0.f};
#pragma unroll 16
                for (int k = 0; k < 256; ++k) { const f32x4 w = *(const f32x4*)(Wp + (size_t)k * (6 * DM));
#pragma unroll
                    for (int r = 0; r < 9; ++r) acc[r] += w * sp[r * DM + k]; }
#pragma unroll
                for (int r = 0; r < 9; ++r) *(f32x4*)(PART + ((size_t)((kc * 4 + l) * 9 + r)) * (6 * DM) + cc * 192 + lane * 4) = acc[r];
            }
        }
        __syncthreads();
        LAS float* scr = (LAS float*)(lds + wave * 16384);
#define CIT_QKV (32 * 96)
#define CIT_O (32 * 64)
#define CIT_G (32 * 176)
#define CIT_D (88 * 64)
#define CIT_LAYER (CIT_QKV + CIT_O + 2 * CIT_G + CIT_D)
#define CONV_ITEMS(LAYER, R0, R1, W0, NW) do { const int lc_ = (LAYER); const int kindc_ = lc_ % 3, slotc_ = lc_ / 3; unsigned char* const wlc_ = ws + WS_W + (size_t)lc_ * W_LAYER; \
        LAS float* const scr_ = (LAS float*)(lds + wave * 16384); \
        for (int it_ = (R0) + (W0); it_ < (R1); it_ += (NW)) { int r = it_; \
            if (r < CIT_QKV) { const float* W = (kindc_ == 0 ? IN(I_WQKVF) + (size_t)slotc_ * DM * NQKV : kindc_ == 1 ? IN(I_WQKVW) : IN(I_WQKVD)); \
                const int kb = r / 96, nb = r % 96; transpose_item(W, DM, NQKV, (bf16*)(wlc_ + W_QKV), 64 * kb, 32 * nb, 32 * nb, scr_, lane); continue; } r -= CIT_QKV; \
            if (r < CIT_O) { const float* W = (kindc_ == 0 ? IN(I_WOF) + (size_t)slotc_ * DM * DM : kindc_ == 1 ? IN(I_WOW) : IN(I_WOD)); \
                const int kb = r / 64, nb = r % 64; transpose_item(W, DM, DM, (bf16*)(wlc_ + W_O), 64 * kb, 32 * nb, 32 * nb, scr_, lane); continue; } r -= CIT_O; \
            if (r < 2 * CIT_G) { const int up = r >= CIT_G; if (up) r -= CIT_G; const float* W = IN(up ? I_WU : I_WG) + (size_t)lc_ * DM * FF; \
                const int kb = r / 176, nb = r % 176, n0 = 32 * nb; transpose_item(W, DM, FF, (bf16*)(wlc_ + W_GU), 64 * kb, n0, (n0 >> 5) * 64 + up * 32, scr_, lane); continue; } r -= 2 * CIT_G; \
            { const float* W = IN(I_WD) + (size_t)lc_ * FF * DM; const int kb = r / 64, nb = r % 64; transpose_item(W, FF, DM, (bf16*)(wlc_ + W_D), 64 * kb, 32 * nb, 32 * nb, scr_, lane); } \
        } } while (0)
        CONV_ITEMS(0, 0, CIT_LAYER, gw, NGW);
        { const int gt = bx * (NWAVES * 64) + tid;
          if (gt < 64 * 32) { const int p = gt >> 5, i = gt & 31; double inv = 1.0; for (int q = 0; q < i; ++q) inv *= 0.7498942093324559;
            const float ang = (float)p * (float)inv; const double a = (double)ang; const double n = __builtin_rint(a * 0.6366197723675814);
            double rr = __builtin_fma(-n, 1.5707963267948966, a); rr = __builtin_fma(-n, 6.123233995736766e-17, rr);
            const double r2 = rr * rr;
            const double sn = rr * (1.0 + r2 * (-1.0 / 6 + r2 * (1.0 / 120 + r2 * (-1.0 / 5040 + r2 * (1.0 / 362880 + r2 * (-1.0 / 39916800 + r2 * (1.0 / 6227020800.0)))))));
            const double cs = 1.0 + r2 * (-0.5 + r2 * (1.0 / 24 + r2 * (-1.0 / 720 + r2 * (1.0 / 40320 + r2 * (-1.0 / 3628800 + r2 * (1.0 / 479001600.0))))));
            const int q4 = ((int)n) & 3; const double s_ = (q4 == 0) ? sn : (q4 == 1) ? cs : (q4 == 2) ? -sn : -cs, c_ = (q4 == 0) ? cs : (q4 == 1) ? -sn : (q4 == 2) ? -cs : sn;
            ropeC[gt] = (float)c_; ropeS[gt] = (float)s_; } }
    }
    xcd_barrier(bar);
    {
    PHASE_ENV
    for (int e = bx * (NWAVES * 64) + tid; e < 4 * 9 * DM; e += G * NWAVES * 64) {
        const int l = e / (9 * DM), r = (e / DM) % 9, c = e & (DM - 1);
        float mod[6];
#pragma unroll
        for (int j = 0; j < 6; ++j) { float s = IN(I_BADA)[(size_t)l * 6 * DM + j * DM + c];
#pragma unroll
            for (int kc = 0; kc < 8; ++kc) s += PART[((size_t)((kc * 4 + l) * 9 + r)) * (6 * DM) + j * DM + c];
            mod[j] = s; }
        const float* gn = IN(I_GNORM) + (size_t)l * 4 * DM;
        float* vb = VEC + (size_t)l * 6 * 9 * DM + (size_t)r * DM + c;
        vb[0 * 9 * DM] = gn[0 * DM + c] * (1.0f + mod[1]); vb[1 * 9 * DM] = mod[0]; vb[2 * 9 * DM] = mod[2] * gn[1 * DM + c];
        vb[3 * 9 * DM] = gn[2 * DM + c] * (1.0f + mod[4]); vb[4 * 9 * DM] = mod[3]; vb[5 * 9 * DM] = mod[5] * gn[3 * DM + c];
    }
    }
    xcd_barrier(bar);

#define BF8_TO_F(W, LO, HI) do { LO = (f32x4){bf2f(W.x & 0xffffu), bf2f(W.x >> 16), bf2f(W.y & 0xffffu), bf2f(W.y >> 16)}; HI = (f32x4){bf2f(W.z & 0xffffu), bf2f(W.z >> 16), bf2f(W.w & 0xffffu), bf2f(W.w >> 16)}; } while (0)
#define THIN_LOADX(ROW, XV, XW, MW, XP, XS, XIN16, RES) do { const int r_ = (ROW); \
        if (XIN16) { _Pragma("unroll") for (int c = 0; c < 4; ++c) XW[c] = __builtin_nontemporal_load(&((const v4u*)(X16 + (size_t)r_ * DM))[64 * c + lane]); } \
        else { const float* xb_ = (XP), * xs_m = (XS) - (size_t)TP * DM; const float* xr_ = (r_ < TP ? xb_ : xs_m) + (size_t)r_ * DM; \
            _Pragma("unroll") for (int c = 0; c < 4; ++c) { XV[2 * c] = __builtin_nontemporal_load(&((const f32x4*)xr_)[128 * c + 2 * lane]); XV[2 * c + 1] = __builtin_nontemporal_load(&((const f32x4*)xr_)[128 * c + 2 * lane + 1]); } } \
        if (RES) { _Pragma("unroll") for (int c = 0; c < 4; ++c) MW[c] = __builtin_nontemporal_load(&((const v4u*)(MF + (size_t)r_ * DM))[64 * c + lane]); } } while (0)
#define THIN_ROW(ROW, XV, XW, MW, XIN16, XOUT16, RES, HOUT) do { const int r_ = (ROW); \
        if (XIN16) { _Pragma("unroll") for (int c = 0; c < 4; ++c) BF8_TO_F(XW[c], XV[2 * c], XV[2 * c + 1]); } \
        if (RES) { \
            f32x4 mv[8]; float ss = 0.f; \
            _Pragma("unroll") for (int c = 0; c < 4; ++c) BF8_TO_F(MW[c], mv[2 * c], mv[2 * c + 1]); \
            _Pragma("unroll") for (int j = 0; j < 8; ++j) ss += (mv[j].x * mv[j].x + mv[j].y * mv[j].y) + (mv[j].z * mv[j].z + mv[j].w * mv[j].w); \
            const float rstd = 1.0f / sqrtf(wave_sum(ss) * (1.0f / DM) + EPS); \
            _Pragma("unroll") for (int j = 0; j < 8; ++j) XV[j] += gv[j] * (mv[j] * rstd); \
            if (XOUT16) { _Pragma("unroll") for (int c = 0; c < 4; ++c) { v4u w; w.x = pkbf(XV[2 * c].x, XV[2 * c].y); w.y = pkbf(XV[2 * c].z, XV[2 * c].w); w.z = pkbf(XV[2 * c + 1].x, XV[2 * c + 1].y); w.w = pkbf(XV[2 * c + 1].z, XV[2 * c + 1].w); \
                    __builtin_nontemporal_store(w, &((v4u*)(X16 + (size_t)r_ * DM))[64 * c + lane]); } } \
            else { _Pragma("unroll") for (int c = 0; c < 4; ++c) { __builtin_nontemporal_store(XV[2 * c], &((f32x4*)(out + (size_t)r_ * DM))[128 * c + 2 * lane]); __builtin_nontemporal_store(XV[2 * c + 1], &((f32x4*)(out + (size_t)r_ * DM))[128 * c + 2 * lane + 1]); } } \
        } \
        if (HOUT) { \
            float s2 = 0.f; \
            _Pragma("unroll") for (int j = 0; j < 8; ++j) s2 += (XV[j].x * XV[j].x + XV[j].y * XV[j].y) + (XV[j].z * XV[j].z + XV[j].w * XV[j].w); \
            const float r2 = 1.0f / sqrtf(wave_sum(s2) * (1.0f / DM) + EPS); \
            _Pragma("unroll") for (int c = 0; c < 4; ++c) { const f32x4 h0 = XV[2 * c] * r2 * av[2 * c] + bv[2 * c], h1 = XV[2 * c + 1] * r2 * av[2 * c + 1] + bv[2 * c + 1]; \
                v4u w; w.x = pkbf(h0.x, h0.y); w.y = pkbf(h0.z, h0.w); w.z = pkbf(h1.x, h1.y); w.w = pkbf(h1.z, h1.w); ((v4u*)(H + (size_t)r_ * DM))[64 * c + lane] = w; } \
        } } while (0)
#define THIN_PHASE(XP, XS, XIN16, XOUT16, RES, GV, HOUT, AV, BV) do { \
    for (int row = 2 * gw; row < TT; row += 2 * NGW) { \
        const int cls = row < TP ? 0 : 1 + ((row - TP) >> 11); \
        f32x4 xa[8], xb[8], gv[8], av[8], bv[8]; v4u xwa[4], xwb[4], mwa[4], mwb[4]; \
        THIN_LOADX(row, xa, xwa, mwa, XP, XS, XIN16, RES); THIN_LOADX(row + 1, xb, xwb, mwb, XP, XS, XIN16, RES); \
        if (RES) { _Pragma("unroll") for (int c = 0; c < 4; ++c) { gv[2 * c] = ((const f32x4*)((GV) + (size_t)cls * DM))[128 * c + 2 * lane]; gv[2 * c + 1] = ((const f32x4*)((GV) + (size_t)cls * DM))[128 * c + 2 * lane + 1]; } } \
        { _Pragma("unroll") for (int c = 0; c < 4; ++c) { av[2 * c] = ((const f32x4*)((AV) + (size_t)cls * DM))[128 * c + 2 * lane]; av[2 * c + 1] = ((const f32x4*)((AV) + (size_t)cls * DM))[128 * c + 2 * lane + 1]; \
                bv[2 * c] = ((const f32x4*)((BV) + (size_t)cls * DM))[128 * c + 2 * lane]; bv[2 * c + 1] = ((const f32x4*)((BV) + (size_t)cls * DM))[128 * c + 2 * lane + 1]; } } \
        THIN_ROW(row, xa, xwa, mwa, XIN16, XOUT16, RES, HOUT); \
        THIN_ROW(row + 1, xb, xwb, mwb, XIN16, XOUT16, RES, HOUT); \
    } } while (0)
#define THIN_DMA_ISSUE(PAIR) do { const size_t r0_ = (size_t)(PAIR) * 2; \
        _Pragma("unroll") for (int q = 0; q < 2; ++q) _Pragma("unroll") for (int c = 0; c < 4; ++c) { \
            __builtin_amdgcn_global_load_lds((const unsigned*)(X16 + (r0_ + q) * DM + c * 512 + lane * 8), (LAS unsigned*)(wl_ + q * 4096 + c * 1024), 16, 0, 2); \
            __builtin_amdgcn_global_load_lds((const unsigned*)(MF + (r0_ + q) * DM + c * 512 + lane * 8), (LAS unsigned*)(wl_ + 8192 + q * 4096 + c * 1024), 16, 0, 2); } } while (0)
#define THIN_PHASE_DMA(XOUT16, GV, HOUT, AV, BV) do { \
    LAS unsigned char* const wl_ = lds + wave * 16384; \
    const int npair_ = TT / 2; \
    if (gw < npair_) THIN_DMA_ISSUE(gw); \
    for (int pr = gw; pr < npair_; pr += NGW) { \
        const int row = 2 * pr; const int cls = row < TP ? 0 : 1 + ((row - TP) >> 11); \
        f32x4 xa[8], xb[8], gv[8], av[8], bv[8]; v4u xwa[4], xwb[4], mwa[4], mwb[4]; \
        { _Pragma("unroll") for (int c = 0; c < 4; ++c) { gv[2 * c] = ((const f32x4*)((GV) + (size_t)cls * DM))[128 * c + 2 * lane]; gv[2 * c + 1] = ((const f32x4*)((GV) + (size_t)cls * DM))[128 * c + 2 * lane + 1]; } } \
        { _Pragma("unroll") for (int c = 0; c < 4; ++c) { av[2 * c] = ((const f32x4*)((AV) + (size_t)cls * DM))[128 * c + 2 * lane]; av[2 * c + 1] = ((const f32x4*)((AV) + (size_t)cls * DM))[128 * c + 2 * lane + 1]; \
                bv[2 * c] = ((const f32x4*)((BV) + (size_t)cls * DM))[128 * c + 2 * lane]; bv[2 * c + 1] = ((const f32x4*)((BV) + (size_t)cls * DM))[128 * c + 2 * lane + 1]; } } \
        asm volatile("" ::: "memory"); __builtin_amdgcn_s_waitcnt(0x0F70); asm volatile("" ::: "memory");     \
        _Pragma("unroll") for (int c = 0; c < 4; ++c) { xwa[c] = *(const LAS v4u*)(wl_ + c * 1024 + lane * 16); xwb[c] = *(const LAS v4u*)(wl_ + 4096 + c * 1024 + lane * 16); \
            mwa[c] = *(const LAS v4u*)(wl_ + 8192 + c * 1024 + lane * 16); mwb[c] = *(const LAS v4u*)(wl_ + 12288 + c * 1024 + lane * 16); } \
        asm volatile("s_waitcnt lgkmcnt(0)" ::: "memory");     \
        if (pr + NGW < npair_) THIN_DMA_ISSUE(pr + NGW); \
        THIN_ROW(row, xa, xwa, mwa, true, XOUT16, true, HOUT); \
        THIN_ROW(row + 1, xb, xwb, mwb, true, XOUT16, true, HOUT); \
    } } while (0)
#define X_IS_BF16 1

    { PHASE_ENV
      THIN_PHASE(IN(I_XP), IN(I_XS), false, false, false, VEC, true, VEC + 0 * 9 * DM, VEC + 1 * 9 * DM); }
    xcd_barrier(bar);

    for (int L = 0; L < 4; ++L) {
        const int kind = L % 3, slot = L / 3, nslot = (kind == 0) ? 2 : 1;
#define LAYER_ENV PHASE_ENV unsigned char* const wl = ws + WS_W + (size_t)L * W_LAYER; const float* const vecL = VEC + (size_t)L * 6 * 9 * DM; (void)wl; (void)vecL;
        { LAYER_ENV pg8::Gemm g{H, (const bf16*)(wl + W_QKV), TT, NQKV, DM}; pg8::StaticOrder S; S.init(TT, NQKV, G, bx);
          pg8::EpiStore E{RAW, NQKV};
          pg8::gemm_phase<pg8::EpiStore, pg8::StaticOrder, true, true>(lds, g, S, E); }
        { LAYER_ENV
          { const int first = ((TT / 256) * (NQKV / 256)) % (int)gridDim.x, bxc = blockIdx.x;
            if (bxc >= first) {
                const float* ck = (kind == 0) ? IN(I_CKF) : (kind == 1) ? IN(I_CKW) : IN(I_CKD);
                const float* cv = (kind == 0) ? IN(I_CVF) : (kind == 1) ? IN(I_CVW) : IN(I_CVD);
                for (int it = (bxc - first) * NWAVES + wave; it < 2 * 8 * 128; it += ((int)gridDim.x - first) * NWAVES) {
                    const int p0 = (it & 127) * 4, b = (it >> 7) & 7, isv = it >> 10;
                    const float* src = (isv ? cv : ck) + ((size_t)(b * nslot + slot) * PAST + p0) * KVW + lane * 8;
                    bf16* dst = (isv ? VC : KC) + ((size_t)b * SKV + p0) * KVW + lane * 8;
                    f32x4 a[8];
#pragma unroll
                    for (int q = 0; q < 4; ++q) { a[2 * q] = *(const f32x4*)(src + q * KVW); a[2 * q + 1] = *(const f32x4*)(src + q * KVW + 4); }
#pragma unroll
                    for (int q = 0; q < 4; ++q) { v4u o; o.x = pkbf(a[2 * q].x, a[2 * q].y); o.y = pkbf(a[2 * q].z, a[2 * q].w); o.z = pkbf(a[2 * q + 1].x, a[2 * q + 1].y); o.w = pkbf(a[2 * q + 1].z, a[2 * q + 1].w); *(v4u*)(dst + q * KVW) = o; }
                }
                if (L < 3) { __syncthreads();
                    CONV_ITEMS(L + 1, 0, CIT_LAYER / 2, (bxc - first) * NWAVES + wave, ((int)gridDim.x - first) * NWAVES); }
            } } }
        xcd_barrier(bar);
        {
            LAYER_ENV
            const float* ck = (kind == 0) ? IN(I_CKF) : (kind == 1) ? IN(I_CKW) : IN(I_CKD);
            const float* cv = (kind == 0) ? IN(I_CVF) : (kind == 1) ? IN(I_CVW) : IN(I_CVD);
            float* const ok = out + ((kind == 0) ? O_KF : (kind == 1) ? O_KW : O_KD);
            float* const ov = out + ((kind == 0) ? O_VF : (kind == 1) ? O_VW : O_VD);
            const int l16 = lane & 15;
            f32x4 gq0, gq1, gk0, gk1;
            { const float* gqp = IN(I_GQF) + slot * 128 + l16 * 8; const float* gkp = IN(I_GKF) + slot * 128 + l16 * 8;
              gq0 = *(const f32x4*)gqp; gq1 = *(const f32x4*)(gqp + 4); gk0 = *(const f32x4*)gkp; gk1 = *(const f32x4*)(gkp + 4); }
            constexpr int LIM = TT;
#define POST_LOAD(ROW, W, CS) do { const int r_ = (ROW); \
        if (r_ < TT) { const bf16* rp_ = RAW + (size_t)r_ * NQKV + lane * 8; _Pragma("unroll") for (int q_ = 0; q_ < 2; ++q_) W[q_] = *(const v4u*)(rp_ + 2048 + q_ * 512); \
            if (r_ >= TP) { const int s_ = (r_ - TP) & (SS - 1); const int p_ = (lane & 8) ? (s_ & 63) : (s_ >> 6); const int i0_ = (lane & 3) * 8; \
                CS[0] = *(const f32x4*)(ropeC + p_ * 32 + i0_); CS[1] = *(const f32x4*)(ropeC + p_ * 32 + i0_ + 4); CS[2] = *(const f32x4*)(ropeS + p_ * 32 + i0_); CS[3] = *(const f32x4*)(ropeS + p_ * 32 + i0_ + 4); } } \
        else { const int ct_ = r_ - TT, isv_ = ct_ >> 12, rr_ = ct_ & 4095, b_ = rr_ >> 9, p_ = rr_ & 511; \
            const float* src_ = (isv_ ? cv : ck) + ((size_t)(b_ * nslot + slot) * PAST + p_) * KVW + lane * 8; W[0] = *(const v4u*)src_; W[1] = *(const v4u*)(src_ + 4); } } while (0)
#define POST_ROW(ROW, W, CS) do { const int row = (ROW); \
                if (row < TT) { \
                    const bool is_s = row >= TP; const int b = is_s ? (row - TP) >> 11 : row >> 8, s = is_s ? (row - TP) & (SS - 1) : row & (SP - 1); \
                    const float cs[8] = {CS[0].x, CS[0].y, CS[0].z, CS[0].w, CS[1].x, CS[1].y, CS[1].z, CS[1].w}; \
                    const float sn[8] = {CS[2].x, CS[2].y, CS[2].z, CS[2].w, CS[3].x, CS[3].y, CS[3].z, CS[3].w}; \
                    const size_t kvrow = is_s ? ((size_t)b * SKV + PAST + s) : (size_t)row; \
                    bf16* const kdst = (is_s ? KC : KP) + kvrow * KVW + lane * 8; \
                    bf16* const vdst = (is_s ? VC : VP) + kvrow * KVW + lane * 8; \
                    const size_t orow = ((size_t)(b * nslot + slot) * SP + s) * KVW + lane * 8; \
                    _Pragma("unroll") for (int step = 4; step < 6; ++step) {     \
                        const v4u w = W[step - 4]; \
                        float f[8] = {bf2f(w.x & 0xffffu), bf2f(w.x >> 16), bf2f(w.y & 0xffffu), bf2f(w.y >> 16), bf2f(w.z & 0xffffu), bf2f(w.z >> 16), bf2f(w.w & 0xffffu), bf2f(w.w >> 16)}; \
                        if (step < 5) { \
                            if (kind == 0) { float ss = 0.f; \
                                _Pragma("unroll") for (int j = 0; j < 8; ++j) ss += f[j] * f[j]; \
                                ss += __shfl_xor(ss, 1); ss += __shfl_xor(ss, 2); ss += __shfl_xor(ss, 4); ss += __shfl_xor(ss, 8); \
                                const float rstd = 1.0f / sqrtf(ss * (1.0f / 128.0f) + EPS); \
                                f[0] *= rstd * gk0.x; f[1] *= rstd * gk0.y; f[2] *= rstd * gk0.z; f[3] *= rstd * gk0.w; f[4] *= rstd * gk1.x; f[5] *= rstd * gk1.y; f[6] *= rstd * gk1.z; f[7] *= rstd * gk1.w; } \
                            if (is_s) { \
                                _Pragma("unroll") for (int j = 0; j < 8; ++j) { const float pf = __shfl_xor(f[j], 4); f[j] = (lane & 4) ? (pf * sn[j] + f[j] * cs[j]) : (f[j] * cs[j] - pf * sn[j]); } } \
                        } \
                        v4u o; o.x = pkbf(f[0], f[1]); o.y = pkbf(f[2], f[3]); o.z = pkbf(f[4], f[5]); o.w = pkbf(f[6], f[7]); \
                        *(v4u*)(step == 4 ? kdst : vdst) = o; \
                        if (!is_s) { float* op = (step == 4 ? ok : ov) + orow; *(f32x4*)op = (f32x4){f[0], f[1], f[2], f[3]}; *(f32x4*)(op + 4) = (f32x4){f[4], f[5], f[6], f[7]}; } \
                    } \
                } else { \
                    const int ct = row - TT, isv = ct >> 12, rr = ct & 4095, b = rr >> 9, p = rr & 511; \
                    const f32x4 a0 = __builtin_bit_cast(f32x4, W[0]), a1 = __builtin_bit_cast(f32x4, W[1]); \
                    v4u o; o.x = pkbf(a0.x, a0.y); o.y = pkbf(a0.z, a0.w); o.z = pkbf(a1.x, a1.y); o.w = pkbf(a1.z, a1.w); \
                    *(v4u*)((isv ? VC : KC) + ((size_t)b * SKV + p) * KVW + lane * 8) = o; \
                } } while (0)
            for (int q4 = gw; q4 < LIM / 4; q4 += NGW) {
                const int row0 = 4 * q4;
                v4u w0[2], w1[2], w2[2], w3[2]; f32x4 c0[4], c1[4], c2[4], c3[4];
#pragma unroll
                for (int q = 0; q < 4; ++q) { c0[q] = (f32x4){0.f, 0.f, 0.f, 0.f}; c1[q] = c0[q]; c2[q] = c0[q]; c3[q] = c0[q]; }
                POST_LOAD(row0, w0, c0); POST_LOAD(row0 + 1, w1, c1); POST_LOAD(row0 + 2, w2, c2); POST_LOAD(row0 + 3, w3, c3);
                POST_ROW(row0, w0, c0); POST_ROW(row0 + 1, w1, c1); POST_ROW(row0 + 2, w2, c2); POST_ROW(row0 + 3, w3, c3);
            }
#undef POST_ROW
#undef POST_LOAD
        }
        xcd_barrier(bar);
        {
            LAYER_ENV
            if (kind != 2) {
                const int nsamp = 1024, nprm = 512;
                for (int u = vcu; u < nsamp + nprm; u += G) {
                    const bf16 *Qp, *Kp_, *Vp_; bf16* Op; int nt, nfirst, skip = 0, qpos0 = 0; float sinkl2 = -1e30f; int b, h, qb;
                    bool hpair = false; float sinkB = -1e30f;
                    if (u < nsamp && kind == 1) {
                        hpair = true; qb = u & 15; const int hp = (u >> 4) & 7; h = 2 * hp; b = u >> 7; const size_t r0 = (size_t)TP + (size_t)b * SS + qb * 128;
                        Qp = RAW + r0 * NQKV + h * 128; Kp_ = KC + (size_t)b * SKV * KVW + (h >> 2) * 128; Vp_ = VC + (size_t)b * SKV * KVW + (h >> 2) * 128; Op = ATT + r0 * DM + h * 128;
                        qpos0 = qb * 128; const int bs = (qpos0 - 128) < 0 ? 0 : qpos0 - 128, be = (qpos0 + 256) > SS ? SS : qpos0 + 256; nfirst = PAST / 64; nt = nfirst + (be - bs) / 64; skip = bs;
                        sinkB = IN(I_SINKW)[h + 1] * 1.4426950408889634f; }
                    else
                    if (u < nsamp) { qb = u & 7; h = (u >> 3) & 15; b = u >> 7; const size_t r0 = (size_t)TP + (size_t)b * SS + qb * 256;
                        Qp = RAW + r0 * NQKV + h * 128; Kp_ = KC + (size_t)b * SKV * KVW + (h >> 2) * 128; Vp_ = VC + (size_t)b * SKV * KVW + (h >> 2) * 128; Op = ATT + r0 * DM + h * 128;
                        nt = SKV / 64; nfirst = nt; qpos0 = qb * 256; }
                    else { const int v = u - nsamp; h = v & 15; b = v >> 4; const size_t r0 = (size_t)b * SP;
                        Qp = RAW + r0 * NQKV + h * 128; Kp_ = KP + r0 * KVW + (h >> 2) * 128; Vp_ = VP + r0 * KVW + (h >> 2) * 128; Op = ATT + r0 * DM + h * 128; nt = SP / 64; nfirst = nt; }
                    if (kind == 1) sinkl2 = IN(I_SINKW)[h] * 1.4426950408889634f;
                    __syncthreads();
#if ATT_DMA_ALL == 6
                    att::attn_unit_g(Qp, Kp_, Vp_, Op, NQKV, KVW, DM, nt, nfirst, skip, qpos0, sinkl2, (LAS char*)lds, (LAS float*)(lds + LDSCTL_OFF + 1024) + wave * 64,
                                        (kind == 0 ? 1 : 0) | (u < nsamp ? 2 : 0) | (hpair ? 4 : 0), sinkB, IN(I_GQF) + slot * 128, ropeC, ropeS);
#elif ATT_DMA_ALL == 5
                    att::attn_unit_pp(Qp, Kp_, Vp_, Op, NQKV, KVW, DM, nt, nfirst, skip, qpos0, sinkl2, (LAS char*)lds, (LAS float*)(lds + LDSCTL_OFF + 1024) + wave * 64,
                                        (kind == 0 ? 1 : 0) | (u < nsamp ? 2 : 0), IN(I_GQF) + slot * 128, ropeC, ropeS);
#elif ATT_DMA_ALL == 2
                    att::attn_unit_dma2(Qp, Kp_, Vp_, Op, NQKV, KVW, DM, nt, nfirst, skip, qpos0, sinkl2, (LAS char*)lds, (LAS float*)(lds + LDSCTL_OFF + 1024) + wave * 64,
                                        (kind == 0 ? 1 : 0) | (u < nsamp ? 2 : 0), IN(I_GQF) + slot * 128, ropeC, ropeS);
#elif ATT_DMA_ALL
                    att::attn_unit_dma<4>(Qp, Kp_, Vp_, Op, NQKV, KVW, DM, nt, nfirst, skip, qpos0, sinkl2, (LAS char*)lds, (LAS float*)(lds + LDSCTL_OFF + 1024) + wave * 64,
                                          (kind == 0 ? 1 : 0) | (u < nsamp ? 2 : 0), IN(I_GQF) + slot * 128, ropeC, ropeS);
#else
                    att::attn_unit(Qp, Kp_, Vp_, Op, NQKV, KVW, DM, nt, nfirst, skip, qpos0, sinkl2, (LAS char*)lds, (kind == 0 ? 1 : 0) | (u < nsamp ? 2 : 0), IN(I_GQF) + slot * 128, ropeC, ropeS);
#endif
                }
            } else {
                const int nsamp = 1024, nprm = 512;
                for (int u = vcu; u < nsamp + nprm; u += G) {
                    int b, g, kvv, nt, qpos0 = 0; size_t r0; const bf16 *kbase, *vbase;
                    if (u < nsamp) { const int qb = u & 7; g = (u >> 3) & 3; kvv = (u >> 5) & 3; b = u >> 7; r0 = (size_t)TP + (size_t)b * SS + qb * 256; kbase = KC + (size_t)b * SKV * KVW; vbase = VC + (size_t)b * SKV * KVW; nt = SKV / 64; qpos0 = qb * 256; }
                    else { const int v = u - nsamp; g = v & 3; kvv = (v >> 2) & 3; b = v >> 4; r0 = (size_t)b * SP; kbase = KP + r0 * KVW; vbase = VP + r0 * KVW; nt = SP / 64; }
                    const int kv = kvv >> 1, m = kvv & 1, hv = ((kv * 4 + g) << 1) | m;
                    __syncthreads();
#if ATT_DIFF_PIPE
                    att::attn_unit_diff2(RAW + r0 * NQKV + hv * 128, kbase + kvv * 128, vbase + kv * 256, ADIF + r0 * 4096 + hv * 256, NQKV, KVW, 4096, nt, qpos0,
                                         (LAS char*)lds, (LAS float*)(lds + LDSCTL_OFF + 1024) + wave * 64, (u < nsamp ? 2 : 0), ropeC, ropeS);
#else
                    att::attn_unit_dma<8>(RAW + r0 * NQKV + hv * 128, kbase + kvv * 128, vbase + kv * 256, ADIF + r0 * 4096 + hv * 256, NQKV, KVW, 4096, nt, nt, 0, qpos0, -1e30f,
                                          (LAS char*)lds, (LAS float*)(lds + LDSCTL_OFF + 1024) + wave * 64, (u < nsamp ? 2 : 0), IN(I_GQF), ropeC, ropeS);
#endif
                }
            }
        }
        xcd_barrier(bar);
        if (kind == 2) { LAYER_ENV
            float d1 = IN(I_LQ1)[lane] * IN(I_LK1)[lane] + IN(I_LQ1)[lane + 64] * IN(I_LK1)[lane + 64];
            float d2 = IN(I_LQ2)[lane] * IN(I_LK2)[lane] + IN(I_LQ2)[lane + 64] * IN(I_LK2)[lane + 64];
            const float lam = expf(wave_sum(d1)) - expf(wave_sum(d2)) + LAM_INIT2;
            const f32x4 gs = *(const f32x4*)(IN(I_GSUB) + lane * 4) * (1.0f - LAM_INIT2);
            for (int row0 = 2 * gw; row0 < TT; row0 += 2 * NGW) {
                v2u la0[8], lc0[8], la1[8], lc1[8];
#pragma unroll
                for (int h = 0; h < 8; ++h) {
                    la0[h] = __builtin_nontemporal_load((const v2u*)(ADIF + (size_t)row0 * 4096 + (2 * h) * 256 + lane * 4)); lc0[h] = __builtin_nontemporal_load((const v2u*)(ADIF + (size_t)row0 * 4096 + (2 * h + 1) * 256 + lane * 4));
                    la1[h] = __builtin_nontemporal_load((const v2u*)(ADIF + (size_t)(row0 + 1) * 4096 + (2 * h) * 256 + lane * 4)); lc1[h] = __builtin_nontemporal_load((const v2u*)(ADIF + (size_t)(row0 + 1) * 4096 + (2 * h + 1) * 256 + lane * 4));
                }
#pragma unroll
                for (int rr = 0; rr < 2; ++rr)
#pragma unroll
                for (int h = 0; h < 8; ++h) {
                    const int row = row0 + rr;
                    const v2u a = rr ? la1[h] : la0[h], c = rr ? lc1[h] : lc0[h];
                    f32x4 o = (f32x4){bf2f(a.x & 0xffffu), bf2f(a.x >> 16), bf2f(a.y & 0xffffu), bf2f(a.y >> 16)} - lam * (f32x4){bf2f(c.x & 0xffffu), bf2f(c.x >> 16), bf2f(c.y & 0xffffu), bf2f(c.y >> 16)};
                    const float ss = wave_sum((o.x * o.x + o.y * o.y) + (o.z * o.z + o.w * o.w));
                    o = o * (1.0f / sqrtf(ss * (1.0f / 256.0f) + EPS)) * gs;
                    v2u w; w.x = pkbf(o.x, o.y); w.y = pkbf(o.z, o.w); *(v2u*)(ATT + (size_t)row * DM + h * 256 + lane * 4) = w;
                }
            }
            xcd_barrier(bar);
        }
        { LAYER_ENV pg8::Gemm g{ATT, (const bf16*)(wl + W_O), TT, DM, DM}; pg8::StaticOrder S; S.init(TT, DM, G, bx);
          pg8::EpiStore E{MF, DM};
          pg8::gemm_phase<pg8::EpiStore, pg8::StaticOrder, true, true>(lds, g, S, E); }
        xcd_barrier(bar);
        { LAYER_ENV const float* const xp_ = (L == 0) ? IN(I_XP) : (const float*)out; const float* const xs_ = (L == 0) ? IN(I_XS) : (const float*)(out + O_YS);
          if (X_IS_BF16 && L != 0) THIN_PHASE_DMA(true, vecL + 2 * 9 * DM, true, vecL + 3 * 9 * DM, vecL + 4 * 9 * DM);
          else THIN_PHASE(xp_, xs_, false, (X_IS_BF16 != 0), true, vecL + 2 * 9 * DM, true, vecL + 3 * 9 * DM, vecL + 4 * 9 * DM); }
        xcd_barrier(bar);
        { LAYER_ENV pg8::Gemm g{H, (const bf16*)(wl + W_GU), TT, NGU, DM}; pg8::StaticOrder S; S.init(TT, NGU, G, bx);
          pg8::EpiSwiglu E{ACT, FF};
          pg8::gemm_phase<pg8::EpiSwiglu, pg8::StaticOrder, true, true>(lds, g, S, E); }
        if (L < 3) { LAYER_ENV
          const int first = ((TT / 256) * (NGU / 256)) % (int)gridDim.x, bxc = blockIdx.x;
          if (bxc >= first) { __syncthreads();
              CONV_ITEMS(L + 1, CIT_LAYER / 2, CIT_LAYER, (bxc - first) * NWAVES + wave, ((int)gridDim.x - first) * NWAVES); } }
        xcd_barrier(bar);
        { LAYER_ENV pg8::Gemm g{ACT, (const bf16*)(wl + W_D), TT, DM, FF}; pg8::StaticOrder S; S.init(TT, DM, G, bx); S.rev = 1;
          pg8::EpiStore E{MF, DM};
          pg8::gemm_phase<pg8::EpiStore, pg8::StaticOrder, true, true>(lds, g, S, E); }
        xcd_barrier(bar);
        { LAYER_ENV const float* vecN = VEC + (size_t)(L < 3 ? L + 1 : L) * 6 * 9 * DM; const bool hout = L < 3;
          if (X_IS_BF16 && hout) THIN_PHASE_DMA(true, vecL + 5 * 9 * DM, true, vecN + 0 * 9 * DM, vecN + 1 * 9 * DM);
          else THIN_PHASE(out, out + O_YS, (X_IS_BF16 != 0), false, true, vecL + 5 * 9 * DM, hout, vecN + 0 * 9 * DM, vecN + 1 * 9 * DM); }
        if (L < 3) xcd_barrier(bar);
    }
#undef THIN_PHASE
#undef THIN_LOADX
#undef THIN_ROW
#undef THIN_PHASE_DMA
#undef THIN_DMA_ISSUE
#undef BF8_TO_F
#undef LAYER_ENV
}

extern "C" void kernel_launch(void* const* d_in, const int* in_sizes, int n_in, void* d_out, int out_size, void* d_ws, size_t ws_size, hipStream_t stream) {
    static int grid = 0;
    if (grid == 0) {
        if (n_in != N_IN || (size_t)out_size != O_END || ws_size < WS_END) { fprintf(stderr, "kernel_launch: shape mismatch: n_in %d out %d ws %zu\n", n_in, out_size, ws_size); grid = -1; return; }
        int dev = 0, cus = 0, per_cu = 0;
        if (hipGetDevice(&dev) != hipSuccess || hipDeviceGetAttribute(&cus, hipDeviceAttributeMultiprocessorCount, dev) != hipSuccess) { grid = -1; return; }
        if (hipFuncSetAttribute((const void*)trunk_fwd, hipFuncAttributeMaxDynamicSharedMemorySize, LDS_BYTES) != hipSuccess) { fprintf(stderr, "kernel_launch: hipFuncSetAttribute failed\n"); grid = -1; return; }
        if (hipOccupancyMaxActiveBlocksPerMultiprocessor(&per_cu, (const void*)trunk_fwd, NWAVES * 64, LDS_BYTES) != hipSuccess || per_cu < 1)
            fprintf(stderr, "kernel_launch: note: occupancy query reports %d workgroups per CU\n", per_cu);
        (void)hipGetLastError();
        grid = cus;
    }
    if (grid < 0) return;
    if (hipMemsetAsync((char*)d_ws + WS_CTL, 0, CTL_ZERO_BYTES, stream) != hipSuccess) { fprintf(stderr, "kernel_launch: memset failed\n"); return; }
    Args a{};
    for (int i = 0; i < N_IN; ++i) a.in[i] = (const float*)d_in[i];
    a.out = (float*)d_out; a.ws = (unsigned char*)d_ws;
    hipLaunchKernelGGL(trunk_fwd, dim3(grid), dim3(NWAVES * 64), LDS_BYTES, stream, a);
    const hipError_t le = hipPeekAtLastError();
    if (le != hipSuccess) fprintf(stderr, "kernel_launch: launch failed: %s\n", hipGetErrorName(le));
}
```
